# Optimizing an MI355X kernel written in HIP

```python
import math
import jax
import jax.numpy as jnp
from jax import lax
import numpy as np

D_MODEL = 1024
BATCH = 32
SEQ = 2048
DEPTH = 4

D_MIX = D_MODEL
GROUP_WIDTH = D_MIX // 4
BLOCK_Q = 128

SB_HEADS = 4
SB_HEAD_DIM = GROUP_WIDTH // SB_HEADS

DA_HEADS = 4
DA_V_DIM = GROUP_WIDTH // DA_HEADS
DA_QK_DIM = DA_V_DIM // 2
DA_SUBLN_EPS = 1e-5

CONV_WIDTH = 3

RW_HEADS = 4
RW_HEAD_DIM = GROUP_WIDTH // RW_HEADS
RW_DECAY_RANK = 32
RW_A_RANK = 32
RW_GATE_RANK = 64
RW_LN_EPS = 64e-5

REL_BUCKETS = 32
REL_MAX_DIST = 128

N_EXPERTS = 16
N_EXPERT_GROUPS = 4
EXPERTS_PER_GROUP = N_EXPERTS // N_EXPERT_GROUPS
TOP_K = 2
D_EXPERT = 256

LN_EPS = 1e-5
DEEPNORM_ALPHA = (2 * DEPTH) ** 0.25
DEEPNORM_BETA = (8 * DEPTH) ** -0.25

SB_COLS = 3 * GROUP_WIDTH
DA_COLS = 3 * GROUP_WIDTH
SC_COLS = 3 * GROUP_WIDTH
RW_COLS = 3 * GROUP_WIDTH + RW_DECAY_RANK + RW_A_RANK + RW_GATE_RANK
P_IN = SB_COLS + DA_COLS + SC_COLS + RW_COLS
IN_SPLITS = [SB_COLS, SB_COLS + DA_COLS, SB_COLS + DA_COLS + SC_COLS]
RW_SPLITS = [GROUP_WIDTH, 2 * GROUP_WIDTH, 3 * GROUP_WIDTH,
             3 * GROUP_WIDTH + RW_DECAY_RANK,
             3 * GROUP_WIDTH + RW_DECAY_RANK + RW_A_RANK]

kernel_name = 'hybrid_parallel_groups_grouped_moe'


def _heads(t, n_heads):
    b, s, _ = t.shape
    return t.reshape(b, s, n_heads, -1).transpose(0, 2, 1, 3)


def _merge(t):
    b, n, s, d = t.shape
    return t.transpose(0, 2, 1, 3).reshape(b, s, n * d)


def layer_norm(x, gain, bias):
    xf = x.astype(jnp.float32)
    mu = xf.mean(-1, keepdims=True)
    var = jnp.square(xf - mu).mean(-1, keepdims=True)
    return ((xf - mu) * lax.rsqrt(var + LN_EPS) * gain + bias).astype(x.dtype)


def relative_bias_by_distance(rel_table, seq):
    n = jnp.arange(seq)
    max_exact = REL_BUCKETS // 2
    nf = jnp.maximum(n, 1).astype(jnp.float32)
    large = max_exact + (jnp.log(nf / max_exact) / math.log(REL_MAX_DIST / max_exact)
                         * (REL_BUCKETS - max_exact)).astype(jnp.int32)
    large = jnp.minimum(large, REL_BUCKETS - 1)
    bucket = jnp.where(n < max_exact, n, large)
    return rel_table[bucket].T


def stick_breaking_attention(q, k, v):
    q = _heads(q, SB_HEADS).astype(jnp.float32) * SB_HEAD_DIM ** -0.5
    k = _heads(k, SB_HEADS).astype(jnp.float32)
    v = _heads(v, SB_HEADS).astype(jnp.float32)
    seq = q.shape[2]
    outs = []
    for i in range(seq // BLOCK_Q):
        q0 = i * BLOCK_Q
        end = q0 + BLOCK_Q
        z = jnp.einsum('bhqd,bhkd->bhqk', q[:, :, q0:end], k[:, :, :end])
        strict = jnp.arange(end)[None, :] < (q0 + jnp.arange(BLOCK_Q))[:, None]
        sp = jnp.where(strict, jax.nn.softplus(z), 0.0)
        log_w = jnp.where(strict, z - lax.cumsum(sp, axis=3, reverse=True), -jnp.inf)
        outs.append(jnp.einsum('bhqk,bhkd->bhqd', jnp.exp(log_w), v[:, :, :end]))
    return _merge(jnp.concatenate(outs, axis=2))


def diff_attention(q, k, v, lam_params, sub_gain, bias_dist, lam_init):
    b, s, _ = q.shape
    q = q.reshape(b, s, DA_HEADS, 2, DA_QK_DIM).transpose(0, 2, 3, 1, 4).astype(jnp.float32) * DA_QK_DIM ** -0.5
    k = k.reshape(b, s, DA_HEADS, 2, DA_QK_DIM).transpose(0, 2, 3, 1, 4).astype(jnp.float32)
    v = _heads(v, DA_HEADS).astype(jnp.float32)
    lp = lam_params.astype(jnp.float32)
    lam = jnp.exp(jnp.sum(lp[0] * lp[1])) - jnp.exp(jnp.sum(lp[2] * lp[3])) + lam_init
    bias_dist = bias_dist.astype(jnp.float32)
    outs = []
    for i in range(s // BLOCK_Q):
        q0 = i * BLOCK_Q
        end = q0 + BLOCK_Q
        logits = jnp.einsum('bhmqd,bhmkd->bhmqk', q[:, :, :, q0:end], k[:, :, :, :end])
        dist = (q0 + jnp.arange(BLOCK_Q))[:, None] - jnp.arange(end)[None, :]
        bias = bias_dist[:, jnp.maximum(dist, 0)]
        logits = jnp.where(dist >= 0, logits + bias[None, :, None], -jnp.inf)
        probs = jax.nn.softmax(logits, axis=-1)
        attn = probs[:, :, 0] - lam * probs[:, :, 1]
        outs.append(jnp.einsum('bhqk,bhkd->bhqd', attn, v[:, :, :end]))
    o = jnp.concatenate(outs, axis=2)
    o = o * lax.rsqrt(jnp.square(o).mean(-1, keepdims=True) + DA_SUBLN_EPS) * sub_gain * (1.0 - lam_init)
    return _merge(o)


def short_conv_mixer(b_gate, c_gate, h, conv_w):
    u = c_gate * h
    y = lax.conv_general_dilated(
        u, conv_w[:, None, :].astype(u.dtype), window_strides=(1,),
        padding=[(CONV_WIDTH - 1, 0)], dimension_numbers=('NWC', 'WIO', 'NWC'),
        feature_group_count=u.shape[-1])
    return b_gate * y


def rwkv7_time_mix(proj, mu, vecs, w_up, a_up, g_up):
    proj = proj.astype(jnp.float32)
    b, s, _ = proj.shape
    shifted = jnp.pad(proj, ((0, 0), (1, 0), (0, 0)))[:, :-1]
    xs = proj + (shifted - proj) * mu
    r, k, v, xw, xa, xg = jnp.split(xs, RW_SPLITS, axis=-1)
    vecs = vecs.astype(jnp.float32)
    w0, a0, k_k, k_a, r_k, lnx_g, lnx_b = [vecs[i] for i in range(7)]
    log_decay = -math.exp(-0.5) * jax.nn.sigmoid(w0 + jnp.tanh(xw) @ w_up)
    a = jax.nn.sigmoid(a0 + xa @ a_up)
    g = jax.nn.sigmoid(xg) @ g_up
    kk = (k * k_k).reshape(b, s, RW_HEADS, RW_HEAD_DIM)
    kk = kk / jnp.maximum(jnp.sqrt(jnp.sum(kk * kk, -1, keepdims=True)), 1e-12)
    k = k * (1.0 + (a - 1.0) * k_a)
    hd = lambda t: t.reshape(b, s, RW_HEADS, RW_HEAD_DIM)
    r_h, k_h, v_h, a_h = hd(r), hd(k), hd(v), hd(a)
    tm = lambda t: jnp.moveaxis(t, 1, 0)

    def step(state, inp):
        r_t, w_t, k_t, v_t, kk_t, ab_t = inp
        sa = jnp.einsum('bhij,bhj->bhi', state, -kk_t)
        state = (state * w_t[:, :, None, :] + sa[..., None] * ab_t[:, :, None, :]
                 + v_t[..., None] * k_t[:, :, None, :])
        return state, jnp.einsum('bhij,bhj->bhi', state, r_t)

    state0 = jnp.zeros((b, RW_HEADS, RW_HEAD_DIM, RW_HEAD_DIM), jnp.float32)
    xs_scan = (tm(r_h), tm(jnp.exp(hd(log_decay))), tm(k_h), tm(v_h), tm(kk), tm(kk * a_h))
    _, y = lax.scan(step, state0, xs_scan)
    y = jnp.moveaxis(y, 0, 1)
    mean = y.mean(-1, keepdims=True)
    var = jnp.square(y - mean).mean(-1, keepdims=True)
    y = ((y - mean) * lax.rsqrt(var + RW_LN_EPS)).reshape(b, s, GROUP_WIDTH) * lnx_g + lnx_b
    bonus = jnp.sum(r_h * k_h * r_k.reshape(RW_HEADS, RW_HEAD_DIM), -1, keepdims=True) * v_h
    return (y + bonus.reshape(b, s, GROUP_WIDTH)) * g


def grouped_moe(x, router_w, router_b, w_in, w_down):
    b, s, d = x.shape
    xf = x.reshape(b * s, d)
    affinity = jax.nn.sigmoid((xf @ router_w).astype(jnp.float32))
    select = affinity + router_b.astype(jnp.float32)
    grouped = select.reshape(-1, N_EXPERT_GROUPS, EXPERTS_PER_GROUP)
    group_score = lax.top_k(grouped, TOP_K)[0].sum(-1)
    best_group = jnp.argmax(group_score, axis=-1)
    in_group = (jnp.arange(N_EXPERTS) // EXPERTS_PER_GROUP)[None, :] == best_group[:, None]
    _, idx = lax.top_k(jnp.where(in_group, select, -jnp.inf), TOP_K)
    gate = jnp.take_along_axis(affinity, idx, axis=1)
    gate = gate / gate.sum(-1, keepdims=True)
    combine = (jax.nn.one_hot(idx, N_EXPERTS, dtype=jnp.float32) * gate[..., None]).sum(1)
    out = jnp.zeros((b * s, d), jnp.float32)
    for e in range(N_EXPERTS):
        gu = xf @ w_in[e]
        h = jax.nn.silu(gu[:, :D_EXPERT]) * gu[:, D_EXPERT:]
        out = out + combine[:, e:e + 1] * (h @ w_down[e]).astype(jnp.float32)
    return out.reshape(b, s, d).astype(x.dtype)


def setup_inputs(seed: int = 0) -> dict:
    key = jax.random.key(seed)
    ks = jax.random.split(key, 24)
    f32 = jnp.float32

    def nrm(k, shape, scale):
        return jax.random.normal(k, shape, f32) * scale

    x = nrm(ks[0], (BATCH, SEQ, D_MODEL), 1.0)
    w_in = nrm(ks[1], (DEPTH, D_MODEL, P_IN), D_MODEL ** -0.5)
    w_out = nrm(ks[2], (DEPTH, D_MIX, D_MODEL), D_MIX ** -0.5 * DEEPNORM_BETA)
    da_lambda = nrm(ks[3], (DEPTH, 4, DA_QK_DIM), 0.1)
    da_subln = 1.0 + nrm(ks[4], (DEPTH, DA_V_DIM), 0.02)
    sc_conv = nrm(ks[5], (DEPTH, CONV_WIDTH, GROUP_WIDTH), CONV_WIDTH ** -0.5)
    rw_mu = jax.random.uniform(ks[6], (DEPTH, RW_COLS), f32)
    vshape = (DEPTH, GROUP_WIDTH)
    rw_vecs = jnp.stack([
        nrm(ks[7], vshape, 0.5),
        nrm(ks[8], vshape, 0.1),
        0.85 + nrm(ks[9], vshape, 0.05),
        1.0 + nrm(ks[10], vshape, 0.05),
        nrm(ks[11], vshape, 0.1),
        1.0 + nrm(ks[12], vshape, 0.02),
        nrm(ks[13], vshape, 0.02),
    ], axis=1)
    rw_w_up = nrm(ks[14], (DEPTH, RW_DECAY_RANK, GROUP_WIDTH), 0.1 * RW_DECAY_RANK ** -0.5)
    rw_a_up = nrm(ks[15], (DEPTH, RW_A_RANK, GROUP_WIDTH), 0.1 * RW_A_RANK ** -0.5)
    rw_g_up = nrm(ks[16], (DEPTH, RW_GATE_RANK, GROUP_WIDTH), RW_GATE_RANK ** -0.5)
    ln_gain = 1.0 + nrm(ks[17], (DEPTH, 2, D_MODEL), 0.02)
    ln_bias = nrm(ks[18], (DEPTH, 2, D_MODEL), 0.02)
    rel_bias = nrm(ks[19], (REL_BUCKETS, DA_HEADS), 0.3)
    router_w = nrm(ks[20], (D_MODEL, N_EXPERTS), D_MODEL ** -0.5)
    router_b = nrm(ks[21], (N_EXPERTS,), 0.01)
    moe_w_in = nrm(ks[22], (DEPTH, N_EXPERTS, D_MODEL, 2 * D_EXPERT), D_MODEL ** -0.5)
    moe_w_down = nrm(ks[23], (DEPTH, N_EXPERTS, D_EXPERT, D_MODEL), D_EXPERT ** -0.5 * DEEPNORM_BETA)
    return {'x': x, 'w_in': w_in, 'w_out': w_out, 'da_lambda': da_lambda, 'da_subln': da_subln,
            'sc_conv': sc_conv, 'rw_mu': rw_mu, 'rw_vecs': rw_vecs, 'rw_w_up': rw_w_up,
            'rw_a_up': rw_a_up, 'rw_g_up': rw_g_up, 'ln_gain': ln_gain, 'ln_bias': ln_bias,
            'rel_bias': rel_bias, 'router_w': router_w, 'router_b': router_b,
            'moe_w_in': moe_w_in, 'moe_w_down': moe_w_down}


def reference(x, w_in, w_out, da_lambda, da_subln, sc_conv, rw_mu, rw_vecs, rw_w_up,
              rw_a_up, rw_g_up, ln_gain, ln_bias, rel_bias, router_w, router_b,
              moe_w_in, moe_w_down):
    bias_dist = relative_bias_by_distance(rel_bias, x.shape[1])
    for l in range(DEPTH):
        proj = x @ w_in[l]
        p_sb, p_da, p_sc, p_rw = jnp.split(proj, IN_SPLITS, axis=-1)
        q, k, v = jnp.split(p_sb, 3, axis=-1)
        y_sb = stick_breaking_attention(q, k, v).astype(x.dtype)
        q, k, v = jnp.split(p_da, 3, axis=-1)
        lam_init = 0.8 - 0.6 * math.exp(-0.3 * l)
        y_da = diff_attention(q, k, v, da_lambda[l], da_subln[l], bias_dist, lam_init).astype(x.dtype)
        b_gate, c_gate, h = jnp.split(p_sc, 3, axis=-1)
        y_sc = short_conv_mixer(b_gate, c_gate, h, sc_conv[l]).astype(x.dtype)
        y_rw = rwkv7_time_mix(p_rw, rw_mu[l], rw_vecs[l], rw_w_up[l], rw_a_up[l], rw_g_up[l]).astype(x.dtype)
        mixed = jnp.concatenate([y_sb, y_da, y_sc, y_rw], axis=-1) @ w_out[l]
        x = layer_norm(DEEPNORM_ALPHA * x + mixed, ln_gain[l, 0], ln_bias[l, 0])
        ffn = grouped_moe(x, router_w, router_b, moe_w_in[l], moe_w_down[l])
        x = layer_norm(DEEPNORM_ALPHA * x + ffn, ln_gain[l, 1], ln_bias[l, 1])
    return x
```

```cpp
#include <hip/hip_runtime.h>
#include <cstdio>
#include <cstdint>

typedef unsigned short bf16_t;
typedef short bf16x8 __attribute__((ext_vector_type(8)));
typedef float f32x4 __attribute__((ext_vector_type(4)));

#define NTOK 65536
#define SEQ 2048
#define DM 1024
#define PIN 3200
#define PINP 3328
#define NLAYER 4
#define NEXP 16
#define DEXP 256
#define NTHREADS 512
#define LDS_BYTES (136 * 1024)
#define ALPHA 1.6817928305074292f

#define WS_CTL 0ull
#define CTL_BYTES 65536ull
#define WS_BIASD (WS_CTL + CTL_BYTES)
#define WS_WIN (WS_BIASD + 4ull * 2048 * 4)
#define WS_WOUT (WS_WIN + 4ull * PINP * DM * 2)
#define WS_MWIN (WS_WOUT + 4ull * DM * DM * 2)
#define WS_MWDN (WS_MWIN + 4ull * 16 * 512 * 1024 * 2)
#define WS_XB (WS_MWDN + 4ull * 16 * 1024 * 256 * 2)
#define WS_MIX (WS_XB + (unsigned long long)NTOK * DM * 2)
#define WS_LTOK (WS_MIX + (unsigned long long)NTOK * DM * 2)
#define WS_LGATE (WS_LTOK + 16ull * NTOK * 4)
#define WS_PROJ (WS_LGATE + 16ull * NTOK * 4)
#define WS_Y WS_PROJ
#define WS_H (WS_Y + (unsigned long long)NTOK * 2 * DM * 2)
#define WS_END (WS_PROJ + (unsigned long long)NTOK * PINP * 2)

#define CW_BAR 0
#define CW_CNT 4096
#define CW_QUEUE 8192

#define XB_TMO      128
#define XB_XCNT(j)  (256  + 64 * (j))
#define XB_XSUB(j)  (1280 + 64 * (j))
#define XB_XGEN(j)  (2304 + 64 * (j))
#define XB_TOP      3328
#define XB_TOPGEN   3392
#define XCD_BAR_WORDS 3456
#define XB_SPIN_CAP (1u << 22)
#define LAS __attribute__((address_space(3)))

__device__ __forceinline__ unsigned xb_ld(unsigned* p)              { return __hip_atomic_load(p, __ATOMIC_RELAXED, __HIP_MEMORY_SCOPE_AGENT); }
__device__ __forceinline__ unsigned xb_add(unsigned* p, unsigned v) { return __hip_atomic_fetch_add(p, v, __ATOMIC_RELAXED, __HIP_MEMORY_SCOPE_AGENT); }
__device__ __forceinline__ unsigned xb_xcc_id() { return (unsigned)__builtin_amdgcn_s_getreg((3 << 11) | 20) & 0xFu; }
#define XB_SPIN(cond, bar) do { unsigned _sp = 0; while (cond) { __builtin_amdgcn_s_sleep(1); \
    if ((++_sp & 255u) == 0u) { if (xb_ld(&(bar)[XB_TMO])) break; if (_sp > XB_SPIN_CAP) { atomicAdd(&(bar)[XB_TMO], 1u); break; } } } } while (0)

struct XcdBarrier { unsigned* bar; unsigned x; volatile LAS unsigned* st; };

__device__ __forceinline__ XcdBarrier xcd_barrier_post(unsigned* bar, volatile LAS unsigned* st) {
    XcdBarrier b; b.bar = bar; b.x = xb_xcc_id(); b.st = st;
    if (threadIdx.x == 0) (void)xb_add(&bar[XB_XCNT(b.x)], 1u);
    return b;
}
__device__ __forceinline__ void xcd_barrier_complete(unsigned* bar, unsigned x, unsigned& nloc, unsigned& nx) {
    const unsigned G = gridDim.x * gridDim.y * gridDim.z;
    unsigned sum, cnt, mine, sp = 0u;
    for (;;) {
        sum = 0u; cnt = 0u; mine = 0u;
#pragma unroll
        for (unsigned j = 0; j < 16; ++j) { const unsigned c = xb_ld(&bar[XB_XCNT(j)]); sum += c; cnt += (c > 0u) ? 1u : 0u; mine = (j == x) ? c : mine; }
        if (sum == G) break;
        __builtin_amdgcn_s_sleep(1);
        if ((++sp & 255u) == 0u) { if (xb_ld(&bar[XB_TMO])) break; if (sp > XB_SPIN_CAP) { atomicAdd(&bar[XB_TMO], 1u); break; } }
    }
    nloc = mine > 0u ? mine : 1u; nx = cnt > 0u ? cnt : 1u;
}
__device__ __forceinline__ void xcd_barrier(const XcdBarrier& b) {
    asm volatile("s_waitcnt vmcnt(0)" ::: "memory");
    __syncthreads();
    if (threadIdx.x == 0) {
        unsigned* bar = b.bar;
        __builtin_amdgcn_s_waitcnt(0);
        unsigned nloc = b.st[0], nx = b.st[1];
        if (nloc == 0u) { xcd_barrier_complete(bar, b.x, nloc, nx); b.st[0] = nloc; b.st[1] = nx; }
        const unsigned old = xb_add(&bar[XB_XSUB(b.x)], 1u);
        const unsigned gen = old / nloc;
        if (old + 1u == (gen + 1u) * nloc) {
            __builtin_amdgcn_fence(__ATOMIC_RELEASE, "agent");
            asm volatile("s_waitcnt vmcnt(0)" ::: "memory");
            const unsigned og = xb_add(&bar[XB_TOP], 1u);
            const unsigned tg = og / nx;
            if (og + 1u == (tg + 1u) * nx) xb_add(&bar[XB_TOPGEN], 1u);
            else XB_SPIN(xb_ld(&bar[XB_TOPGEN]) == tg, bar);
            __builtin_amdgcn_fence(__ATOMIC_ACQUIRE, "agent");
            xb_add(&bar[XB_XGEN(b.x)], 1u);
            asm volatile("s_waitcnt vmcnt(0)" ::: "memory");
        } else {
            XB_SPIN(xb_ld(&bar[XB_XGEN(b.x)]) == gen, bar);
            __builtin_amdgcn_fence(__ATOMIC_ACQUIRE, "agent");
            asm volatile("s_waitcnt vmcnt(0)" ::: "memory");
        }
    }
    __syncthreads();
}

__device__ __forceinline__ int otid() { int t = threadIdx.x; asm volatile("" : "+v"(t)); return t; }
__device__ __forceinline__ int obid() { int t = blockIdx.x; asm volatile("" : "+s"(t)); return t; }
__device__ __forceinline__ float bf2f(bf16_t v) { return __uint_as_float(((unsigned)v) << 16); }
__device__ __forceinline__ bf16_t f2bf(float f) { unsigned u = __float_as_uint(f); u += 0x7fffu + ((u >> 16) & 1u); return (bf16_t)(u >> 16); }
__device__ __forceinline__ float sigmoidf_(float x) { return 1.0f / (1.0f + expf(-x)); }
__device__ __forceinline__ float wave_sum(float v) {
#pragma unroll
    for (int o = 32; o >= 1; o >>= 1) v += __shfl_xor(v, o);
    return v;
}

struct Params {
    const float* x; const float* w_in; const float* w_out; const float* da_lambda; const float* da_subln; const float* sc_conv;
    const float* rw_mu; const float* rw_vecs; const float* rw_w_up; const float* rw_a_up; const float* rw_g_up;
    const float* ln_gain; const float* ln_bias; const float* rel_bias; const float* router_w; const float* router_b;
    const float* moe_w_in; const float* moe_w_down;
    float* out; unsigned char* ws;
};

template <int MODE>
__device__ __forceinline__ void transpose_tile(const float* __restrict__ src, bf16_t* __restrict__ dst, int K, int N, int k0, int n0, float* tile  ) {
    const int tid = otid();
    const int c = tid & 63, r0 = tid >> 6;
    __syncthreads();
    if (n0 < N) {
#pragma unroll
        for (int i = 0; i < 8; ++i) { const int kk = r0 + i * 8; tile[kk * 65 + c] = src[(size_t)(k0 + kk) * N + n0 + c]; }
    } else {
#pragma unroll
        for (int i = 0; i < 8; ++i) { const int kk = r0 + i * 8; tile[kk * 65 + c] = 0.f; }
    }
    __syncthreads();
#pragma unroll
    for (int i = 0; i < 8; ++i) {
        const int nn = r0 + i * 8; int n = n0 + nn;
        if (MODE == 1) { const int j = n & 255; const int isu = n >> 8; n = (j >> 4) * 32 + isu * 16 + (j & 15); }
        dst[(size_t)n * K + k0 + c] = f2bf(tile[c * 65 + nn]);
    }
}

__device__ __forceinline__ void prologue(const Params& p, unsigned char* lds) {
    float* tile = (float*)lds;
    const int G = gridDim.x, w = obid(), tid = otid();
    bf16_t* win = (bf16_t*)(p.ws + WS_WIN); bf16_t* wout = (bf16_t*)(p.ws + WS_WOUT);
    bf16_t* mwin = (bf16_t*)(p.ws + WS_MWIN); bf16_t* mwdn = (bf16_t*)(p.ws + WS_MWDN);
    for (int it = w; it < 4 * 16 * 52; it += G) { const int l = it / (16 * 52), r = it % (16 * 52), kt = r / 52, nt = r % 52;
        transpose_tile<0>(p.w_in + (size_t)l * DM * PIN, win + (size_t)l * PINP * DM, DM, PIN, kt * 64, nt * 64, tile); }
    for (int it = w; it < 4 * 16 * 16; it += G) { const int l = it / 256, r = it % 256, kt = r / 16, nt = r % 16;
        transpose_tile<0>(p.w_out + (size_t)l * DM * DM, wout + (size_t)l * DM * DM, DM, DM, kt * 64, nt * 64, tile); }
    for (int it = w; it < 64 * 16 * 8; it += G) { const int le = it / 128, r = it % 128, kt = r / 8, nt = r % 8;
        transpose_tile<1>(p.moe_w_in + (size_t)le * 1024 * 512, mwin + (size_t)le * 512 * 1024, 1024, 512, kt * 64, nt * 64, tile); }
    for (int it = w; it < 64 * 4 * 16; it += G) { const int le = it / 64, r = it % 64, kt = r / 16, nt = r % 16;
        transpose_tile<0>(p.moe_w_down + (size_t)le * 256 * 1024, mwdn + (size_t)le * 1024 * 256, 256, 1024, kt * 64, nt * 64, tile); }
    {
        bf16_t* xb = (bf16_t*)(p.ws + WS_XB);
        const size_t n4 = (size_t)NTOK * DM / 4;
        for (size_t i = (size_t)w * NTHREADS + tid; i < n4; i += (size_t)G * NTHREADS) {
            const float4 v = ((const float4*)p.x)[i];
            ushort4 o; o.x = f2bf(v.x); o.y = f2bf(v.y); o.z = f2bf(v.z); o.w = f2bf(v.w);
            ((ushort4*)xb)[i] = o;
        }
    }
    {
        float* bd = (float*)(p.ws + WS_BIASD);
        for (int i = w * NTHREADS + tid; i < 4 * 2048; i += G * NTHREADS) {
            const int h = i >> 11, n = i & 2047;
            int bucket;
            if (n < 16) bucket = n;
            else { const float nf = (float)n; int lg = 16 + (int)(logf(nf / 16.0f) / 2.0794415416798357f * 16.0f); bucket = lg < 31 ? lg : 31; }
            bd[i] = p.rel_bias[bucket * 4 + h];
        }
    }
}

template <class ARow, class Epi>
__device__ __forceinline__ void gemm128(unsigned char* lds, const ARow& arow, const bf16_t* __restrict__ bt, int K, const Epi& epi) {
    const int tid = otid(), lane = tid & 63, wid = tid >> 6, wm = wid >> 1, wn = wid & 1;
    const int lr = tid >> 2, lc = (tid & 3) * 8;
    bf16_t* As = (bf16_t*)lds; bf16_t* Bs = (bf16_t*)(lds + 10240);
    const bf16_t* ap = arow(lr) + lc;
    const bf16_t* bp = bt + (size_t)lr * K + lc;
    f32x4 acc[2][4];
#pragma unroll
    for (int m = 0; m < 2; ++m)
#pragma unroll
        for (int n = 0; n < 4; ++n) acc[m][n] = (f32x4){0.f, 0.f, 0.f, 0.f};
    uint4 ra = *(const uint4*)ap, rb = *(const uint4*)bp;
    const int fr = lane & 15, fq = lane >> 4;
    for (int k0 = 0; k0 < K; k0 += 32) {
        __syncthreads();
        *(uint4*)(As + lr * 40 + lc) = ra;
        *(uint4*)(Bs + lr * 40 + lc) = rb;
        __syncthreads();
        if (k0 + 32 < K) { ra = *(const uint4*)(ap + k0 + 32); rb = *(const uint4*)(bp + k0 + 32); }
        bf16x8 a[2], b[4];
#pragma unroll
        for (int m = 0; m < 2; ++m) a[m] = *(const bf16x8*)(As + (wm * 32 + m * 16 + fr) * 40 + fq * 8);
#pragma unroll
        for (int n = 0; n < 4; ++n) b[n] = *(const bf16x8*)(Bs + (wn * 64 + n * 16 + fr) * 40 + fq * 8);
#pragma unroll
        for (int m = 0; m < 2; ++m)
#pragma unroll
            for (int n = 0; n < 4; ++n) acc[m][n] = __builtin_amdgcn_mfma_f32_16x16x32_bf16(a[m], b[n], acc[m][n], 0, 0, 0);
    }
    epi(acc, wm, wn, lane);
}

struct RowContig { const bf16_t* base; int ld; __device__ __forceinline__ const bf16_t* operator()(int r) const { return base + (size_t)r * ld; } };

struct EpiProj {
    bf16_t* out;
    __device__ __forceinline__ void operator()(const f32x4 (&acc)[2][4], int wm, int wn, int lane) const {
#pragma unroll
        for (int m = 0; m < 2; ++m)
#pragma unroll
            for (int n = 0; n < 4; ++n)
#pragma unroll
                for (int j = 0; j < 4; ++j) {
                    const int row = wm * 32 + m * 16 + (lane >> 4) * 4 + j, col = wn * 64 + n * 16 + (lane & 15);
                    out[(size_t)row * PINP + col] = f2bf(acc[m][n][j]);
                }
    }
};
__device__ __forceinline__ void phase_inproj(const Params& p, int l, unsigned char* lds) {
    const bf16_t* xb = (const bf16_t*)(p.ws + WS_XB);
    const bf16_t* wt = (const bf16_t*)(p.ws + WS_WIN) + (size_t)l * PINP * DM;
    bf16_t* proj = (bf16_t*)(p.ws + WS_PROJ);
    const int nct = PINP / 128;
    for (int it = obid(); it < (NTOK / 128) * nct; it += gridDim.x) {
        const int mt = it / nct, ct = it % nct;
        RowContig ar{xb + (size_t)mt * 128 * DM, DM};
        EpiProj ep{proj + (size_t)mt * 128 * PINP + ct * 128};
        gemm128(lds, ar, wt + (size_t)ct * 128 * DM, DM, ep);
    }
}

struct EpiOut {
    const float* xin; float* out;
    __device__ __forceinline__ void operator()(const f32x4 (&acc)[2][4], int wm, int wn, int lane) const {
#pragma unroll
        for (int m = 0; m < 2; ++m)
#pragma unroll
            for (int n = 0; n < 4; ++n)
#pragma unroll
                for (int j = 0; j < 4; ++j) {
                    const int row = wm * 32 + m * 16 + (lane >> 4) * 4 + j, col = wn * 64 + n * 16 + (lane & 15);
                    const size_t o = (size_t)row * DM + col;
                    out[o] = ALPHA * xin[o] + acc[m][n][j];
                }
    }
};
__device__ __forceinline__ void phase_outproj(const Params& p, int l, unsigned char* lds) {
    const bf16_t* mix = (const bf16_t*)(p.ws + WS_MIX);
    const bf16_t* wt = (const bf16_t*)(p.ws + WS_WOUT) + (size_t)l * DM * DM;
    const float* xin = (l == 0) ? p.x : p.out;
    for (int it = obid(); it < (NTOK / 128) * 8; it += gridDim.x) {
        const int mt = it / 8, ct = it % 8;
        RowContig ar{mix + (size_t)mt * 128 * DM, DM};
        const size_t o = (size_t)mt * 128 * DM + ct * 128;
        EpiOut ep{xin + o, p.out + o};
        gemm128(lds, ar, wt + (size_t)ct * 128 * DM, DM, ep);
    }
}

__device__ __forceinline__ void ln_row(float (&v)[16], const float* gain, const float* bias, int lane) {
    float s = 0.f;
#pragma unroll
    for (int i = 0; i < 16; ++i) s += v[i];
    s = wave_sum(s);
    const float mean = s * (1.0f / 1024.0f);
    float q = 0.f;
#pragma unroll
    for (int i = 0; i < 16; ++i) { const float d = v[i] - mean; q += d * d; }
    q = wave_sum(q);
    const float rstd = rsqrtf(q * (1.0f / 1024.0f) + 1e-5f);
#pragma unroll
    for (int j = 0; j < 4; ++j) {
        const float4 g = *(const float4*)(gain + j * 256 + lane * 4), b = *(const float4*)(bias + j * 256 + lane * 4);
        v[j * 4 + 0] = (v[j * 4 + 0] - mean) * rstd * g.x + b.x; v[j * 4 + 1] = (v[j * 4 + 1] - mean) * rstd * g.y + b.y;
        v[j * 4 + 2] = (v[j * 4 + 2] - mean) * rstd * g.z + b.z; v[j * 4 + 3] = (v[j * 4 + 3] - mean) * rstd * g.w + b.w;
    }
}
__device__ __forceinline__ void store_row(const float (&v)[16], float* xo, bf16_t* xbo, int lane) {
#pragma unroll
    for (int j = 0; j < 4; ++j) {
        *(float4*)(xo + j * 256 + lane * 4) = make_float4(v[j * 4], v[j * 4 + 1], v[j * 4 + 2], v[j * 4 + 3]);
        ushort4 o; o.x = f2bf(v[j * 4]); o.y = f2bf(v[j * 4 + 1]); o.z = f2bf(v[j * 4 + 2]); o.w = f2bf(v[j * 4 + 3]);
        *(ushort4*)(xbo + j * 256 + lane * 4) = o;
    }
}

__device__ __forceinline__ void phase_ln1_route(const Params& p, int l, unsigned char* lds) {
    const int tid = otid(), lane = tid & 63, wid = tid >> 6;
    int* sel_e = (int*)lds;
    float* sel_g = (float*)(lds + 2048);
    int* rank = (int*)(lds + 4096);
    int* base = (int*)(lds + 6144);
    bf16_t* xb = (bf16_t*)(p.ws + WS_XB);
    unsigned* ctl = (unsigned*)(p.ws + WS_CTL);
    int* ltok = (int*)(p.ws + WS_LTOK); float* lgate = (float*)(p.ws + WS_LGATE);
    const float* gain = p.ln_gain + (size_t)(l * 2 + 0) * DM; const float* bias = p.ln_bias + (size_t)(l * 2 + 0) * DM;
    for (int chunk = obid(); chunk < NTOK / 256; chunk += gridDim.x) {
        __syncthreads();
        for (int rr = 0; rr < 32; ++rr) {
            const int lrow = wid * 32 + rr; const size_t row = (size_t)chunk * 256 + lrow;
            float v[16];
#pragma unroll
            for (int j = 0; j < 4; ++j) { const float4 t = *(const float4*)(p.out + row * DM + j * 256 + lane * 4); v[j * 4] = t.x; v[j * 4 + 1] = t.y; v[j * 4 + 2] = t.z; v[j * 4 + 3] = t.w; }
            ln_row(v, gain, bias, lane);
            store_row(v, p.out + row * DM, xb + row * DM, lane);
            float lg[16];
#pragma unroll
            for (int e = 0; e < 16; ++e) lg[e] = 0.f;
#pragma unroll
            for (int j = 0; j < 4; ++j)
#pragma unroll
                for (int i = 0; i < 4; ++i) {
                    const float* rw = p.router_w + (size_t)(j * 256 + lane * 4 + i) * 16;
                    const float xv = v[j * 4 + i];
#pragma unroll
                    for (int e4 = 0; e4 < 4; ++e4) { const float4 wv = *(const float4*)(rw + e4 * 4);
                        lg[e4 * 4 + 0] += xv * wv.x; lg[e4 * 4 + 1] += xv * wv.y; lg[e4 * 4 + 2] += xv * wv.z; lg[e4 * 4 + 3] += xv * wv.w; }
                }
#pragma unroll
            for (int e = 0; e < 16; ++e) lg[e] = wave_sum(lg[e]);
            if (lane == 0) {
                float aff[16], sl[16];
#pragma unroll
                for (int e = 0; e < 16; ++e) { aff[e] = sigmoidf_(lg[e]); sl[e] = aff[e] + p.router_b[e]; }
                float bestg = -INFINITY; int bg = 0;
#pragma unroll
                for (int g = 0; g < 4; ++g) {
                    float m1 = -INFINITY, m2 = -INFINITY;
#pragma unroll
                    for (int k = 0; k < 4; ++k) { const float s = sl[g * 4 + k]; if (s > m1) { m2 = m1; m1 = s; } else if (s > m2) m2 = s; }
                    const float gs = m1 + m2;
                    if (gs > bestg) { bestg = gs; bg = g; }
                }
                float b1 = -INFINITY; int i1 = 0; float a1 = 0.f;
#pragma unroll
                for (int e = 0; e < 16; ++e) { const bool in = (e >> 2) == bg; if (in && sl[e] > b1) { b1 = sl[e]; i1 = e; a1 = aff[e]; } }
                float b2 = -INFINITY; int i2 = 0; float a2 = 0.f;
#pragma unroll
                for (int e = 0; e < 16; ++e) { const bool in = ((e >> 2) == bg) && (e != i1); if (in && sl[e] > b2) { b2 = sl[e]; i2 = e; a2 = aff[e]; } }
                const float inv = 1.0f / (a1 + a2);
                sel_e[lrow * 2] = i1; sel_e[lrow * 2 + 1] = i2; sel_g[lrow * 2] = a1 * inv; sel_g[lrow * 2 + 1] = a2 * inv;
            }
        }
        __syncthreads();
        if (tid < 16) {
            int c = 0;
            for (int i = 0; i < 512; ++i) if (sel_e[i] == tid) { rank[i] = c; ++c; }
            base[tid] = (int)atomicAdd(&ctl[CW_CNT + (l * 16 + tid) * 64], (unsigned)c);
        }
        __syncthreads();
        {
            const int e = sel_e[tid]; const int pos = base[e] + rank[tid];
            ltok[(size_t)e * NTOK + pos] = (chunk * 256 + (tid >> 1)) * 2 + (tid & 1);
            lgate[(size_t)e * NTOK + pos] = sel_g[tid];
        }
    }
}

__device__ __forceinline__ void moe_setup(const Params& p, int l, int* meta) {
    if (otid() == 0) {
        unsigned* ctl = (unsigned*)(p.ws + WS_CTL);
        int tb = 0, pb = 0;
        for (int e = 0; e < 16; ++e) { const int c = (int)xb_ld(&ctl[CW_CNT + (l * 16 + e) * 64]); meta[e] = c; meta[16 + e] = tb; meta[33 + e] = pb; tb += (c + 127) >> 7; pb += c; }
        meta[32] = tb; meta[49] = pb;
    }
    __syncthreads();
}
struct RowGather { const bf16_t* xb; const int* lt; int n; __device__ __forceinline__ const bf16_t* operator()(int r) const { const int tok = (r < n) ? (lt[r] >> 1) : 0; return xb + (size_t)tok * DM; } };
struct EpiG1 {
    bf16_t* h; int n; int jb;
    __device__ __forceinline__ void operator()(const f32x4 (&acc)[2][4], int wm, int wn, int lane) const {
#pragma unroll
        for (int m = 0; m < 2; ++m)
#pragma unroll
            for (int q = 0; q < 2; ++q)
#pragma unroll
                for (int j = 0; j < 4; ++j) {
                    const int row = wm * 32 + m * 16 + (lane >> 4) * 4 + j; const int jj = jb + wn * 32 + q * 16 + (lane & 15);
                    const float g = acc[m][2 * q][j], u = acc[m][2 * q + 1][j];
                    const float hv = g / (1.0f + expf(-g)) * u;
                    if (row < n) h[(size_t)row * DEXP + jj] = f2bf(hv);
                }
    }
};
__device__ __forceinline__ void phase_moe_up(const Params& p, int l, unsigned char* lds) {
    int* meta = (int*)(lds + 32768);
    __syncthreads();
    moe_setup(p, l, meta);
    const bf16_t* xb = (const bf16_t*)(p.ws + WS_XB);
    const int* ltok = (const int*)(p.ws + WS_LTOK);
    bf16_t* H = (bf16_t*)(p.ws + WS_H);
    const int ntile = meta[32];
    for (int it = obid(); it < ntile * 4; it += gridDim.x) {
        const int rt = it >> 2, ct = it & 3;
        int e = 0;
#pragma unroll
        for (int k = 1; k < 16; ++k) if (rt >= meta[16 + k]) e = k;
        const int rl = rt - meta[16 + e]; const int n = meta[e] - rl * 128;
        RowGather ar{xb, ltok + (size_t)e * NTOK + rl * 128, n};
        EpiG1 ep{H + (size_t)(meta[33 + e] + rl * 128) * DEXP, n, ct * 64};
        gemm128(lds, ar, (const bf16_t*)(p.ws + WS_MWIN) + ((size_t)(l * 16 + e) * 512 + ct * 128) * 1024, 1024, ep);
    }
}
struct EpiG2 {
    bf16_t* Y; const int* lt; const float* lg; int n; int c0;
    __device__ __forceinline__ void operator()(const f32x4 (&acc)[2][4], int wm, int wn, int lane) const {
#pragma unroll
        for (int m = 0; m < 2; ++m)
#pragma unroll
            for (int j = 0; j < 4; ++j) {
                const int row = wm * 32 + m * 16 + (lane >> 4) * 4 + j;
                if (row < n) {
                    const int ent = lt[row]; const float g = lg[row];
                    bf16_t* yo = Y + (size_t)ent * DM + c0 + wn * 64 + (lane & 15);
#pragma unroll
                    for (int nn = 0; nn < 4; ++nn) yo[nn * 16] = f2bf(acc[m][nn][j] * g);
                }
            }
    }
};
__device__ __forceinline__ void phase_moe_down(const Params& p, int l, unsigned char* lds) {
    int* meta = (int*)(lds + 32768);
    __syncthreads();
    moe_setup(p, l, meta);
    const int* ltok = (const int*)(p.ws + WS_LTOK); const float* lgate = (const float*)(p.ws + WS_LGATE);
    const bf16_t* H = (const bf16_t*)(p.ws + WS_H); bf16_t* Y = (bf16_t*)(p.ws + WS_Y);
    const int ntile = meta[32];
    for (int it = obid(); it < ntile * 8; it += gridDim.x) {
        const int rt = it >> 3, ct = it & 7;
        int e = 0;
#pragma unroll
        for (int k = 1; k < 16; ++k) if (rt >= meta[16 + k]) e = k;
        const int rl = rt - meta[16 + e]; const int n = meta[e] - rl * 128;
        RowContig ar{H + (size_t)(meta[33 + e] + rl * 128) * DEXP, DEXP};
        EpiG2 ep{Y, ltok + (size_t)e * NTOK + rl * 128, lgate + (size_t)e * NTOK + rl * 128, n, ct * 128};
        gemm128(lds, ar, (const bf16_t*)(p.ws + WS_MWDN) + ((size_t)(l * 16 + e) * 1024 + ct * 128) * 256, 256, ep);
    }
}

__device__ __forceinline__ void phase_ln2(const Params& p, int l) {
    const int tid = otid(), lane = tid & 63, wid = tid >> 6;
    bf16_t* xb = (bf16_t*)(p.ws + WS_XB); const bf16_t* Y = (const bf16_t*)(p.ws + WS_Y);
    const float* gain = p.ln_gain + (size_t)(l * 2 + 1) * DM; const float* bias = p.ln_bias + (size_t)(l * 2 + 1) * DM;
    for (size_t row = (size_t)obid() * 8 + wid; row < NTOK; row += (size_t)gridDim.x * 8) {
        float v[16];
#pragma unroll
        for (int j = 0; j < 4; ++j) {
            const float4 t = *(const float4*)(p.out + row * DM + j * 256 + lane * 4);
            const ushort4 y0 = *(const ushort4*)(Y + (row * 2) * DM + j * 256 + lane * 4), y1 = *(const ushort4*)(Y + (row * 2 + 1) * DM + j * 256 + lane * 4);
            v[j * 4 + 0] = ALPHA * t.x + bf2f(y0.x) + bf2f(y1.x); v[j * 4 + 1] = ALPHA * t.y + bf2f(y0.y) + bf2f(y1.y);
            v[j * 4 + 2] = ALPHA * t.z + bf2f(y0.z) + bf2f(y1.z); v[j * 4 + 3] = ALPHA * t.w + bf2f(y0.w) + bf2f(y1.w);
        }
        ln_row(v, gain, bias, lane);
        store_row(v, p.out + row * DM, xb + row * DM, lane);
    }
}

__device__ __forceinline__ void sb_item(const Params& p, int bh, int qc, unsigned char* lds) {
    const int tid = otid(), b = bh >> 2, h = bh & 3;
    const bf16_t* proj = (const bf16_t*)(p.ws + WS_PROJ) + (size_t)b * SEQ * PINP;
    bf16_t* mix = (bf16_t*)(p.ws + WS_MIX) + (size_t)b * SEQ * DM;
    float* Ks = (float*)lds; float* Vs = (float*)(lds + 16384);
    const int t = qc * 512 + tid; const int twmax = qc * 512 + (tid | 63);
    float q[64], acc[64];
#pragma unroll
    for (int d8 = 0; d8 < 8; ++d8) { const uint4 raw = *(const uint4*)(proj + (size_t)t * PINP + h * 64 + d8 * 8); const bf16_t* rp = (const bf16_t*)&raw;
#pragma unroll
        for (int i = 0; i < 8; ++i) q[d8 * 8 + i] = bf2f(rp[i]) * 0.125f; }
#pragma unroll
    for (int d = 0; d < 64; ++d) acc[d] = 0.f;
    float cs = 0.f;
    for (int kb = qc * 8 + 7; kb >= 0; --kb) {
        __syncthreads();
        { const int key = tid >> 3, d8 = tid & 7; const size_t ro = (size_t)(kb * 64 + key) * PINP + h * 64 + d8 * 8;
          const uint4 rk = *(const uint4*)(proj + ro + 256), rv = *(const uint4*)(proj + ro + 512); const bf16_t* pk = (const bf16_t*)&rk; const bf16_t* pv = (const bf16_t*)&rv;
#pragma unroll
          for (int i = 0; i < 8; ++i) { Ks[key * 64 + d8 * 8 + i] = bf2f(pk[i]); Vs[key * 64 + d8 * 8 + i] = bf2f(pv[i]); } }
        __syncthreads();
        if (kb * 64 < twmax) {
            for (int sl = 63; sl >= 0; --sl) {
                const int s = kb * 64 + sl;
                if (s < t) {
                    float z = 0.f;
#pragma unroll
                    for (int d4 = 0; d4 < 16; ++d4) { const float4 kv = *(const float4*)(Ks + sl * 64 + d4 * 4); z += q[d4 * 4] * kv.x + q[d4 * 4 + 1] * kv.y + q[d4 * 4 + 2] * kv.z + q[d4 * 4 + 3] * kv.w; }
                    const float sp = fmaxf(z, 0.f) + log1pf(expf(-fabsf(z)));
                    cs += sp;
                    const float w = expf(z - cs);
#pragma unroll
                    for (int d4 = 0; d4 < 16; ++d4) { const float4 vv = *(const float4*)(Vs + sl * 64 + d4 * 4); acc[d4 * 4] += w * vv.x; acc[d4 * 4 + 1] += w * vv.y; acc[d4 * 4 + 2] += w * vv.z; acc[d4 * 4 + 3] += w * vv.w; }
                }
            }
        }
    }
#pragma unroll
    for (int d8 = 0; d8 < 8; ++d8) { uint4 o; bf16_t* op = (bf16_t*)&o;
#pragma unroll
        for (int i = 0; i < 8; ++i) op[i] = f2bf(acc[d8 * 8 + i]);
        *(uint4*)(mix + (size_t)t * DM + h * 64 + d8 * 8) = o; }
}

__device__ __forceinline__ void da_item(const Params& p, int l, int bh, int qc, unsigned char* lds) {
    const int tid = otid(), b = bh >> 2, h = bh & 3, map = tid >> 8, row = tid & 255;
    const bf16_t* proj = (const bf16_t*)(p.ws + WS_PROJ) + (size_t)b * SEQ * PINP;
    bf16_t* mix = (bf16_t*)(p.ws + WS_MIX) + (size_t)b * SEQ * DM;
    const float* biasd = (const float*)(p.ws + WS_BIASD) + h * 2048;
    float* Ks = (float*)lds; float* Vs = (float*)(lds + 16384); float* Bd = (float*)(lds + 32768); float* Ex = (float*)(lds + 40960);
    const int t = qc * 256 + row; const int twmax = qc * 256 + (row | 63);
    __syncthreads();
    for (int i = tid; i < 2048; i += NTHREADS) Bd[i] = biasd[i];
    float q[32], O[64];
#pragma unroll
    for (int d8 = 0; d8 < 4; ++d8) { const uint4 raw = *(const uint4*)(proj + (size_t)t * PINP + 768 + h * 64 + map * 32 + d8 * 8); const bf16_t* rp = (const bf16_t*)&raw;
#pragma unroll
        for (int i = 0; i < 8; ++i) q[d8 * 8 + i] = bf2f(rp[i]) * 0.17677669529663687f; }
#pragma unroll
    for (int d = 0; d < 64; ++d) O[d] = 0.f;
    float mrun = -INFINITY, lsum = 0.f;
    for (int kb = 0; kb <= qc * 4 + 3; ++kb) {
        __syncthreads();
        { const int key = tid >> 3, d8 = tid & 7; const size_t ro = (size_t)(kb * 64 + key) * PINP + 768 + h * 64 + d8 * 8;
          const uint4 rk = *(const uint4*)(proj + ro + 256), rv = *(const uint4*)(proj + ro + 512); const bf16_t* pk = (const bf16_t*)&rk; const bf16_t* pv = (const bf16_t*)&rv;
#pragma unroll
          for (int i = 0; i < 8; ++i) { Ks[key * 64 + d8 * 8 + i] = bf2f(pk[i]); Vs[key * 64 + d8 * 8 + i] = bf2f(pv[i]); } }
        __syncthreads();
        if (kb * 64 <= twmax) {
            for (int sl = 0; sl < 64; ++sl) {
                const int s = kb * 64 + sl;
                if (s <= t) {
                    float z = Bd[t - s];
#pragma unroll
                    for (int d4 = 0; d4 < 8; ++d4) { const float4 kv = *(const float4*)(Ks + sl * 64 + map * 32 + d4 * 4); z += q[d4 * 4] * kv.x + q[d4 * 4 + 1] * kv.y + q[d4 * 4 + 2] * kv.z + q[d4 * 4 + 3] * kv.w; }
                    if (z > mrun) { const float sc = expf(mrun - z); lsum *= sc;
#pragma unroll
                        for (int d = 0; d < 64; ++d) O[d] *= sc;
                        mrun = z; }
                    const float pw = expf(z - mrun);
                    lsum += pw;
#pragma unroll
                    for (int d4 = 0; d4 < 16; ++d4) { const float4 vv = *(const float4*)(Vs + sl * 64 + d4 * 4); O[d4 * 4] += pw * vv.x; O[d4 * 4 + 1] += pw * vv.y; O[d4 * 4 + 2] += pw * vv.z; O[d4 * 4 + 3] += pw * vv.w; }
                }
            }
        }
    }
    const float il = 1.0f / lsum;
    __syncthreads();
    if (map == 1) {
#pragma unroll
        for (int d = 0; d < 64; ++d) Ex[d * 256 + row] = O[d] * il;
    }
    __syncthreads();
    if (map == 0) {
        const float* lp = p.da_lambda + (size_t)l * 128;
        float s1 = 0.f, s2 = 0.f;
        for (int i = 0; i < 32; ++i) { s1 += lp[i] * lp[32 + i]; s2 += lp[64 + i] * lp[96 + i]; }
        const float lam_init = 0.8f - 0.6f * expf(-0.3f * (float)l);
        const float lam = expf(s1) - expf(s2) + lam_init;
        float ms = 0.f;
#pragma unroll
        for (int d = 0; d < 64; ++d) { O[d] = O[d] * il - lam * Ex[d * 256 + row]; ms += O[d] * O[d]; }
        const float r = rsqrtf(ms * (1.0f / 64.0f) + 1e-5f) * (1.0f - lam_init);
        const float* sg = p.da_subln + l * 64;
#pragma unroll
        for (int d8 = 0; d8 < 8; ++d8) { uint4 o; bf16_t* op = (bf16_t*)&o;
#pragma unroll
            for (int i = 0; i < 8; ++i) op[i] = f2bf(O[d8 * 8 + i] * r * sg[d8 * 8 + i]);
            *(uint4*)(mix + (size_t)t * DM + 256 + h * 64 + d8 * 8) = o; }
    }
}

__device__ __forceinline__ void conv_item(const Params& p, int l, int item) {
    const int tid = otid();
    const bf16_t* proj = (const bf16_t*)(p.ws + WS_PROJ); bf16_t* mix = (bf16_t*)(p.ws + WS_MIX);
    const float* cw = p.sc_conv + (size_t)l * 3 * 256;
    const int c = tid & 255;
    const float w0 = cw[c], w1 = cw[256 + c], w2 = cw[512 + c];
    for (int rr = tid >> 8; rr < 256; rr += 2) {
        const size_t row = (size_t)item * 256 + rr; const int t = (int)(row & (SEQ - 1));
        const bf16_t* pr = proj + row * PINP + 1536;
        const float u2 = bf2f(pr[256 + c]) * bf2f(pr[512 + c]);
        const float u1 = (t >= 1) ? bf2f(pr[256 + c - PINP]) * bf2f(pr[512 + c - PINP]) : 0.f;
        const float u0 = (t >= 2) ? bf2f(pr[256 + c - 2 * PINP]) * bf2f(pr[512 + c - 2 * PINP]) : 0.f;
        mix[row * DM + 512 + c] = f2bf(bf2f(pr[c]) * (w0 * u0 + w1 * u1 + w2 * u2));
    }
}

__device__ __forceinline__ void rwkv_item(const Params& p, int l, int bh, unsigned char* lds) {
    const int tid = otid(), b = bh >> 2, h = bh & 3;
    const bf16_t* proj = (const bf16_t*)(p.ws + WS_PROJ) + (size_t)b * SEQ * PINP + 2304;
    bf16_t* mix = (bf16_t*)(p.ws + WS_MIX) + (size_t)b * SEQ * DM + 768 + h * 64;
    const float* mu = p.rw_mu + (size_t)l * 896;
    const float* vecs = p.rw_vecs + (size_t)l * 7 * 256 + h * 64;
    float* Wup = (float*)lds; float* Aup = Wup + 2048; float* Gup = Aup + 2048;
    float* xr = Gup + 4096; float* xk = xr + 2048; float* xv = xk + 2048;
    float* xw = xv + 2048; float* xa = xw + 1024; float* xg = xa + 1024;
    float* wd = xg + 2048; float* ab = wd + 2048; float* kk = ab + 2048; float* gg = kk + 2048;
    float* yy = gg + 2048;
    float* sm = yy + 2048;
    __syncthreads();
    for (int i = tid; i < 2048; i += NTHREADS) { const int m = i >> 6, c = i & 63; Wup[i] = p.rw_w_up[(size_t)l * 32 * 256 + m * 256 + h * 64 + c]; Aup[i] = p.rw_a_up[(size_t)l * 32 * 256 + m * 256 + h * 64 + c]; }
    for (int i = tid; i < 4096; i += NTHREADS) { const int m = i >> 6, c = i & 63; Gup[i] = p.rw_g_up[(size_t)l * 64 * 256 + m * 256 + h * 64 + c]; }
    const int si = tid >> 3, jc = tid & 7;
    float S[8];
#pragma unroll
    for (int j = 0; j < 8; ++j) S[j] = 0.f;
    for (int t0 = 0; t0 < SEQ; t0 += 32) {
        __syncthreads();
        for (int i = tid; i < 32 * 320; i += NTHREADS) {
            const int tt = i / 320, cc = i % 320; const int t = t0 + tt;
            int col; float* dst;
            if (cc < 64) { col = h * 64 + cc; dst = xr + tt * 64 + cc; }
            else if (cc < 128) { col = 256 + h * 64 + (cc - 64); dst = xk + tt * 64 + (cc - 64); }
            else if (cc < 192) { col = 512 + h * 64 + (cc - 128); dst = xv + tt * 64 + (cc - 128); }
            else if (cc < 224) { col = 768 + (cc - 192); dst = xw + tt * 32 + (cc - 192); }
            else if (cc < 256) { col = 800 + (cc - 224); dst = xa + tt * 32 + (cc - 224); }
            else { col = 832 + (cc - 256); dst = xg + tt * 64 + (cc - 256); }
            const float cur = bf2f(proj[(size_t)t * PINP + col]);
            const float prev = (t > 0) ? bf2f(proj[(size_t)(t - 1) * PINP + col]) : 0.f;
            float v = cur + (prev - cur) * mu[col];
            if (cc >= 192 && cc < 224) v = tanhf(v);
            if (cc >= 256) v = sigmoidf_(v);
            *dst = v;
        }
        __syncthreads();
        for (int i = tid; i < 2048; i += NTHREADS) {
            const int tt = i >> 6, c = i & 63;
            float dec = vecs[0 * 256 + c], av = vecs[1 * 256 + c], g = 0.f;
            for (int m = 0; m < 32; ++m) { dec += xw[tt * 32 + m] * Wup[m * 64 + c]; av += xa[tt * 32 + m] * Aup[m * 64 + c]; }
            for (int m = 0; m < 64; ++m) g += xg[tt * 64 + m] * Gup[m * 64 + c];
            const float a = sigmoidf_(av);
            const float kraw = xk[i];
            wd[i] = expf(-0.6065306597126334f * sigmoidf_(dec));
            ab[i] = a;
            gg[i] = g;
            kk[i] = kraw * vecs[2 * 256 + c];
            xk[i] = kraw * (1.0f + (a - 1.0f) * vecs[3 * 256 + c]);
        }
        __syncthreads();
        if (tid < 32) {
            float s = 0.f, bo = 0.f;
            for (int c = 0; c < 64; ++c) { const float v = kk[tid * 64 + c]; s += v * v; bo += xr[tid * 64 + c] * xk[tid * 64 + c] * vecs[4 * 256 + c]; }
            sm[tid] = 1.0f / fmaxf(sqrtf(s), 1e-12f); sm[96 + tid] = bo;
        }
        __syncthreads();
        for (int i = tid; i < 2048; i += NTHREADS) { const float k2 = kk[i] * sm[i >> 6]; kk[i] = k2; ab[i] = k2 * ab[i]; }
        __syncthreads();
        for (int tt = 0; tt < 32; ++tt) {
            const int o = tt * 64 + jc * 8;
            const float4 k0 = *(const float4*)(kk + o), k1 = *(const float4*)(kk + o + 4);
            const float4 w0 = *(const float4*)(wd + o), w1 = *(const float4*)(wd + o + 4);
            const float4 a0 = *(const float4*)(ab + o), a1 = *(const float4*)(ab + o + 4);
            const float4 p0 = *(const float4*)(xk + o), p1 = *(const float4*)(xk + o + 4);
            const float4 r0 = *(const float4*)(xr + o), r1 = *(const float4*)(xr + o + 4);
            const float vi = xv[tt * 64 + si];
            float sa = S[0] * k0.x + S[1] * k0.y + S[2] * k0.z + S[3] * k0.w + S[4] * k1.x + S[5] * k1.y + S[6] * k1.z + S[7] * k1.w;
            sa += __shfl_xor(sa, 1); sa += __shfl_xor(sa, 2); sa += __shfl_xor(sa, 4);
            sa = -sa;
            S[0] = S[0] * w0.x + sa * a0.x + vi * p0.x; S[1] = S[1] * w0.y + sa * a0.y + vi * p0.y; S[2] = S[2] * w0.z + sa * a0.z + vi * p0.z; S[3] = S[3] * w0.w + sa * a0.w + vi * p0.w;
            S[4] = S[4] * w1.x + sa * a1.x + vi * p1.x; S[5] = S[5] * w1.y + sa * a1.y + vi * p1.y; S[6] = S[6] * w1.z + sa * a1.z + vi * p1.z; S[7] = S[7] * w1.w + sa * a1.w + vi * p1.w;
            float y = S[0] * r0.x + S[1] * r0.y + S[2] * r0.z + S[3] * r0.w + S[4] * r1.x + S[5] * r1.y + S[6] * r1.z + S[7] * r1.w;
            y += __shfl_xor(y, 1); y += __shfl_xor(y, 2); y += __shfl_xor(y, 4);
            if (jc == 0) yy[tt * 64 + si] = y;
        }
        __syncthreads();
        if (tid < 32) {
            float s = 0.f;
            for (int c = 0; c < 64; ++c) s += yy[tid * 64 + c];
            const float mean = s * (1.0f / 64.0f);
            float q = 0.f;
            for (int c = 0; c < 64; ++c) { const float d = yy[tid * 64 + c] - mean; q += d * d; }
            sm[32 + tid] = mean; sm[64 + tid] = rsqrtf(q * (1.0f / 64.0f) + 64e-5f);
        }
        __syncthreads();
        for (int i = tid; i < 2048; i += NTHREADS) {
            const int tt = i >> 6, c = i & 63;
            const float yn = (yy[i] - sm[32 + tt]) * sm[64 + tt] * vecs[5 * 256 + c] + vecs[6 * 256 + c];
            const float o = (yn + sm[96 + tt] * xv[i]) * gg[i];
            mix[(size_t)(t0 + tt) * DM + c] = f2bf(o);
        }
    }
}

__device__ __forceinline__ void phase_mixers(const Params& p, int l, unsigned char* lds) {
    unsigned* ctl = (unsigned*)(p.ws + WS_CTL);
    int* slot = (int*)(lds + LDS_BYTES - 64);
#ifndef NO_RW
    for (int it = obid(); it < 128; it += gridDim.x) rwkv_item(p, l, it, lds);
#endif
    for (;;) {
        __syncthreads();
        if (otid() == 0) *slot = (int)atomicAdd(&ctl[CW_QUEUE + l * 64], 1u);
        __syncthreads();
        const int it = *slot;
        if (it >= 512 + 1024 + 256) break;
        if (it < 512) {
#ifndef NO_SB
            sb_item(p, it & 127, 3 - (it >> 7), lds);
#endif
        } else if (it < 1536) {
#ifndef NO_DA
            const int j = it - 512; da_item(p, l, j & 127, 7 - (j >> 7), lds);
#endif
        } else conv_item(p, l, it - 1536);
    }
}

__global__ void __launch_bounds__(NTHREADS) fwd(Params p) {
    extern __shared__ __attribute__((aligned(16))) unsigned char lds_raw[];
    if (threadIdx.x == 0) { ((unsigned*)lds_raw)[0] = 0u; ((unsigned*)lds_raw)[1] = 0u; ((unsigned*)lds_raw)[2] = 0u; ((unsigned*)lds_raw)[3] = 0u; }
    __syncthreads();
    unsigned char* lds = lds_raw + 16;
    XcdBarrier bar = xcd_barrier_post((unsigned*)(p.ws + WS_CTL) + CW_BAR, (volatile LAS unsigned*)lds_raw);
#ifndef ONLY
#define ONLY -1
#endif
#define PH(k) (ONLY < 0 || ONLY == (k))
    if (PH(0)) prologue(p, lds);
    xcd_barrier(bar);
    for (int l = 0; l < NLAYER; ++l) {
        if (PH(1)) phase_inproj(p, l, lds);
        xcd_barrier(bar);
        if (PH(2)) phase_mixers(p, l, lds);
        xcd_barrier(bar);
        if (PH(3)) phase_outproj(p, l, lds);
        xcd_barrier(bar);
        if (PH(4)) phase_ln1_route(p, l, lds);
        xcd_barrier(bar);
        if (PH(5)) phase_moe_up(p, l, lds);
        xcd_barrier(bar);
        if (PH(6)) phase_moe_down(p, l, lds);
        xcd_barrier(bar);
        if (PH(7)) phase_ln2(p, l);
        xcd_barrier(bar);
    }
}

extern "C" void kernel_launch(void* const* d_in, const int* in_sizes, int n_in, void* d_out, int out_size, void* d_ws, size_t ws_size, hipStream_t stream) {
    static int grid = 0;
    if (grid == 0) {
        if (n_in != 18 || in_sizes[0] != NTOK * DM || out_size != NTOK * DM || ws_size < WS_END) {
            fprintf(stderr, "kernel_launch: unexpected shapes: n_in %d in0 %d out %d ws %zu (need %llu)\n", n_in, n_in > 0 ? in_sizes[0] : -1, out_size, ws_size, (unsigned long long)WS_END);
            grid = -1; return;
        }
        int dev = 0, cus = 0, per_cu = 0;
        hipGetDevice(&dev);
        hipDeviceGetAttribute(&cus, hipDeviceAttributeMultiprocessorCount, dev);
        hipFuncSetAttribute((const void*)fwd, hipFuncAttributeMaxDynamicSharedMemorySize, LDS_BYTES);
        hipOccupancyMaxActiveBlocksPerMultiprocessor(&per_cu, (const void*)fwd, NTHREADS, LDS_BYTES);
        if (per_cu < 1) { fprintf(stderr, "kernel_launch: occupancy query says %d blocks per CU\n", per_cu); grid = -1; return; }
        grid = cus;
    }
    if (grid < 0) return;
    Params p{};
    p.x = (const float*)d_in[0]; p.w_in = (const float*)d_in[1]; p.w_out = (const float*)d_in[2]; p.da_lambda = (const float*)d_in[3]; p.da_subln = (const float*)d_in[4];
    p.sc_conv = (const float*)d_in[5]; p.rw_mu = (const float*)d_in[6]; p.rw_vecs = (const float*)d_in[7]; p.rw_w_up = (const float*)d_in[8]; p.rw_a_up = (const float*)d_in[9];
    p.rw_g_up = (const float*)d_in[10]; p.ln_gain = (const float*)d_in[11]; p.ln_bias = (const float*)d_in[12]; p.rel_bias = (const float*)d_in[13]; p.router_w = (const float*)d_in[14];
    p.router_b = (const float*)d_in[15]; p.moe_w_in = (const float*)d_in[16]; p.moe_w_down = (const float*)d_in[17];
    p.out = (float*)d_out; p.ws = (unsigned char*)d_ws;
    hipMemsetAsync((char*)d_ws + WS_CTL, 0, CTL_BYTES, stream);
    hipLaunchKernelGGL(fwd, dim3(grid), dim3(NTHREADS), LDS_BYTES, stream, p);
}
```

```cpp
#include <hip/hip_runtime.h>
#include <cstdio>
#include <cstdint>

typedef unsigned short bf16_t;
typedef short bf16x8 __attribute__((ext_vector_type(8)));
typedef float f32x4 __attribute__((ext_vector_type(4)));

#define NTOK 65536
#define SEQ 2048
#define DM 1024
#define PIN 3200
#define PINP 3328
#define NLAYER 4
#define NEXP 16
#define DEXP 256
#define NTHREADS 512
#define LDS_BYTES (136 * 1024)
#define ALPHA 1.6817928305074292f

#define WS_CTL 0ull
#define CTL_BYTES 65536ull
#define WS_BIASD (WS_CTL + CTL_BYTES)
#define WS_WIN (WS_BIASD + 4ull * 2048 * 4)
#define WS_WOUT (WS_WIN + 4ull * PINP * DM * 2)
#define WS_MWIN (WS_WOUT + 4ull * DM * DM * 2)
#define WS_MWDN (WS_MWIN + 4ull * 16 * 512 * 1024 * 2)
#define WS_XB (WS_MWDN + 4ull * 16 * 1024 * 256 * 2)
#define WS_MIX (WS_XB + (unsigned long long)NTOK * DM * 2)
#define WS_LTOK (WS_MIX + (unsigned long long)NTOK * DM * 2)
#define WS_LGATE (WS_LTOK + 16ull * NTOK * 4)
#define WS_PROJ (WS_LGATE + 16ull * NTOK * 4)
#define WS_Y WS_PROJ
#define WS_H (WS_Y + (unsigned long long)NTOK * 2 * DM * 2)
#define WS_END (WS_PROJ + (unsigned long long)NTOK * PINP * 2)

#define CW_BAR 0
#define CW_CNT 4096
#define CW_QUEUE 8192

#define XB_TMO      128
#define XB_XCNT(j)  (256  + 64 * (j))
#define XB_XSUB(j)  (1280 + 64 * (j))
#define XB_XGEN(j)  (2304 + 64 * (j))
#define XB_TOP      3328
#define XB_TOPGEN   3392
#define XCD_BAR_WORDS 3456
#define XB_SPIN_CAP (1u << 22)
#define LAS __attribute__((address_space(3)))

__device__ __forceinline__ unsigned xb_ld(unsigned* p)              { return __hip_atomic_load(p, __ATOMIC_RELAXED, __HIP_MEMORY_SCOPE_AGENT); }
__device__ __forceinline__ unsigned xb_add(unsigned* p, unsigned v) { return __hip_atomic_fetch_add(p, v, __ATOMIC_RELAXED, __HIP_MEMORY_SCOPE_AGENT); }
__device__ __forceinline__ unsigned xb_xcc_id() { return (unsigned)__builtin_amdgcn_s_getreg((3 << 11) | 20) & 0xFu; }
#define XB_SPIN(cond, bar) do { unsigned _sp = 0; while (cond) { __builtin_amdgcn_s_sleep(1); \
    if ((++_sp & 255u) == 0u) { if (xb_ld(&(bar)[XB_TMO])) break; if (_sp > XB_SPIN_CAP) { atomicAdd(&(bar)[XB_TMO], 1u); break; } } } } while (0)

struct XcdBarrier { unsigned* bar; unsigned x; volatile LAS unsigned* st; };

__device__ __forceinline__ XcdBarrier xcd_barrier_post(unsigned* bar, volatile LAS unsigned* st) {
    XcdBarrier b; b.bar = bar; b.x = xb_xcc_id(); b.st = st;
    if (threadIdx.x == 0) (void)xb_add(&bar[XB_XCNT(b.x)], 1u);
    return b;
}
__device__ __forceinline__ void xcd_barrier_complete(unsigned* bar, unsigned x, unsigned& nloc, unsigned& nx) {
    const unsigned G = gridDim.x * gridDim.y * gridDim.z;
    unsigned sum, cnt, mine, sp = 0u;
    for (;;) {
        sum = 0u; cnt = 0u; mine = 0u;
#pragma unroll
        for (unsigned j = 0; j < 16; ++j) { const unsigned c = xb_ld(&bar[XB_XCNT(j)]); sum += c; cnt += (c > 0u) ? 1u : 0u; mine = (j == x) ? c : mine; }
        if (sum == G) break;
        __builtin_amdgcn_s_sleep(1);
        if ((++sp & 255u) == 0u) { if (xb_ld(&bar[XB_TMO])) break; if (sp > XB_SPIN_CAP) { atomicAdd(&bar[XB_TMO], 1u); break; } }
    }
    nloc = mine > 0u ? mine : 1u; nx = cnt > 0u ? cnt : 1u;
}
__device__ __forceinline__ void xcd_barrier(const XcdBarrier& b) {
    asm volatile("s_waitcnt vmcnt(0)" ::: "memory");
    __syncthreads();
    if (threadIdx.x == 0) {
        unsigned* bar = b.bar;
        __builtin_amdgcn_s_waitcnt(0);
        unsigned nloc = b.st[0], nx = b.st[1];
        if (nloc == 0u) { xcd_barrier_complete(bar, b.x, nloc, nx); b.st[0] = nloc; b.st[1] = nx; }
        const unsigned old = xb_add(&bar[XB_XSUB(b.x)], 1u);
        const unsigned gen = old / nloc;
        if (old + 1u == (gen + 1u) * nloc) {
            __builtin_amdgcn_fence(__ATOMIC_RELEASE, "agent");
            asm volatile("s_waitcnt vmcnt(0)" ::: "memory");
            const unsigned og = xb_add(&bar[XB_TOP], 1u);
            const unsigned tg = og / nx;
            if (og + 1u == (tg + 1u) * nx) xb_add(&bar[XB_TOPGEN], 1u);
            else XB_SPIN(xb_ld(&bar[XB_TOPGEN]) == tg, bar);
            __builtin_amdgcn_fence(__ATOMIC_ACQUIRE, "agent");
            xb_add(&bar[XB_XGEN(b.x)], 1u);
            asm volatile("s_waitcnt vmcnt(0)" ::: "memory");
        } else {
            XB_SPIN(xb_ld(&bar[XB_XGEN(b.x)]) == gen, bar);
            __builtin_amdgcn_fence(__ATOMIC_ACQUIRE, "agent");
            asm volatile("s_waitcnt vmcnt(0)" ::: "memory");
        }
    }
    __syncthreads();
}

__device__ __forceinline__ int otid() { int t = threadIdx.x; asm volatile("" : "+v"(t)); return t; }
__device__ __forceinline__ int obid() { int t = blockIdx.x; asm volatile("" : "+s"(t)); return t; }
__device__ __forceinline__ float bf2f(bf16_t v) { return __uint_as_float(((unsigned)v) << 16); }
__device__ __forceinline__ bf16_t f2bf(float f) { unsigned u = __float_as_uint(f); u += 0x7fffu + ((u >> 16) & 1u); return (bf16_t)(u >> 16); }
__device__ __forceinline__ float sigmoidf_(float x) { return 1.0f / (1.0f + expf(-x)); }
__device__ __forceinline__ float wave_sum(float v) {
#pragma unroll
    for (int o = 32; o >= 1; o >>= 1) v += __shfl_xor(v, o);
    return v;
}

struct Params {
    const float* x; const float* w_in; const float* w_out; const float* da_lambda; const float* da_subln; const float* sc_conv;
    const float* rw_mu; const float* rw_vecs; const float* rw_w_up; const float* rw_a_up; const float* rw_g_up;
    const float* ln_gain; const float* ln_bias; const float* rel_bias; const float* router_w; const float* router_b;
    const float* moe_w_in; const float* moe_w_down;
    float* out; unsigned char* ws;
};

namespace pg8 {
#define PG8_LAS __attribute__((address_space(3)))
typedef unsigned short bf16_t;
typedef short bf16x8 __attribute__((ext_vector_type(8)));
typedef float f32x4 __attribute__((ext_vector_type(4)));
typedef unsigned u32x4 __attribute__((ext_vector_type(4)));
constexpr int BM = 256, BK = 64, HALF = 128, HTB = HALF * BK * 2  , STAGE_BYTES = 8 * HTB, NXCD = 8, WGM = 8;

__host__ __device__ __forceinline__ int lds_byte(int r, int c) { const int st = (r >> 4) * 2 + (c >> 5), rr = r & 15, cc = c & 31, ob = rr * 64 + cc * 2; return st * 1024 + (ob ^ (((ob >> 9) & 1) << 5)); }
__host__ __device__ __forceinline__ void stage_rc(int b, int& R, int& C) { const int st = b / 1024, sb = b % 1024, swz = sb ^ (((sb >> 9) & 1) << 5); R = (st >> 1) * 16 + swz / 64; C = (st & 1) * 32 + (swz % 64) / 2; }
__host__ __device__ __forceinline__ int perm32(int rho) { const int n = rho >> 4, i = rho & 15; return 8 * (i >> 2) + 4 * n + (i & 3); }

struct Unit { int pm, pn; };
struct Gemm { const bf16_t* A; const bf16_t* Bt; int M, N, K; };

struct StaticOrder {
    int nM, nN, nwg, G, c;
    __host__ __device__ void init(int M, int N, int G_, int c_) { nM = M / BM; nN = N / BM; nwg = nM * nN; G = G_; c = c_; }
    __host__ __device__ bool next(int i, Unit& u) const {
        const long L = (long)i * G + c; if (L >= nwg) return false;
        int wgid = (int)L; { const int q = nwg / NXCD, r = nwg % NXCD, xcd = wgid % NXCD, off = wgid / NXCD; wgid = (xcd < r ? xcd * (q + 1) : r * (q + 1) + (xcd - r) * q) + off; }
        const int nig = WGM * nN, gid = wgid / nig, fm = gid * WGM, gsz = (nM - fm) < WGM ? (nM - fm) : WGM;
        u.pm = fm + ((wgid % nig) % gsz); u.pn = (wgid % nig) / gsz; return true;
    }
    __device__ __forceinline__ void a_ready(const Unit&) const {}
    __device__ __forceinline__ void done(const Unit&) const {}
};
__device__ __forceinline__ unsigned cvt_pk_bf16(float lo, float hi) { unsigned r; asm volatile("v_cvt_pk_bf16_f32 %0, %1, %2" : "=v"(r) : "v"(lo), "v"(hi)); return r; }
template <class Epi, class Sched, bool ALIGN_EPI = false, bool SP2 = false>
__device__ __forceinline__ void gemm_phase(PG8_LAS unsigned char* lds, const Gemm g, const Sched& S, const Epi& E) {
    const int tid = otid(), wid = __builtin_amdgcn_readfirstlane(tid >> 6), lane = tid & 63, wr = wid >> 2, wc = wid & 3, fr = lane & 15, fq = lane >> 4;
    const int K = g.K, nt = K / BK;
    unsigned voffA[2], voffB[2];
#pragma unroll
    for (int i = 0; i < 2; ++i) { int R, C; stage_rc(tid * 16 + i * 8192, R, C); const int Rb = Epi::PERM ? ((R & ~31) + perm32(R & 31)) : R;
        voffA[i] = (unsigned)(R * K + C) * 2u; voffB[i] = (unsigned)(Rb * K + C) * 2u; }
    const size_t kstep = (size_t)(BK * 2);
    const size_t hstep = (size_t)HALF * K * 2;
    const size_t tstep = 2 * hstep;
    const unsigned ldsw = (unsigned)wid * 1024u;
    const int aoff = lds_byte(wr * 64 + fr, fq * 8), boff = lds_byte(wc * 32 + fr, fq * 8);
#define PG8_SA(b, h) (((b) * 2 + (h)) * HTB)
#define PG8_SB(b, h) ((4 + (b) * 2 + (h)) * HTB)
#define PG8_STAGE(bufoff, gbase, voff) do { _Pragma("unroll") for (int _i = 0; _i < 2; ++_i) \
        __builtin_amdgcn_global_load_lds((const unsigned*)((const char*)(gbase) + (voff)[_i]), (PG8_LAS unsigned*)(lds + (bufoff) + ldsw + _i * 8192), 16, 0, 0); } while (0)
#define PG8_LDA(dst, b, h) do { _Pragma("unroll") for (int m = 0; m < 4; ++m) _Pragma("unroll") for (int k = 0; k < 2; ++k) dst[m][k] = *(const PG8_LAS bf16x8*)(lds + PG8_SA(b, h) + aoff + m * 2048 + k * 1024); } while (0)
#define PG8_LDB(dst, b, h) do { _Pragma("unroll") for (int n = 0; n < 2; ++n) _Pragma("unroll") for (int k = 0; k < 2; ++k) dst[n][k] = *(const PG8_LAS bf16x8*)(lds + PG8_SB(b, h) + boff + n * 2048 + k * 1024); } while (0)
#define PG8_MMA(ai, bj, At, Bt) do { __builtin_amdgcn_s_setprio(1); _Pragma("unroll") for (int m = 0; m < 4; ++m) _Pragma("unroll") for (int n = 0; n < 2; ++n) _Pragma("unroll") for (int k = 0; k < 2; ++k) \
        acc[ai][bj][m][n] = __builtin_amdgcn_mfma_f32_16x16x32_bf16(Bt[n][k], At[m][k], acc[ai][bj][m][n], 0, 0, 0); __builtin_amdgcn_s_setprio(0); } while (0)
#define PG8_WAIT_V(n) asm volatile("s_waitcnt vmcnt(" #n ")" ::: "memory")
#define PG8_WAIT_L(n) asm volatile("s_waitcnt lgkmcnt(" #n ")" ::: "memory")
#define PG8_BAR __builtin_amdgcn_s_barrier()
#define PG8_SCHED __builtin_amdgcn_sched_barrier(0)
    Unit cur, nxt; int ui = 0;
    if (!S.next(0, cur)) return;
    f32x4 acc[2][2][4][2];
#pragma unroll
    for (int a = 0; a < 2; ++a)
#pragma unroll
        for (int b = 0; b < 2; ++b)
#pragma unroll
            for (int m = 0; m < 4; ++m)
#pragma unroll
                for (int n = 0; n < 2; ++n) acc[a][b][m][n] = (f32x4){0.f, 0.f, 0.f, 0.f};
    bf16x8 At[4][2], B0[2][2], B1[2][2];
    const char* cA = (const char*)g.A + (size_t)cur.pm * tstep; const char* cB = (const char*)g.Bt + (size_t)cur.pn * tstep;
    S.a_ready(cur);
    if constexpr (SP2) {
        PG8_STAGE(PG8_SB(0, 0), cB, voffB); PG8_STAGE(PG8_SB(0, 1), cB + hstep, voffB); PG8_STAGE(PG8_SA(0, 0), cA, voffA); PG8_STAGE(PG8_SA(0, 1), cA + hstep, voffA);
        if (wr == 1) PG8_BAR;
        PG8_WAIT_V(2); PG8_BAR;
        PG8_STAGE(PG8_SB(1, 0), cB + kstep, voffB); PG8_STAGE(PG8_SA(1, 0), cA + kstep, voffA); PG8_STAGE(PG8_SB(1, 1), cB + hstep + kstep, voffB);
        PG8_WAIT_V(6); PG8_BAR;
    } else {
        PG8_STAGE(PG8_SB(0, 0), cB, voffB); PG8_STAGE(PG8_SA(0, 0), cA, voffA); PG8_STAGE(PG8_SB(0, 1), cB + hstep, voffB); PG8_STAGE(PG8_SA(0, 1), cA + hstep, voffA);
        if (wr == 1) PG8_BAR;
        PG8_WAIT_V(4); PG8_BAR;
        PG8_STAGE(PG8_SB(1, 0), cB + kstep, voffB); PG8_STAGE(PG8_SA(1, 0), cA + kstep, voffA); PG8_STAGE(PG8_SB(1, 1), cB + hstep + kstep, voffB);
        PG8_WAIT_V(6); PG8_BAR;
    }
    for (;;) {
        const bool has_next = S.next(ui + 1, nxt);
        const char* nA = has_next ? (const char*)g.A + (size_t)nxt.pm * tstep : cA; const char* nB = has_next ? (const char*)g.Bt + (size_t)nxt.pn * tstep : cB;
        for (int t = 0; t < nt; t += 2) {
            const bool last = (t == nt - 2);
            const char* a1 = cA + (size_t)(t + 1) * kstep;
            const char* a2 = last ? nA : cA + (size_t)(t + 2) * kstep; const char* b2 = last ? nB : cB + (size_t)(t + 2) * kstep;
            const char* a3 = a2 + kstep; const char* b3 = b2 + kstep;
            if (last && has_next) S.a_ready(nxt);
            if constexpr (SP2) {
            PG8_LDB(B0, 0, 0); PG8_LDB(B1, 0, 1); PG8_SCHED; PG8_LDA(At, 0, 0); PG8_STAGE(PG8_SA(1, 1), a1 + hstep, voffA);
            PG8_WAIT_V(8); PG8_WAIT_L(0); PG8_BAR; PG8_MMA(0, 0, At, B0); PG8_MMA(0, 1, At, B1); PG8_BAR; PG8_SCHED;
            PG8_LDA(At, 0, 1); PG8_STAGE(PG8_SB(0, 0), b2, voffB); PG8_STAGE(PG8_SB(0, 1), b2 + hstep, voffB); PG8_STAGE(PG8_SA(0, 0), a2, voffA);
            PG8_WAIT_V(8); PG8_WAIT_L(0); PG8_BAR; PG8_MMA(1, 0, At, B0); PG8_MMA(1, 1, At, B1); PG8_BAR; PG8_SCHED;
            PG8_LDB(B0, 1, 0); PG8_LDB(B1, 1, 1); PG8_SCHED; PG8_LDA(At, 1, 0); PG8_STAGE(PG8_SA(0, 1), a2 + hstep, voffA);
            PG8_WAIT_V(8); PG8_WAIT_L(0); PG8_BAR; PG8_MMA(0, 0, At, B0); PG8_MMA(0, 1, At, B1); PG8_BAR; PG8_SCHED;
            PG8_LDA(At, 1, 1); PG8_STAGE(PG8_SB(1, 0), b3, voffB); PG8_STAGE(PG8_SB(1, 1), b3 + hstep, voffB); PG8_STAGE(PG8_SA(1, 0), a3, voffA);
            PG8_WAIT_V(8); PG8_WAIT_L(0); PG8_BAR; PG8_MMA(1, 0, At, B0); PG8_MMA(1, 1, At, B1); PG8_BAR; PG8_SCHED;
            } else {
            PG8_LDB(B0, 0, 0); PG8_SCHED; PG8_LDA(At, 0, 0); PG8_STAGE(PG8_SA(1, 1), a1 + hstep, voffA);
            PG8_WAIT_L(8); PG8_BAR; PG8_WAIT_L(0); PG8_MMA(0, 0, At, B0); PG8_BAR; PG8_SCHED;
            PG8_LDB(B1, 0, 1); PG8_STAGE(PG8_SB(0, 0), b2, voffB);
            PG8_BAR; PG8_WAIT_L(0); PG8_MMA(0, 1, At, B1); PG8_BAR;
            PG8_LDA(At, 0, 1); PG8_STAGE(PG8_SA(0, 0), a2, voffA);
            PG8_BAR; PG8_WAIT_L(0); PG8_MMA(1, 0, At, B0); PG8_BAR; PG8_SCHED;
            PG8_STAGE(PG8_SB(0, 1), b2 + hstep, voffB);
            PG8_WAIT_V(6); PG8_BAR; PG8_MMA(1, 1, At, B1); PG8_BAR;
            PG8_LDB(B0, 1, 0); PG8_SCHED; PG8_LDA(At, 1, 0); PG8_STAGE(PG8_SA(0, 1), a2 + hstep, voffA);
            PG8_WAIT_L(8); PG8_BAR; PG8_WAIT_L(0); PG8_MMA(0, 0, At, B0); PG8_BAR; PG8_SCHED;
            PG8_LDB(B1, 1, 1); PG8_STAGE(PG8_SB(1, 0), b3, voffB);
            PG8_BAR; PG8_WAIT_L(0); PG8_MMA(0, 1, At, B1); PG8_BAR;
            PG8_LDA(At, 1, 1); PG8_STAGE(PG8_SA(1, 0), a3, voffA);
            PG8_BAR; PG8_WAIT_L(0); PG8_MMA(1, 0, At, B0); PG8_BAR; PG8_SCHED;
            PG8_STAGE(PG8_SB(1, 1), b3 + hstep, voffB);
            PG8_WAIT_V(6); PG8_BAR; PG8_MMA(1, 1, At, B1); PG8_BAR;
            }
        }
        if constexpr (ALIGN_EPI) { if (wr == 0) PG8_BAR; }
        if constexpr (!Epi::AFTER_DRAIN) { E(acc, cur, wr, wc, fr, fq); S.done(cur); }
        if (!has_next) break;
#pragma unroll
        for (int a = 0; a < 2; ++a)
#pragma unroll
            for (int b = 0; b < 2; ++b)
#pragma unroll
                for (int m = 0; m < 4; ++m)
#pragma unroll
                    for (int n = 0; n < 2; ++n) acc[a][b][m][n] = (f32x4){0.f, 0.f, 0.f, 0.f};
        cur = nxt; cA = nA; cB = nB; ++ui;
        if constexpr (ALIGN_EPI) { if (wr == 1) PG8_BAR; }
    }
    PG8_WAIT_V(0);
    if constexpr (!ALIGN_EPI) { if (wr == 0) PG8_BAR; }
    PG8_BAR;
    if constexpr (Epi::AFTER_DRAIN) { E.fused(acc, cur, wr, wc, fr, fq, lds, wid, lane); S.done(cur); }
#undef PG8_SA
#undef PG8_SB
#undef PG8_STAGE
#undef PG8_LDA
#undef PG8_LDB
#undef PG8_MMA
#undef PG8_WAIT_V
#undef PG8_WAIT_L
#undef PG8_BAR
#undef PG8_SCHED
}
}

template <int MODE>
__device__ __forceinline__ void transpose_tile(const float* __restrict__ src, bf16_t* __restrict__ dst, int K, int N, int k0, int n0, float* tile  ) {
    const int tid = otid();
    const int c = tid & 63, r0 = tid >> 6;
    __syncthreads();
    if (n0 < N) {
#pragma unroll
        for (int i = 0; i < 8; ++i) { const int kk = r0 + i * 8; tile[kk * 65 + c] = src[(size_t)(k0 + kk) * N + n0 + c]; }
    } else {
#pragma unroll
        for (int i = 0; i < 8; ++i) { const int kk = r0 + i * 8; tile[kk * 65 + c] = 0.f; }
    }
    __syncthreads();
#pragma unroll
    for (int i = 0; i < 8; ++i) {
        const int nn = r0 + i * 8; int n = n0 + nn;
        if (MODE == 1) { const int j = n & 255; const int isu = n >> 8; n = (j >> 4) * 32 + isu * 16 + (j & 15); }
        dst[(size_t)n * K + k0 + c] = f2bf(tile[c * 65 + nn]);
    }
}

__device__ __forceinline__ void prologue(const Params& p, unsigned char* lds) {
    float* tile = (float*)lds;
    const int G = gridDim.x, w = obid(), tid = otid();
    bf16_t* win = (bf16_t*)(p.ws + WS_WIN); bf16_t* wout = (bf16_t*)(p.ws + WS_WOUT);
    bf16_t* mwin = (bf16_t*)(p.ws + WS_MWIN); bf16_t* mwdn = (bf16_t*)(p.ws + WS_MWDN);
    for (int it = w; it < 4 * 16 * 52; it += G) { const int l = it / (16 * 52), r = it % (16 * 52), kt = r / 52, nt = r % 52;
        transpose_tile<0>(p.w_in + (size_t)l * DM * PIN, win + (size_t)l * PINP * DM, DM, PIN, kt * 64, nt * 64, tile); }
    for (int it = w; it < 4 * 16 * 16; it += G) { const int l = it / 256, r = it % 256, kt = r / 16, nt = r % 16;
        transpose_tile<0>(p.w_out + (size_t)l * DM * DM, wout + (size_t)l * DM * DM, DM, DM, kt * 64, nt * 64, tile); }
    for (int it = w; it < 64 * 16 * 8; it += G) { const int le = it / 128, r = it % 128, kt = r / 8, nt = r % 8;
        transpose_tile<1>(p.moe_w_in + (size_t)le * 1024 * 512, mwin + (size_t)le * 512 * 1024, 1024, 512, kt * 64, nt * 64, tile); }
    for (int it = w; it < 64 * 4 * 16; it += G) { const int le = it / 64, r = it % 64, kt = r / 16, nt = r % 16;
        transpose_tile<0>(p.moe_w_down + (size_t)le * 256 * 1024, mwdn + (size_t)le * 1024 * 256, 256, 1024, kt * 64, nt * 64, tile); }
    {
        bf16_t* xb = (bf16_t*)(p.ws + WS_XB);
        const size_t n4 = (size_t)NTOK * DM / 4;
        for (size_t i = (size_t)w * NTHREADS + tid; i < n4; i += (size_t)G * NTHREADS) {
            const float4 v = ((const float4*)p.x)[i];
            ushort4 o; o.x = f2bf(v.x); o.y = f2bf(v.y); o.z = f2bf(v.z); o.w = f2bf(v.w);
            ((ushort4*)xb)[i] = o;
        }
    }
    {
        float* bd = (float*)(p.ws + WS_BIASD);
        for (int i = w * NTHREADS + tid; i < 4 * 2048; i += G * NTHREADS) {
            const int h = i >> 11, n = i & 2047;
            int bucket;
            if (n < 16) bucket = n;
            else { const float nf = (float)n; int lg = 16 + (int)(logf(nf / 16.0f) / 2.0794415416798357f * 16.0f); bucket = lg < 31 ? lg : 31; }
            bd[i] = p.rel_bias[bucket * 4 + h];
        }
    }
}

template <class ARow, class Epi>
__device__ __forceinline__ void gemm128(unsigned char* lds, const ARow& arow, const bf16_t* __restrict__ bt, int K, const Epi& epi) {
    const int tid = otid(), lane = tid & 63, wid = tid >> 6, wm = wid >> 1, wn = wid & 1;
    const int lr = tid >> 2, lc = (tid & 3) * 8;
    bf16_t* As = (bf16_t*)lds; bf16_t* Bs = (bf16_t*)(lds + 10240);
    const bf16_t* ap = arow(lr) + lc;
    const bf16_t* bp = bt + (size_t)lr * K + lc;
    f32x4 acc[2][4];
#pragma unroll
    for (int m = 0; m < 2; ++m)
#pragma unroll
        for (int n = 0; n < 4; ++n) acc[m][n] = (f32x4){0.f, 0.f, 0.f, 0.f};
    uint4 ra = *(const uint4*)ap, rb = *(const uint4*)bp;
    const int fr = lane & 15, fq = lane >> 4;
    for (int k0 = 0; k0 < K; k0 += 32) {
        __syncthreads();
        *(uint4*)(As + lr * 40 + lc) = ra;
        *(uint4*)(Bs + lr * 40 + lc) = rb;
        __syncthreads();
        if (k0 + 32 < K) { ra = *(const uint4*)(ap + k0 + 32); rb = *(const uint4*)(bp + k0 + 32); }
        bf16x8 a[2], b[4];
#pragma unroll
        for (int m = 0; m < 2; ++m) a[m] = *(const bf16x8*)(As + (wm * 32 + m * 16 + fr) * 40 + fq * 8);
#pragma unroll
        for (int n = 0; n < 4; ++n) b[n] = *(const bf16x8*)(Bs + (wn * 64 + n * 16 + fr) * 40 + fq * 8);
#pragma unroll
        for (int m = 0; m < 2; ++m)
#pragma unroll
            for (int n = 0; n < 4; ++n) acc[m][n] = __builtin_amdgcn_mfma_f32_16x16x32_bf16(a[m], b[n], acc[m][n], 0, 0, 0);
    }
    epi(acc, wm, wn, lane);
}

struct RowContig { const bf16_t* base; int ld; __device__ __forceinline__ const bf16_t* operator()(int r) const { return base + (size_t)r * ld; } };

struct EpiProjP {
    static constexpr bool PERM = true, AFTER_DRAIN = false;
    bf16_t* O;
    __device__ __forceinline__ void operator()(const pg8::f32x4 (&acc)[2][2][4][2], const pg8::Unit& u, int wr, int wc, int fr, int fq) const {
        const int row0 = u.pm * 256 + wr * 64 + fr, col0 = u.pn * 256 + wc * 32 + 8 * fq;
#pragma unroll
        for (int ai = 0; ai < 2; ++ai)
#pragma unroll
            for (int m = 0; m < 4; ++m) { bf16_t* rowp = O + (size_t)(row0 + ai * 128 + m * 16) * PINP + col0;
#pragma unroll
                for (int bj = 0; bj < 2; ++bj) { const pg8::f32x4 v0 = acc[ai][bj][m][0], v1 = acc[ai][bj][m][1];
                    pg8::u32x4 w; w.x = pg8::cvt_pk_bf16(v0[0], v0[1]); w.y = pg8::cvt_pk_bf16(v0[2], v0[3]); w.z = pg8::cvt_pk_bf16(v1[0], v1[1]); w.w = pg8::cvt_pk_bf16(v1[2], v1[3]);
                    *(pg8::u32x4*)(rowp + bj * 128) = w; } }
    }
};
__device__ __forceinline__ void phase_inproj(const Params& p, int l, unsigned char* lds) {
    pg8::Gemm g{(const bf16_t*)(p.ws + WS_XB), (const bf16_t*)(p.ws + WS_WIN) + (size_t)l * PINP * DM, NTOK, PINP, DM};
    pg8::StaticOrder S; S.init(NTOK, PINP, (int)gridDim.x, obid());
    EpiProjP E{(bf16_t*)(p.ws + WS_PROJ)};
    pg8::gemm_phase<EpiProjP, pg8::StaticOrder, true, true>((PG8_LAS unsigned char*)lds, g, S, E);
}

struct EpiOutP {
    static constexpr bool PERM = false, AFTER_DRAIN = false;
    const float* xin; float* out;
    __device__ __forceinline__ void operator()(const pg8::f32x4 (&acc)[2][2][4][2], const pg8::Unit& u, int wr, int wc, int fr, int fq) const {
        const int row0 = u.pm * 256 + wr * 64 + fr, col0 = u.pn * 256 + wc * 32 + 4 * fq;
#pragma unroll
        for (int ai = 0; ai < 2; ++ai)
#pragma unroll
            for (int m = 0; m < 4; ++m) { const size_t ro = (size_t)(row0 + ai * 128 + m * 16) * DM + col0;
#pragma unroll
                for (int bj = 0; bj < 2; ++bj)
#pragma unroll
                    for (int n = 0; n < 2; ++n) { const size_t o = ro + bj * 128 + n * 16; const pg8::f32x4 xv = *(const pg8::f32x4*)(xin + o);
                        *(pg8::f32x4*)(out + o) = xv * ALPHA + acc[ai][bj][m][n]; } }
    }
};
__device__ __forceinline__ void phase_outproj(const Params& p, int l, unsigned char* lds) {
    pg8::Gemm g{(const bf16_t*)(p.ws + WS_MIX), (const bf16_t*)(p.ws + WS_WOUT) + (size_t)l * DM * DM, NTOK, DM, DM};
    pg8::StaticOrder S; S.init(NTOK, DM, (int)gridDim.x, obid());
    EpiOutP E{(l == 0) ? p.x : p.out, p.out};
    pg8::gemm_phase<EpiOutP, pg8::StaticOrder, true, true>((PG8_LAS unsigned char*)lds, g, S, E);
}

__device__ __forceinline__ void ln_row(float (&v)[16], const float* gain, const float* bias, int lane) {
    float s = 0.f;
#pragma unroll
    for (int i = 0; i < 16; ++i) s += v[i];
    s = wave_sum(s);
    const float mean = s * (1.0f / 1024.0f);
    float q = 0.f;
#pragma unroll
    for (int i = 0; i < 16; ++i) { const float d = v[i] - mean; q += d * d; }
    q = wave_sum(q);
    const float rstd = rsqrtf(q * (1.0f / 1024.0f) + 1e-5f);
#pragma unroll
    for (int j = 0; j < 4; ++j) {
        const float4 g = *(const float4*)(gain + j * 256 + lane * 4), b = *(const float4*)(bias + j * 256 + lane * 4);
        v[j * 4 + 0] = (v[j * 4 + 0] - mean) * rstd * g.x + b.x; v[j * 4 + 1] = (v[j * 4 + 1] - mean) * rstd * g.y + b.y;
        v[j * 4 + 2] = (v[j * 4 + 2] - mean) * rstd * g.z + b.z; v[j * 4 + 3] = (v[j * 4 + 3] - mean) * rstd * g.w + b.w;
    }
}
__device__ __forceinline__ void store_row(const float (&v)[16], float* xo, bf16_t* xbo, int lane) {
#pragma unroll
    for (int j = 0; j < 4; ++j) {
        *(float4*)(xo + j * 256 + lane * 4) = make_float4(v[j * 4], v[j * 4 + 1], v[j * 4 + 2], v[j * 4 + 3]);
        ushort4 o; o.x = f2bf(v[j * 4]); o.y = f2bf(v[j * 4 + 1]); o.z = f2bf(v[j * 4 + 2]); o.w = f2bf(v[j * 4 + 3]);
        *(ushort4*)(xbo + j * 256 + lane * 4) = o;
    }
}

__device__ __forceinline__ void phase_ln1_route(const Params& p, int l, unsigned char* lds) {
    const int tid = otid(), lane = tid & 63, wid = tid >> 6;
    int* sel_e = (int*)lds;
    float* sel_g = (float*)(lds + 2048);
    int* rank = (int*)(lds + 4096);
    int* base = (int*)(lds + 6144);
    bf16_t* xb = (bf16_t*)(p.ws + WS_XB);
    unsigned* ctl = (unsigned*)(p.ws + WS_CTL);
    int* ltok = (int*)(p.ws + WS_LTOK); float* lgate = (float*)(p.ws + WS_LGATE);
    const float* gain = p.ln_gain + (size_t)(l * 2 + 0) * DM; const float* bias = p.ln_bias + (size_t)(l * 2 + 0) * DM;
    for (int chunk = obid(); chunk < NTOK / 256; chunk += gridDim.x) {
        __syncthreads();
        for (int rr = 0; rr < 32; ++rr) {
            const int lrow = wid * 32 + rr; const size_t row = (size_t)chunk * 256 + lrow;
            float v[16];
#pragma unroll
            for (int j = 0; j < 4; ++j) { const float4 t = *(const float4*)(p.out + row * DM + j * 256 + lane * 4); v[j * 4] = t.x; v[j * 4 + 1] = t.y; v[j * 4 + 2] = t.z; v[j * 4 + 3] = t.w; }
            ln_row(v, gain, bias, lane);
            store_row(v, p.out + row * DM, xb + row * DM, lane);
            float lg[16];
#pragma unroll
            for (int e = 0; e < 16; ++e) lg[e] = 0.f;
#pragma unroll
            for (int j = 0; j < 4; ++j)
#pragma unroll
                for (int i = 0; i < 4; ++i) {
                    const float* rw = p.router_w + (size_t)(j * 256 + lane * 4 + i) * 16;
                    const float xv = v[j * 4 + i];
#pragma unroll
                    for (int e4 = 0; e4 < 4; ++e4) { const float4 wv = *(const float4*)(rw + e4 * 4);
                        lg[e4 * 4 + 0] += xv * wv.x; lg[e4 * 4 + 1] += xv * wv.y; lg[e4 * 4 + 2] += xv * wv.z; lg[e4 * 4 + 3] += xv * wv.w; }
                }
#pragma unroll
            for (int e = 0; e < 16; ++e) lg[e] = wave_sum(lg[e]);
            if (lane == 0) {
                float aff[16], sl[16];
#pragma unroll
                for (int e = 0; e < 16; ++e) { aff[e] = sigmoidf_(lg[e]); sl[e] = aff[e] + p.router_b[e]; }
                float bestg = -INFINITY; int bg = 0;
#pragma unroll
                for (int g = 0; g < 4; ++g) {
                    float m1 = -INFINITY, m2 = -INFINITY;
#pragma unroll
                    for (int k = 0; k < 4; ++k) { const float s = sl[g * 4 + k]; if (s > m1) { m2 = m1; m1 = s; } else if (s > m2) m2 = s; }
                    const float gs = m1 + m2;
                    if (gs > bestg) { bestg = gs; bg = g; }
                }
                float b1 = -INFINITY; int i1 = 0; float a1 = 0.f;
#pragma unroll
                for (int e = 0; e < 16; ++e) { const bool in = (e >> 2) == bg; if (in && sl[e] > b1) { b1 = sl[e]; i1 = e; a1 = aff[e]; } }
                float b2 = -INFINITY; int i2 = 0; float a2 = 0.f;
#pragma unroll
                for (int e = 0; e < 16; ++e) { const bool in = ((e >> 2) == bg) && (e != i1); if (in && sl[e] > b2) { b2 = sl[e]; i2 = e; a2 = aff[e]; } }
                const float inv = 1.0f / (a1 + a2);
                sel_e[lrow * 2] = i1; sel_e[lrow * 2 + 1] = i2; sel_g[lrow * 2] = a1 * inv; sel_g[lrow * 2 + 1] = a2 * inv;
            }
        }
        __syncthreads();
        if (tid < 16) {
            int c = 0;
            for (int i = 0; i < 512; ++i) if (sel_e[i] == tid) { rank[i] = c; ++c; }
            base[tid] = (int)atomicAdd(&ctl[CW_CNT + (l * 16 + tid) * 64], (unsigned)c);
        }
        __syncthreads();
        {
            const int e = sel_e[tid]; const int pos = base[e] + rank[tid];
            ltok[(size_t)e * NTOK + pos] = (chunk * 256 + (tid >> 1)) * 2 + (tid & 1);
            lgate[(size_t)e * NTOK + pos] = sel_g[tid];
        }
    }
}

__device__ __forceinline__ void moe_setup(const Params& p, int l, int* meta) {
    if (otid() == 0) {
        unsigned* ctl = (unsigned*)(p.ws + WS_CTL);
        int tb = 0, pb = 0;
        for (int e = 0; e < 16; ++e) { const int c = (int)xb_ld(&ctl[CW_CNT + (l * 16 + e) * 64]); meta[e] = c; meta[16 + e] = tb; meta[33 + e] = pb; tb += (c + 127) >> 7; pb += c; }
        meta[32] = tb; meta[49] = pb;
    }
    __syncthreads();
}
struct RowGather { const bf16_t* xb; const int* lt; int n; __device__ __forceinline__ const bf16_t* operator()(int r) const { const int tok = (r < n) ? (lt[r] >> 1) : 0; return xb + (size_t)tok * DM; } };
struct EpiG1 {
    bf16_t* h; int n; int jb;
    __device__ __forceinline__ void operator()(const f32x4 (&acc)[2][4], int wm, int wn, int lane) const {
#pragma unroll
        for (int m = 0; m < 2; ++m)
#pragma unroll
            for (int q = 0; q < 2; ++q)
#pragma unroll
                for (int j = 0; j < 4; ++j) {
                    const int row = wm * 32 + m * 16 + (lane >> 4) * 4 + j; const int jj = jb + wn * 32 + q * 16 + (lane & 15);
                    const float g = acc[m][2 * q][j], u = acc[m][2 * q + 1][j];
                    const float hv = g / (1.0f + expf(-g)) * u;
                    if (row < n) h[(size_t)row * DEXP + jj] = f2bf(hv);
                }
    }
};
__device__ __forceinline__ void phase_moe_up(const Params& p, int l, unsigned char* lds) {
    int* meta = (int*)(lds + 32768);
    __syncthreads();
    moe_setup(p, l, meta);
    const bf16_t* xb = (const bf16_t*)(p.ws + WS_XB);
    const int* ltok = (const int*)(p.ws + WS_LTOK);
    bf16_t* H = (bf16_t*)(p.ws + WS_H);
    const int ntile = meta[32];
    for (int it = obid(); it < ntile * 4; it += gridDim.x) {
        const int rt = it >> 2, ct = it & 3;
        int e = 0;
#pragma unroll
        for (int k = 1; k < 16; ++k) if (rt >= meta[16 + k]) e = k;
        const int rl = rt - meta[16 + e]; const int n = meta[e] - rl * 128;
        RowGather ar{xb, ltok + (size_t)e * NTOK + rl * 128, n};
        EpiG1 ep{H + (size_t)(meta[33 + e] + rl * 128) * DEXP, n, ct * 64};
        gemm128(lds, ar, (const bf16_t*)(p.ws + WS_MWIN) + ((size_t)(l * 16 + e) * 512 + ct * 128) * 1024, 1024, ep);
    }
}
struct EpiG2 {
    bf16_t* Y; const int* lt; const float* lg; int n; int c0;
    __device__ __forceinline__ void operator()(const f32x4 (&acc)[2][4], int wm, int wn, int lane) const {
#pragma unroll
        for (int m = 0; m < 2; ++m)
#pragma unroll
            for (int j = 0; j < 4; ++j) {
                const int row = wm * 32 + m * 16 + (lane >> 4) * 4 + j;
                if (row < n) {
                    const int ent = lt[row]; const float g = lg[row];
                    bf16_t* yo = Y + (size_t)ent * DM + c0 + wn * 64 + (lane & 15);
#pragma unroll
                    for (int nn = 0; nn < 4; ++nn) yo[nn * 16] = f2bf(acc[m][nn][j] * g);
                }
            }
    }
};
__device__ __forceinline__ void phase_moe_down(const Params& p, int l, unsigned char* lds) {
    int* meta = (int*)(lds + 32768);
    __syncthreads();
    moe_setup(p, l, meta);
    const int* ltok = (const int*)(p.ws + WS_LTOK); const float* lgate = (const float*)(p.ws + WS_LGATE);
    const bf16_t* H = (const bf16_t*)(p.ws + WS_H); bf16_t* Y = (bf16_t*)(p.ws + WS_Y);
    const int ntile = meta[32];
    for (int it = obid(); it < ntile * 8; it += gridDim.x) {
        const int rt = it >> 3, ct = it & 7;
        int e = 0;
#pragma unroll
        for (int k = 1; k < 16; ++k) if (rt >= meta[16 + k]) e = k;
        const int rl = rt - meta[16 + e]; const int n = meta[e] - rl * 128;
        RowContig ar{H + (size_t)(meta[33 + e] + rl * 128) * DEXP, DEXP};
        EpiG2 ep{Y, ltok + (size_t)e * NTOK + rl * 128, lgate + (size_t)e * NTOK + rl * 128, n, ct * 128};
        gemm128(lds, ar, (const bf16_t*)(p.ws + WS_MWDN) + ((size_t)(l * 16 + e) * 1024 + ct * 128) * 256, 256, ep);
    }
}

__device__ __forceinline__ void phase_ln2(const Params& p, int l) {
    const int tid = otid(), lane = tid & 63, wid = tid >> 6;
    bf16_t* xb = (bf16_t*)(p.ws + WS_XB); const bf16_t* Y = (const bf16_t*)(p.ws + WS_Y);
    const float* gain = p.ln_gain + (size_t)(l * 2 + 1) * DM; const float* bias = p.ln_bias + (size_t)(l * 2 + 1) * DM;
    for (size_t row = (size_t)obid() * 8 + wid; row < NTOK; row += (size_t)gridDim.x * 8) {
        float v[16];
#pragma unroll
        for (int j = 0; j < 4; ++j) {
            const float4 t = *(const float4*)(p.out + row * DM + j * 256 + lane * 4);
            const ushort4 y0 = *(const ushort4*)(Y + (row * 2) * DM + j * 256 + lane * 4), y1 = *(const ushort4*)(Y + (row * 2 + 1) * DM + j * 256 + lane * 4);
            v[j * 4 + 0] = ALPHA * t.x + bf2f(y0.x) + bf2f(y1.x); v[j * 4 + 1] = ALPHA * t.y + bf2f(y0.y) + bf2f(y1.y);
            v[j * 4 + 2] = ALPHA * t.z + bf2f(y0.z) + bf2f(y1.z); v[j * 4 + 3] = ALPHA * t.w + bf2f(y0.w) + bf2f(y1.w);
        }
        ln_row(v, gain, bias, lane);
        store_row(v, p.out + row * DM, xb + row * DM, lane);
    }
}

__device__ __forceinline__ void sb_item(const Params& p, int bh, int qc, unsigned char* lds) {
    const int tid = otid(), b = bh >> 2, h = bh & 3;
    const bf16_t* proj = (const bf16_t*)(p.ws + WS_PROJ) + (size_t)b * SEQ * PINP;
    bf16_t* mix = (bf16_t*)(p.ws + WS_MIX) + (size_t)b * SEQ * DM;
    float* Ks = (float*)lds; float* Vs = (float*)(lds + 16384);
    const int t = qc * 512 + tid; const int twmax = qc * 512 + (tid | 63);
    float q[64], acc[64];
#pragma unroll
    for (int d8 = 0; d8 < 8; ++d8) { const uint4 raw = *(const uint4*)(proj + (size_t)t * PINP + h * 64 + d8 * 8); const bf16_t* rp = (const bf16_t*)&raw;
#pragma unroll
        for (int i = 0; i < 8; ++i) q[d8 * 8 + i] = bf2f(rp[i]) * 0.125f; }
#pragma unroll
    for (int d = 0; d < 64; ++d) acc[d] = 0.f;
    float cs = 0.f;
    for (int kb = qc * 8 + 7; kb >= 0; --kb) {
        __syncthreads();
        { const int key = tid >> 3, d8 = tid & 7; const size_t ro = (size_t)(kb * 64 + key) * PINP + h * 64 + d8 * 8;
          const uint4 rk = *(const uint4*)(proj + ro + 256), rv = *(const uint4*)(proj + ro + 512); const bf16_t* pk = (const bf16_t*)&rk; const bf16_t* pv = (const bf16_t*)&rv;
#pragma unroll
          for (int i = 0; i < 8; ++i) { Ks[key * 64 + d8 * 8 + i] = bf2f(pk[i]); Vs[key * 64 + d8 * 8 + i] = bf2f(pv[i]); } }
        __syncthreads();
        if (kb * 64 < twmax) {
            for (int sl = 63; sl >= 0; --sl) {
                const int s = kb * 64 + sl;
                if (s < t) {
                    float z = 0.f;
#pragma unroll
                    for (int d4 = 0; d4 < 16; ++d4) { const float4 kv = *(const float4*)(Ks + sl * 64 + d4 * 4); z += q[d4 * 4] * kv.x + q[d4 * 4 + 1] * kv.y + q[d4 * 4 + 2] * kv.z + q[d4 * 4 + 3] * kv.w; }
                    const float sp = fmaxf(z, 0.f) + log1pf(expf(-fabsf(z)));
                    cs += sp;
                    const float w = expf(z - cs);
#pragma unroll
                    for (int d4 = 0; d4 < 16; ++d4) { const float4 vv = *(const float4*)(Vs + sl * 64 + d4 * 4); acc[d4 * 4] += w * vv.x; acc[d4 * 4 + 1] += w * vv.y; acc[d4 * 4 + 2] += w * vv.z; acc[d4 * 4 + 3] += w * vv.w; }
                }
            }
        }
    }
#pragma unroll
    for (int d8 = 0; d8 < 8; ++d8) { uint4 o; bf16_t* op = (bf16_t*)&o;
#pragma unroll
        for (int i = 0; i < 8; ++i) op[i] = f2bf(acc[d8 * 8 + i]);
        *(uint4*)(mix + (size_t)t * DM + h * 64 + d8 * 8) = o; }
}

__device__ __forceinline__ void da_item(const Params& p, int l, int bh, int qc, unsigned char* lds) {
    const int tid = otid(), b = bh >> 2, h = bh & 3, map = tid >> 8, row = tid & 255;
    const bf16_t* proj = (const bf16_t*)(p.ws + WS_PROJ) + (size_t)b * SEQ * PINP;
    bf16_t* mix = (bf16_t*)(p.ws + WS_MIX) + (size_t)b * SEQ * DM;
    const float* biasd = (const float*)(p.ws + WS_BIASD) + h * 2048;
    float* Ks = (float*)lds; float* Vs = (float*)(lds + 16384); float* Bd = (float*)(lds + 32768); float* Ex = (float*)(lds + 40960);
    const int t = qc * 256 + row; const int twmax = qc * 256 + (row | 63);
    __syncthreads();
    for (int i = tid; i < 2048; i += NTHREADS) Bd[i] = biasd[i];
    float q[32], O[64];
#pragma unroll
    for (int d8 = 0; d8 < 4; ++d8) { const uint4 raw = *(const uint4*)(proj + (size_t)t * PINP + 768 + h * 64 + map * 32 + d8 * 8); const bf16_t* rp = (const bf16_t*)&raw;
#pragma unroll
        for (int i = 0; i < 8; ++i) q[d8 * 8 + i] = bf2f(rp[i]) * 0.17677669529663687f; }
#pragma unroll
    for (int d = 0; d < 64; ++d) O[d] = 0.f;
    float mrun = -INFINITY, lsum = 0.f;
    for (int kb = 0; kb <= qc * 4 + 3; ++kb) {
        __syncthreads();
        { const int key = tid >> 3, d8 = tid & 7; const size_t ro = (size_t)(kb * 64 + key) * PINP + 768 + h * 64 + d8 * 8;
          const uint4 rk = *(const uint4*)(proj + ro + 256), rv = *(const uint4*)(proj + ro + 512); const bf16_t* pk = (const bf16_t*)&rk; const bf16_t* pv = (const bf16_t*)&rv;
#pragma unroll
          for (int i = 0; i < 8; ++i) { Ks[key * 64 + d8 * 8 + i] = bf2f(pk[i]); Vs[key * 64 + d8 * 8 + i] = bf2f(pv[i]); } }
        __syncthreads();
        if (kb * 64 <= twmax) {
            for (int sl = 0; sl < 64; ++sl) {
                const int s = kb * 64 + sl;
                if (s <= t) {
                    float z = Bd[t - s];
#pragma unroll
                    for (int d4 = 0; d4 < 8; ++d4) { const float4 kv = *(const float4*)(Ks + sl * 64 + map * 32 + d4 * 4); z += q[d4 * 4] * kv.x + q[d4 * 4 + 1] * kv.y + q[d4 * 4 + 2] * kv.z + q[d4 * 4 + 3] * kv.w; }
                    if (z > mrun) { const float sc = expf(mrun - z); lsum *= sc;
#pragma unroll
                        for (int d = 0; d < 64; ++d) O[d] *= sc;
                        mrun = z; }
                    const float pw = expf(z - mrun);
                    lsum += pw;
#pragma unroll
                    for (int d4 = 0; d4 < 16; ++d4) { const float4 vv = *(const float4*)(Vs + sl * 64 + d4 * 4); O[d4 * 4] += pw * vv.x; O[d4 * 4 + 1] += pw * vv.y; O[d4 * 4 + 2] += pw * vv.z; O[d4 * 4 + 3] += pw * vv.w; }
                }
            }
        }
    }
    const float il = 1.0f / lsum;
    __syncthreads();
    if (map == 1) {
#pragma unroll
        for (int d = 0; d < 64; ++d) Ex[d * 256 + row] = O[d] * il;
    }
    __syncthreads();
    if (map == 0) {
        const float* lp = p.da_lambda + (size_t)l * 128;
        float s1 = 0.f, s2 = 0.f;
        for (int i = 0; i < 32; ++i) { s1 += lp[i] * lp[32 + i]; s2 += lp[64 + i] * lp[96 + i]; }
        const float lam_init = 0.8f - 0.6f * expf(-0.3f * (float)l);
        const float lam = expf(s1) - expf(s2) + lam_init;
        float ms = 0.f;
#pragma unroll
        for (int d = 0; d < 64; ++d) { O[d] = O[d] * il - lam * Ex[d * 256 + row]; ms += O[d] * O[d]; }
        const float r = rsqrtf(ms * (1.0f / 64.0f) + 1e-5f) * (1.0f - lam_init);
        const float* sg = p.da_subln + l * 64;
#pragma unroll
        for (int d8 = 0; d8 < 8; ++d8) { uint4 o; bf16_t* op = (bf16_t*)&o;
#pragma unroll
            for (int i = 0; i < 8; ++i) op[i] = f2bf(O[d8 * 8 + i] * r * sg[d8 * 8 + i]);
            *(uint4*)(mix + (size_t)t * DM + 256 + h * 64 + d8 * 8) = o; }
    }
}

__device__ __forceinline__ void conv_item(const Params& p, int l, int item) {
    const int tid = otid();
    const bf16_t* proj = (const bf16_t*)(p.ws + WS_PROJ); bf16_t* mix = (bf16_t*)(p.ws + WS_MIX);
    const float* cw = p.sc_conv + (size_t)l * 3 * 256;
    const int c = tid & 255;
    const float w0 = cw[c], w1 = cw[256 + c], w2 = cw[512 + c];
    for (int rr = tid >> 8; rr < 256; rr += 2) {
        const size_t row = (size_t)item * 256 + rr; const int t = (int)(row & (SEQ - 1));
        const bf16_t* pr = proj + row * PINP + 1536;
        const float u2 = bf2f(pr[256 + c]) * bf2f(pr[512 + c]);
        const float u1 = (t >= 1) ? bf2f(pr[256 + c - PINP]) * bf2f(pr[512 + c - PINP]) : 0.f;
        const float u0 = (t >= 2) ? bf2f(pr[256 + c - 2 * PINP]) * bf2f(pr[512 + c - 2 * PINP]) : 0.f;
        mix[row * DM + 512 + c] = f2bf(bf2f(pr[c]) * (w0 * u0 + w1 * u1 + w2 * u2));
    }
}

__device__ __forceinline__ void rwkv_item(const Params& p, int l, int bh, unsigned char* lds) {
    const int tid = otid(), b = bh >> 2, h = bh & 3;
    const bf16_t* proj = (const bf16_t*)(p.ws + WS_PROJ) + (size_t)b * SEQ * PINP + 2304;
    bf16_t* mix = (bf16_t*)(p.ws + WS_MIX) + (size_t)b * SEQ * DM + 768 + h * 64;
    const float* mu = p.rw_mu + (size_t)l * 896;
    const float* vecs = p.rw_vecs + (size_t)l * 7 * 256 + h * 64;
    float* Wup = (float*)lds; float* Aup = Wup + 2048; float* Gup = Aup + 2048;
    float* xr = Gup + 4096; float* xk = xr + 2048; float* xv = xk + 2048;
    float* xw = xv + 2048; float* xa = xw + 1024; float* xg = xa + 1024;
    float* wd = xg + 2048; float* ab = wd + 2048; float* kk = ab + 2048; float* gg = kk + 2048;
    float* yy = gg + 2048;
    float* sm = yy + 2048;
    __syncthreads();
    for (int i = tid; i < 2048; i += NTHREADS) { const int m = i >> 6, c = i & 63; Wup[i] = p.rw_w_up[(size_t)l * 32 * 256 + m * 256 + h * 64 + c]; Aup[i] = p.rw_a_up[(size_t)l * 32 * 256 + m * 256 + h * 64 + c]; }
    for (int i = tid; i < 4096; i += NTHREADS) { const int m = i >> 6, c = i & 63; Gup[i] = p.rw_g_up[(size_t)l * 64 * 256 + m * 256 + h * 64 + c]; }
    const int si = tid >> 3, jc = tid & 7;
    float S[8];
#pragma unroll
    for (int j = 0; j < 8; ++j) S[j] = 0.f;
    for (int t0 = 0; t0 < SEQ; t0 += 32) {
        __syncthreads();
        for (int i = tid; i < 32 * 320; i += NTHREADS) {
            const int tt = i / 320, cc = i % 320; const int t = t0 + tt;
            int col; float* dst;
            if (cc < 64) { col = h * 64 + cc; dst = xr + tt * 64 + cc; }
            else if (cc < 128) { col = 256 + h * 64 + (cc - 64); dst = xk + tt * 64 + (cc - 64); }
            else if (cc < 192) { col = 512 + h * 64 + (cc - 128); dst = xv + tt * 64 + (cc - 128); }
            else if (cc < 224) { col = 768 + (cc - 192); dst = xw + tt * 32 + (cc - 192); }
            else if (cc < 256) { col = 800 + (cc - 224); dst = xa + tt * 32 + (cc - 224); }
            else { col = 832 + (cc - 256); dst = xg + tt * 64 + (cc - 256); }
            const float cur = bf2f(proj[(size_t)t * PINP + col]);
            const float prev = (t > 0) ? bf2f(proj[(size_t)(t - 1) * PINP + col]) : 0.f;
            float v = cur + (prev - cur) * mu[col];
            if (cc >= 192 && cc < 224) v = tanhf(v);
            if (cc >= 256) v = sigmoidf_(v);
            *dst = v;
        }
        __syncthreads();
        for (int i = tid; i < 2048; i += NTHREADS) {
            const int tt = i >> 6, c = i & 63;
            float dec = vecs[0 * 256 + c], av = vecs[1 * 256 + c], g = 0.f;
            for (int m = 0; m < 32; ++m) { dec += xw[tt * 32 + m] * Wup[m * 64 + c]; av += xa[tt * 32 + m] * Aup[m * 64 + c]; }
            for (int m = 0; m < 64; ++m) g += xg[tt * 64 + m] * Gup[m * 64 + c];
            const float a = sigmoidf_(av);
            const float kraw = xk[i];
            wd[i] = expf(-0.6065306597126334f * sigmoidf_(dec));
            ab[i] = a;
            gg[i] = g;
            kk[i] = kraw * vecs[2 * 256 + c];
            xk[i] = kraw * (1.0f + (a - 1.0f) * vecs[3 * 256 + c]);
        }
        __syncthreads();
        if (tid < 32) {
            float s = 0.f, bo = 0.f;
            for (int c = 0; c < 64; ++c) { const float v = kk[tid * 64 + c]; s += v * v; bo += xr[tid * 64 + c] * xk[tid * 64 + c] * vecs[4 * 256 + c]; }
            sm[tid] = 1.0f / fmaxf(sqrtf(s), 1e-12f); sm[96 + tid] = bo;
        }
        __syncthreads();
        for (int i = tid; i < 2048; i += NTHREADS) { const float k2 = kk[i] * sm[i >> 6]; kk[i] = k2; ab[i] = k2 * ab[i]; }
        __syncthreads();
        for (int tt = 0; tt < 32; ++tt) {
            const int o = tt * 64 + jc * 8;
            const float4 k0 = *(const float4*)(kk + o), k1 = *(const float4*)(kk + o + 4);
            const float4 w0 = *(const float4*)(wd + o), w1 = *(const float4*)(wd + o + 4);
            const float4 a0 = *(const float4*)(ab + o), a1 = *(const float4*)(ab + o + 4);
            const float4 p0 = *(const float4*)(xk + o), p1 = *(const float4*)(xk + o + 4);
            const float4 r0 = *(const float4*)(xr + o), r1 = *(const float4*)(xr + o + 4);
            const float vi = xv[tt * 64 + si];
            float sa = S[0] * k0.x + S[1] * k0.y + S[2] * k0.z + S[3] * k0.w + S[4] * k1.x + S[5] * k1.y + S[6] * k1.z + S[7] * k1.w;
            sa += __shfl_xor(sa, 1); sa += __shfl_xor(sa, 2); sa += __shfl_xor(sa, 4);
            sa = -sa;
            S[0] = S[0] * w0.x + sa * a0.x + vi * p0.x; S[1] = S[1] * w0.y + sa * a0.y + vi * p0.y; S[2] = S[2] * w0.z + sa * a0.z + vi * p0.z; S[3] = S[3] * w0.w + sa * a0.w + vi * p0.w;
            S[4] = S[4] * w1.x + sa * a1.x + vi * p1.x; S[5] = S[5] * w1.y + sa * a1.y + vi * p1.y; S[6] = S[6] * w1.z + sa * a1.z + vi * p1.z; S[7] = S[7] * w1.w + sa * a1.w + vi * p1.w;
            float y = S[0] * r0.x + S[1] * r0.y + S[2] * r0.z + S[3] * r0.w + S[4] * r1.x + S[5] * r1.y + S[6] * r1.z + S[7] * r1.w;
            y += __shfl_xor(y, 1); y += __shfl_xor(y, 2); y += __shfl_xor(y, 4);
            if (jc == 0) yy[tt * 64 + si] = y;
        }
        __syncthreads();
        if (tid < 32) {
            float s = 0.f;
            for (int c = 0; c < 64; ++c) s += yy[tid * 64 + c];
            const float mean = s * (1.0f / 64.0f);
            float q = 0.f;
            for (int c = 0; c < 64; ++c) { const float d = yy[tid * 64 + c] - mean; q += d * d; }
            sm[32 + tid] = mean; sm[64 + tid] = rsqrtf(q * (1.0f / 64.0f) + 64e-5f);
        }
        __syncthreads();
        for (int i = tid; i < 2048; i += NTHREADS) {
            const int tt = i >> 6, c = i & 63;
            const float yn = (yy[i] - sm[32 + tt]) * sm[64 + tt] * vecs[5 * 256 + c] + vecs[6 * 256 + c];
            const float o = (yn + sm[96 + tt] * xv[i]) * gg[i];
            mix[(size_t)(t0 + tt) * DM + c] = f2bf(o);
        }
    }
}

__device__ __forceinline__ void phase_mixers(const Params& p, int l, unsigned char* lds) {
    unsigned* ctl = (unsigned*)(p.ws + WS_CTL);
    int* slot = (int*)(lds + LDS_BYTES - 64);
#ifndef NO_RW
    for (int it = obid(); it < 128; it += gridDim.x) rwkv_item(p, l, it, lds);
#endif
    for (;;) {
        __syncthreads();
        if (otid() == 0) *slot = (int)atomicAdd(&ctl[CW_QUEUE + l * 64], 1u);
        __syncthreads();
        const int it = *slot;
        if (it >= 512 + 1024 + 256) break;
        if (it < 512) {
#ifndef NO_SB
            sb_item(p, it & 127, 3 - (it >> 7), lds);
#endif
        } else if (it < 1536) {
#ifndef NO_DA
            const int j = it - 512; da_item(p, l, j & 127, 7 - (j >> 7), lds);
#endif
        } else conv_item(p, l, it - 1536);
    }
}

__global__ void __launch_bounds__(NTHREADS, 2) fwd(Params p) {
    extern __shared__ __attribute__((aligned(16))) unsigned char lds_raw[];
    if (threadIdx.x == 0) { ((unsigned*)lds_raw)[0] = 0u; ((unsigned*)lds_raw)[1] = 0u; ((unsigned*)lds_raw)[2] = 0u; ((unsigned*)lds_raw)[3] = 0u; }
    __syncthreads();
    unsigned char* lds = lds_raw + 16;
    XcdBarrier bar = xcd_barrier_post((unsigned*)(p.ws + WS_CTL) + CW_BAR, (volatile LAS unsigned*)lds_raw);
#ifndef ONLY
#define ONLY -1
#endif
#define PH(k) (ONLY < 0 || ONLY == (k))
    if (PH(0)) prologue(p, lds);
    xcd_barrier(bar);
    for (int l = 0; l < NLAYER; ++l) {
        if (PH(1)) phase_inproj(p, l, lds);
        xcd_barrier(bar);
        if (PH(2)) phase_mixers(p, l, lds);
        xcd_barrier(bar);
        if (PH(3)) phase_outproj(p, l, lds);
        xcd_barrier(bar);
        if (PH(4)) phase_ln1_route(p, l, lds);
        xcd_barrier(bar);
        if (PH(5)) phase_moe_up(p, l, lds);
        xcd_barrier(bar);
        if (PH(6)) phase_moe_down(p, l, lds);
        xcd_barrier(bar);
        if (PH(7)) phase_ln2(p, l);
        xcd_barrier(bar);
    }
}

extern "C" void kernel_launch(void* const* d_in, const int* in_sizes, int n_in, void* d_out, int out_size, void* d_ws, size_t ws_size, hipStream_t stream) {
    static int grid = 0;
    if (grid == 0) {
        if (n_in != 18 || in_sizes[0] != NTOK * DM || out_size != NTOK * DM || ws_size < WS_END) {
            fprintf(stderr, "kernel_launch: unexpected shapes: n_in %d in0 %d out %d ws %zu (need %llu)\n", n_in, n_in > 0 ? in_sizes[0] : -1, out_size, ws_size, (unsigned long long)WS_END);
            grid = -1; return;
        }
        int dev = 0, cus = 0, per_cu = 0;
        hipGetDevice(&dev);
        hipDeviceGetAttribute(&cus, hipDeviceAttributeMultiprocessorCount, dev);
        hipFuncSetAttribute((const void*)fwd, hipFuncAttributeMaxDynamicSharedMemorySize, LDS_BYTES);
        hipOccupancyMaxActiveBlocksPerMultiprocessor(&per_cu, (const void*)fwd, NTHREADS, LDS_BYTES);
        if (per_cu < 1) { fprintf(stderr, "kernel_launch: occupancy query says %d blocks per CU\n", per_cu); grid = -1; return; }
        grid = cus;
    }
    if (grid < 0) return;
    Params p{};
    p.x = (const float*)d_in[0]; p.w_in = (const float*)d_in[1]; p.w_out = (const float*)d_in[2]; p.da_lambda = (const float*)d_in[3]; p.da_subln = (const float*)d_in[4];
    p.sc_conv = (const float*)d_in[5]; p.rw_mu = (const float*)d_in[6]; p.rw_vecs = (const float*)d_in[7]; p.rw_w_up = (const float*)d_in[8]; p.rw_a_up = (const float*)d_in[9];
    p.rw_g_up = (const float*)d_in[10]; p.ln_gain = (const float*)d_in[11]; p.ln_bias = (const float*)d_in[12]; p.rel_bias = (const float*)d_in[13]; p.router_w = (const float*)d_in[14];
    p.router_b = (const float*)d_in[15]; p.moe_w_in = (const float*)d_in[16]; p.moe_w_down = (const float*)d_in[17];
    p.out = (float*)d_out; p.ws = (unsigned char*)d_ws;
    hipMemsetAsync((char*)d_ws + WS_CTL, 0, CTL_BYTES, stream);
    hipLaunchKernelGGL(fwd, dim3(grid), dim3(NTHREADS), LDS_BYTES, stream, p);
}
```

```cpp
#include <hip/hip_runtime.h>
#include <cstdio>
#include <cstdint>

typedef unsigned short bf16_t;
typedef short bf16x8 __attribute__((ext_vector_type(8)));
typedef float f32x4 __attribute__((ext_vector_type(4)));

#define NTOK 65536
#define SEQ 2048
#define DM 1024
#define PIN 3200
#define PINP 3328
#define NLAYER 4
#define NEXP 16
#define DEXP 256
#define NTHREADS 512
#define LDS_BYTES (136 * 1024)
#define ALPHA 1.6817928305074292f
#define LOG2E 1.4426950408889634f

#define WS_CTL 0ull
#define CTL_BYTES 65536ull
#define WS_BIASD (WS_CTL + CTL_BYTES)
#define WS_WIN (WS_BIASD + 4ull * 2048 * 4)
#define WS_WOUT (WS_WIN + 4ull * PINP * DM * 2)
#define WS_MWIN (WS_WOUT + 4ull * DM * DM * 2)
#define WS_MWDN (WS_MWIN + 4ull * 16 * 512 * 1024 * 2)
#define WS_XB (WS_MWDN + 4ull * 16 * 1024 * 256 * 2)
#define WS_MIX (WS_XB + (unsigned long long)NTOK * DM * 2)
#define WS_LTOK (WS_MIX + (unsigned long long)NTOK * DM * 2)
#define WS_LGATE (WS_LTOK + 16ull * NTOK * 4)
#define WS_PROJ (WS_LGATE + 16ull * NTOK * 4)
#define WS_Y WS_PROJ
#define WS_H (WS_Y + (unsigned long long)(2 * NTOK + 256) * DM * 2)
#define WS_END (WS_PROJ + (unsigned long long)NTOK * PINP * 2)

#define CW_BAR 0
#define CW_CNT 4096
#define CW_QUEUE 8192

#define XB_TMO      128
#define XB_XCNT(j)  (256  + 64 * (j))
#define XB_XSUB(j)  (1280 + 64 * (j))
#define XB_XGEN(j)  (2304 + 64 * (j))
#define XB_TOP      3328
#define XB_TOPGEN   3392
#define XCD_BAR_WORDS 3456
#define XB_SPIN_CAP (1u << 22)
#define LAS __attribute__((address_space(3)))

__device__ __forceinline__ unsigned xb_ld(unsigned* p)              { return __hip_atomic_load(p, __ATOMIC_RELAXED, __HIP_MEMORY_SCOPE_AGENT); }
__device__ __forceinline__ unsigned xb_add(unsigned* p, unsigned v) { return __hip_atomic_fetch_add(p, v, __ATOMIC_RELAXED, __HIP_MEMORY_SCOPE_AGENT); }
__device__ __forceinline__ unsigned xb_xcc_id() { return (unsigned)__builtin_amdgcn_s_getreg((3 << 11) | 20) & 0xFu; }
#define XB_SPIN(cond, bar) do { unsigned _sp = 0; while (cond) { __builtin_amdgcn_s_sleep(1); \
    if ((++_sp & 255u) == 0u) { if (xb_ld(&(bar)[XB_TMO])) break; if (_sp > XB_SPIN_CAP) { atomicAdd(&(bar)[XB_TMO], 1u); break; } } } } while (0)

struct XcdBarrier { unsigned* bar; unsigned x; volatile LAS unsigned* st; };

__device__ __forceinline__ XcdBarrier xcd_barrier_post(unsigned* bar, volatile LAS unsigned* st) {
    XcdBarrier b; b.bar = bar; b.x = xb_xcc_id(); b.st = st;
    if (threadIdx.x == 0) (void)xb_add(&bar[XB_XCNT(b.x)], 1u);
    return b;
}
__device__ __forceinline__ void xcd_barrier_complete(unsigned* bar, unsigned x, unsigned& nloc, unsigned& nx) {
    const unsigned G = gridDim.x * gridDim.y * gridDim.z;
    unsigned sum, cnt, mine, sp = 0u;
    for (;;) {
        sum = 0u; cnt = 0u; mine = 0u;
#pragma unroll
        for (unsigned j = 0; j < 16; ++j) { const unsigned c = xb_ld(&bar[XB_XCNT(j)]); sum += c; cnt += (c > 0u) ? 1u : 0u; mine = (j == x) ? c : mine; }
        if (sum == G) break;
        __builtin_amdgcn_s_sleep(1);
        if ((++sp & 255u) == 0u) { if (xb_ld(&bar[XB_TMO])) break; if (sp > XB_SPIN_CAP) { atomicAdd(&bar[XB_TMO], 1u); break; } }
    }
    nloc = mine > 0u ? mine : 1u; nx = cnt > 0u ? cnt : 1u;
}
__device__ __forceinline__ void xcd_barrier(const XcdBarrier& b) {
    asm volatile("s_waitcnt vmcnt(0)" ::: "memory");
    __syncthreads();
    if (threadIdx.x == 0) {
        unsigned* bar = b.bar;
        __builtin_amdgcn_s_waitcnt(0);
        const unsigned bx = xb_xcc_id();
        unsigned nloc = b.st[0], nx = b.st[1];
        if (nloc == 0u) { xcd_barrier_complete(bar, bx, nloc, nx); b.st[0] = nloc; b.st[1] = nx; }
        const unsigned old = xb_add(&bar[XB_XSUB(bx)], 1u);
        const unsigned gen = old / nloc;
        if (old + 1u == (gen + 1u) * nloc) {
            __builtin_amdgcn_fence(__ATOMIC_RELEASE, "agent");
            asm volatile("s_waitcnt vmcnt(0)" ::: "memory");
            const unsigned og = xb_add(&bar[XB_TOP], 1u);
            const unsigned tg = og / nx;
            if (og + 1u == (tg + 1u) * nx) xb_add(&bar[XB_TOPGEN], 1u);
            else XB_SPIN(xb_ld(&bar[XB_TOPGEN]) == tg, bar);
            __builtin_amdgcn_fence(__ATOMIC_ACQUIRE, "agent");
            xb_add(&bar[XB_XGEN(bx)], 1u);
            asm volatile("s_waitcnt vmcnt(0)" ::: "memory");
        } else {
            XB_SPIN(xb_ld(&bar[XB_XGEN(bx)]) == gen, bar);
            __builtin_amdgcn_fence(__ATOMIC_ACQUIRE, "agent");
            asm volatile("s_waitcnt vmcnt(0)" ::: "memory");
        }
    }
    __syncthreads();
}

__device__ __forceinline__ int otid() { int t = threadIdx.x; asm volatile("" : "+v"(t)); return t; }
__device__ __forceinline__ int obid() { int t = blockIdx.x; asm volatile("" : "+s"(t)); return t; }
__device__ __forceinline__ float bf2f(bf16_t v) { return __uint_as_float(((unsigned)v) << 16); }
__device__ __forceinline__ bf16_t f2bf(float f) { unsigned u = __float_as_uint(f); u += 0x7fffu + ((u >> 16) & 1u); return (bf16_t)(u >> 16); }
__device__ __forceinline__ float sigmoidf_(float x) { return 1.0f / (1.0f + expf(-x)); }
__device__ __forceinline__ float wave_sum(float v) {
#pragma unroll
    for (int o = 32; o >= 1; o >>= 1) v += __shfl_xor(v, o);
    return v;
}

struct Params {
    const float* x; const float* w_in; const float* w_out; const float* da_lambda; const float* da_subln; const float* sc_conv;
    const float* rw_mu; const float* rw_vecs; const float* rw_w_up; const float* rw_a_up; const float* rw_g_up;
    const float* ln_gain; const float* ln_bias; const float* rel_bias; const float* router_w; const float* router_b;
    const float* moe_w_in; const float* moe_w_down;
    float* out; unsigned char* ws;
};

namespace pg8 {
#define PG8_LAS __attribute__((address_space(3)))
typedef unsigned short bf16_t;
typedef short bf16x8 __attribute__((ext_vector_type(8)));
typedef float f32x4 __attribute__((ext_vector_type(4)));
typedef unsigned u32x4 __attribute__((ext_vector_type(4)));
constexpr int BM = 256, BK = 64, HALF = 128, HTB = HALF * BK * 2  , STAGE_BYTES = 8 * HTB, NXCD = 8, WGM = 8;

__host__ __device__ __forceinline__ int lds_byte(int r, int c) { const int st = (r >> 4) * 2 + (c >> 5), rr = r & 15, cc = c & 31, ob = rr * 64 + cc * 2; return st * 1024 + (ob ^ (((ob >> 9) & 1) << 5)); }
__host__ __device__ __forceinline__ void stage_rc(int b, int& R, int& C) { const int st = b / 1024, sb = b % 1024, swz = sb ^ (((sb >> 9) & 1) << 5); R = (st >> 1) * 16 + swz / 64; C = (st & 1) * 32 + (swz % 64) / 2; }
__host__ __device__ __forceinline__ int perm32(int rho) { const int n = rho >> 4, i = rho & 15; return 8 * (i >> 2) + 4 * n + (i & 3); }

struct Unit { int pm, pn; };
struct Gemm { const bf16_t* A; const bf16_t* Bt; int M, N, K; };

struct StaticOrder {
    int nM, nN, nwg, G, c;
    __host__ __device__ void init(int M, int N, int G_, int c_) { nM = M / BM; nN = N / BM; nwg = nM * nN; G = G_; c = c_; }
    __host__ __device__ bool next(int i, Unit& u) const {
        const long L = (long)i * G + c; if (L >= nwg) return false;
        int wgid = (int)L; { const int q = nwg / NXCD, r = nwg % NXCD, xcd = wgid % NXCD, off = wgid / NXCD; wgid = (xcd < r ? xcd * (q + 1) : r * (q + 1) + (xcd - r) * q) + off; }
        const int nig = WGM * nN, gid = wgid / nig, fm = gid * WGM, gsz = (nM - fm) < WGM ? (nM - fm) : WGM;
        u.pm = fm + ((wgid % nig) % gsz); u.pn = (wgid % nig) / gsz; return true;
    }
    __device__ __forceinline__ void a_ready(const Unit&) const {}
    __device__ __forceinline__ void done(const Unit&) const {}
};
__device__ __forceinline__ unsigned cvt_pk_bf16(float lo, float hi) { unsigned r; asm volatile("v_cvt_pk_bf16_f32 %0, %1, %2" : "=v"(r) : "v"(lo), "v"(hi)); return r; }
template <class Epi, class Sched, bool ALIGN_EPI = false, bool SP2 = false>
__device__ __forceinline__ void gemm_phase(PG8_LAS unsigned char* lds, const Gemm g, const Sched& S, const Epi& E) {
    const int tid = otid(), wid = __builtin_amdgcn_readfirstlane(tid >> 6), lane = tid & 63, wr = wid >> 2, wc = wid & 3, fr = lane & 15, fq = lane >> 4;
    const int K = g.K, nt = K / BK;
    unsigned voffA[2], voffB[2];
#pragma unroll
    for (int i = 0; i < 2; ++i) { int R, C; stage_rc(tid * 16 + i * 8192, R, C); const int Rb = Epi::PERM ? ((R & ~31) + perm32(R & 31)) : R;
        voffA[i] = (unsigned)(R * K + C) * 2u; voffB[i] = (unsigned)(Rb * K + C) * 2u; }
    const size_t kstep = (size_t)(BK * 2);
    const size_t hstep = (size_t)HALF * K * 2;
    const size_t tstep = 2 * hstep;
    const unsigned ldsw = (unsigned)wid * 1024u;
    const int aoff = lds_byte(wr * 64 + fr, fq * 8), boff = lds_byte(wc * 32 + fr, fq * 8);
#define PG8_SA(b, h) (((b) * 2 + (h)) * HTB)
#define PG8_SB(b, h) ((4 + (b) * 2 + (h)) * HTB)
#define PG8_STAGE(bufoff, gbase, voff) do { _Pragma("unroll") for (int _i = 0; _i < 2; ++_i) \
        __builtin_amdgcn_global_load_lds((const unsigned*)((const char*)(gbase) + (voff)[_i]), (PG8_LAS unsigned*)(lds + (bufoff) + ldsw + _i * 8192), 16, 0, 0); } while (0)
#define PG8_LDA(dst, b, h) do { _Pragma("unroll") for (int m = 0; m < 4; ++m) _Pragma("unroll") for (int k = 0; k < 2; ++k) dst[m][k] = *(const PG8_LAS bf16x8*)(lds + PG8_SA(b, h) + aoff + m * 2048 + k * 1024); } while (0)
#define PG8_LDB(dst, b, h) do { _Pragma("unroll") for (int n = 0; n < 2; ++n) _Pragma("unroll") for (int k = 0; k < 2; ++k) dst[n][k] = *(const PG8_LAS bf16x8*)(lds + PG8_SB(b, h) + boff + n * 2048 + k * 1024); } while (0)
#define PG8_MMA(ai, bj, At, Bt) do { __builtin_amdgcn_s_setprio(1); _Pragma("unroll") for (int m = 0; m < 4; ++m) _Pragma("unroll") for (int n = 0; n < 2; ++n) _Pragma("unroll") for (int k = 0; k < 2; ++k) \
        acc[ai][bj][m][n] = __builtin_amdgcn_mfma_f32_16x16x32_bf16(Bt[n][k], At[m][k], acc[ai][bj][m][n], 0, 0, 0); __builtin_amdgcn_s_setprio(0); } while (0)
#define PG8_WAIT_V(n) asm volatile("s_waitcnt vmcnt(" #n ")" ::: "memory")
#define PG8_WAIT_L(n) asm volatile("s_waitcnt lgkmcnt(" #n ")" ::: "memory")
#define PG8_BAR __builtin_amdgcn_s_barrier()
#define PG8_SCHED __builtin_amdgcn_sched_barrier(0)
    Unit cur, nxt; int ui = 0;
    if (!S.next(0, cur)) return;
    f32x4 acc[2][2][4][2];
#pragma unroll
    for (int a = 0; a < 2; ++a)
#pragma unroll
        for (int b = 0; b < 2; ++b)
#pragma unroll
            for (int m = 0; m < 4; ++m)
#pragma unroll
                for (int n = 0; n < 2; ++n) acc[a][b][m][n] = (f32x4){0.f, 0.f, 0.f, 0.f};
    bf16x8 At[4][2], B0[2][2], B1[2][2];
    const char* cA = (const char*)g.A + (size_t)cur.pm * tstep; const char* cB = (const char*)g.Bt + (size_t)cur.pn * tstep;
    S.a_ready(cur);
    if constexpr (SP2) {
        PG8_STAGE(PG8_SB(0, 0), cB, voffB); PG8_STAGE(PG8_SB(0, 1), cB + hstep, voffB); PG8_STAGE(PG8_SA(0, 0), cA, voffA); PG8_STAGE(PG8_SA(0, 1), cA + hstep, voffA);
        if (wr == 1) PG8_BAR;
        PG8_WAIT_V(2); PG8_BAR;
        PG8_STAGE(PG8_SB(1, 0), cB + kstep, voffB); PG8_STAGE(PG8_SA(1, 0), cA + kstep, voffA); PG8_STAGE(PG8_SB(1, 1), cB + hstep + kstep, voffB);
        PG8_WAIT_V(6); PG8_BAR;
    } else {
        PG8_STAGE(PG8_SB(0, 0), cB, voffB); PG8_STAGE(PG8_SA(0, 0), cA, voffA); PG8_STAGE(PG8_SB(0, 1), cB + hstep, voffB); PG8_STAGE(PG8_SA(0, 1), cA + hstep, voffA);
        if (wr == 1) PG8_BAR;
        PG8_WAIT_V(4); PG8_BAR;
        PG8_STAGE(PG8_SB(1, 0), cB + kstep, voffB); PG8_STAGE(PG8_SA(1, 0), cA + kstep, voffA); PG8_STAGE(PG8_SB(1, 1), cB + hstep + kstep, voffB);
        PG8_WAIT_V(6); PG8_BAR;
    }
    for (;;) {
        const bool has_next = S.next(ui + 1, nxt);
        const char* nA = has_next ? (const char*)g.A + (size_t)nxt.pm * tstep : cA; const char* nB = has_next ? (const char*)g.Bt + (size_t)nxt.pn * tstep : cB;
        for (int t = 0; t < nt; t += 2) {
            const bool last = (t == nt - 2);
            const char* a1 = cA + (size_t)(t + 1) * kstep;
            const char* a2 = last ? nA : cA + (size_t)(t + 2) * kstep; const char* b2 = last ? nB : cB + (size_t)(t + 2) * kstep;
            const char* a3 = a2 + kstep; const char* b3 = b2 + kstep;
            if (last && has_next) S.a_ready(nxt);
            if constexpr (SP2) {
            PG8_LDB(B0, 0, 0); PG8_LDB(B1, 0, 1); PG8_SCHED; PG8_LDA(At, 0, 0); PG8_STAGE(PG8_SA(1, 1), a1 + hstep, voffA);
            PG8_WAIT_V(8); PG8_WAIT_L(0); PG8_BAR; PG8_MMA(0, 0, At, B0); PG8_MMA(0, 1, At, B1); PG8_BAR; PG8_SCHED;
            PG8_LDA(At, 0, 1); PG8_STAGE(PG8_SB(0, 0), b2, voffB); PG8_STAGE(PG8_SB(0, 1), b2 + hstep, voffB); PG8_STAGE(PG8_SA(0, 0), a2, voffA);
            PG8_WAIT_V(8); PG8_WAIT_L(0); PG8_BAR; PG8_MMA(1, 0, At, B0); PG8_MMA(1, 1, At, B1); PG8_BAR; PG8_SCHED;
            PG8_LDB(B0, 1, 0); PG8_LDB(B1, 1, 1); PG8_SCHED; PG8_LDA(At, 1, 0); PG8_STAGE(PG8_SA(0, 1), a2 + hstep, voffA);
            PG8_WAIT_V(8); PG8_WAIT_L(0); PG8_BAR; PG8_MMA(0, 0, At, B0); PG8_MMA(0, 1, At, B1); PG8_BAR; PG8_SCHED;
            PG8_LDA(At, 1, 1); PG8_STAGE(PG8_SB(1, 0), b3, voffB); PG8_STAGE(PG8_SB(1, 1), b3 + hstep, voffB); PG8_STAGE(PG8_SA(1, 0), a3, voffA);
            PG8_WAIT_V(8); PG8_WAIT_L(0); PG8_BAR; PG8_MMA(1, 0, At, B0); PG8_MMA(1, 1, At, B1); PG8_BAR; PG8_SCHED;
            } else {
            PG8_LDB(B0, 0, 0); PG8_SCHED; PG8_LDA(At, 0, 0); PG8_STAGE(PG8_SA(1, 1), a1 + hstep, voffA);
            PG8_WAIT_L(8); PG8_BAR; PG8_WAIT_L(0); PG8_MMA(0, 0, At, B0); PG8_BAR; PG8_SCHED;
            PG8_LDB(B1, 0, 1); PG8_STAGE(PG8_SB(0, 0), b2, voffB);
            PG8_BAR; PG8_WAIT_L(0); PG8_MMA(0, 1, At, B1); PG8_BAR;
            PG8_LDA(At, 0, 1); PG8_STAGE(PG8_SA(0, 0), a2, voffA);
            PG8_BAR; PG8_WAIT_L(0); PG8_MMA(1, 0, At, B0); PG8_BAR; PG8_SCHED;
            PG8_STAGE(PG8_SB(0, 1), b2 + hstep, voffB);
            PG8_WAIT_V(6); PG8_BAR; PG8_MMA(1, 1, At, B1); PG8_BAR;
            PG8_LDB(B0, 1, 0); PG8_SCHED; PG8_LDA(At, 1, 0); PG8_STAGE(PG8_SA(0, 1), a2 + hstep, voffA);
            PG8_WAIT_L(8); PG8_BAR; PG8_WAIT_L(0); PG8_MMA(0, 0, At, B0); PG8_BAR; PG8_SCHED;
            PG8_LDB(B1, 1, 1); PG8_STAGE(PG8_SB(1, 0), b3, voffB);
            PG8_BAR; PG8_WAIT_L(0); PG8_MMA(0, 1, At, B1); PG8_BAR;
            PG8_LDA(At, 1, 1); PG8_STAGE(PG8_SA(1, 0), a3, voffA);
            PG8_BAR; PG8_WAIT_L(0); PG8_MMA(1, 0, At, B0); PG8_BAR; PG8_SCHED;
            PG8_STAGE(PG8_SB(1, 1), b3 + hstep, voffB);
            PG8_WAIT_V(6); PG8_BAR; PG8_MMA(1, 1, At, B1); PG8_BAR;
            }
        }
        if constexpr (ALIGN_EPI) { if (wr == 0) PG8_BAR; }
        if constexpr (!Epi::AFTER_DRAIN) { E(acc, cur, wr, wc, fr, fq); S.done(cur); }
        if (!has_next) break;
#pragma unroll
        for (int a = 0; a < 2; ++a)
#pragma unroll
            for (int b = 0; b < 2; ++b)
#pragma unroll
                for (int m = 0; m < 4; ++m)
#pragma unroll
                    for (int n = 0; n < 2; ++n) acc[a][b][m][n] = (f32x4){0.f, 0.f, 0.f, 0.f};
        cur = nxt; cA = nA; cB = nB; ++ui;
        if constexpr (ALIGN_EPI) { if (wr == 1) PG8_BAR; }
    }
    PG8_WAIT_V(0);
    if constexpr (!ALIGN_EPI) { if (wr == 0) PG8_BAR; }
    PG8_BAR;
    if constexpr (Epi::AFTER_DRAIN) { E.fused(acc, cur, wr, wc, fr, fq, lds, wid, lane); S.done(cur); }
#undef PG8_SA
#undef PG8_SB
#undef PG8_STAGE
#undef PG8_LDA
#undef PG8_LDB
#undef PG8_MMA
#undef PG8_WAIT_V
#undef PG8_WAIT_L
#undef PG8_BAR
#undef PG8_SCHED
}
}

namespace pg8 {
template <class Epi, class Sched, bool GATHER>
__device__ __forceinline__ void gemm_phase_g(PG8_LAS unsigned char* lds, const int K, const Sched& S, const Epi& E) {
    typedef typename Sched::Unit UnitT;
    const int tid = otid(), wid = __builtin_amdgcn_readfirstlane(tid >> 6), lane = tid & 63, wr = wid >> 2, wc = wid & 3, fr = lane & 15, fq = lane >> 4;
    const int nt = K / BK;
    unsigned voffB[2];
#pragma unroll
    for (int i = 0; i < 2; ++i) { int R, C; stage_rc(tid * 16 + i * 8192, R, C); const int Rb = Epi::PERM ? ((R & ~31) + perm32(R & 31)) : R; voffB[i] = (unsigned)(Rb * K + C) * 2u; }
#define PG8_AOFF(unit, o0, o1) do { const int _tz = otid(); _Pragma("unroll") for (int _i = 0; _i < 2; ++_i) { int _R, _C; stage_rc(_tz * 16 + _i * 8192, _R, _C); \
        o0[_i] = S.arow_off(unit, _R) + (unsigned)_C * 2u; o1[_i] = S.arow_off(unit, HALF + _R) + (unsigned)_C * 2u; } } while (0)
    const size_t kstep = (size_t)(BK * 2);
    const size_t hstep = (size_t)HALF * K * 2;
    const unsigned ldsw = (unsigned)wid * 1024u;
    const int aoff = lds_byte(wr * 64 + fr, fq * 8), boff = lds_byte(wc * 32 + fr, fq * 8);
#define PG8_SA(b, h) (((b) * 2 + (h)) * HTB)
#define PG8_SB(b, h) ((4 + (b) * 2 + (h)) * HTB)
#define PG8_STAGE(bufoff, gbase, voff) do { _Pragma("unroll") for (int _i = 0; _i < 2; ++_i) \
        __builtin_amdgcn_global_load_lds((const unsigned*)((const char*)(gbase) + (voff)[_i]), (PG8_LAS unsigned*)(lds + (bufoff) + ldsw + _i * 8192), 16, 0, 0); } while (0)
#define PG8_LDA(dst, b, h) do { _Pragma("unroll") for (int m = 0; m < 4; ++m) _Pragma("unroll") for (int k = 0; k < 2; ++k) dst[m][k] = *(const PG8_LAS bf16x8*)(lds + PG8_SA(b, h) + aoff + m * 2048 + k * 1024); } while (0)
#define PG8_LDB(dst, b, h) do { _Pragma("unroll") for (int n = 0; n < 2; ++n) _Pragma("unroll") for (int k = 0; k < 2; ++k) dst[n][k] = *(const PG8_LAS bf16x8*)(lds + PG8_SB(b, h) + boff + n * 2048 + k * 1024); } while (0)
#define PG8_MMA(ai, bj, At, Bt) do { __builtin_amdgcn_s_setprio(1); _Pragma("unroll") for (int m = 0; m < 4; ++m) _Pragma("unroll") for (int n = 0; n < 2; ++n) _Pragma("unroll") for (int k = 0; k < 2; ++k) \
        acc[ai][bj][m][n] = __builtin_amdgcn_mfma_f32_16x16x32_bf16(Bt[n][k], At[m][k], acc[ai][bj][m][n], 0, 0, 0); __builtin_amdgcn_s_setprio(0); } while (0)
#define PG8_WAIT_V(n) asm volatile("s_waitcnt vmcnt(" #n ")" ::: "memory")
#define PG8_WAIT_L(n) asm volatile("s_waitcnt lgkmcnt(" #n ")" ::: "memory")
#define PG8_BAR __builtin_amdgcn_s_barrier()
#define PG8_SCHED __builtin_amdgcn_sched_barrier(0)
    UnitT cur, nxt; int ui = 0;
    if (!S.next(0, cur)) return;
    f32x4 acc[2][2][4][2];
#pragma unroll
    for (int a = 0; a < 2; ++a)
#pragma unroll
        for (int b = 0; b < 2; ++b)
#pragma unroll
            for (int m = 0; m < 4; ++m)
#pragma unroll
                for (int n = 0; n < 2; ++n) acc[a][b][m][n] = (f32x4){0.f, 0.f, 0.f, 0.f};
    bf16x8 At[4][2], B0[2][2], B1[2][2];
    unsigned cvo0[2], cvo1[2];
    PG8_AOFF(cur, cvo0, cvo1);
    const char* cA = S.abase(cur); const char* cB = S.bbase(cur);
    PG8_STAGE(PG8_SB(0, 0), cB, voffB); PG8_STAGE(PG8_SB(0, 1), cB + hstep, voffB); PG8_STAGE(PG8_SA(0, 0), cA, cvo0); PG8_STAGE(PG8_SA(0, 1), cA, cvo1);
    if (wr == 1) PG8_BAR;
    PG8_WAIT_V(2); PG8_BAR;
    PG8_STAGE(PG8_SB(1, 0), cB + kstep, voffB); PG8_STAGE(PG8_SA(1, 0), cA + kstep, cvo0); PG8_STAGE(PG8_SB(1, 1), cB + hstep + kstep, voffB);
    PG8_WAIT_V(6); PG8_BAR;
#pragma unroll 1
    for (;;) {
        const bool has_next = S.next(ui + 1, nxt);
        const char* nA = has_next ? S.abase(nxt) : cA; const char* nB = has_next ? S.bbase(nxt) : cB;
        unsigned nvo0[2], nvo1[2];
#pragma unroll 1
        for (int t = 0; t < nt; t += 2) {
            const bool last = (t == nt - 2);
            const char* a1 = cA + (size_t)(t + 1) * kstep;
            const char* a2 = last ? nA : cA + (size_t)(t + 2) * kstep; const char* b2 = last ? nB : cB + (size_t)(t + 2) * kstep;
            const char* a3 = a2 + kstep; const char* b3 = b2 + kstep;
            unsigned v20[2], v21[2];
            if constexpr (GATHER) {
                if (last && has_next) { PG8_AOFF(nxt, nvo0, nvo1); }
                else {
#pragma unroll
                    for (int i = 0; i < 2; ++i) { nvo0[i] = cvo0[i]; nvo1[i] = cvo1[i]; } }
#pragma unroll
                for (int i = 0; i < 2; ++i) { v20[i] = nvo0[i]; v21[i] = nvo1[i]; }
            } else {
#pragma unroll
                for (int i = 0; i < 2; ++i) { v20[i] = cvo0[i]; v21[i] = cvo1[i]; nvo0[i] = cvo0[i]; nvo1[i] = cvo1[i]; }
            }
            PG8_LDB(B0, 0, 0); PG8_LDB(B1, 0, 1); PG8_SCHED; PG8_LDA(At, 0, 0); PG8_STAGE(PG8_SA(1, 1), a1, cvo1);
            PG8_WAIT_V(8); PG8_WAIT_L(0); PG8_BAR; PG8_MMA(0, 0, At, B0); PG8_MMA(0, 1, At, B1); PG8_BAR; PG8_SCHED;
            PG8_LDA(At, 0, 1); PG8_STAGE(PG8_SB(0, 0), b2, voffB); PG8_STAGE(PG8_SB(0, 1), b2 + hstep, voffB); PG8_STAGE(PG8_SA(0, 0), a2, v20);
            PG8_WAIT_V(8); PG8_WAIT_L(0); PG8_BAR; PG8_MMA(1, 0, At, B0); PG8_MMA(1, 1, At, B1); PG8_BAR; PG8_SCHED;
            PG8_LDB(B0, 1, 0); PG8_LDB(B1, 1, 1); PG8_SCHED; PG8_LDA(At, 1, 0); PG8_STAGE(PG8_SA(0, 1), a2, v21);
            PG8_WAIT_V(8); PG8_WAIT_L(0); PG8_BAR; PG8_MMA(0, 0, At, B0); PG8_MMA(0, 1, At, B1); PG8_BAR; PG8_SCHED;
            PG8_LDA(At, 1, 1); PG8_STAGE(PG8_SB(1, 0), b3, voffB); PG8_STAGE(PG8_SB(1, 1), b3 + hstep, voffB); PG8_STAGE(PG8_SA(1, 0), a3, v20);
            PG8_WAIT_V(8); PG8_WAIT_L(0); PG8_BAR; PG8_MMA(1, 0, At, B0); PG8_MMA(1, 1, At, B1); PG8_BAR; PG8_SCHED;
        }
        if (wr == 0) PG8_BAR;
        E(acc, cur, wr, wc, fr, fq);
        if (!has_next) break;
#pragma unroll
        for (int a = 0; a < 2; ++a)
#pragma unroll
            for (int b = 0; b < 2; ++b)
#pragma unroll
                for (int m = 0; m < 4; ++m)
#pragma unroll
                    for (int n = 0; n < 2; ++n) acc[a][b][m][n] = (f32x4){0.f, 0.f, 0.f, 0.f};
        cur = nxt; cA = nA; cB = nB; ++ui;
#pragma unroll
        for (int i = 0; i < 2; ++i) { cvo0[i] = nvo0[i]; cvo1[i] = nvo1[i]; }
        if (wr == 1) PG8_BAR;
    }
    PG8_WAIT_V(0);
    PG8_BAR;
#undef PG8_AOFF
#undef PG8_SA
#undef PG8_SB
#undef PG8_STAGE
#undef PG8_LDA
#undef PG8_LDB
#undef PG8_MMA
#undef PG8_WAIT_V
#undef PG8_WAIT_L
#undef PG8_BAR
#undef PG8_SCHED
}
}

template <int MODE>
__device__ __forceinline__ void transpose_tile(const float* __restrict__ src, bf16_t* __restrict__ dst, int K, int N, int k0, int n0, float* tile  ) {
    const int tid = otid();
    const int c = tid & 63, r0 = tid >> 6;
    __syncthreads();
    if (n0 < N) {
#pragma unroll
        for (int i = 0; i < 8; ++i) { const int kk = r0 + i * 8; tile[kk * 65 + c] = src[(size_t)(k0 + kk) * N + n0 + c]; }
    } else {
#pragma unroll
        for (int i = 0; i < 8; ++i) { const int kk = r0 + i * 8; tile[kk * 65 + c] = 0.f; }
    }
    __syncthreads();
#pragma unroll
    for (int i = 0; i < 8; ++i) {
        const int nn = r0 + i * 8; int n = n0 + nn;
        if (MODE == 1) { const int j = n & 255; const int isu = n >> 8; n = (j >> 4) * 32 + isu * 16 + (j & 15); }
        dst[(size_t)n * K + k0 + c] = f2bf(tile[c * 65 + nn]);
    }
}

__device__ __forceinline__ void prologue(const Params& p, unsigned char* lds) {
    float* tile = (float*)lds;
    const int G = gridDim.x, w = obid(), tid = otid();
    bf16_t* win = (bf16_t*)(p.ws + WS_WIN); bf16_t* wout = (bf16_t*)(p.ws + WS_WOUT);
    bf16_t* mwin = (bf16_t*)(p.ws + WS_MWIN); bf16_t* mwdn = (bf16_t*)(p.ws + WS_MWDN);
    for (int it = w; it < 4 * 16 * 52; it += G) { const int l = it / (16 * 52), r = it % (16 * 52), kt = r / 52, nt = r % 52;
        transpose_tile<0>(p.w_in + (size_t)l * DM * PIN, win + (size_t)l * PINP * DM, DM, PIN, kt * 64, nt * 64, tile); }
    for (int it = w; it < 4 * 16 * 16; it += G) { const int l = it / 256, r = it % 256, kt = r / 16, nt = r % 16;
        transpose_tile<0>(p.w_out + (size_t)l * DM * DM, wout + (size_t)l * DM * DM, DM, DM, kt * 64, nt * 64, tile); }
    for (int it = w; it < 64 * 16 * 8; it += G) { const int le = it / 128, r = it % 128, kt = r / 8, nt = r % 8;
        transpose_tile<1>(p.moe_w_in + (size_t)le * 1024 * 512, mwin + (size_t)le * 512 * 1024, 1024, 512, kt * 64, nt * 64, tile); }
    for (int it = w; it < 64 * 4 * 16; it += G) { const int le = it / 64, r = it % 64, kt = r / 16, nt = r % 16;
        transpose_tile<0>(p.moe_w_down + (size_t)le * 256 * 1024, mwdn + (size_t)le * 1024 * 256, 256, 1024, kt * 64, nt * 64, tile); }
    {
        bf16_t* xb = (bf16_t*)(p.ws + WS_XB);
        const size_t n4 = (size_t)NTOK * DM / 4;
        for (size_t i = (size_t)w * NTHREADS + tid; i < n4; i += (size_t)G * NTHREADS) {
            const float4 v = ((const float4*)p.x)[i];
            ushort4 o; o.x = f2bf(v.x); o.y = f2bf(v.y); o.z = f2bf(v.z); o.w = f2bf(v.w);
            ((ushort4*)xb)[i] = o;
        }
    }
    {
        float* bd = (float*)(p.ws + WS_BIASD);
        for (int i = w * NTHREADS + tid; i < 4 * 2048; i += G * NTHREADS) {
            const int h = i >> 11, n = i & 2047;
            int bucket;
            if (n < 16) bucket = n;
            else { const float nf = (float)n; int lg = 16 + (int)(logf(nf / 16.0f) / 2.0794415416798357f * 16.0f); bucket = lg < 31 ? lg : 31; }
            bd[i] = p.rel_bias[bucket * 4 + h];
        }
    }
}

template <class ARow, class Epi>
__device__ __forceinline__ void gemm128(unsigned char* lds, const ARow& arow, const bf16_t* __restrict__ bt, int K, const Epi& epi) {
    const int tid = otid(), lane = tid & 63, wid = tid >> 6, wm = wid >> 1, wn = wid & 1;
    const int lr = tid >> 2, lc = (tid & 3) * 8;
    bf16_t* As = (bf16_t*)lds; bf16_t* Bs = (bf16_t*)(lds + 10240);
    const bf16_t* ap = arow(lr) + lc;
    const bf16_t* bp = bt + (size_t)lr * K + lc;
    f32x4 acc[2][4];
#pragma unroll
    for (int m = 0; m < 2; ++m)
#pragma unroll
        for (int n = 0; n < 4; ++n) acc[m][n] = (f32x4){0.f, 0.f, 0.f, 0.f};
    uint4 ra = *(const uint4*)ap, rb = *(const uint4*)bp;
    const int fr = lane & 15, fq = lane >> 4;
    for (int k0 = 0; k0 < K; k0 += 32) {
        __syncthreads();
        *(uint4*)(As + lr * 40 + lc) = ra;
        *(uint4*)(Bs + lr * 40 + lc) = rb;
        __syncthreads();
        if (k0 + 32 < K) { ra = *(const uint4*)(ap + k0 + 32); rb = *(const uint4*)(bp + k0 + 32); }
        bf16x8 a[2], b[4];
#pragma unroll
        for (int m = 0; m < 2; ++m) a[m] = *(const bf16x8*)(As + (wm * 32 + m * 16 + fr) * 40 + fq * 8);
#pragma unroll
        for (int n = 0; n < 4; ++n) b[n] = *(const bf16x8*)(Bs + (wn * 64 + n * 16 + fr) * 40 + fq * 8);
#pragma unroll
        for (int m = 0; m < 2; ++m)
#pragma unroll
            for (int n = 0; n < 4; ++n) acc[m][n] = __builtin_amdgcn_mfma_f32_16x16x32_bf16(a[m], b[n], acc[m][n], 0, 0, 0);
    }
    epi(acc, wm, wn, lane);
}

struct RowContig { const bf16_t* base; int ld; __device__ __forceinline__ const bf16_t* operator()(int r) const { return base + (size_t)r * ld; } };

struct EpiProjP {
    static constexpr bool PERM = true, AFTER_DRAIN = false;
    bf16_t* O;
    __device__ __forceinline__ void operator()(const pg8::f32x4 (&acc)[2][2][4][2], const pg8::Unit& u, int wr, int wc, int fr, int fq) const {
        const int row0 = u.pm * 256 + wr * 64 + fr, col0 = u.pn * 256 + wc * 32 + 8 * fq;
#pragma unroll
        for (int ai = 0; ai < 2; ++ai)
#pragma unroll
            for (int m = 0; m < 4; ++m) { bf16_t* rowp = O + (size_t)(row0 + ai * 128 + m * 16) * PINP + col0;
#pragma unroll
                for (int bj = 0; bj < 2; ++bj) { const pg8::f32x4 v0 = acc[ai][bj][m][0], v1 = acc[ai][bj][m][1];
                    pg8::u32x4 w; w.x = pg8::cvt_pk_bf16(v0[0], v0[1]); w.y = pg8::cvt_pk_bf16(v0[2], v0[3]); w.z = pg8::cvt_pk_bf16(v1[0], v1[1]); w.w = pg8::cvt_pk_bf16(v1[2], v1[3]);
                    *(pg8::u32x4*)(rowp + bj * 128) = w; } }
    }
};
__device__ __forceinline__ void phase_inproj(const Params& p, int l, unsigned char* lds) {
    pg8::Gemm g{(const bf16_t*)(p.ws + WS_XB), (const bf16_t*)(p.ws + WS_WIN) + (size_t)l * PINP * DM, NTOK, PINP, DM};
    pg8::StaticOrder S; S.init(NTOK, PINP, (int)gridDim.x, obid());
    EpiProjP E{(bf16_t*)(p.ws + WS_PROJ)};
    pg8::gemm_phase<EpiProjP, pg8::StaticOrder, true, true>((PG8_LAS unsigned char*)lds, g, S, E);
}

struct EpiOutP {
    static constexpr bool PERM = false, AFTER_DRAIN = false;
    const float* xin; float* out;
    __device__ __forceinline__ void operator()(const pg8::f32x4 (&acc)[2][2][4][2], const pg8::Unit& u, int wr, int wc, int fr, int fq) const {
        const int row0 = u.pm * 256 + wr * 64 + fr, col0 = u.pn * 256 + wc * 32 + 4 * fq;
#pragma unroll
        for (int ai = 0; ai < 2; ++ai)
#pragma unroll
            for (int m = 0; m < 4; ++m) { const size_t ro = (size_t)(row0 + ai * 128 + m * 16) * DM + col0;
#pragma unroll
                for (int bj = 0; bj < 2; ++bj)
#pragma unroll
                    for (int n = 0; n < 2; ++n) { const size_t o = ro + bj * 128 + n * 16; const pg8::f32x4 xv = *(const pg8::f32x4*)(xin + o);
                        *(pg8::f32x4*)(out + o) = xv * ALPHA + acc[ai][bj][m][n]; } }
    }
};
__device__ __forceinline__ void phase_outproj(const Params& p, int l, unsigned char* lds) {
    pg8::Gemm g{(const bf16_t*)(p.ws + WS_MIX), (const bf16_t*)(p.ws + WS_WOUT) + (size_t)l * DM * DM, NTOK, DM, DM};
    pg8::StaticOrder S; S.init(NTOK, DM, (int)gridDim.x, obid());
    EpiOutP E{(l == 0) ? p.x : p.out, p.out};
    pg8::gemm_phase<EpiOutP, pg8::StaticOrder, true, true>((PG8_LAS unsigned char*)lds, g, S, E);
}

__device__ __forceinline__ void ln_row(float (&v)[16], const float* gain, const float* bias, int lane) {
    float s = 0.f;
#pragma unroll
    for (int i = 0; i < 16; ++i) s += v[i];
    s = wave_sum(s);
    const float mean = s * (1.0f / 1024.0f);
    float q = 0.f;
#pragma unroll
    for (int i = 0; i < 16; ++i) { const float d = v[i] - mean; q += d * d; }
    q = wave_sum(q);
    const float rstd = rsqrtf(q * (1.0f / 1024.0f) + 1e-5f);
#pragma unroll
    for (int j = 0; j < 4; ++j) {
        const float4 g = *(const float4*)(gain + j * 256 + lane * 4), b = *(const float4*)(bias + j * 256 + lane * 4);
        v[j * 4 + 0] = (v[j * 4 + 0] - mean) * rstd * g.x + b.x; v[j * 4 + 1] = (v[j * 4 + 1] - mean) * rstd * g.y + b.y;
        v[j * 4 + 2] = (v[j * 4 + 2] - mean) * rstd * g.z + b.z; v[j * 4 + 3] = (v[j * 4 + 3] - mean) * rstd * g.w + b.w;
    }
}
__device__ __forceinline__ void store_row(const float (&v)[16], float* xo, bf16_t* xbo, int lane) {
#pragma unroll
    for (int j = 0; j < 4; ++j) {
        *(float4*)(xo + j * 256 + lane * 4) = make_float4(v[j * 4], v[j * 4 + 1], v[j * 4 + 2], v[j * 4 + 3]);
        ushort4 o; o.x = f2bf(v[j * 4]); o.y = f2bf(v[j * 4 + 1]); o.z = f2bf(v[j * 4 + 2]); o.w = f2bf(v[j * 4 + 3]);
        *(ushort4*)(xbo + j * 256 + lane * 4) = o;
    }
}

__device__ __forceinline__ void route_pick(const float (&lg)[16], const float* rb, int& i1, int& i2, float& g1, float& g2) {
    float aff[16], sl[16];
#pragma unroll
    for (int e = 0; e < 16; ++e) { aff[e] = sigmoidf_(lg[e]); sl[e] = aff[e] + rb[e]; }
    float bestg = -INFINITY; int bg = 0;
#pragma unroll
    for (int g = 0; g < 4; ++g) {
        float m1 = -INFINITY, m2 = -INFINITY;
#pragma unroll
        for (int k = 0; k < 4; ++k) { const float s = sl[g * 4 + k]; if (s > m1) { m2 = m1; m1 = s; } else if (s > m2) m2 = s; }
        const float gs = m1 + m2;
        if (gs > bestg) { bestg = gs; bg = g; }
    }
    float b1 = -INFINITY; i1 = 0; float a1 = 0.f;
#pragma unroll
    for (int e = 0; e < 16; ++e) { const bool in = (e >> 2) == bg; if (in && sl[e] > b1) { b1 = sl[e]; i1 = e; a1 = aff[e]; } }
    float b2 = -INFINITY; i2 = 0; float a2 = 0.f;
#pragma unroll
    for (int e = 0; e < 16; ++e) { const bool in = ((e >> 2) == bg) && (e != i1); if (in && sl[e] > b2) { b2 = sl[e]; i2 = e; a2 = aff[e]; } }
    const float inv = 1.0f / (a1 + a2);
    g1 = a1 * inv; g2 = a2 * inv;
}
__device__ __forceinline__ void phase_ln1_route(const Params& p, int l, unsigned char* lds) {
    const int tid = otid(), lane = tid & 63, wid = tid >> 6;
    int* sel_e = (int*)lds;
    float* sel_g = (float*)(lds + 2048);
    int* rank = (int*)(lds + 4096);
    int* base = (int*)(lds + 6144);
    float* rwT = (float*)(lds + 8192);
    bf16_t* xb = (bf16_t*)(p.ws + WS_XB);
    unsigned* ctl = (unsigned*)(p.ws + WS_CTL);
    int* ltok = (int*)(p.ws + WS_LTOK);
    const float* gain = p.ln_gain + (size_t)(l * 2 + 0) * DM; const float* bias = p.ln_bias + (size_t)(l * 2 + 0) * DM;
    __syncthreads();
    for (int i = tid; i < 16384; i += NTHREADS) { const int c = i >> 4, e = i & 15; rwT[e * 1024 + c] = p.router_w[i]; }
    for (int chunk = obid(); chunk < NTOK / 256; chunk += gridDim.x) {
        __syncthreads();
        for (int rr = 0; rr < 32; rr += 2) {
            const int lrow = wid * 32 + rr; const size_t row = (size_t)chunk * 256 + lrow;
            float v0[16], v1[16];
#pragma unroll
            for (int j = 0; j < 4; ++j) { const float4 t = *(const float4*)(p.out + row * DM + j * 256 + lane * 4); v0[j * 4] = t.x; v0[j * 4 + 1] = t.y; v0[j * 4 + 2] = t.z; v0[j * 4 + 3] = t.w;
                const float4 u = *(const float4*)(p.out + (row + 1) * DM + j * 256 + lane * 4); v1[j * 4] = u.x; v1[j * 4 + 1] = u.y; v1[j * 4 + 2] = u.z; v1[j * 4 + 3] = u.w; }
            ln_row(v0, gain, bias, lane); ln_row(v1, gain, bias, lane);
            store_row(v0, p.out + row * DM, xb + row * DM, lane); store_row(v1, p.out + (row + 1) * DM, xb + (row + 1) * DM, lane);
            float lg0[16], lg1[16];
#pragma unroll
            for (int e = 0; e < 16; ++e) {
                float s0 = 0.f, s1 = 0.f;
#pragma unroll
                for (int j = 0; j < 4; ++j) { const float4 w = *(const float4*)(rwT + e * 1024 + j * 256 + lane * 4);
                    s0 += v0[j * 4] * w.x + v0[j * 4 + 1] * w.y + v0[j * 4 + 2] * w.z + v0[j * 4 + 3] * w.w;
                    s1 += v1[j * 4] * w.x + v1[j * 4 + 1] * w.y + v1[j * 4 + 2] * w.z + v1[j * 4 + 3] * w.w; }
                lg0[e] = wave_sum(s0); lg1[e] = wave_sum(s1);
            }
            if (lane < 2) {
                int i1, i2; float g1, g2;
                if (lane == 0) route_pick(lg0, p.router_b, i1, i2, g1, g2); else route_pick(lg1, p.router_b, i1, i2, g1, g2);
                const int lr = lrow + lane;
                sel_e[lr * 2] = i1; sel_e[lr * 2 + 1] = i2; sel_g[lr * 2] = g1; sel_g[lr * 2 + 1] = g2;
            }
        }
        __syncthreads();
        if (tid < 16) {
            int c = 0;
            for (int i = 0; i < 512; ++i) if (sel_e[i] == tid) { rank[i] = c; ++c; }
            base[tid] = (int)atomicAdd(&ctl[CW_CNT + (l * 16 + tid) * 64], (unsigned)c);
        }
        __syncthreads();
        {
            const int e = sel_e[tid]; const int pos = base[e] + rank[tid];
            ltok[(size_t)e * NTOK + pos] = chunk * 256 + (tid >> 1);
            int* ti = (int*)(p.ws + WS_LGATE) + (size_t)(chunk * 256 + (tid >> 1)) * 4;
            ti[tid & 1] = (e << 17) | pos; ((float*)ti)[2 + (tid & 1)] = sel_g[tid];
        }
    }
}

#define MOE_TAB_OFF 131072
#define MOE_META_OFF (131072 + 4096)
struct MoeUnit { int e, rl, pn, n, ui, pb; };
__device__ __forceinline__ void moe_meta(const Params& p, int l, PG8_LAS int* meta) {
    if (otid() == 0) {
        unsigned* ctl = (unsigned*)(p.ws + WS_CTL);
        int tb = 0, pb = 0;
        for (int e = 0; e < 16; ++e) { const int c = (int)xb_ld(&ctl[CW_CNT + (l * 16 + e) * 64]); meta[e] = c; meta[16 + e] = tb; meta[33 + e] = pb; tb += (c + 255) >> 8; pb += c; }
        meta[32] = tb; meta[49] = pb;
    }
    __syncthreads();
}
template <int NCOL_LOG2>
struct MoeSchedBase {
    typedef MoeUnit Unit;
    PG8_LAS const int* meta; int G, c;
    __device__ __forceinline__ int mu(int idx) const { return __builtin_amdgcn_readfirstlane(meta[idx]); }
    __device__ __forceinline__ bool next(int i, MoeUnit& u) const {
        const int L = i * G + c; const int ntile = mu(32);
        if (L >= (ntile << NCOL_LOG2)) return false;
        const int rt = L >> NCOL_LOG2; u.pn = L & ((1 << NCOL_LOG2) - 1);
        int e = 0;
#pragma unroll
        for (int k = 1; k < 16; ++k) if (rt >= mu(16 + k)) e = k;
        u.e = e; u.rl = rt - mu(16 + e); u.n = mu(e) - u.rl * 256; u.pb = mu(33 + e) + u.rl * 256; u.ui = i; return true;
    }
};
struct MoeSchedUp : MoeSchedBase<1> {
    PG8_LAS const unsigned short* tok16; const char* xb; const char* wbase;
    __device__ __forceinline__ const char* abase(const MoeUnit&) const { return xb; }
    __device__ __forceinline__ unsigned arow_off(const MoeUnit& u, int r) const { return (unsigned)tok16[u.ui * 256 + r] * 2048u; }
    __device__ __forceinline__ const char* bbase(const MoeUnit& u) const { return wbase + ((size_t)u.e * 512 + u.pn * 256) * 2048; }
};
struct MoeSchedDown : MoeSchedBase<2> {
    const char* hb; const char* wbase;
    __device__ __forceinline__ const char* abase(const MoeUnit& u) const { return hb + (size_t)u.pb * 512; }
    __device__ __forceinline__ unsigned arow_off(const MoeUnit&, int r) const { return (unsigned)r * 512u; }
    __device__ __forceinline__ const char* bbase(const MoeUnit& u) const { return wbase + ((size_t)u.e * 1024 + u.pn * 256) * 512; }
};
struct EpiUp {
    static constexpr bool PERM = false, AFTER_DRAIN = false;
    bf16_t* H;
    __device__ __forceinline__ void operator()(const pg8::f32x4 (&acc)[2][2][4][2], const MoeUnit& u, int wr, int wc, int fr, int fq) const {
        bf16_t* hb = H + u.pn * 128 + wc * 16 + fq * 4;
#pragma unroll
        for (int ai = 0; ai < 2; ++ai)
#pragma unroll
            for (int m = 0; m < 4; ++m) {
                const int r = ai * 128 + wr * 64 + m * 16 + fr;
                const int rr = (r < u.n) ? (u.pb + r) : (2 * NTOK + r);
#pragma unroll
                for (int bj = 0; bj < 2; ++bj) {
                    const pg8::f32x4 g = acc[ai][bj][m][0], uu = acc[ai][bj][m][1];
                    float hv[4];
#pragma unroll
                    for (int i = 0; i < 4; ++i) hv[i] = g[i] * __builtin_amdgcn_rcpf(1.0f + __builtin_amdgcn_exp2f(-g[i] * LOG2E)) * uu[i];
                    uint2 w; w.x = pg8::cvt_pk_bf16(hv[0], hv[1]); w.y = pg8::cvt_pk_bf16(hv[2], hv[3]);
                    *(uint2*)(hb + (size_t)rr * DEXP + bj * 64) = w;
                }
            }
    }
};
struct EpiDown {
    static constexpr bool PERM = true, AFTER_DRAIN = false;
    bf16_t* Y;
    __device__ __forceinline__ void operator()(const pg8::f32x4 (&acc)[2][2][4][2], const MoeUnit& u, int wr, int wc, int fr, int fq) const {
        bf16_t* yb = Y + u.pn * 256 + wc * 32 + 8 * fq;
#pragma unroll
        for (int ai = 0; ai < 2; ++ai)
#pragma unroll
            for (int m = 0; m < 4; ++m) {
                const int r = ai * 128 + wr * 64 + m * 16 + fr;
                const int rr = (r < u.n) ? (u.pb + r) : (2 * NTOK + r);
#pragma unroll
                for (int bj = 0; bj < 2; ++bj) { const pg8::f32x4 v0 = acc[ai][bj][m][0], v1 = acc[ai][bj][m][1];
                    pg8::u32x4 w; w.x = pg8::cvt_pk_bf16(v0[0], v0[1]); w.y = pg8::cvt_pk_bf16(v0[2], v0[3]); w.z = pg8::cvt_pk_bf16(v1[0], v1[1]); w.w = pg8::cvt_pk_bf16(v1[2], v1[3]);
                    *(pg8::u32x4*)(yb + (size_t)rr * DM + bj * 128) = w; }
            }
    }
};
__device__ __forceinline__ void phase_moe_up(const Params& p, int l, unsigned char* lds) {
    PG8_LAS unsigned char* L = (PG8_LAS unsigned char*)lds;
    PG8_LAS int* meta = (PG8_LAS int*)(L + MOE_META_OFF);
    PG8_LAS unsigned short* tok16 = (PG8_LAS unsigned short*)(L + MOE_TAB_OFF);
    __syncthreads();
    moe_meta(p, l, meta);
    MoeSchedUp S; S.meta = meta; S.G = (int)gridDim.x; S.c = obid(); S.tok16 = tok16; S.xb = (const char*)(p.ws + WS_XB); S.wbase = (const char*)(p.ws + WS_MWIN) + (size_t)l * 16 * 512 * 2048;
    {
        const int* ltok = (const int*)(p.ws + WS_LTOK); const int tid = otid();
        MoeUnit u;
        for (int i = 0; i < 8 && S.next(i, u); ++i)
            if (tid < 256) tok16[i * 256 + tid] = (tid < u.n) ? (unsigned short)ltok[(size_t)u.e * NTOK + u.rl * 256 + tid] : (unsigned short)0;
    }
    __syncthreads();
    EpiUp E{(bf16_t*)(p.ws + WS_H)};
    pg8::gemm_phase_g<EpiUp, MoeSchedUp, true>(L, 1024, S, E);
}
__device__ __forceinline__ void phase_moe_down(const Params& p, int l, unsigned char* lds) {
    PG8_LAS unsigned char* L = (PG8_LAS unsigned char*)lds;
    PG8_LAS int* meta = (PG8_LAS int*)(L + MOE_META_OFF);
    __syncthreads();
    moe_meta(p, l, meta);
    MoeSchedDown S; S.meta = meta; S.G = (int)gridDim.x; S.c = obid(); S.hb = (const char*)(p.ws + WS_H); S.wbase = (const char*)(p.ws + WS_MWDN) + (size_t)l * 16 * 1024 * 512;
    EpiDown E{(bf16_t*)(p.ws + WS_Y)};
    pg8::gemm_phase_g<EpiDown, MoeSchedDown, false>(L, 256, S, E);
}

__device__ __forceinline__ void phase_ln2(const Params& p, int l, unsigned char* lds) {
    const int tid = otid(), lane = tid & 63, wid = tid >> 6;
    bf16_t* xb = (bf16_t*)(p.ws + WS_XB); const bf16_t* Y = (const bf16_t*)(p.ws + WS_Y);
    const float* gain = p.ln_gain + (size_t)(l * 2 + 1) * DM; const float* bias = p.ln_bias + (size_t)(l * 2 + 1) * DM;
    int* pbase = (int*)lds;
    __syncthreads();
    if (tid == 0) { unsigned* ctl = (unsigned*)(p.ws + WS_CTL); int pb = 0; for (int e = 0; e < 16; ++e) { pbase[e] = pb; pb += (int)xb_ld(&ctl[CW_CNT + (l * 16 + e) * 64]); } }
    __syncthreads();
    for (size_t row = (size_t)obid() * 8 + wid; row < NTOK; row += (size_t)gridDim.x * 8) {
        const int4 ti = *(const int4*)(p.ws + WS_LGATE + row * 16);
        const size_t p0 = (size_t)(pbase[ti.x >> 17] + (ti.x & 0x1ffff)), p1 = (size_t)(pbase[ti.y >> 17] + (ti.y & 0x1ffff));
        const float g0 = __int_as_float(ti.z), g1 = __int_as_float(ti.w);
        float v[16];
#pragma unroll
        for (int j = 0; j < 4; ++j) {
            const float4 t = *(const float4*)(p.out + row * DM + j * 256 + lane * 4);
            const ushort4 y0 = *(const ushort4*)(Y + p0 * DM + j * 256 + lane * 4), y1 = *(const ushort4*)(Y + p1 * DM + j * 256 + lane * 4);
            v[j * 4 + 0] = ALPHA * t.x + g0 * bf2f(y0.x) + g1 * bf2f(y1.x); v[j * 4 + 1] = ALPHA * t.y + g0 * bf2f(y0.y) + g1 * bf2f(y1.y);
            v[j * 4 + 2] = ALPHA * t.z + g0 * bf2f(y0.z) + g1 * bf2f(y1.z); v[j * 4 + 3] = ALPHA * t.w + g0 * bf2f(y0.w) + g1 * bf2f(y1.w);
        }
        ln_row(v, gain, bias, lane);
        store_row(v, p.out + row * DM, xb + row * DM, lane);
    }
}

__device__ __forceinline__ void sb_item(const Params& p, int bh, int qc, unsigned char* lds) {
    const int tid = otid(), b = bh >> 2, h = bh & 3;
    const bf16_t* proj = (const bf16_t*)(p.ws + WS_PROJ) + (size_t)b * SEQ * PINP;
    bf16_t* mix = (bf16_t*)(p.ws + WS_MIX) + (size_t)b * SEQ * DM;
    float* Ks = (float*)lds; float* Vs = (float*)(lds + 16384);
    const int t = qc * 512 + tid; const int twmax = qc * 512 + (tid | 63);
    float q[64], acc[64];
#pragma unroll
    for (int d8 = 0; d8 < 8; ++d8) { const uint4 raw = *(const uint4*)(proj + (size_t)t * PINP + h * 64 + d8 * 8); const bf16_t* rp = (const bf16_t*)&raw;
#pragma unroll
        for (int i = 0; i < 8; ++i) q[d8 * 8 + i] = bf2f(rp[i]) * 0.125f; }
#pragma unroll
    for (int d = 0; d < 64; ++d) acc[d] = 0.f;
    float cs = 0.f;
    for (int kb = qc * 8 + 7; kb >= 0; --kb) {
        __syncthreads();
        { const int key = tid >> 3, d8 = tid & 7; const size_t ro = (size_t)(kb * 64 + key) * PINP + h * 64 + d8 * 8;
          const uint4 rk = *(const uint4*)(proj + ro + 256), rv = *(const uint4*)(proj + ro + 512); const bf16_t* pk = (const bf16_t*)&rk; const bf16_t* pv = (const bf16_t*)&rv;
#pragma unroll
          for (int i = 0; i < 8; ++i) { Ks[key * 64 + d8 * 8 + i] = bf2f(pk[i]); Vs[key * 64 + d8 * 8 + i] = bf2f(pv[i]); } }
        __syncthreads();
        if (kb * 64 < twmax) {
            for (int sl = 63; sl >= 0; --sl) {
                const int s = kb * 64 + sl;
                if (s < t) {
                    float z = 0.f;
#pragma unroll
                    for (int d4 = 0; d4 < 16; ++d4) { const float4 kv = *(const float4*)(Ks + sl * 64 + d4 * 4); z += q[d4 * 4] * kv.x + q[d4 * 4 + 1] * kv.y + q[d4 * 4 + 2] * kv.z + q[d4 * 4 + 3] * kv.w; }
                    const float sp = fmaxf(z, 0.f) + log1pf(expf(-fabsf(z)));
                    cs += sp;
                    const float w = expf(z - cs);
#pragma unroll
                    for (int d4 = 0; d4 < 16; ++d4) { const float4 vv = *(const float4*)(Vs + sl * 64 + d4 * 4); acc[d4 * 4] += w * vv.x; acc[d4 * 4 + 1] += w * vv.y; acc[d4 * 4 + 2] += w * vv.z; acc[d4 * 4 + 3] += w * vv.w; }
                }
            }
        }
    }
#pragma unroll
    for (int d8 = 0; d8 < 8; ++d8) { uint4 o; bf16_t* op = (bf16_t*)&o;
#pragma unroll
        for (int i = 0; i < 8; ++i) op[i] = f2bf(acc[d8 * 8 + i]);
        *(uint4*)(mix + (size_t)t * DM + h * 64 + d8 * 8) = o; }
}

__device__ __forceinline__ void da_item(const Params& p, int l, int bh, int qc, unsigned char* lds) {
    const int tid = otid(), b = bh >> 2, h = bh & 3, map = tid >> 8, row = tid & 255;
    const bf16_t* proj = (const bf16_t*)(p.ws + WS_PROJ) + (size_t)b * SEQ * PINP;
    bf16_t* mix = (bf16_t*)(p.ws + WS_MIX) + (size_t)b * SEQ * DM;
    const float* biasd = (const float*)(p.ws + WS_BIASD) + h * 2048;
    float* Ks = (float*)lds; float* Vs = (float*)(lds + 16384); float* Bd = (float*)(lds + 32768); float* Ex = (float*)(lds + 40960);
    const int t = qc * 256 + row; const int twmax = qc * 256 + (row | 63);
    __syncthreads();
    for (int i = tid; i < 2048; i += NTHREADS) Bd[i] = biasd[i];
    float q[32], O[64];
#pragma unroll
    for (int d8 = 0; d8 < 4; ++d8) { const uint4 raw = *(const uint4*)(proj + (size_t)t * PINP + 768 + h * 64 + map * 32 + d8 * 8); const bf16_t* rp = (const bf16_t*)&raw;
#pragma unroll
        for (int i = 0; i < 8; ++i) q[d8 * 8 + i] = bf2f(rp[i]) * 0.17677669529663687f; }
#pragma unroll
    for (int d = 0; d < 64; ++d) O[d] = 0.f;
    float mrun = -INFINITY, lsum = 0.f;
    for (int kb = 0; kb <= qc * 4 + 3; ++kb) {
        __syncthreads();
        { const int key = tid >> 3, d8 = tid & 7; const size_t ro = (size_t)(kb * 64 + key) * PINP + 768 + h * 64 + d8 * 8;
          const uint4 rk = *(const uint4*)(proj + ro + 256), rv = *(const uint4*)(proj + ro + 512); const bf16_t* pk = (const bf16_t*)&rk; const bf16_t* pv = (const bf16_t*)&rv;
#pragma unroll
          for (int i = 0; i < 8; ++i) { Ks[key * 64 + d8 * 8 + i] = bf2f(pk[i]); Vs[key * 64 + d8 * 8 + i] = bf2f(pv[i]); } }
        __syncthreads();
        if (kb * 64 <= twmax) {
            for (int sl = 0; sl < 64; ++sl) {
                const int s = kb * 64 + sl;
                if (s <= t) {
                    float z = Bd[t - s];
#pragma unroll
                    for (int d4 = 0; d4 < 8; ++d4) { const float4 kv = *(const float4*)(Ks + sl * 64 + map * 32 + d4 * 4); z += q[d4 * 4] * kv.x + q[d4 * 4 + 1] * kv.y + q[d4 * 4 + 2] * kv.z + q[d4 * 4 + 3] * kv.w; }
                    if (z > mrun) { const float sc = expf(mrun - z); lsum *= sc;
#pragma unroll
                        for (int d = 0; d < 64; ++d) O[d] *= sc;
                        mrun = z; }
                    const float pw = expf(z - mrun);
                    lsum += pw;
#pragma unroll
                    for (int d4 = 0; d4 < 16; ++d4) { const float4 vv = *(const float4*)(Vs + sl * 64 + d4 * 4); O[d4 * 4] += pw * vv.x; O[d4 * 4 + 1] += pw * vv.y; O[d4 * 4 + 2] += pw * vv.z; O[d4 * 4 + 3] += pw * vv.w; }
                }
            }
        }
    }
    const float il = 1.0f / lsum;
    __syncthreads();
    if (map == 1) {
#pragma unroll
        for (int d = 0; d < 64; ++d) Ex[d * 256 + row] = O[d] * il;
    }
    __syncthreads();
    if (map == 0) {
        const float* lp = p.da_lambda + (size_t)l * 128;
        float s1 = 0.f, s2 = 0.f;
        for (int i = 0; i < 32; ++i) { s1 += lp[i] * lp[32 + i]; s2 += lp[64 + i] * lp[96 + i]; }
        const float lam_init = 0.8f - 0.6f * expf(-0.3f * (float)l);
        const float lam = expf(s1) - expf(s2) + lam_init;
        float ms = 0.f;
#pragma unroll
        for (int d = 0; d < 64; ++d) { O[d] = O[d] * il - lam * Ex[d * 256 + row]; ms += O[d] * O[d]; }
        const float r = rsqrtf(ms * (1.0f / 64.0f) + 1e-5f) * (1.0f - lam_init);
        const float* sg = p.da_subln + l * 64;
#pragma unroll
        for (int d8 = 0; d8 < 8; ++d8) { uint4 o; bf16_t* op = (bf16_t*)&o;
#pragma unroll
            for (int i = 0; i < 8; ++i) op[i] = f2bf(O[d8 * 8 + i] * r * sg[d8 * 8 + i]);
            *(uint4*)(mix + (size_t)t * DM + 256 + h * 64 + d8 * 8) = o; }
    }
}

typedef float f32x16 __attribute__((ext_vector_type(16)));
typedef unsigned u32x4v __attribute__((ext_vector_type(4)));
#define AT_KSTR 72
#define AT_VSTR 68
#define AT_KBYTES (64 * AT_KSTR * 2)
#define AT_VBYTES (64 * AT_VSTR * 2)
__device__ __forceinline__ unsigned pk_bf16(float lo, float hi) { return pg8::cvt_pk_bf16(lo, hi); }
__device__ __forceinline__ bf16x8 mk_frag(unsigned a, unsigned b, unsigned c, unsigned d) { u32x4v v; v.x = a; v.y = b; v.z = c; v.w = d; return __builtin_bit_cast(bf16x8, v); }
__device__ __forceinline__ bf16x8 scale_frag(uint4 raw, float sc) {
    return mk_frag(pk_bf16(__uint_as_float(raw.x << 16) * sc, __uint_as_float(raw.x & 0xffff0000u) * sc), pk_bf16(__uint_as_float(raw.y << 16) * sc, __uint_as_float(raw.y & 0xffff0000u) * sc),
                   pk_bf16(__uint_as_float(raw.z << 16) * sc, __uint_as_float(raw.z & 0xffff0000u) * sc), pk_bf16(__uint_as_float(raw.w << 16) * sc, __uint_as_float(raw.w & 0xffff0000u) * sc));
}
struct AtStage {
    uint4 rk; uint2 rv0, rv1;
    __device__ __forceinline__ void load(const bf16_t* kbase, const bf16_t* vbase, int kt, int tid) {
        const int skey = tid >> 3, sc8 = tid & 7, vkp = tid >> 4, vdg = tid & 15;
        rk = *(const uint4*)(kbase + (size_t)(kt * 64 + skey) * PINP + sc8 * 8);
        rv0 = *(const uint2*)(vbase + (size_t)(kt * 64 + 2 * vkp) * PINP + vdg * 4);
        rv1 = *(const uint2*)(vbase + (size_t)(kt * 64 + 2 * vkp + 1) * PINP + vdg * 4);
    }
    __device__ __forceinline__ void store(unsigned char* kb, unsigned char* vb, int tid) const {
        const int skey = tid >> 3, sc8 = tid & 7, vkp = tid >> 4, vdg = tid & 15;
        *(uint4*)(kb + (skey * AT_KSTR + sc8 * 8) * 2) = rk;
        unsigned* vt = (unsigned*)vb;
        vt[(vdg * 4 + 0) * (AT_VSTR / 2) + vkp] = (rv0.x & 0xffffu) | (rv1.x << 16);
        vt[(vdg * 4 + 1) * (AT_VSTR / 2) + vkp] = (rv0.x >> 16) | (rv1.x & 0xffff0000u);
        vt[(vdg * 4 + 2) * (AT_VSTR / 2) + vkp] = (rv0.y & 0xffffu) | (rv1.y << 16);
        vt[(vdg * 4 + 3) * (AT_VSTR / 2) + vkp] = (rv0.y >> 16) | (rv1.y & 0xffff0000u);
    }
};
__device__ __forceinline__ bf16x8 k_frag(const unsigned char* kb, int keyrow, int dcol) { return *(const bf16x8*)(kb + (keyrow * AT_KSTR + dcol) * 2); }
__device__ __forceinline__ bf16x8 v_frag(const unsigned char* vb, int drow, int keycol) {
    const uint2 a = *(const uint2*)(vb + (drow * AT_VSTR + keycol) * 2), b = *(const uint2*)(vb + (drow * AT_VSTR + keycol + 8) * 2);
    return mk_frag(a.x, a.y, b.x, b.y);
}
__device__ __forceinline__ void store_ot(bf16_t* dst  , const f32x16& o0, const f32x16& o1, int hh) {
#pragma unroll
    for (int q = 0; q < 4; ++q) {
        uint2 w; w.x = pk_bf16(o0[4 * q], o0[4 * q + 1]); w.y = pk_bf16(o0[4 * q + 2], o0[4 * q + 3]);
        *(uint2*)(dst + 8 * q + 4 * hh) = w;
        uint2 w1; w1.x = pk_bf16(o1[4 * q], o1[4 * q + 1]); w1.y = pk_bf16(o1[4 * q + 2], o1[4 * q + 3]);
        *(uint2*)(dst + 32 + 8 * q + 4 * hh) = w1;
    }
}

__device__ __forceinline__ void sbm_item(const Params& p, int bh, int qb, unsigned char* lds) {
    const int tid = otid(), lane = tid & 63, wid = tid >> 6, r = lane & 31, hh = lane >> 5;
    const int b = bh >> 2, h = bh & 3;
    const bf16_t* proj = (const bf16_t*)(p.ws + WS_PROJ) + (size_t)b * SEQ * PINP;
    const bf16_t* kbase = proj + 256 + h * 64; const bf16_t* vbase = proj + 512 + h * 64;
    const int q0w = qb * 256 + wid * 32, t = q0w + r;
    unsigned char* KB[2] = {lds, lds + AT_KBYTES}; unsigned char* VB[2] = {lds + 2 * AT_KBYTES, lds + 2 * AT_KBYTES + AT_VBYTES};
    volatile int* flags = (volatile int*)(lds + 2 * AT_KBYTES + 2 * AT_VBYTES);
    bf16x8 qf[4];
#pragma unroll
    for (int s = 0; s < 4; ++s) qf[s] = scale_frag(*(const uint4*)(proj + (size_t)t * PINP + h * 64 + 16 * s + 8 * hh), 0.125f * LOG2E);
    f32x16 O0, O1;
#pragma unroll
    for (int i = 0; i < 16; ++i) { O0[i] = 0.f; O1[i] = 0.f; }
    float carry = 1.f;
    bool wdone = false;
    AtStage st;
    const int ktop = qb * 4 + 3;
    __syncthreads();
    st.load(kbase, vbase, ktop, tid); st.store(KB[0], VB[0], tid);
    __syncthreads();
    int it = 0;
#pragma unroll 1
    for (int kt = ktop; kt >= 0; --kt, ++it) {
        const int buf = it & 1;
        if (kt > 0) st.load(kbase, vbase, kt - 1, tid);
        if (!wdone && 64 * kt < q0w + 31) {
#pragma unroll
            for (int kb32 = 1; kb32 >= 0; --kb32) {
                const int kbs = 64 * kt + 32 * kb32;
                if (kbs < q0w + 31) {
                    f32x16 S;
#pragma unroll
                    for (int i = 0; i < 16; ++i) S[i] = 0.f;
#pragma unroll
                    for (int s = 0; s < 4; ++s) S = __builtin_amdgcn_mfma_f32_32x32x16_bf16(k_frag(KB[buf], kb32 * 32 + r, 16 * s + 8 * hh), qf[s], S, 0, 0, 0);
                    const bool needmask = (kbs + 31 >= q0w);
                    float sg[16], G[4];
#pragma unroll
                    for (int q = 0; q < 4; ++q) {
                        float om[4];
#pragma unroll
                        for (int i = 0; i < 4; ++i) {
                            const float z = S[4 * q + i];
                            const float e = __builtin_amdgcn_exp2f(-fabsf(z));
                            const float rr = __builtin_amdgcn_rcpf(1.0f + e);
                            const float er = e * rr;
                            float sgm = z >= 0.f ? rr : er, omm = z >= 0.f ? er : rr;
                            if (needmask) { const int key = kbs + i + 8 * q + 4 * hh; if (key >= t) { sgm = 0.f; omm = 1.f; } }
                            sg[4 * q + i] = sgm; om[i] = omm;
                        }
                        const float pp2 = om[3], pp1 = pp2 * om[2], pp0 = pp1 * om[1];
                        G[q] = pp0 * om[0];
                        sg[4 * q + 2] *= pp2; sg[4 * q + 1] *= pp1; sg[4 * q + 0] *= pp0;
                    }
                    float Gp[4];
#pragma unroll
                    for (int q = 0; q < 4; ++q) Gp[q] = __shfl_xor(G[q], 32);
                    const float T0 = G[0] * Gp[0], T1 = G[1] * Gp[1], T2 = G[2] * Gp[2], T3 = G[3] * Gp[3];
                    const float U2 = T3, U1 = T3 * T2, U0 = U1 * T1;
                    float E[4];
                    E[3] = carry; E[2] = carry * U2; E[1] = carry * U1; E[0] = carry * U0;
                    if (hh == 0) { E[3] *= Gp[3]; E[2] *= Gp[2]; E[1] *= Gp[1]; E[0] *= Gp[0]; }
                    carry = carry * U0 * T0;
#pragma unroll
                    for (int q = 0; q < 4; ++q) { sg[4 * q] *= E[q]; sg[4 * q + 1] *= E[q]; sg[4 * q + 2] *= E[q]; sg[4 * q + 3] *= E[q]; }
                    const bf16x8 P0 = mk_frag(pk_bf16(sg[0], sg[1]), pk_bf16(sg[2], sg[3]), pk_bf16(sg[4], sg[5]), pk_bf16(sg[6], sg[7]));
                    const bf16x8 P1 = mk_frag(pk_bf16(sg[8], sg[9]), pk_bf16(sg[10], sg[11]), pk_bf16(sg[12], sg[13]), pk_bf16(sg[14], sg[15]));
                    O0 = __builtin_amdgcn_mfma_f32_32x32x16_bf16(v_frag(VB[buf], r, kb32 * 32 + 4 * hh), P0, O0, 0, 0, 0);
                    O0 = __builtin_amdgcn_mfma_f32_32x32x16_bf16(v_frag(VB[buf], r, kb32 * 32 + 16 + 4 * hh), P1, O0, 0, 0, 0);
                    O1 = __builtin_amdgcn_mfma_f32_32x32x16_bf16(v_frag(VB[buf], 32 + r, kb32 * 32 + 4 * hh), P0, O1, 0, 0, 0);
                    O1 = __builtin_amdgcn_mfma_f32_32x32x16_bf16(v_frag(VB[buf], 32 + r, kb32 * 32 + 16 + 4 * hh), P1, O1, 0, 0, 0);
                }
            }
            wdone = __all(carry < 1e-30f);
        }
        if (lane == 0) flags[buf * 8 + wid] = wdone ? 1 : 0;
        if (kt > 0) st.store(KB[buf ^ 1], VB[buf ^ 1], tid);
        __syncthreads();
        int alld = 1;
#pragma unroll
        for (int w = 0; w < 8; ++w) alld &= flags[buf * 8 + w];
        if (alld) break;
    }
    { const int tid2 = otid(), hh2 = (tid2 & 63) >> 5, t2 = qb * 256 + (tid2 >> 6) * 32 + (tid2 & 31);
      store_ot((bf16_t*)(p.ws + WS_MIX) + (size_t)((bh >> 2) * SEQ + t2) * DM + (bh & 3) * 64, O0, O1, hh2); }
}

__device__ __forceinline__ void dam_item(const Params& p, int l, int bh, int qb, unsigned char* lds) {
    const int tid = otid(), lane = tid & 63, wid = tid >> 6, r = lane & 31, hh = lane >> 5;
    const int b = bh >> 2, h = bh & 3;
    const bf16_t* proj = (const bf16_t*)(p.ws + WS_PROJ) + (size_t)b * SEQ * PINP;
    const bf16_t* kbase = proj + 1024 + h * 64; const bf16_t* vbase = proj + 1280 + h * 64;
    const float* biasd = (const float*)(p.ws + WS_BIASD) + h * 2048;
    const int q0w = qb * 256 + wid * 32, t = q0w + r;
    unsigned char* KB[2] = {lds, lds + AT_KBYTES}; unsigned char* VB[2] = {lds + 2 * AT_KBYTES, lds + 2 * AT_KBYTES + AT_VBYTES};
    float* Bd = (float*)(lds + 2 * AT_KBYTES + 2 * AT_VBYTES + 64);
    bf16x8 qf[2][2];
#pragma unroll
    for (int m = 0; m < 2; ++m)
#pragma unroll
        for (int s = 0; s < 2; ++s) qf[m][s] = scale_frag(*(const uint4*)(proj + (size_t)t * PINP + 768 + h * 64 + m * 32 + 16 * s + 8 * hh), 0.17677669529663687f * LOG2E);
    f32x16 O[2][2];
#pragma unroll
    for (int m = 0; m < 2; ++m)
#pragma unroll
        for (int d = 0; d < 2; ++d)
#pragma unroll
            for (int i = 0; i < 16; ++i) O[m][d][i] = 0.f;
    float mrun[2] = {-INFINITY, -INFINITY}, lrun[2] = {0.f, 0.f};
    const float cfar = biasd[2047] * LOG2E;
    AtStage st;
    const int ktop = qb * 4 + 3;
    __syncthreads();
    if (tid < 320) Bd[tid] = tid >= 64 ? biasd[tid - 64] * LOG2E : 0.f;
    st.load(kbase, vbase, 0, tid); st.store(KB[0], VB[0], tid);
    __syncthreads();
#pragma unroll 1
    for (int kt = 0; kt <= ktop; ++kt) {
        const int buf = kt & 1;
        if (kt < ktop) st.load(kbase, vbase, kt + 1, tid);
        if (64 * kt <= q0w + 31) {
            const bool far = (q0w - (64 * kt + 63) >= 128);
            const int dbase = t - 64 * kt - 4 * hh;
            const float* bp = Bd + 64 + dbase;
#pragma unroll
            for (int m = 0; m < 2; ++m) {
#pragma unroll
                for (int kb32 = 0; kb32 < 2; ++kb32) {
                    if (64 * kt + 32 * kb32 <= q0w + 31) {
                        f32x16 S;
#pragma unroll
                        for (int i = 0; i < 16; ++i) S[i] = 0.f;
#pragma unroll
                        for (int s = 0; s < 2; ++s) S = __builtin_amdgcn_mfma_f32_32x32x16_bf16(k_frag(KB[buf], kb32 * 32 + r, m * 32 + 16 * s + 8 * hh), qf[m][s], S, 0, 0, 0);
                        float bmax = -INFINITY;
                        if (far) {
#pragma unroll
                            for (int i = 0; i < 16; ++i) { S[i] += cfar; bmax = fmaxf(bmax, S[i]); }
                        } else {
#pragma unroll
                            for (int i = 0; i < 16; ++i) {
                                const int c = 32 * kb32 + (i & 3) + 8 * (i >> 2);
                                const float bb = bp[-c];
                                float z = S[i] + bb;
                                z = (dbase - c >= 0) ? z : -INFINITY;
                                S[i] = z; bmax = fmaxf(bmax, z);
                            }
                        }
                        bmax = fmaxf(bmax, __shfl_xor(bmax, 32));
                        const float mnew = fmaxf(mrun[m], bmax);
                        const float sc = __builtin_amdgcn_exp2f(mrun[m] - mnew);
                        mrun[m] = mnew;
                        float ls = 0.f;
#pragma unroll
                        for (int i = 0; i < 16; ++i) { const float pv = __builtin_amdgcn_exp2f(S[i] - mnew); S[i] = pv; ls += pv; }
                        lrun[m] = lrun[m] * sc + ls;
#pragma unroll
                        for (int d = 0; d < 2; ++d)
#pragma unroll
                            for (int i = 0; i < 16; ++i) O[m][d][i] *= sc;
                        const bf16x8 P0 = mk_frag(pk_bf16(S[0], S[1]), pk_bf16(S[2], S[3]), pk_bf16(S[4], S[5]), pk_bf16(S[6], S[7]));
                        const bf16x8 P1 = mk_frag(pk_bf16(S[8], S[9]), pk_bf16(S[10], S[11]), pk_bf16(S[12], S[13]), pk_bf16(S[14], S[15]));
#pragma unroll
                        for (int d = 0; d < 2; ++d) {
                            O[m][d] = __builtin_amdgcn_mfma_f32_32x32x16_bf16(v_frag(VB[buf], d * 32 + r, kb32 * 32 + 4 * hh), P0, O[m][d], 0, 0, 0);
                            O[m][d] = __builtin_amdgcn_mfma_f32_32x32x16_bf16(v_frag(VB[buf], d * 32 + r, kb32 * 32 + 16 + 4 * hh), P1, O[m][d], 0, 0, 0);
                        }
                    }
                }
            }
        }
        if (kt < ktop) st.store(KB[buf ^ 1], VB[buf ^ 1], tid);
        __syncthreads();
    }
    const int tid2 = otid(), hh2 = (tid2 & 63) >> 5, t2 = qb * 256 + (tid2 >> 6) * 32 + (tid2 & 31);
    const float* lp = p.da_lambda + (size_t)l * 128;
    float s1 = 0.f, s2 = 0.f;
    for (int i = 0; i < 32; ++i) { s1 += lp[i] * lp[32 + i]; s2 += lp[64 + i] * lp[96 + i]; }
    const float lam_init = 0.8f - 0.6f * expf(-0.3f * (float)l);
    const float lam = expf(s1) - expf(s2) + lam_init;
    const float l0 = lrun[0] + __shfl_xor(lrun[0], 32), l1 = lrun[1] + __shfl_xor(lrun[1], 32);
    const float i0 = 1.0f / l0, i1 = lam / l1;
    float ms = 0.f;
#pragma unroll
    for (int d = 0; d < 2; ++d)
#pragma unroll
        for (int i = 0; i < 16; ++i) { const float o = O[0][d][i] * i0 - O[1][d][i] * i1; O[0][d][i] = o; ms += o * o; }
    ms += __shfl_xor(ms, 32);
    const float rs = rsqrtf(ms * (1.0f / 64.0f) + 1e-5f) * (1.0f - lam_init);
    const float* sgn = p.da_subln + l * 64;
#pragma unroll
    for (int d = 0; d < 2; ++d)
#pragma unroll
        for (int i = 0; i < 16; ++i) O[0][d][i] *= rs * sgn[d * 32 + (i & 3) + 8 * (i >> 2) + 4 * hh2];
    store_ot((bf16_t*)(p.ws + WS_MIX) + (size_t)((bh >> 2) * SEQ + t2) * DM + 256 + (bh & 3) * 64, O[0][0], O[0][1], hh2);
}

__device__ __forceinline__ void conv_item(const Params& p, int l, int item) {
    const int tid = otid();
    const bf16_t* proj = (const bf16_t*)(p.ws + WS_PROJ); bf16_t* mix = (bf16_t*)(p.ws + WS_MIX);
    const float* cw = p.sc_conv + (size_t)l * 3 * 256;
    const int c = tid & 255;
    const float w0 = cw[c], w1 = cw[256 + c], w2 = cw[512 + c];
    for (int rr = tid >> 8; rr < 256; rr += 2) {
        const size_t row = (size_t)item * 256 + rr; const int t = (int)(row & (SEQ - 1));
        const bf16_t* pr = proj + row * PINP + 1536;
        const float u2 = bf2f(pr[256 + c]) * bf2f(pr[512 + c]);
        const float u1 = (t >= 1) ? bf2f(pr[256 + c - PINP]) * bf2f(pr[512 + c - PINP]) : 0.f;
        const float u0 = (t >= 2) ? bf2f(pr[256 + c - 2 * PINP]) * bf2f(pr[512 + c - 2 * PINP]) : 0.f;
        mix[row * DM + 512 + c] = f2bf(bf2f(pr[c]) * (w0 * u0 + w1 * u1 + w2 * u2));
    }
}

template <int CTRL> __device__ __forceinline__ float dpp_f(float v) { return __int_as_float(__builtin_amdgcn_update_dpp(0, __float_as_int(v), CTRL, 0xf, 0xf, true)); }
__device__ __forceinline__ float red8(float x) {
    x += dpp_f<0xB1>(x);
    x += dpp_f<0x4E>(x);
    x += dpp_f<0x141>(x);
    return x;
}
struct RwStep { float4 k0, k1, w0, w1, a0, a1, p0, p1, r0, r1; float vi; };
__device__ __forceinline__ void rw_load(RwStep& s, const float* kk, const float* wd, const float* ab, const float* xk, const float* xr, const float* xv, int tt, int jc, int si) {
    const int o = tt * 64 + jc * 8;
    s.k0 = *(const float4*)(kk + o); s.k1 = *(const float4*)(kk + o + 4);
    s.w0 = *(const float4*)(wd + o); s.w1 = *(const float4*)(wd + o + 4);
    s.a0 = *(const float4*)(ab + o); s.a1 = *(const float4*)(ab + o + 4);
    s.p0 = *(const float4*)(xk + o); s.p1 = *(const float4*)(xk + o + 4);
    s.r0 = *(const float4*)(xr + o); s.r1 = *(const float4*)(xr + o + 4);
    s.vi = xv[tt * 64 + si];
}
__device__ __forceinline__ void rwkv_item(const Params& p, int l, int bh, unsigned char* lds) {
    const int tid = otid(), b = bh >> 2, h = bh & 3;
    const bf16_t* proj = (const bf16_t*)(p.ws + WS_PROJ) + (size_t)b * SEQ * PINP + 2304;
    bf16_t* mix = (bf16_t*)(p.ws + WS_MIX) + (size_t)b * SEQ * DM + 768 + h * 64;
    const float* mu = p.rw_mu + (size_t)l * 896;
    const float* vecs = p.rw_vecs + (size_t)l * 7 * 256 + h * 64;
    float* Wup = (float*)lds; float* Aup = Wup + 2048; float* Gup = Aup + 2048;
    float* xr = Gup + 4096; float* xk = xr + 2048; float* xv = xk + 2048;
    float* xw = xv + 2048; float* xa = xw + 1024; float* xg = xa + 1024;
    float* wd = xg + 2048; float* ab = wd + 2048; float* kk = ab + 2048; float* gg = kk + 2048;
    float* yy = gg + 2048;
    float* sm = yy + 2048;
    __syncthreads();
    for (int i = tid; i < 2048; i += NTHREADS) { const int m = i >> 6, c = i & 63; Wup[i] = p.rw_w_up[(size_t)l * 32 * 256 + m * 256 + h * 64 + c]; Aup[i] = p.rw_a_up[(size_t)l * 32 * 256 + m * 256 + h * 64 + c]; }
    for (int i = tid; i < 4096; i += NTHREADS) { const int m = i >> 6, c = i & 63; Gup[i] = p.rw_g_up[(size_t)l * 64 * 256 + m * 256 + h * 64 + c]; }
    const int si = tid >> 3, jc = tid & 7;
    const int pc = tid & 63, pg = tid >> 6;
    const float v_w0 = vecs[pc], v_a0 = vecs[256 + pc], v_kk = vecs[512 + pc], v_ka = vecs[768 + pc], v_rk = vecs[1024 + pc], v_lg = vecs[1280 + pc], v_lb = vecs[1536 + pc];
    float S[8];
#pragma unroll
    for (int j = 0; j < 8; ++j) S[j] = 0.f;
#pragma unroll 1
    for (int t0 = 0; t0 < SEQ; t0 += 32) {
        __syncthreads();
        for (int i = tid; i < 32 * 40; i += NTHREADS) {
            const int tt = i / 40, gq = i % 40; const int t = t0 + tt;
            int col; float* dst; int kind = 0;
            if (gq < 8) { col = h * 64 + gq * 8; dst = xr + tt * 64 + gq * 8; }
            else if (gq < 16) { col = 256 + h * 64 + (gq - 8) * 8; dst = xk + tt * 64 + (gq - 8) * 8; }
            else if (gq < 24) { col = 512 + h * 64 + (gq - 16) * 8; dst = xv + tt * 64 + (gq - 16) * 8; }
            else if (gq < 28) { col = 768 + (gq - 24) * 8; dst = xw + tt * 32 + (gq - 24) * 8; kind = 1; }
            else if (gq < 32) { col = 800 + (gq - 28) * 8; dst = xa + tt * 32 + (gq - 28) * 8; }
            else { col = 832 + (gq - 32) * 8; dst = xg + tt * 64 + (gq - 32) * 8; kind = 2; }
            const uint4 cu = *(const uint4*)(proj + (size_t)t * PINP + col);
            uint4 pr = make_uint4(0u, 0u, 0u, 0u);
            if (t > 0) pr = *(const uint4*)(proj + (size_t)(t - 1) * PINP + col);
            const float4 m0 = *(const float4*)(mu + col), m1 = *(const float4*)(mu + col + 4);
            float o[8];
            { float c, q;
              c = __uint_as_float(cu.x << 16); q = __uint_as_float(pr.x << 16); o[0] = c + (q - c) * m0.x;
              c = __uint_as_float(cu.x & 0xffff0000u); q = __uint_as_float(pr.x & 0xffff0000u); o[1] = c + (q - c) * m0.y;
              c = __uint_as_float(cu.y << 16); q = __uint_as_float(pr.y << 16); o[2] = c + (q - c) * m0.z;
              c = __uint_as_float(cu.y & 0xffff0000u); q = __uint_as_float(pr.y & 0xffff0000u); o[3] = c + (q - c) * m0.w;
              c = __uint_as_float(cu.z << 16); q = __uint_as_float(pr.z << 16); o[4] = c + (q - c) * m1.x;
              c = __uint_as_float(cu.z & 0xffff0000u); q = __uint_as_float(pr.z & 0xffff0000u); o[5] = c + (q - c) * m1.y;
              c = __uint_as_float(cu.w << 16); q = __uint_as_float(pr.w << 16); o[6] = c + (q - c) * m1.z;
              c = __uint_as_float(cu.w & 0xffff0000u); q = __uint_as_float(pr.w & 0xffff0000u); o[7] = c + (q - c) * m1.w; }
            if (kind == 1) {
#pragma unroll
                for (int k = 0; k < 8; ++k) o[k] = tanhf(o[k]);
            } else if (kind == 2) {
#pragma unroll
                for (int k = 0; k < 8; ++k) o[k] = sigmoidf_(o[k]);
            }
            *(float4*)dst = make_float4(o[0], o[1], o[2], o[3]); *(float4*)(dst + 4) = make_float4(o[4], o[5], o[6], o[7]);
        }
        __syncthreads();
        {
            float dec[4], av[4], g[4];
#pragma unroll
            for (int k = 0; k < 4; ++k) { dec[k] = v_w0; av[k] = v_a0; g[k] = 0.f; }
#pragma unroll 2
            for (int m4 = 0; m4 < 8; ++m4) {
                float4 xwv[4], xav[4];
#pragma unroll
                for (int k = 0; k < 4; ++k) { xwv[k] = *(const float4*)(xw + (pg * 4 + k) * 32 + m4 * 4); xav[k] = *(const float4*)(xa + (pg * 4 + k) * 32 + m4 * 4); }
                const float wu0 = Wup[(m4 * 4 + 0) * 64 + pc], wu1 = Wup[(m4 * 4 + 1) * 64 + pc], wu2 = Wup[(m4 * 4 + 2) * 64 + pc], wu3 = Wup[(m4 * 4 + 3) * 64 + pc];
                const float au0 = Aup[(m4 * 4 + 0) * 64 + pc], au1 = Aup[(m4 * 4 + 1) * 64 + pc], au2 = Aup[(m4 * 4 + 2) * 64 + pc], au3 = Aup[(m4 * 4 + 3) * 64 + pc];
#pragma unroll
                for (int k = 0; k < 4; ++k) { dec[k] += xwv[k].x * wu0 + xwv[k].y * wu1 + xwv[k].z * wu2 + xwv[k].w * wu3; av[k] += xav[k].x * au0 + xav[k].y * au1 + xav[k].z * au2 + xav[k].w * au3; }
            }
#pragma unroll 2
            for (int m4 = 0; m4 < 16; ++m4) {
                float4 xgv[4];
#pragma unroll
                for (int k = 0; k < 4; ++k) xgv[k] = *(const float4*)(xg + (pg * 4 + k) * 64 + m4 * 4);
                const float gu0 = Gup[(m4 * 4 + 0) * 64 + pc], gu1 = Gup[(m4 * 4 + 1) * 64 + pc], gu2 = Gup[(m4 * 4 + 2) * 64 + pc], gu3 = Gup[(m4 * 4 + 3) * 64 + pc];
#pragma unroll
                for (int k = 0; k < 4; ++k) g[k] += xgv[k].x * gu0 + xgv[k].y * gu1 + xgv[k].z * gu2 + xgv[k].w * gu3;
            }
#pragma unroll
            for (int k = 0; k < 4; ++k) {
                const int i = (pg * 4 + k) * 64 + pc;
                const float a = sigmoidf_(av[k]);
                const float kraw = xk[i];
                const float kku = kraw * v_kk;
                const float kp = kraw * (1.0f + (a - 1.0f) * v_ka);
                const float n2 = wave_sum(kku * kku);
                const float bo = wave_sum(xr[i] * kp * v_rk);
                const float kkn = kku * (1.0f / fmaxf(sqrtf(n2), 1e-12f));
                wd[i] = expf(-0.6065306597126334f * sigmoidf_(dec[k]));
                gg[i] = g[k];
                kk[i] = kkn;
                ab[i] = kkn * a;
                xk[i] = kp;
                if (pc == 0) sm[96 + pg * 4 + k] = bo;
            }
        }
        __syncthreads();
        {
            RwStep cur, nxt;
            rw_load(cur, kk, wd, ab, xk, xr, xv, 0, jc, si);
#pragma unroll 2
            for (int tt = 0; tt < 32; ++tt) {
                rw_load(nxt, kk, wd, ab, xk, xr, xv, (tt + 1) & 31, jc, si);
                float sa0 = S[0] * cur.k0.x + S[1] * cur.k0.y, sa1 = S[2] * cur.k0.z + S[3] * cur.k0.w, sa2 = S[4] * cur.k1.x + S[5] * cur.k1.y, sa3 = S[6] * cur.k1.z + S[7] * cur.k1.w;
                float sa = red8((sa0 + sa1) + (sa2 + sa3));
                sa = -sa;
                S[0] = S[0] * cur.w0.x + (sa * cur.a0.x + cur.vi * cur.p0.x); S[1] = S[1] * cur.w0.y + (sa * cur.a0.y + cur.vi * cur.p0.y);
                S[2] = S[2] * cur.w0.z + (sa * cur.a0.z + cur.vi * cur.p0.z); S[3] = S[3] * cur.w0.w + (sa * cur.a0.w + cur.vi * cur.p0.w);
                S[4] = S[4] * cur.w1.x + (sa * cur.a1.x + cur.vi * cur.p1.x); S[5] = S[5] * cur.w1.y + (sa * cur.a1.y + cur.vi * cur.p1.y);
                S[6] = S[6] * cur.w1.z + (sa * cur.a1.z + cur.vi * cur.p1.z); S[7] = S[7] * cur.w1.w + (sa * cur.a1.w + cur.vi * cur.p1.w);
                float y0 = S[0] * cur.r0.x + S[1] * cur.r0.y, y1 = S[2] * cur.r0.z + S[3] * cur.r0.w, y2 = S[4] * cur.r1.x + S[5] * cur.r1.y, y3 = S[6] * cur.r1.z + S[7] * cur.r1.w;
                const float y = red8((y0 + y1) + (y2 + y3));
                if (jc == 0) yy[tt * 64 + si] = y;
                cur = nxt;
            }
        }
        __syncthreads();
#pragma unroll
        for (int k = 0; k < 4; ++k) {
            const int tt = pg * 4 + k, i = tt * 64 + pc;
            const float yv = yy[i];
            const float mean = wave_sum(yv) * (1.0f / 64.0f);
            const float d = yv - mean;
            const float var = wave_sum(d * d) * (1.0f / 64.0f);
            const float yn = d * rsqrtf(var + 64e-5f) * v_lg + v_lb;
            const float o = (yn + sm[96 + tt] * xv[i]) * gg[i];
            mix[(size_t)(t0 + tt) * DM + pc] = f2bf(o);
        }
    }
}

__device__ __forceinline__ void phase_mixers(const Params& p, int l, unsigned char* lds) {
    unsigned* ctl = (unsigned*)(p.ws + WS_CTL);
    int* slot = (int*)(lds + LDS_BYTES - 64);
#ifndef NO_RW
    for (int it = obid(); it < 128; it += gridDim.x) rwkv_item(p, l, it, lds);
#endif
    for (;;) {
        __syncthreads();
        if (otid() == 0) *slot = (int)atomicAdd(&ctl[CW_QUEUE + l * 64], 1u);
        __syncthreads();
        const int it = *slot;
        if (it >= 1024 + 1024 + 256) break;
        if (it < 1024) {
#ifndef NO_DA
            dam_item(p, l, it & 127, 7 - (it >> 7), lds);
#endif
        } else if (it < 2048) {
#ifndef NO_SB
            const int j = it - 1024; sbm_item(p, j & 127, 7 - (j >> 7), lds);
#endif
        } else conv_item(p, l, it - 2048);
    }
}

__global__ void __launch_bounds__(NTHREADS, 2) fwd(Params p) {
    extern __shared__ __attribute__((aligned(16))) unsigned char lds_raw[];
    if (threadIdx.x == 0) { ((unsigned*)lds_raw)[0] = 0u; ((unsigned*)lds_raw)[1] = 0u; ((unsigned*)lds_raw)[2] = 0u; ((unsigned*)lds_raw)[3] = 0u; }
    __syncthreads();
    unsigned char* lds = lds_raw + 16;
    XcdBarrier bar = xcd_barrier_post((unsigned*)(p.ws + WS_CTL) + CW_BAR, (volatile LAS unsigned*)lds_raw);
#ifndef ONLY
#define ONLY -1
#endif
#define PH(k) (ONLY < 0 || ONLY == (k))
    if (PH(0)) prologue(p, lds);
    xcd_barrier(bar);
    for (int l = 0; l < NLAYER; ++l) {
        if (PH(1)) phase_inproj(p, l, lds);
        xcd_barrier(bar);
        if (PH(2)) phase_mixers(p, l, lds);
        xcd_barrier(bar);
        if (PH(3)) phase_outproj(p, l, lds);
        xcd_barrier(bar);
        if (PH(4)) phase_ln1_route(p, l, lds);
        xcd_barrier(bar);
        if (PH(5)) phase_moe_up(p, l, lds);
        xcd_barrier(bar);
        if (PH(6)) phase_moe_down(p, l, lds);
        xcd_barrier(bar);
        if (PH(7)) phase_ln2(p, l, lds);
        xcd_barrier(bar);
    }
}

extern "C" void kernel_launch(void* const* d_in, const int* in_sizes, int n_in, void* d_out, int out_size, void* d_ws, size_t ws_size, hipStream_t stream) {
    static int grid = 0;
    if (grid == 0) {
        if (n_in != 18 || in_sizes[0] != NTOK * DM || out_size != NTOK * DM || ws_size < WS_END) {
            fprintf(stderr, "kernel_launch: unexpected shapes: n_in %d in0 %d out %d ws %zu (need %llu)\n", n_in, n_in > 0 ? in_sizes[0] : -1, out_size, ws_size, (unsigned long long)WS_END);
            grid = -1; return;
        }
        int dev = 0, cus = 0, per_cu = 0;
        hipGetDevice(&dev);
        hipDeviceGetAttribute(&cus, hipDeviceAttributeMultiprocessorCount, dev);
        hipFuncSetAttribute((const void*)fwd, hipFuncAttributeMaxDynamicSharedMemorySize, LDS_BYTES);
        hipOccupancyMaxActiveBlocksPerMultiprocessor(&per_cu, (const void*)fwd, NTHREADS, LDS_BYTES);
        if (per_cu < 1) { fprintf(stderr, "kernel_launch: occupancy query says %d blocks per CU\n", per_cu); grid = -1; return; }
        grid = cus;
    }
    if (grid < 0) return;
    Params p{};
    p.x = (const float*)d_in[0]; p.w_in = (const float*)d_in[1]; p.w_out = (const float*)d_in[2]; p.da_lambda = (const float*)d_in[3]; p.da_subln = (const float*)d_in[4];
    p.sc_conv = (const float*)d_in[5]; p.rw_mu = (const float*)d_in[6]; p.rw_vecs = (const float*)d_in[7]; p.rw_w_up = (const float*)d_in[8]; p.rw_a_up = (const float*)d_in[9];
    p.rw_g_up = (const float*)d_in[10]; p.ln_gain = (const float*)d_in[11]; p.ln_bias = (const float*)d_in[12]; p.rel_bias = (const float*)d_in[13]; p.router_w = (const float*)d_in[14];
    p.router_b = (const float*)d_in[15]; p.moe_w_in = (const float*)d_in[16]; p.moe_w_down = (const float*)d_in[17];
    p.out = (float*)d_out; p.ws = (unsigned char*)d_ws;
    hipMemsetAsync((char*)d_ws + WS_CTL, 0, CTL_BYTES, stream);
    hipLaunchKernelGGL(fwd, dim3(grid), dim3(NTHREADS), LDS_BYTES, stream, p);
}
```

```cpp
#include <hip/hip_runtime.h>
#include <cstdio>
#include <cstdint>

typedef unsigned short bf16_t;
typedef short bf16x8 __attribute__((ext_vector_type(8)));
typedef float f32x4 __attribute__((ext_vector_type(4)));

#define NTOK 65536
#define SEQ 2048
#define DM 1024
#define PIN 3200
#define PINP 3328
#define NLAYER 4
#define NEXP 16
#define DEXP 256
#define NTHREADS 512
#define LDS_BYTES (152 * 1024)
#define ALPHA 1.6817928305074292f
#define LOG2E 1.4426950408889634f

#define WS_CTL 0ull
#define CTL_BYTES 65536ull
#define WS_BIASD (WS_CTL + CTL_BYTES)
#define WS_WIN (WS_BIASD + 4ull * 2048 * 4)
#define WS_WOUT (WS_WIN + 4ull * PINP * DM * 2)
#define WS_MWIN (WS_WOUT + 4ull * DM * DM * 2)
#define WS_MWDN (WS_MWIN + 4ull * 16 * 512 * 1024 * 2)
#define WS_XB (WS_MWDN + 4ull * 16 * 1024 * 256 * 2)
#define WS_MIX (WS_XB + (unsigned long long)NTOK * DM * 2)
#define WS_LTOK (WS_MIX + (unsigned long long)NTOK * DM * 2)
#define WS_LGATE (WS_LTOK + 16ull * NTOK * 4)
#define WS_PROJ (WS_LGATE + 16ull * NTOK * 4)
#define WS_Y WS_PROJ
#define WS_H (WS_Y + (unsigned long long)(2 * NTOK + 256) * DM * 2)
#define WS_END (WS_PROJ + (unsigned long long)NTOK * PINP * 2)

#define CW_BAR 0
#define CW_CNT 4096
#define CW_QUEUE 8192

#define XB_TMO      128
#define XB_XCNT(j)  (256  + 64 * (j))
#define XB_XSUB(j)  (1280 + 64 * (j))
#define XB_XGEN(j)  (2304 + 64 * (j))
#define XB_TOP      3328
#define XB_TOPGEN   3392
#define XCD_BAR_WORDS 3456
#define XB_SPIN_CAP (1u << 22)
#define LAS __attribute__((address_space(3)))

__device__ __forceinline__ unsigned xb_ld(unsigned* p)              { return __hip_atomic_load(p, __ATOMIC_RELAXED, __HIP_MEMORY_SCOPE_AGENT); }
__device__ __forceinline__ unsigned xb_add(unsigned* p, unsigned v) { return __hip_atomic_fetch_add(p, v, __ATOMIC_RELAXED, __HIP_MEMORY_SCOPE_AGENT); }
__device__ __forceinline__ unsigned xb_xcc_id() { return (unsigned)__builtin_amdgcn_s_getreg((3 << 11) | 20) & 0xFu; }
#define XB_SPIN(cond, bar) do { unsigned _sp = 0; while (cond) { __builtin_amdgcn_s_sleep(1); \
    if ((++_sp & 255u) == 0u) { if (xb_ld(&(bar)[XB_TMO])) break; if (_sp > XB_SPIN_CAP) { atomicAdd(&(bar)[XB_TMO], 1u); break; } } } } while (0)

struct XcdBarrier { unsigned* bar; unsigned x; volatile LAS unsigned* st; };

__device__ __forceinline__ XcdBarrier xcd_barrier_post(unsigned* bar, volatile LAS unsigned* st) {
    XcdBarrier b; b.bar = bar; b.x = xb_xcc_id(); b.st = st;
    if (threadIdx.x == 0) (void)xb_add(&bar[XB_XCNT(b.x)], 1u);
    return b;
}
__device__ __forceinline__ void xcd_barrier_complete(unsigned* bar, unsigned x, unsigned& nloc, unsigned& nx) {
    const unsigned G = gridDim.x * gridDim.y * gridDim.z;
    unsigned sum, cnt, mine, sp = 0u;
    for (;;) {
        sum = 0u; cnt = 0u; mine = 0u;
#pragma unroll
        for (unsigned j = 0; j < 16; ++j) { const unsigned c = xb_ld(&bar[XB_XCNT(j)]); sum += c; cnt += (c > 0u) ? 1u : 0u; mine = (j == x) ? c : mine; }
        if (sum == G) break;
        __builtin_amdgcn_s_sleep(1);
        if ((++sp & 255u) == 0u) { if (xb_ld(&bar[XB_TMO])) break; if (sp > XB_SPIN_CAP) { atomicAdd(&bar[XB_TMO], 1u); break; } }
    }
    nloc = mine > 0u ? mine : 1u; nx = cnt > 0u ? cnt : 1u;
}
__device__ __forceinline__ void xcd_barrier(const XcdBarrier& b) {
    asm volatile("s_waitcnt vmcnt(0)" ::: "memory");
    __syncthreads();
    if (threadIdx.x == 0) {
        unsigned* bar = b.bar;
        __builtin_amdgcn_s_waitcnt(0);
        const unsigned bx = xb_xcc_id();
        unsigned nloc = b.st[0], nx = b.st[1];
        if (nloc == 0u) { xcd_barrier_complete(bar, bx, nloc, nx); b.st[0] = nloc; b.st[1] = nx; }
        const unsigned old = xb_add(&bar[XB_XSUB(bx)], 1u);
        const unsigned gen = old / nloc;
        if (old + 1u == (gen + 1u) * nloc) {
            __builtin_amdgcn_fence(__ATOMIC_RELEASE, "agent");
            asm volatile("s_waitcnt vmcnt(0)" ::: "memory");
            const unsigned og = xb_add(&bar[XB_TOP], 1u);
            const unsigned tg = og / nx;
            if (og + 1u == (tg + 1u) * nx) xb_add(&bar[XB_TOPGEN], 1u);
            else XB_SPIN(xb_ld(&bar[XB_TOPGEN]) == tg, bar);
            __builtin_amdgcn_fence(__ATOMIC_ACQUIRE, "agent");
            xb_add(&bar[XB_XGEN(bx)], 1u);
            asm volatile("s_waitcnt vmcnt(0)" ::: "memory");
        } else {
            XB_SPIN(xb_ld(&bar[XB_XGEN(bx)]) == gen, bar);
            __builtin_amdgcn_fence(__ATOMIC_ACQUIRE, "agent");
            asm volatile("s_waitcnt vmcnt(0)" ::: "memory");
        }
    }
    __syncthreads();
}

__device__ __forceinline__ int otid() { int t = threadIdx.x; asm volatile("" : "+v"(t)); return t; }
__device__ __forceinline__ int obid() { int t = blockIdx.x; asm volatile("" : "+s"(t)); return t; }
__device__ __forceinline__ float bf2f(bf16_t v) { return __uint_as_float(((unsigned)v) << 16); }
__device__ __forceinline__ bf16_t f2bf(float f) { unsigned u = __float_as_uint(f); u += 0x7fffu + ((u >> 16) & 1u); return (bf16_t)(u >> 16); }
__device__ __forceinline__ float sigmoidf_(float x) { return 1.0f / (1.0f + expf(-x)); }
__device__ __forceinline__ float wave_sum(float v) {
#pragma unroll
    for (int o = 32; o >= 1; o >>= 1) v += __shfl_xor(v, o);
    return v;
}

struct Params {
    const float* x; const float* w_in; const float* w_out; const float* da_lambda; const float* da_subln; const float* sc_conv;
    const float* rw_mu; const float* rw_vecs; const float* rw_w_up; const float* rw_a_up; const float* rw_g_up;
    const float* ln_gain; const float* ln_bias; const float* rel_bias; const float* router_w; const float* router_b;
    const float* moe_w_in; const float* moe_w_down;
    float* out; unsigned char* ws;
};

namespace pg8 {
#define PG8_LAS __attribute__((address_space(3)))
typedef unsigned short bf16_t;
typedef short bf16x8 __attribute__((ext_vector_type(8)));
typedef float f32x4 __attribute__((ext_vector_type(4)));
typedef unsigned u32x4 __attribute__((ext_vector_type(4)));
constexpr int BM = 256, BK = 64, HALF = 128, HTB = HALF * BK * 2  , STAGE_BYTES = 8 * HTB, NXCD = 8, WGM = 8;

__host__ __device__ __forceinline__ int lds_byte(int r, int c) { const int st = (r >> 4) * 2 + (c >> 5), rr = r & 15, cc = c & 31, ob = rr * 64 + cc * 2; return st * 1024 + (ob ^ (((ob >> 9) & 1) << 5)); }
__host__ __device__ __forceinline__ void stage_rc(int b, int& R, int& C) { const int st = b / 1024, sb = b % 1024, swz = sb ^ (((sb >> 9) & 1) << 5); R = (st >> 1) * 16 + swz / 64; C = (st & 1) * 32 + (swz % 64) / 2; }
__host__ __device__ __forceinline__ int perm32(int rho) { const int n = rho >> 4, i = rho & 15; return 8 * (i >> 2) + 4 * n + (i & 3); }

struct Unit { int pm, pn; };
struct Gemm { const bf16_t* A; const bf16_t* Bt; int M, N, K; };

struct StaticOrder {
    int nM, nN, nwg, G, c;
    __host__ __device__ void init(int M, int N, int G_, int c_) { nM = M / BM; nN = N / BM; nwg = nM * nN; G = G_; c = c_; }
    __host__ __device__ bool next(int i, Unit& u) const {
        const long L = (long)i * G + c; if (L >= nwg) return false;
        int wgid = (int)L; { const int q = nwg / NXCD, r = nwg % NXCD, xcd = wgid % NXCD, off = wgid / NXCD; wgid = (xcd < r ? xcd * (q + 1) : r * (q + 1) + (xcd - r) * q) + off; }
        const int nig = WGM * nN, gid = wgid / nig, fm = gid * WGM, gsz = (nM - fm) < WGM ? (nM - fm) : WGM;
        u.pm = fm + ((wgid % nig) % gsz); u.pn = (wgid % nig) / gsz; return true;
    }
    __device__ __forceinline__ void a_ready(const Unit&) const {}
    __device__ __forceinline__ void done(const Unit&) const {}
};
__device__ __forceinline__ unsigned cvt_pk_bf16(float lo, float hi) { unsigned r; asm volatile("v_cvt_pk_bf16_f32 %0, %1, %2" : "=v"(r) : "v"(lo), "v"(hi)); return r; }
template <class Epi, class Sched, bool ALIGN_EPI = false, bool SP2 = false>
__device__ __forceinline__ void gemm_phase(PG8_LAS unsigned char* lds, const Gemm g, const Sched& S, const Epi& E) {
    const int tid = otid(), wid = __builtin_amdgcn_readfirstlane(tid >> 6), lane = tid & 63, wr = wid >> 2, wc = wid & 3, fr = lane & 15, fq = lane >> 4;
    const int K = g.K, nt = K / BK;
    unsigned voffA[2], voffB[2];
#pragma unroll
    for (int i = 0; i < 2; ++i) { int R, C; stage_rc(tid * 16 + i * 8192, R, C); const int Rb = Epi::PERM ? ((R & ~31) + perm32(R & 31)) : R;
        voffA[i] = (unsigned)(R * K + C) * 2u; voffB[i] = (unsigned)(Rb * K + C) * 2u; }
    const size_t kstep = (size_t)(BK * 2);
    const size_t hstep = (size_t)HALF * K * 2;
    const size_t tstep = 2 * hstep;
    const unsigned ldsw = (unsigned)wid * 1024u;
    const int aoff = lds_byte(wr * 64 + fr, fq * 8), boff = lds_byte(wc * 32 + fr, fq * 8);
#define PG8_SA(b, h) (((b) * 2 + (h)) * HTB)
#define PG8_SB(b, h) ((4 + (b) * 2 + (h)) * HTB)
#define PG8_STAGE(bufoff, gbase, voff) do { _Pragma("unroll") for (int _i = 0; _i < 2; ++_i) \
        __builtin_amdgcn_global_load_lds((const unsigned*)((const char*)(gbase) + (voff)[_i]), (PG8_LAS unsigned*)(lds + (bufoff) + ldsw + _i * 8192), 16, 0, 0); } while (0)
#define PG8_LDA(dst, b, h) do { _Pragma("unroll") for (int m = 0; m < 4; ++m) _Pragma("unroll") for (int k = 0; k < 2; ++k) dst[m][k] = *(const PG8_LAS bf16x8*)(lds + PG8_SA(b, h) + aoff + m * 2048 + k * 1024); } while (0)
#define PG8_LDB(dst, b, h) do { _Pragma("unroll") for (int n = 0; n < 2; ++n) _Pragma("unroll") for (int k = 0; k < 2; ++k) dst[n][k] = *(const PG8_LAS bf16x8*)(lds + PG8_SB(b, h) + boff + n * 2048 + k * 1024); } while (0)
#define PG8_MMA(ai, bj, At, Bt) do { __builtin_amdgcn_s_setprio(1); _Pragma("unroll") for (int m = 0; m < 4; ++m) _Pragma("unroll") for (int n = 0; n < 2; ++n) _Pragma("unroll") for (int k = 0; k < 2; ++k) \
        acc[ai][bj][m][n] = __builtin_amdgcn_mfma_f32_16x16x32_bf16(Bt[n][k], At[m][k], acc[ai][bj][m][n], 0, 0, 0); __builtin_amdgcn_s_setprio(0); } while (0)
#define PG8_WAIT_V(n) asm volatile("s_waitcnt vmcnt(" #n ")" ::: "memory")
#define PG8_WAIT_L(n) asm volatile("s_waitcnt lgkmcnt(" #n ")" ::: "memory")
#define PG8_BAR __builtin_amdgcn_s_barrier()
#define PG8_SCHED __builtin_amdgcn_sched_barrier(0)
    Unit cur, nxt; int ui = 0;
    if (!S.next(0, cur)) return;
    f32x4 acc[2][2][4][2];
#pragma unroll
    for (int a = 0; a < 2; ++a)
#pragma unroll
        for (int b = 0; b < 2; ++b)
#pragma unroll
            for (int m = 0; m < 4; ++m)
#pragma unroll
                for (int n = 0; n < 2; ++n) acc[a][b][m][n] = (f32x4){0.f, 0.f, 0.f, 0.f};
    bf16x8 At[4][2], B0[2][2], B1[2][2];
    const char* cA = (const char*)g.A + (size_t)cur.pm * tstep; const char* cB = (const char*)g.Bt + (size_t)cur.pn * tstep;
    S.a_ready(cur);
    if constexpr (SP2) {
        PG8_STAGE(PG8_SB(0, 0), cB, voffB); PG8_STAGE(PG8_SB(0, 1), cB + hstep, voffB); PG8_STAGE(PG8_SA(0, 0), cA, voffA); PG8_STAGE(PG8_SA(0, 1), cA + hstep, voffA);
        if (wr == 1) PG8_BAR;
        PG8_WAIT_V(2); PG8_BAR;
        PG8_STAGE(PG8_SB(1, 0), cB + kstep, voffB); PG8_STAGE(PG8_SA(1, 0), cA + kstep, voffA); PG8_STAGE(PG8_SB(1, 1), cB + hstep + kstep, voffB);
        PG8_WAIT_V(6); PG8_BAR;
    } else {
        PG8_STAGE(PG8_SB(0, 0), cB, voffB); PG8_STAGE(PG8_SA(0, 0), cA, voffA); PG8_STAGE(PG8_SB(0, 1), cB + hstep, voffB); PG8_STAGE(PG8_SA(0, 1), cA + hstep, voffA);
        if (wr == 1) PG8_BAR;
        PG8_WAIT_V(4); PG8_BAR;
        PG8_STAGE(PG8_SB(1, 0), cB + kstep, voffB); PG8_STAGE(PG8_SA(1, 0), cA + kstep, voffA); PG8_STAGE(PG8_SB(1, 1), cB + hstep + kstep, voffB);
        PG8_WAIT_V(6); PG8_BAR;
    }
    for (;;) {
        const bool has_next = S.next(ui + 1, nxt);
        const char* nA = has_next ? (const char*)g.A + (size_t)nxt.pm * tstep : cA; const char* nB = has_next ? (const char*)g.Bt + (size_t)nxt.pn * tstep : cB;
        for (int t = 0; t < nt; t += 2) {
            const bool last = (t == nt - 2);
            const char* a1 = cA + (size_t)(t + 1) * kstep;
            const char* a2 = last ? nA : cA + (size_t)(t + 2) * kstep; const char* b2 = last ? nB : cB + (size_t)(t + 2) * kstep;
            const char* a3 = a2 + kstep; const char* b3 = b2 + kstep;
            if (last && has_next) S.a_ready(nxt);
            if constexpr (SP2) {
            PG8_LDB(B0, 0, 0); PG8_LDB(B1, 0, 1); PG8_SCHED; PG8_LDA(At, 0, 0); PG8_STAGE(PG8_SA(1, 1), a1 + hstep, voffA);
            PG8_WAIT_V(8); PG8_WAIT_L(0); PG8_BAR; PG8_MMA(0, 0, At, B0); PG8_MMA(0, 1, At, B1); PG8_BAR; PG8_SCHED;
            PG8_LDA(At, 0, 1); PG8_STAGE(PG8_SB(0, 0), b2, voffB); PG8_STAGE(PG8_SB(0, 1), b2 + hstep, voffB); PG8_STAGE(PG8_SA(0, 0), a2, voffA);
            PG8_WAIT_V(8); PG8_WAIT_L(0); PG8_BAR; PG8_MMA(1, 0, At, B0); PG8_MMA(1, 1, At, B1); PG8_BAR; PG8_SCHED;
            PG8_LDB(B0, 1, 0); PG8_LDB(B1, 1, 1); PG8_SCHED; PG8_LDA(At, 1, 0); PG8_STAGE(PG8_SA(0, 1), a2 + hstep, voffA);
            PG8_WAIT_V(8); PG8_WAIT_L(0); PG8_BAR; PG8_MMA(0, 0, At, B0); PG8_MMA(0, 1, At, B1); PG8_BAR; PG8_SCHED;
            PG8_LDA(At, 1, 1); PG8_STAGE(PG8_SB(1, 0), b3, voffB); PG8_STAGE(PG8_SB(1, 1), b3 + hstep, voffB); PG8_STAGE(PG8_SA(1, 0), a3, voffA);
            PG8_WAIT_V(8); PG8_WAIT_L(0); PG8_BAR; PG8_MMA(1, 0, At, B0); PG8_MMA(1, 1, At, B1); PG8_BAR; PG8_SCHED;
            } else {
            PG8_LDB(B0, 0, 0); PG8_SCHED; PG8_LDA(At, 0, 0); PG8_STAGE(PG8_SA(1, 1), a1 + hstep, voffA);
            PG8_WAIT_L(8); PG8_BAR; PG8_WAIT_L(0); PG8_MMA(0, 0, At, B0); PG8_BAR; PG8_SCHED;
            PG8_LDB(B1, 0, 1); PG8_STAGE(PG8_SB(0, 0), b2, voffB);
            PG8_BAR; PG8_WAIT_L(0); PG8_MMA(0, 1, At, B1); PG8_BAR;
            PG8_LDA(At, 0, 1); PG8_STAGE(PG8_SA(0, 0), a2, voffA);
            PG8_BAR; PG8_WAIT_L(0); PG8_MMA(1, 0, At, B0); PG8_BAR; PG8_SCHED;
            PG8_STAGE(PG8_SB(0, 1), b2 + hstep, voffB);
            PG8_WAIT_V(6); PG8_BAR; PG8_MMA(1, 1, At, B1); PG8_BAR;
            PG8_LDB(B0, 1, 0); PG8_SCHED; PG8_LDA(At, 1, 0); PG8_STAGE(PG8_SA(0, 1), a2 + hstep, voffA);
            PG8_WAIT_L(8); PG8_BAR; PG8_WAIT_L(0); PG8_MMA(0, 0, At, B0); PG8_BAR; PG8_SCHED;
            PG8_LDB(B1, 1, 1); PG8_STAGE(PG8_SB(1, 0), b3, voffB);
            PG8_BAR; PG8_WAIT_L(0); PG8_MMA(0, 1, At, B1); PG8_BAR;
            PG8_LDA(At, 1, 1); PG8_STAGE(PG8_SA(1, 0), a3, voffA);
            PG8_BAR; PG8_WAIT_L(0); PG8_MMA(1, 0, At, B0); PG8_BAR; PG8_SCHED;
            PG8_STAGE(PG8_SB(1, 1), b3 + hstep, voffB);
            PG8_WAIT_V(6); PG8_BAR; PG8_MMA(1, 1, At, B1); PG8_BAR;
            }
        }
        if constexpr (ALIGN_EPI) { if (wr == 0) PG8_BAR; }
        if constexpr (!Epi::AFTER_DRAIN) { E(acc, cur, wr, wc, fr, fq); S.done(cur); }
        if (!has_next) break;
#pragma unroll
        for (int a = 0; a < 2; ++a)
#pragma unroll
            for (int b = 0; b < 2; ++b)
#pragma unroll
                for (int m = 0; m < 4; ++m)
#pragma unroll
                    for (int n = 0; n < 2; ++n) acc[a][b][m][n] = (f32x4){0.f, 0.f, 0.f, 0.f};
        cur = nxt; cA = nA; cB = nB; ++ui;
        if constexpr (ALIGN_EPI) { if (wr == 1) PG8_BAR; }
    }
    PG8_WAIT_V(0);
    if constexpr (!ALIGN_EPI) { if (wr == 0) PG8_BAR; }
    PG8_BAR;
    if constexpr (Epi::AFTER_DRAIN) { E.fused(acc, cur, wr, wc, fr, fq, lds, wid, lane); S.done(cur); }
#undef PG8_SA
#undef PG8_SB
#undef PG8_STAGE
#undef PG8_LDA
#undef PG8_LDB
#undef PG8_MMA
#undef PG8_WAIT_V
#undef PG8_WAIT_L
#undef PG8_BAR
#undef PG8_SCHED
}
}

namespace pg8 {
template <class Epi, class Sched, bool GATHER>
__device__ __forceinline__ void gemm_phase_g(PG8_LAS unsigned char* lds, const int K, const Sched& S, const Epi& E) {
    typedef typename Sched::Unit UnitT;
    const int tid = otid(), wid = __builtin_amdgcn_readfirstlane(tid >> 6), lane = tid & 63, wr = wid >> 2, wc = wid & 3, fr = lane & 15, fq = lane >> 4;
    const int nt = K / BK;
    unsigned voffB[2];
#pragma unroll
    for (int i = 0; i < 2; ++i) { int R, C; stage_rc(tid * 16 + i * 8192, R, C); const int Rb = Epi::PERM ? ((R & ~31) + perm32(R & 31)) : R; voffB[i] = (unsigned)(Rb * K + C) * 2u; }
#define PG8_AOFF(unit, o0, o1) do { const int _tz = otid(); _Pragma("unroll") for (int _i = 0; _i < 2; ++_i) { int _R, _C; stage_rc(_tz * 16 + _i * 8192, _R, _C); \
        o0[_i] = S.arow_off(unit, _R) + (unsigned)_C * 2u; o1[_i] = S.arow_off(unit, HALF + _R) + (unsigned)_C * 2u; } } while (0)
    const size_t kstep = (size_t)(BK * 2);
    const size_t hstep = (size_t)HALF * K * 2;
    const unsigned ldsw = (unsigned)wid * 1024u;
    const int aoff = lds_byte(wr * 64 + fr, fq * 8), boff = lds_byte(wc * 32 + fr, fq * 8);
#define PG8_SA(b, h) (((b) * 2 + (h)) * HTB)
#define PG8_SB(b, h) ((4 + (b) * 2 + (h)) * HTB)
#define PG8_STAGE(bufoff, gbase, voff) do { _Pragma("unroll") for (int _i = 0; _i < 2; ++_i) \
        __builtin_amdgcn_global_load_lds((const unsigned*)((const char*)(gbase) + (voff)[_i]), (PG8_LAS unsigned*)(lds + (bufoff) + ldsw + _i * 8192), 16, 0, 0); } while (0)
#define PG8_LDA(dst, b, h) do { _Pragma("unroll") for (int m = 0; m < 4; ++m) _Pragma("unroll") for (int k = 0; k < 2; ++k) dst[m][k] = *(const PG8_LAS bf16x8*)(lds + PG8_SA(b, h) + aoff + m * 2048 + k * 1024); } while (0)
#define PG8_LDB(dst, b, h) do { _Pragma("unroll") for (int n = 0; n < 2; ++n) _Pragma("unroll") for (int k = 0; k < 2; ++k) dst[n][k] = *(const PG8_LAS bf16x8*)(lds + PG8_SB(b, h) + boff + n * 2048 + k * 1024); } while (0)
#define PG8_MMA(ai, bj, At, Bt) do { __builtin_amdgcn_s_setprio(1); _Pragma("unroll") for (int m = 0; m < 4; ++m) _Pragma("unroll") for (int n = 0; n < 2; ++n) _Pragma("unroll") for (int k = 0; k < 2; ++k) \
        acc[ai][bj][m][n] = __builtin_amdgcn_mfma_f32_16x16x32_bf16(Bt[n][k], At[m][k], acc[ai][bj][m][n], 0, 0, 0); __builtin_amdgcn_s_setprio(0); } while (0)
#define PG8_WAIT_V(n) asm volatile("s_waitcnt vmcnt(" #n ")" ::: "memory")
#define PG8_WAIT_L(n) asm volatile("s_waitcnt lgkmcnt(" #n ")" ::: "memory")
#define PG8_BAR __builtin_amdgcn_s_barrier()
#define PG8_SCHED __builtin_amdgcn_sched_barrier(0)
    UnitT cur, nxt; int ui = 0;
    if (!S.next(0, cur)) return;
    f32x4 acc[2][2][4][2];
#pragma unroll
    for (int a = 0; a < 2; ++a)
#pragma unroll
        for (int b = 0; b < 2; ++b)
#pragma unroll
            for (int m = 0; m < 4; ++m)
#pragma unroll
                for (int n = 0; n < 2; ++n) acc[a][b][m][n] = (f32x4){0.f, 0.f, 0.f, 0.f};
    bf16x8 At[4][2], B0[2][2], B1[2][2];
    unsigned cvo0[2], cvo1[2];
    PG8_AOFF(cur, cvo0, cvo1);
    const char* cA = S.abase(cur); const char* cB = S.bbase(cur);
    PG8_STAGE(PG8_SB(0, 0), cB, voffB); PG8_STAGE(PG8_SB(0, 1), cB + hstep, voffB); PG8_STAGE(PG8_SA(0, 0), cA, cvo0); PG8_STAGE(PG8_SA(0, 1), cA, cvo1);
    if (wr == 1) PG8_BAR;
    PG8_WAIT_V(2); PG8_BAR;
    PG8_STAGE(PG8_SB(1, 0), cB + kstep, voffB); PG8_STAGE(PG8_SA(1, 0), cA + kstep, cvo0); PG8_STAGE(PG8_SB(1, 1), cB + hstep + kstep, voffB);
    PG8_WAIT_V(6); PG8_BAR;
#pragma unroll 1
    for (;;) {
        const bool has_next = S.next(ui + 1, nxt);
        const char* nA = has_next ? S.abase(nxt) : cA; const char* nB = has_next ? S.bbase(nxt) : cB;
        unsigned nvo0[2], nvo1[2];
#pragma unroll 1
        for (int t = 0; t < nt; t += 2) {
            const bool last = (t == nt - 2);
            const char* a1 = cA + (size_t)(t + 1) * kstep;
            const char* a2 = last ? nA : cA + (size_t)(t + 2) * kstep; const char* b2 = last ? nB : cB + (size_t)(t + 2) * kstep;
            const char* a3 = a2 + kstep; const char* b3 = b2 + kstep;
            unsigned v20[2], v21[2];
            if constexpr (GATHER) {
                if (last && has_next) { PG8_AOFF(nxt, nvo0, nvo1); }
                else {
#pragma unroll
                    for (int i = 0; i < 2; ++i) { nvo0[i] = cvo0[i]; nvo1[i] = cvo1[i]; } }
#pragma unroll
                for (int i = 0; i < 2; ++i) { v20[i] = nvo0[i]; v21[i] = nvo1[i]; }
            } else {
#pragma unroll
                for (int i = 0; i < 2; ++i) { v20[i] = cvo0[i]; v21[i] = cvo1[i]; nvo0[i] = cvo0[i]; nvo1[i] = cvo1[i]; }
            }
            PG8_LDB(B0, 0, 0); PG8_LDB(B1, 0, 1); PG8_SCHED; PG8_LDA(At, 0, 0); PG8_STAGE(PG8_SA(1, 1), a1, cvo1);
            PG8_WAIT_V(8); PG8_WAIT_L(0); PG8_BAR; PG8_MMA(0, 0, At, B0); PG8_MMA(0, 1, At, B1); PG8_BAR; PG8_SCHED;
            PG8_LDA(At, 0, 1); PG8_STAGE(PG8_SB(0, 0), b2, voffB); PG8_STAGE(PG8_SB(0, 1), b2 + hstep, voffB); PG8_STAGE(PG8_SA(0, 0), a2, v20);
            PG8_WAIT_V(8); PG8_WAIT_L(0); PG8_BAR; PG8_MMA(1, 0, At, B0); PG8_MMA(1, 1, At, B1); PG8_BAR; PG8_SCHED;
            PG8_LDB(B0, 1, 0); PG8_LDB(B1, 1, 1); PG8_SCHED; PG8_LDA(At, 1, 0); PG8_STAGE(PG8_SA(0, 1), a2, v21);
            PG8_WAIT_V(8); PG8_WAIT_L(0); PG8_BAR; PG8_MMA(0, 0, At, B0); PG8_MMA(0, 1, At, B1); PG8_BAR; PG8_SCHED;
            PG8_LDA(At, 1, 1); PG8_STAGE(PG8_SB(1, 0), b3, voffB); PG8_STAGE(PG8_SB(1, 1), b3 + hstep, voffB); PG8_STAGE(PG8_SA(1, 0), a3, v20);
            PG8_WAIT_V(8); PG8_WAIT_L(0); PG8_BAR; PG8_MMA(1, 0, At, B0); PG8_MMA(1, 1, At, B1); PG8_BAR; PG8_SCHED;
        }
        if (wr == 0) PG8_BAR;
        E(acc, cur, wr, wc, fr, fq);
        if (!has_next) break;
#pragma unroll
        for (int a = 0; a < 2; ++a)
#pragma unroll
            for (int b = 0; b < 2; ++b)
#pragma unroll
                for (int m = 0; m < 4; ++m)
#pragma unroll
                    for (int n = 0; n < 2; ++n) acc[a][b][m][n] = (f32x4){0.f, 0.f, 0.f, 0.f};
        cur = nxt; cA = nA; cB = nB; ++ui;
#pragma unroll
        for (int i = 0; i < 2; ++i) { cvo0[i] = nvo0[i]; cvo1[i] = nvo1[i]; }
        if (wr == 1) PG8_BAR;
    }
    PG8_WAIT_V(0);
    PG8_BAR;
#undef PG8_AOFF
#undef PG8_SA
#undef PG8_SB
#undef PG8_STAGE
#undef PG8_LDA
#undef PG8_LDB
#undef PG8_MMA
#undef PG8_WAIT_V
#undef PG8_WAIT_L
#undef PG8_BAR
#undef PG8_SCHED
}
}

template <int MODE>
__device__ __forceinline__ void transpose_tile(const float* __restrict__ src, bf16_t* __restrict__ dst, int K, int N, int k0, int n0, float* tile  ) {
    const int tid = otid();
    const int c = tid & 63, r0 = tid >> 6;
    __syncthreads();
    if (n0 < N) {
#pragma unroll
        for (int i = 0; i < 8; ++i) { const int kk = r0 + i * 8; tile[kk * 65 + c] = src[(size_t)(k0 + kk) * N + n0 + c]; }
    } else {
#pragma unroll
        for (int i = 0; i < 8; ++i) { const int kk = r0 + i * 8; tile[kk * 65 + c] = 0.f; }
    }
    __syncthreads();
#pragma unroll
    for (int i = 0; i < 8; ++i) {
        const int nn = r0 + i * 8; int n = n0 + nn;
        if (MODE == 1) { const int j = n & 255; const int isu = n >> 8; n = (j >> 4) * 32 + isu * 16 + (j & 15); }
        dst[(size_t)n * K + k0 + c] = f2bf(tile[c * 65 + nn]);
    }
}

__device__ __forceinline__ void prologue(const Params& p, unsigned char* lds) {
    float* tile = (float*)lds;
    const int G = gridDim.x, w = obid(), tid = otid();
    bf16_t* win = (bf16_t*)(p.ws + WS_WIN); bf16_t* wout = (bf16_t*)(p.ws + WS_WOUT);
    bf16_t* mwin = (bf16_t*)(p.ws + WS_MWIN); bf16_t* mwdn = (bf16_t*)(p.ws + WS_MWDN);
    for (int it = w; it < 4 * 16 * 52; it += G) { const int l = it / (16 * 52), r = it % (16 * 52), kt = r / 52, nt = r % 52;
        transpose_tile<0>(p.w_in + (size_t)l * DM * PIN, win + (size_t)l * PINP * DM, DM, PIN, kt * 64, nt * 64, tile); }
    for (int it = w; it < 4 * 16 * 16; it += G) { const int l = it / 256, r = it % 256, kt = r / 16, nt = r % 16;
        transpose_tile<0>(p.w_out + (size_t)l * DM * DM, wout + (size_t)l * DM * DM, DM, DM, kt * 64, nt * 64, tile); }
    for (int it = w; it < 64 * 16 * 8; it += G) { const int le = it / 128, r = it % 128, kt = r / 8, nt = r % 8;
        transpose_tile<1>(p.moe_w_in + (size_t)le * 1024 * 512, mwin + (size_t)le * 512 * 1024, 1024, 512, kt * 64, nt * 64, tile); }
    for (int it = w; it < 64 * 4 * 16; it += G) { const int le = it / 64, r = it % 64, kt = r / 16, nt = r % 16;
        transpose_tile<0>(p.moe_w_down + (size_t)le * 256 * 1024, mwdn + (size_t)le * 1024 * 256, 256, 1024, kt * 64, nt * 64, tile); }
    {
        bf16_t* xb = (bf16_t*)(p.ws + WS_XB);
        const size_t n4 = (size_t)NTOK * DM / 4;
        for (size_t i = (size_t)w * NTHREADS + tid; i < n4; i += (size_t)G * NTHREADS) {
            const float4 v = ((const float4*)p.x)[i];
            ushort4 o; o.x = f2bf(v.x); o.y = f2bf(v.y); o.z = f2bf(v.z); o.w = f2bf(v.w);
            ((ushort4*)xb)[i] = o;
        }
    }
    {
        float* bd = (float*)(p.ws + WS_BIASD);
        for (int i = w * NTHREADS + tid; i < 4 * 2048; i += G * NTHREADS) {
            const int h = i >> 11, n = i & 2047;
            int bucket;
            if (n < 16) bucket = n;
            else { const float nf = (float)n; int lg = 16 + (int)(logf(nf / 16.0f) / 2.0794415416798357f * 16.0f); bucket = lg < 31 ? lg : 31; }
            bd[i] = p.rel_bias[bucket * 4 + h];
        }
    }
}

template <class ARow, class Epi>
__device__ __forceinline__ void gemm128(unsigned char* lds, const ARow& arow, const bf16_t* __restrict__ bt, int K, const Epi& epi) {
    const int tid = otid(), lane = tid & 63, wid = tid >> 6, wm = wid >> 1, wn = wid & 1;
    const int lr = tid >> 2, lc = (tid & 3) * 8;
    bf16_t* As = (bf16_t*)lds; bf16_t* Bs = (bf16_t*)(lds + 10240);
    const bf16_t* ap = arow(lr) + lc;
    const bf16_t* bp = bt + (size_t)lr * K + lc;
    f32x4 acc[2][4];
#pragma unroll
    for (int m = 0; m < 2; ++m)
#pragma unroll
        for (int n = 0; n < 4; ++n) acc[m][n] = (f32x4){0.f, 0.f, 0.f, 0.f};
    uint4 ra = *(const uint4*)ap, rb = *(const uint4*)bp;
    const int fr = lane & 15, fq = lane >> 4;
    for (int k0 = 0; k0 < K; k0 += 32) {
        __syncthreads();
        *(uint4*)(As + lr * 40 + lc) = ra;
        *(uint4*)(Bs + lr * 40 + lc) = rb;
        __syncthreads();
        if (k0 + 32 < K) { ra = *(const uint4*)(ap + k0 + 32); rb = *(const uint4*)(bp + k0 + 32); }
        bf16x8 a[2], b[4];
#pragma unroll
        for (int m = 0; m < 2; ++m) a[m] = *(const bf16x8*)(As + (wm * 32 + m * 16 + fr) * 40 + fq * 8);
#pragma unroll
        for (int n = 0; n < 4; ++n) b[n] = *(const bf16x8*)(Bs + (wn * 64 + n * 16 + fr) * 40 + fq * 8);
#pragma unroll
        for (int m = 0; m < 2; ++m)
#pragma unroll
            for (int n = 0; n < 4; ++n) acc[m][n] = __builtin_amdgcn_mfma_f32_16x16x32_bf16(a[m], b[n], acc[m][n], 0, 0, 0);
    }
    epi(acc, wm, wn, lane);
}

struct RowContig { const bf16_t* base; int ld; __device__ __forceinline__ const bf16_t* operator()(int r) const { return base + (size_t)r * ld; } };

struct EpiProjP {
    static constexpr bool PERM = true, AFTER_DRAIN = false;
    bf16_t* O;
    __device__ __forceinline__ void operator()(const pg8::f32x4 (&acc)[2][2][4][2], const pg8::Unit& u, int wr, int wc, int fr, int fq) const {
        const int row0 = u.pm * 256 + wr * 64 + fr, col0 = u.pn * 256 + wc * 32 + 8 * fq;
#pragma unroll
        for (int ai = 0; ai < 2; ++ai)
#pragma unroll
            for (int m = 0; m < 4; ++m) { bf16_t* rowp = O + (size_t)(row0 + ai * 128 + m * 16) * PINP + col0;
#pragma unroll
                for (int bj = 0; bj < 2; ++bj) { const pg8::f32x4 v0 = acc[ai][bj][m][0], v1 = acc[ai][bj][m][1];
                    pg8::u32x4 w; w.x = pg8::cvt_pk_bf16(v0[0], v0[1]); w.y = pg8::cvt_pk_bf16(v0[2], v0[3]); w.z = pg8::cvt_pk_bf16(v1[0], v1[1]); w.w = pg8::cvt_pk_bf16(v1[2], v1[3]);
                    *(pg8::u32x4*)(rowp + bj * 128) = w; } }
    }
};
__device__ __forceinline__ void phase_inproj(const Params& p, int l, unsigned char* lds) {
    pg8::Gemm g{(const bf16_t*)(p.ws + WS_XB), (const bf16_t*)(p.ws + WS_WIN) + (size_t)l * PINP * DM, NTOK, PINP, DM};
    pg8::StaticOrder S; S.init(NTOK, PINP, (int)gridDim.x, obid());
    EpiProjP E{(bf16_t*)(p.ws + WS_PROJ)};
    pg8::gemm_phase<EpiProjP, pg8::StaticOrder, true, true>((PG8_LAS unsigned char*)lds, g, S, E);
}

struct EpiOutP {
    static constexpr bool PERM = false, AFTER_DRAIN = false;
    const float* xin; float* out;
    __device__ __forceinline__ void operator()(const pg8::f32x4 (&acc)[2][2][4][2], const pg8::Unit& u, int wr, int wc, int fr, int fq) const {
        const int row0 = u.pm * 256 + wr * 64 + fr, col0 = u.pn * 256 + wc * 32 + 4 * fq;
#pragma unroll
        for (int ai = 0; ai < 2; ++ai)
#pragma unroll
            for (int m = 0; m < 4; ++m) { const size_t ro = (size_t)(row0 + ai * 128 + m * 16) * DM + col0;
#pragma unroll
                for (int bj = 0; bj < 2; ++bj)
#pragma unroll
                    for (int n = 0; n < 2; ++n) { const size_t o = ro + bj * 128 + n * 16; const pg8::f32x4 xv = *(const pg8::f32x4*)(xin + o);
                        *(pg8::f32x4*)(out + o) = xv * ALPHA + acc[ai][bj][m][n]; } }
    }
};
__device__ __forceinline__ void phase_outproj(const Params& p, int l, unsigned char* lds) {
    pg8::Gemm g{(const bf16_t*)(p.ws + WS_MIX), (const bf16_t*)(p.ws + WS_WOUT) + (size_t)l * DM * DM, NTOK, DM, DM};
    pg8::StaticOrder S; S.init(NTOK, DM, (int)gridDim.x, obid());
    EpiOutP E{(l == 0) ? p.x : p.out, p.out};
    pg8::gemm_phase<EpiOutP, pg8::StaticOrder, true, true>((PG8_LAS unsigned char*)lds, g, S, E);
}

__device__ __forceinline__ void ln_row(float (&v)[16], const float* gain, const float* bias, int lane) {
    float s = 0.f;
#pragma unroll
    for (int i = 0; i < 16; ++i) s += v[i];
    s = wave_sum(s);
    const float mean = s * (1.0f / 1024.0f);
    float q = 0.f;
#pragma unroll
    for (int i = 0; i < 16; ++i) { const float d = v[i] - mean; q += d * d; }
    q = wave_sum(q);
    const float rstd = rsqrtf(q * (1.0f / 1024.0f) + 1e-5f);
#pragma unroll
    for (int j = 0; j < 4; ++j) {
        const float4 g = *(const float4*)(gain + j * 256 + lane * 4), b = *(const float4*)(bias + j * 256 + lane * 4);
        v[j * 4 + 0] = (v[j * 4 + 0] - mean) * rstd * g.x + b.x; v[j * 4 + 1] = (v[j * 4 + 1] - mean) * rstd * g.y + b.y;
        v[j * 4 + 2] = (v[j * 4 + 2] - mean) * rstd * g.z + b.z; v[j * 4 + 3] = (v[j * 4 + 3] - mean) * rstd * g.w + b.w;
    }
}
__device__ __forceinline__ void store_row(const float (&v)[16], float* xo, bf16_t* xbo, int lane) {
#pragma unroll
    for (int j = 0; j < 4; ++j) {
        *(float4*)(xo + j * 256 + lane * 4) = make_float4(v[j * 4], v[j * 4 + 1], v[j * 4 + 2], v[j * 4 + 3]);
        ushort4 o; o.x = f2bf(v[j * 4]); o.y = f2bf(v[j * 4 + 1]); o.z = f2bf(v[j * 4 + 2]); o.w = f2bf(v[j * 4 + 3]);
        *(ushort4*)(xbo + j * 256 + lane * 4) = o;
    }
}

__device__ __forceinline__ void route_pick(const float (&lg)[16], const float* rb, int& i1, int& i2, float& g1, float& g2) {
    float aff[16], sl[16];
#pragma unroll
    for (int e = 0; e < 16; ++e) { aff[e] = sigmoidf_(lg[e]); sl[e] = aff[e] + rb[e]; }
    float bestg = -INFINITY; int bg = 0;
#pragma unroll
    for (int g = 0; g < 4; ++g) {
        float m1 = -INFINITY, m2 = -INFINITY;
#pragma unroll
        for (int k = 0; k < 4; ++k) { const float s = sl[g * 4 + k]; if (s > m1) { m2 = m1; m1 = s; } else if (s > m2) m2 = s; }
        const float gs = m1 + m2;
        if (gs > bestg) { bestg = gs; bg = g; }
    }
    float b1 = -INFINITY; i1 = 0; float a1 = 0.f;
#pragma unroll
    for (int e = 0; e < 16; ++e) { const bool in = (e >> 2) == bg; if (in && sl[e] > b1) { b1 = sl[e]; i1 = e; a1 = aff[e]; } }
    float b2 = -INFINITY; i2 = 0; float a2 = 0.f;
#pragma unroll
    for (int e = 0; e < 16; ++e) { const bool in = ((e >> 2) == bg) && (e != i1); if (in && sl[e] > b2) { b2 = sl[e]; i2 = e; a2 = aff[e]; } }
    const float inv = 1.0f / (a1 + a2);
    g1 = a1 * inv; g2 = a2 * inv;
}
__device__ __forceinline__ void phase_ln1_route(const Params& p, int l, unsigned char* lds) {
    const int tid = otid(), lane = tid & 63, wid = tid >> 6;
    int* sel_e = (int*)lds;
    float* sel_g = (float*)(lds + 2048);
    int* rank = (int*)(lds + 4096);
    int* base = (int*)(lds + 6144);
    float* rwT = (float*)(lds + 8192);
    bf16_t* xb = (bf16_t*)(p.ws + WS_XB);
    unsigned* ctl = (unsigned*)(p.ws + WS_CTL);
    int* ltok = (int*)(p.ws + WS_LTOK);
    const float* gain = p.ln_gain + (size_t)(l * 2 + 0) * DM; const float* bias = p.ln_bias + (size_t)(l * 2 + 0) * DM;
    __syncthreads();
    for (int i = tid; i < 16384; i += NTHREADS) { const int c = i >> 4, e = i & 15; rwT[e * 1024 + c] = p.router_w[i]; }
    for (int chunk = obid(); chunk < NTOK / 256; chunk += gridDim.x) {
        __syncthreads();
        for (int rr = 0; rr < 32; rr += 2) {
            const int lrow = wid * 32 + rr; const size_t row = (size_t)chunk * 256 + lrow;
            float v0[16], v1[16];
#pragma unroll
            for (int j = 0; j < 4; ++j) { const float4 t = *(const float4*)(p.out + row * DM + j * 256 + lane * 4); v0[j * 4] = t.x; v0[j * 4 + 1] = t.y; v0[j * 4 + 2] = t.z; v0[j * 4 + 3] = t.w;
                const float4 u = *(const float4*)(p.out + (row + 1) * DM + j * 256 + lane * 4); v1[j * 4] = u.x; v1[j * 4 + 1] = u.y; v1[j * 4 + 2] = u.z; v1[j * 4 + 3] = u.w; }
            ln_row(v0, gain, bias, lane); ln_row(v1, gain, bias, lane);
            store_row(v0, p.out + row * DM, xb + row * DM, lane); store_row(v1, p.out + (row + 1) * DM, xb + (row + 1) * DM, lane);
            float lg0[16], lg1[16];
#pragma unroll
            for (int e = 0; e < 16; ++e) {
                float s0 = 0.f, s1 = 0.f;
#pragma unroll
                for (int j = 0; j < 4; ++j) { const float4 w = *(const float4*)(rwT + e * 1024 + j * 256 + lane * 4);
                    s0 += v0[j * 4] * w.x + v0[j * 4 + 1] * w.y + v0[j * 4 + 2] * w.z + v0[j * 4 + 3] * w.w;
                    s1 += v1[j * 4] * w.x + v1[j * 4 + 1] * w.y + v1[j * 4 + 2] * w.z + v1[j * 4 + 3] * w.w; }
                lg0[e] = wave_sum(s0); lg1[e] = wave_sum(s1);
            }
            if (lane < 2) {
                int i1, i2; float g1, g2;
                if (lane == 0) route_pick(lg0, p.router_b, i1, i2, g1, g2); else route_pick(lg1, p.router_b, i1, i2, g1, g2);
                const int lr = lrow + lane;
                sel_e[lr * 2] = i1; sel_e[lr * 2 + 1] = i2; sel_g[lr * 2] = g1; sel_g[lr * 2 + 1] = g2;
            }
        }
        __syncthreads();
        if (tid < 16) {
            int c = 0;
            for (int i = 0; i < 512; ++i) if (sel_e[i] == tid) { rank[i] = c; ++c; }
            base[tid] = (int)atomicAdd(&ctl[CW_CNT + (l * 16 + tid) * 64], (unsigned)c);
        }
        __syncthreads();
        {
            const int e = sel_e[tid]; const int pos = base[e] + rank[tid];
            ltok[(size_t)e * NTOK + pos] = chunk * 256 + (tid >> 1);
            int* ti = (int*)(p.ws + WS_LGATE) + (size_t)(chunk * 256 + (tid >> 1)) * 4;
            ti[tid & 1] = (e << 17) | pos; ((float*)ti)[2 + (tid & 1)] = sel_g[tid];
        }
    }
}

#define MOE_TAB_OFF 131072
#define MOE_META_OFF (131072 + 4096)
struct MoeUnit { int e, rl, pn, n, ui, pb; };
__device__ __forceinline__ void moe_meta(const Params& p, int l, PG8_LAS int* meta) {
    if (otid() == 0) {
        unsigned* ctl = (unsigned*)(p.ws + WS_CTL);
        int tb = 0, pb = 0;
        for (int e = 0; e < 16; ++e) { const int c = (int)xb_ld(&ctl[CW_CNT + (l * 16 + e) * 64]); meta[e] = c; meta[16 + e] = tb; meta[33 + e] = pb; tb += (c + 255) >> 8; pb += c; }
        meta[32] = tb; meta[49] = pb;
    }
    __syncthreads();
}
template <int NCOL_LOG2>
struct MoeSchedBase {
    typedef MoeUnit Unit;
    PG8_LAS const int* meta; int G, c;
    __device__ __forceinline__ int mu(int idx) const { return __builtin_amdgcn_readfirstlane(meta[idx]); }
    __device__ __forceinline__ bool next(int i, MoeUnit& u) const {
        const int L = i * G + c; const int ntile = mu(32);
        if (L >= (ntile << NCOL_LOG2)) return false;
        const int rt = L >> NCOL_LOG2; u.pn = L & ((1 << NCOL_LOG2) - 1);
        int e = 0;
#pragma unroll
        for (int k = 1; k < 16; ++k) if (rt >= mu(16 + k)) e = k;
        u.e = e; u.rl = rt - mu(16 + e); u.n = mu(e) - u.rl * 256; u.pb = mu(33 + e) + u.rl * 256; u.ui = i; return true;
    }
};
struct MoeSchedUp : MoeSchedBase<1> {
    PG8_LAS const unsigned short* tok16; const char* xb; const char* wbase;
    __device__ __forceinline__ const char* abase(const MoeUnit&) const { return xb; }
    __device__ __forceinline__ unsigned arow_off(const MoeUnit& u, int r) const { return (unsigned)tok16[u.ui * 256 + r] * 2048u; }
    __device__ __forceinline__ const char* bbase(const MoeUnit& u) const { return wbase + ((size_t)u.e * 512 + u.pn * 256) * 2048; }
};
struct MoeSchedDown : MoeSchedBase<2> {
    const char* hb; const char* wbase;
    __device__ __forceinline__ const char* abase(const MoeUnit& u) const { return hb + (size_t)u.pb * 512; }
    __device__ __forceinline__ unsigned arow_off(const MoeUnit&, int r) const { return (unsigned)r * 512u; }
    __device__ __forceinline__ const char* bbase(const MoeUnit& u) const { return wbase + ((size_t)u.e * 1024 + u.pn * 256) * 512; }
};
struct EpiUp {
    static constexpr bool PERM = false, AFTER_DRAIN = false;
    bf16_t* H;
    __device__ __forceinline__ void operator()(const pg8::f32x4 (&acc)[2][2][4][2], const MoeUnit& u, int wr, int wc, int fr, int fq) const {
        bf16_t* hb = H + u.pn * 128 + wc * 16 + fq * 4;
#pragma unroll
        for (int ai = 0; ai < 2; ++ai)
#pragma unroll
            for (int m = 0; m < 4; ++m) {
                const int r = ai * 128 + wr * 64 + m * 16 + fr;
                const int rr = (r < u.n) ? (u.pb + r) : (2 * NTOK + r);
#pragma unroll
                for (int bj = 0; bj < 2; ++bj) {
                    const pg8::f32x4 g = acc[ai][bj][m][0], uu = acc[ai][bj][m][1];
                    float hv[4];
#pragma unroll
                    for (int i = 0; i < 4; ++i) hv[i] = g[i] * __builtin_amdgcn_rcpf(1.0f + __builtin_amdgcn_exp2f(-g[i] * LOG2E)) * uu[i];
                    uint2 w; w.x = pg8::cvt_pk_bf16(hv[0], hv[1]); w.y = pg8::cvt_pk_bf16(hv[2], hv[3]);
                    *(uint2*)(hb + (size_t)rr * DEXP + bj * 64) = w;
                }
            }
    }
};
struct EpiDown {
    static constexpr bool PERM = true, AFTER_DRAIN = false;
    bf16_t* Y;
    __device__ __forceinline__ void operator()(const pg8::f32x4 (&acc)[2][2][4][2], const MoeUnit& u, int wr, int wc, int fr, int fq) const {
        bf16_t* yb = Y + u.pn * 256 + wc * 32 + 8 * fq;
#pragma unroll
        for (int ai = 0; ai < 2; ++ai)
#pragma unroll
            for (int m = 0; m < 4; ++m) {
                const int r = ai * 128 + wr * 64 + m * 16 + fr;
                const int rr = (r < u.n) ? (u.pb + r) : (2 * NTOK + r);
#pragma unroll
                for (int bj = 0; bj < 2; ++bj) { const pg8::f32x4 v0 = acc[ai][bj][m][0], v1 = acc[ai][bj][m][1];
                    pg8::u32x4 w; w.x = pg8::cvt_pk_bf16(v0[0], v0[1]); w.y = pg8::cvt_pk_bf16(v0[2], v0[3]); w.z = pg8::cvt_pk_bf16(v1[0], v1[1]); w.w = pg8::cvt_pk_bf16(v1[2], v1[3]);
                    *(pg8::u32x4*)(yb + (size_t)rr * DM + bj * 128) = w; }
            }
    }
};
__device__ __forceinline__ void phase_moe_up(const Params& p, int l, unsigned char* lds) {
    PG8_LAS unsigned char* L = (PG8_LAS unsigned char*)lds;
    PG8_LAS int* meta = (PG8_LAS int*)(L + MOE_META_OFF);
    PG8_LAS unsigned short* tok16 = (PG8_LAS unsigned short*)(L + MOE_TAB_OFF);
    __syncthreads();
    moe_meta(p, l, meta);
    MoeSchedUp S; S.meta = meta; S.G = (int)gridDim.x; S.c = obid(); S.tok16 = tok16; S.xb = (const char*)(p.ws + WS_XB); S.wbase = (const char*)(p.ws + WS_MWIN) + (size_t)l * 16 * 512 * 2048;
    {
        const int* ltok = (const int*)(p.ws + WS_LTOK); const int tid = otid();
        MoeUnit u;
        for (int i = 0; i < 8 && S.next(i, u); ++i)
            if (tid < 256) tok16[i * 256 + tid] = (tid < u.n) ? (unsigned short)ltok[(size_t)u.e * NTOK + u.rl * 256 + tid] : (unsigned short)0;
    }
    __syncthreads();
    EpiUp E{(bf16_t*)(p.ws + WS_H)};
    pg8::gemm_phase_g<EpiUp, MoeSchedUp, true>(L, 1024, S, E);
}
__device__ __forceinline__ void phase_moe_down(const Params& p, int l, unsigned char* lds) {
    PG8_LAS unsigned char* L = (PG8_LAS unsigned char*)lds;
    PG8_LAS int* meta = (PG8_LAS int*)(L + MOE_META_OFF);
    __syncthreads();
    moe_meta(p, l, meta);
    MoeSchedDown S; S.meta = meta; S.G = (int)gridDim.x; S.c = obid(); S.hb = (const char*)(p.ws + WS_H); S.wbase = (const char*)(p.ws + WS_MWDN) + (size_t)l * 16 * 1024 * 512;
    EpiDown E{(bf16_t*)(p.ws + WS_Y)};
    pg8::gemm_phase_g<EpiDown, MoeSchedDown, false>(L, 256, S, E);
}

__device__ __forceinline__ void phase_ln2(const Params& p, int l, unsigned char* lds) {
    const int tid = otid(), lane = tid & 63, wid = tid >> 6;
    bf16_t* xb = (bf16_t*)(p.ws + WS_XB); const bf16_t* Y = (const bf16_t*)(p.ws + WS_Y);
    const float* gain = p.ln_gain + (size_t)(l * 2 + 1) * DM; const float* bias = p.ln_bias + (size_t)(l * 2 + 1) * DM;
    int* pbase = (int*)lds;
    __syncthreads();
    if (tid == 0) { unsigned* ctl = (unsigned*)(p.ws + WS_CTL); int pb = 0; for (int e = 0; e < 16; ++e) { pbase[e] = pb; pb += (int)xb_ld(&ctl[CW_CNT + (l * 16 + e) * 64]); } }
    __syncthreads();
    for (size_t row = (size_t)obid() * 8 + wid; row < NTOK; row += (size_t)gridDim.x * 8) {
        const int4 ti = *(const int4*)(p.ws + WS_LGATE + row * 16);
        const size_t p0 = (size_t)(pbase[ti.x >> 17] + (ti.x & 0x1ffff)), p1 = (size_t)(pbase[ti.y >> 17] + (ti.y & 0x1ffff));
        const float g0 = __int_as_float(ti.z), g1 = __int_as_float(ti.w);
        float v[16];
#pragma unroll
        for (int j = 0; j < 4; ++j) {
            const float4 t = *(const float4*)(p.out + row * DM + j * 256 + lane * 4);
            const ushort4 y0 = *(const ushort4*)(Y + p0 * DM + j * 256 + lane * 4), y1 = *(const ushort4*)(Y + p1 * DM + j * 256 + lane * 4);
            v[j * 4 + 0] = ALPHA * t.x + g0 * bf2f(y0.x) + g1 * bf2f(y1.x); v[j * 4 + 1] = ALPHA * t.y + g0 * bf2f(y0.y) + g1 * bf2f(y1.y);
            v[j * 4 + 2] = ALPHA * t.z + g0 * bf2f(y0.z) + g1 * bf2f(y1.z); v[j * 4 + 3] = ALPHA * t.w + g0 * bf2f(y0.w) + g1 * bf2f(y1.w);
        }
        ln_row(v, gain, bias, lane);
        store_row(v, p.out + row * DM, xb + row * DM, lane);
    }
}

__device__ __forceinline__ void sb_item(const Params& p, int bh, int qc, unsigned char* lds) {
    const int tid = otid(), b = bh >> 2, h = bh & 3;
    const bf16_t* proj = (const bf16_t*)(p.ws + WS_PROJ) + (size_t)b * SEQ * PINP;
    bf16_t* mix = (bf16_t*)(p.ws + WS_MIX) + (size_t)b * SEQ * DM;
    float* Ks = (float*)lds; float* Vs = (float*)(lds + 16384);
    const int t = qc * 512 + tid; const int twmax = qc * 512 + (tid | 63);
    float q[64], acc[64];
#pragma unroll
    for (int d8 = 0; d8 < 8; ++d8) { const uint4 raw = *(const uint4*)(proj + (size_t)t * PINP + h * 64 + d8 * 8); const bf16_t* rp = (const bf16_t*)&raw;
#pragma unroll
        for (int i = 0; i < 8; ++i) q[d8 * 8 + i] = bf2f(rp[i]) * 0.125f; }
#pragma unroll
    for (int d = 0; d < 64; ++d) acc[d] = 0.f;
    float cs = 0.f;
    for (int kb = qc * 8 + 7; kb >= 0; --kb) {
        __syncthreads();
        { const int key = tid >> 3, d8 = tid & 7; const size_t ro = (size_t)(kb * 64 + key) * PINP + h * 64 + d8 * 8;
          const uint4 rk = *(const uint4*)(proj + ro + 256), rv = *(const uint4*)(proj + ro + 512); const bf16_t* pk = (const bf16_t*)&rk; const bf16_t* pv = (const bf16_t*)&rv;
#pragma unroll
          for (int i = 0; i < 8; ++i) { Ks[key * 64 + d8 * 8 + i] = bf2f(pk[i]); Vs[key * 64 + d8 * 8 + i] = bf2f(pv[i]); } }
        __syncthreads();
        if (kb * 64 < twmax) {
            for (int sl = 63; sl >= 0; --sl) {
                const int s = kb * 64 + sl;
                if (s < t) {
                    float z = 0.f;
#pragma unroll
                    for (int d4 = 0; d4 < 16; ++d4) { const float4 kv = *(const float4*)(Ks + sl * 64 + d4 * 4); z += q[d4 * 4] * kv.x + q[d4 * 4 + 1] * kv.y + q[d4 * 4 + 2] * kv.z + q[d4 * 4 + 3] * kv.w; }
                    const float sp = fmaxf(z, 0.f) + log1pf(expf(-fabsf(z)));
                    cs += sp;
                    const float w = expf(z - cs);
#pragma unroll
                    for (int d4 = 0; d4 < 16; ++d4) { const float4 vv = *(const float4*)(Vs + sl * 64 + d4 * 4); acc[d4 * 4] += w * vv.x; acc[d4 * 4 + 1] += w * vv.y; acc[d4 * 4 + 2] += w * vv.z; acc[d4 * 4 + 3] += w * vv.w; }
                }
            }
        }
    }
#pragma unroll
    for (int d8 = 0; d8 < 8; ++d8) { uint4 o; bf16_t* op = (bf16_t*)&o;
#pragma unroll
        for (int i = 0; i < 8; ++i) op[i] = f2bf(acc[d8 * 8 + i]);
        *(uint4*)(mix + (size_t)t * DM + h * 64 + d8 * 8) = o; }
}

__device__ __forceinline__ void da_item(const Params& p, int l, int bh, int qc, unsigned char* lds) {
    const int tid = otid(), b = bh >> 2, h = bh & 3, map = tid >> 8, row = tid & 255;
    const bf16_t* proj = (const bf16_t*)(p.ws + WS_PROJ) + (size_t)b * SEQ * PINP;
    bf16_t* mix = (bf16_t*)(p.ws + WS_MIX) + (size_t)b * SEQ * DM;
    const float* biasd = (const float*)(p.ws + WS_BIASD) + h * 2048;
    float* Ks = (float*)lds; float* Vs = (float*)(lds + 16384); float* Bd = (float*)(lds + 32768); float* Ex = (float*)(lds + 40960);
    const int t = qc * 256 + row; const int twmax = qc * 256 + (row | 63);
    __syncthreads();
    for (int i = tid; i < 2048; i += NTHREADS) Bd[i] = biasd[i];
    float q[32], O[64];
#pragma unroll
    for (int d8 = 0; d8 < 4; ++d8) { const uint4 raw = *(const uint4*)(proj + (size_t)t * PINP + 768 + h * 64 + map * 32 + d8 * 8); const bf16_t* rp = (const bf16_t*)&raw;
#pragma unroll
        for (int i = 0; i < 8; ++i) q[d8 * 8 + i] = bf2f(rp[i]) * 0.17677669529663687f; }
#pragma unroll
    for (int d = 0; d < 64; ++d) O[d] = 0.f;
    float mrun = -INFINITY, lsum = 0.f;
    for (int kb = 0; kb <= qc * 4 + 3; ++kb) {
        __syncthreads();
        { const int key = tid >> 3, d8 = tid & 7; const size_t ro = (size_t)(kb * 64 + key) * PINP + 768 + h * 64 + d8 * 8;
          const uint4 rk = *(const uint4*)(proj + ro + 256), rv = *(const uint4*)(proj + ro + 512); const bf16_t* pk = (const bf16_t*)&rk; const bf16_t* pv = (const bf16_t*)&rv;
#pragma unroll
          for (int i = 0; i < 8; ++i) { Ks[key * 64 + d8 * 8 + i] = bf2f(pk[i]); Vs[key * 64 + d8 * 8 + i] = bf2f(pv[i]); } }
        __syncthreads();
        if (kb * 64 <= twmax) {
            for (int sl = 0; sl < 64; ++sl) {
                const int s = kb * 64 + sl;
                if (s <= t) {
                    float z = Bd[t - s];
#pragma unroll
                    for (int d4 = 0; d4 < 8; ++d4) { const float4 kv = *(const float4*)(Ks + sl * 64 + map * 32 + d4 * 4); z += q[d4 * 4] * kv.x + q[d4 * 4 + 1] * kv.y + q[d4 * 4 + 2] * kv.z + q[d4 * 4 + 3] * kv.w; }
                    if (z > mrun) { const float sc = expf(mrun - z); lsum *= sc;
#pragma unroll
                        for (int d = 0; d < 64; ++d) O[d] *= sc;
                        mrun = z; }
                    const float pw = expf(z - mrun);
                    lsum += pw;
#pragma unroll
                    for (int d4 = 0; d4 < 16; ++d4) { const float4 vv = *(const float4*)(Vs + sl * 64 + d4 * 4); O[d4 * 4] += pw * vv.x; O[d4 * 4 + 1] += pw * vv.y; O[d4 * 4 + 2] += pw * vv.z; O[d4 * 4 + 3] += pw * vv.w; }
                }
            }
        }
    }
    const float il = 1.0f / lsum;
    __syncthreads();
    if (map == 1) {
#pragma unroll
        for (int d = 0; d < 64; ++d) Ex[d * 256 + row] = O[d] * il;
    }
    __syncthreads();
    if (map == 0) {
        const float* lp = p.da_lambda + (size_t)l * 128;
        float s1 = 0.f, s2 = 0.f;
        for (int i = 0; i < 32; ++i) { s1 += lp[i] * lp[32 + i]; s2 += lp[64 + i] * lp[96 + i]; }
        const float lam_init = 0.8f - 0.6f * expf(-0.3f * (float)l);
        const float lam = expf(s1) - expf(s2) + lam_init;
        float ms = 0.f;
#pragma unroll
        for (int d = 0; d < 64; ++d) { O[d] = O[d] * il - lam * Ex[d * 256 + row]; ms += O[d] * O[d]; }
        const float r = rsqrtf(ms * (1.0f / 64.0f) + 1e-5f) * (1.0f - lam_init);
        const float* sg = p.da_subln + l * 64;
#pragma unroll
        for (int d8 = 0; d8 < 8; ++d8) { uint4 o; bf16_t* op = (bf16_t*)&o;
#pragma unroll
            for (int i = 0; i < 8; ++i) op[i] = f2bf(O[d8 * 8 + i] * r * sg[d8 * 8 + i]);
            *(uint4*)(mix + (size_t)t * DM + 256 + h * 64 + d8 * 8) = o; }
    }
}

typedef float f32x16 __attribute__((ext_vector_type(16)));
typedef unsigned u32x4v __attribute__((ext_vector_type(4)));
typedef unsigned u32x2v __attribute__((ext_vector_type(2)));
#define AT_KSTR 72
#define AT_VSTR 68
#define AT_KBYTES (64 * AT_KSTR * 2)
#define AT_VBYTES (64 * AT_VSTR * 2)
typedef __bf16 bf16x2_t __attribute__((ext_vector_type(2)));
typedef float f32x2_t __attribute__((ext_vector_type(2)));
__device__ __forceinline__ unsigned pk_bf16(float lo, float hi) { const f32x2_t v = {lo, hi}; const bf16x2_t b = __builtin_convertvector(v, bf16x2_t); return __builtin_bit_cast(unsigned, b); }
__device__ __forceinline__ bf16x8 mk_frag(unsigned a, unsigned b, unsigned c, unsigned d) { u32x4v v; v.x = a; v.y = b; v.z = c; v.w = d; return __builtin_bit_cast(bf16x8, v); }
__device__ __forceinline__ bf16x8 scale_frag(uint4 raw, float sc) {
    return mk_frag(pk_bf16(__uint_as_float(raw.x << 16) * sc, __uint_as_float(raw.x & 0xffff0000u) * sc), pk_bf16(__uint_as_float(raw.y << 16) * sc, __uint_as_float(raw.y & 0xffff0000u) * sc),
                   pk_bf16(__uint_as_float(raw.z << 16) * sc, __uint_as_float(raw.z & 0xffff0000u) * sc), pk_bf16(__uint_as_float(raw.w << 16) * sc, __uint_as_float(raw.w & 0xffff0000u) * sc));
}
struct AtStage {
    uint4 rk; uint2 rv0, rv1;
    __device__ __forceinline__ void load(const bf16_t* kbase, const bf16_t* vbase, int kt, int tid) {
        const int skey = tid >> 3, sc8 = tid & 7, vkp = tid >> 4, vdg = tid & 15;
        rk = *(const uint4*)(kbase + (size_t)(kt * 64 + skey) * PINP + sc8 * 8);
        rv0 = *(const uint2*)(vbase + (size_t)(kt * 64 + 2 * vkp) * PINP + vdg * 4);
        rv1 = *(const uint2*)(vbase + (size_t)(kt * 64 + 2 * vkp + 1) * PINP + vdg * 4);
    }
    __device__ __forceinline__ void store(LAS unsigned char* kb, LAS unsigned char* vb, int tid) const {
        const int skey = tid >> 3, sc8 = tid & 7, vkp = tid >> 4, vdg = tid & 15;
        { u32x4v t_; t_.x = rk.x; t_.y = rk.y; t_.z = rk.z; t_.w = rk.w; *(LAS u32x4v*)(kb + (skey * AT_KSTR + sc8 * 8) * 2) = t_; }
        LAS unsigned* vt = (LAS unsigned*)vb;
        vt[(vdg * 4 + 0) * (AT_VSTR / 2) + vkp] = (rv0.x & 0xffffu) | (rv1.x << 16);
        vt[(vdg * 4 + 1) * (AT_VSTR / 2) + vkp] = (rv0.x >> 16) | (rv1.x & 0xffff0000u);
        vt[(vdg * 4 + 2) * (AT_VSTR / 2) + vkp] = (rv0.y & 0xffffu) | (rv1.y << 16);
        vt[(vdg * 4 + 3) * (AT_VSTR / 2) + vkp] = (rv0.y >> 16) | (rv1.y & 0xffff0000u);
    }
};
__device__ __forceinline__ bf16x8 k_frag(const LAS unsigned char* kb, int keyrow, int dcol) { return *(const LAS bf16x8*)(kb + (keyrow * AT_KSTR + dcol) * 2); }
__device__ __forceinline__ bf16x8 v_frag(const LAS unsigned char* vb, int drow, int keycol) {
    const u32x2v a = *(const LAS u32x2v*)(vb + (drow * AT_VSTR + keycol) * 2), b = *(const LAS u32x2v*)(vb + (drow * AT_VSTR + keycol + 8) * 2);
    return mk_frag(a.x, a.y, b.x, b.y);
}
__device__ __forceinline__ void store_ot(bf16_t* dst  , const f32x16& o0, const f32x16& o1, int hh) {
#pragma unroll
    for (int q = 0; q < 4; ++q) {
        uint2 w; w.x = pk_bf16(o0[4 * q], o0[4 * q + 1]); w.y = pk_bf16(o0[4 * q + 2], o0[4 * q + 3]);
        *(uint2*)(dst + 8 * q + 4 * hh) = w;
        uint2 w1; w1.x = pk_bf16(o1[4 * q], o1[4 * q + 1]); w1.y = pk_bf16(o1[4 * q + 2], o1[4 * q + 3]);
        *(uint2*)(dst + 32 + 8 * q + 4 * hh) = w1;
    }
}

#define SB_VSTR 36
#define SB_WBYTES (32 * AT_KSTR * 2 + 64 * SB_VSTR * 2)
struct SbStage {
    u32x4v rk[4]; u32x2v rv0[4], rv1[4];
    __device__ __forceinline__ void load(const bf16_t* kbase, const bf16_t* vbase, int kb, int lane) {
        const int rsub = lane >> 3, c8 = lane & 7, kps = lane >> 4, dg = lane & 15;
#pragma unroll
        for (int j = 0; j < 4; ++j) {
            rk[j] = *(const u32x4v*)(kbase + (size_t)(kb * 32 + 8 * j + rsub) * PINP + c8 * 8);
            const int kp = 4 * j + kps;
            rv0[j] = *(const u32x2v*)(vbase + (size_t)(kb * 32 + 2 * kp) * PINP + dg * 4);
            rv1[j] = *(const u32x2v*)(vbase + (size_t)(kb * 32 + 2 * kp + 1) * PINP + dg * 4);
        }
    }
    __device__ __forceinline__ void store(LAS unsigned char* kb_, LAS unsigned char* vb_, int lane) const {
        const int rsub = lane >> 3, c8 = lane & 7, kps = lane >> 4, dg = lane & 15;
        LAS unsigned* vt = (LAS unsigned*)vb_;
#pragma unroll
        for (int j = 0; j < 4; ++j) {
            *(LAS u32x4v*)(kb_ + ((8 * j + rsub) * AT_KSTR + c8 * 8) * 2) = rk[j];
            const int kp = 4 * j + kps;
            vt[(dg * 4 + 0) * (SB_VSTR / 2) + kp] = (rv0[j].x & 0xffffu) | (rv1[j].x << 16);
            vt[(dg * 4 + 1) * (SB_VSTR / 2) + kp] = (rv0[j].x >> 16) | (rv1[j].x & 0xffff0000u);
            vt[(dg * 4 + 2) * (SB_VSTR / 2) + kp] = (rv0[j].y & 0xffffu) | (rv1[j].y << 16);
            vt[(dg * 4 + 3) * (SB_VSTR / 2) + kp] = (rv0[j].y >> 16) | (rv1[j].y & 0xffff0000u);
        }
    }
};
__device__ __forceinline__ bf16x8 sbv_frag(const LAS unsigned char* vb, int drow, int keycol) {
    const u32x2v a = *(const LAS u32x2v*)(vb + (drow * SB_VSTR + keycol) * 2), b = *(const LAS u32x2v*)(vb + (drow * SB_VSTR + keycol + 8) * 2);
    return mk_frag(a.x, a.y, b.x, b.y);
}
__device__ __forceinline__ void sbm_item(const Params& p, int bh, int qb, unsigned char* lds) {
    const int tid = otid(), lane = tid & 63, wid = tid >> 6, r = lane & 31, hh = lane >> 5;
    const int b = bh >> 2, h = bh & 3;
    const bf16_t* proj = (const bf16_t*)(p.ws + WS_PROJ) + (size_t)b * SEQ * PINP;
    const bf16_t* kbase = proj + 256 + h * 64; const bf16_t* vbase = proj + 512 + h * 64;
    const int q0w = qb * 256 + wid * 32, t = q0w + r;
    LAS unsigned char* const KW = (LAS unsigned char*)lds + wid * SB_WBYTES; LAS unsigned char* const VW = KW + 32 * AT_KSTR * 2;
    bf16x8 qf[4];
#pragma unroll
    for (int s = 0; s < 4; ++s) qf[s] = scale_frag(*(const uint4*)(proj + (size_t)t * PINP + h * 64 + 16 * s + 8 * hh), 0.125f * LOG2E);
    f32x16 O0, O1;
#pragma unroll
    for (int i = 0; i < 16; ++i) { O0[i] = 0.f; O1[i] = 0.f; }
    float carry = 1.f;
    SbStage st;
    __syncthreads();
    if (q0w + 31 > 0) {
        int kb = (q0w + 30) >> 5;
        st.load(kbase, vbase, kb, lane);
#pragma unroll 1
        for (; kb >= 0; --kb) {
            st.store(KW, VW, lane);
            if (kb > 0) st.load(kbase, vbase, kb - 1, lane);
            const int kbs = 32 * kb;
            f32x16 S;
#pragma unroll
            for (int i = 0; i < 16; ++i) S[i] = 0.f;
#pragma unroll
            for (int s = 0; s < 4; ++s) S = __builtin_amdgcn_mfma_f32_32x32x16_bf16(k_frag(KW, r, 16 * s + 8 * hh), qf[s], S, 0, 0, 0);
            const bool needmask = (kbs + 31 >= q0w);
            float sg[16], G[4];
#pragma unroll
            for (int q = 0; q < 4; ++q) {
                float om[4];
#pragma unroll
                for (int i = 0; i < 4; ++i) {
                    const float z = S[4 * q + i];
                    const float e = __builtin_amdgcn_exp2f(-fabsf(z));
                    const float rr = __builtin_amdgcn_rcpf(1.0f + e);
                    const float er = e * rr;
                    float sgm = z >= 0.f ? rr : er, omm = z >= 0.f ? er : rr;
                    if (needmask) { const int key = kbs + i + 8 * q + 4 * hh; if (key >= t) { sgm = 0.f; omm = 1.f; } }
                    sg[4 * q + i] = sgm; om[i] = omm;
                }
                const float pp2 = om[3], pp1 = pp2 * om[2], pp0 = pp1 * om[1];
                G[q] = pp0 * om[0];
                sg[4 * q + 2] *= pp2; sg[4 * q + 1] *= pp1; sg[4 * q + 0] *= pp0;
            }
            float Gp[4];
#pragma unroll
            for (int q = 0; q < 4; ++q) Gp[q] = __shfl_xor(G[q], 32);
            const float T0 = G[0] * Gp[0], T1 = G[1] * Gp[1], T2 = G[2] * Gp[2], T3 = G[3] * Gp[3];
            const float U2 = T3, U1 = T3 * T2, U0 = U1 * T1;
            float E[4];
            E[3] = carry; E[2] = carry * U2; E[1] = carry * U1; E[0] = carry * U0;
            if (hh == 0) { E[3] *= Gp[3]; E[2] *= Gp[2]; E[1] *= Gp[1]; E[0] *= Gp[0]; }
            carry = carry * U0 * T0;
#pragma unroll
            for (int q = 0; q < 4; ++q) { sg[4 * q] *= E[q]; sg[4 * q + 1] *= E[q]; sg[4 * q + 2] *= E[q]; sg[4 * q + 3] *= E[q]; }
            const bf16x8 P0 = mk_frag(pk_bf16(sg[0], sg[1]), pk_bf16(sg[2], sg[3]), pk_bf16(sg[4], sg[5]), pk_bf16(sg[6], sg[7]));
            const bf16x8 P1 = mk_frag(pk_bf16(sg[8], sg[9]), pk_bf16(sg[10], sg[11]), pk_bf16(sg[12], sg[13]), pk_bf16(sg[14], sg[15]));
            O0 = __builtin_amdgcn_mfma_f32_32x32x16_bf16(sbv_frag(VW, r, 4 * hh), P0, O0, 0, 0, 0);
            O0 = __builtin_amdgcn_mfma_f32_32x32x16_bf16(sbv_frag(VW, r, 16 + 4 * hh), P1, O0, 0, 0, 0);
            O1 = __builtin_amdgcn_mfma_f32_32x32x16_bf16(sbv_frag(VW, 32 + r, 4 * hh), P0, O1, 0, 0, 0);
            O1 = __builtin_amdgcn_mfma_f32_32x32x16_bf16(sbv_frag(VW, 32 + r, 16 + 4 * hh), P1, O1, 0, 0, 0);
            if (__all(carry < 1e-30f)) break;
        }
    }
    { const int tid2 = otid(), hh2 = (tid2 & 63) >> 5, t2 = qb * 256 + (tid2 >> 6) * 32 + (tid2 & 31);
      store_ot((bf16_t*)(p.ws + WS_MIX) + (size_t)((bh >> 2) * SEQ + t2) * DM + (bh & 3) * 64, O0, O1, hh2); }
}

__device__ __forceinline__ void dam_item(const Params& p, int l, int bh, int qb, unsigned char* lds) {
    const int tid = otid(), lane = tid & 63, wid = tid >> 6, r = lane & 31, hh = lane >> 5;
    const int b = bh >> 2, h = bh & 3;
    const bf16_t* proj = (const bf16_t*)(p.ws + WS_PROJ) + (size_t)b * SEQ * PINP;
    const bf16_t* kbase = proj + 1024 + h * 64; const bf16_t* vbase = proj + 1280 + h * 64;
    const float* biasd = (const float*)(p.ws + WS_BIASD) + h * 2048;
    const int q0w = qb * 256 + wid * 32, t = q0w + r;
    LAS unsigned char* const L = (LAS unsigned char*)lds;
#define KBUF(b_) (L + (b_) * AT_KBYTES)
#define VBUF(b_) (L + 2 * AT_KBYTES + (b_) * AT_VBYTES)
    LAS float* Bd = (LAS float*)(L + 2 * AT_KBYTES + 2 * AT_VBYTES + 64);
    bf16x8 qf[2][2];
#pragma unroll
    for (int m = 0; m < 2; ++m)
#pragma unroll
        for (int s = 0; s < 2; ++s) qf[m][s] = scale_frag(*(const uint4*)(proj + (size_t)t * PINP + 768 + h * 64 + m * 32 + 16 * s + 8 * hh), 0.17677669529663687f * LOG2E);
    f32x16 O[2][2];
#pragma unroll
    for (int m = 0; m < 2; ++m)
#pragma unroll
        for (int d = 0; d < 2; ++d)
#pragma unroll
            for (int i = 0; i < 16; ++i) O[m][d][i] = 0.f;
    float lrun[2] = {0.f, 0.f};
    const float cfar = biasd[2047] * LOG2E;
    AtStage st;
    const int ktop = qb * 4 + 3;
    __syncthreads();
    if (tid < 320) Bd[tid] = tid >= 64 ? biasd[tid - 64] * LOG2E : 0.f;
    st.load(kbase, vbase, 0, tid); st.store(KBUF(0), VBUF(0), tid);
    __syncthreads();
#pragma unroll 1
    for (int kt = 0; kt <= ktop; ++kt) {
        const int buf = kt & 1;
        if (kt < ktop) st.load(kbase, vbase, kt + 1, tid);
        if (64 * kt <= q0w + 31) {
            const bool far = (q0w - (64 * kt + 63) >= 128);
            const int dbase = t - 64 * kt - 4 * hh;
            const LAS float* bp = Bd + 64 + dbase;
            const float sinit = far ? cfar : 0.f;
#pragma unroll
            for (int m = 0; m < 2; ++m) {
#pragma unroll
                for (int kb32 = 0; kb32 < 2; ++kb32) {
                    if (64 * kt + 32 * kb32 <= q0w + 31) {
                        f32x16 S;
#pragma unroll
                        for (int i = 0; i < 16; ++i) S[i] = sinit;
#pragma unroll
                        for (int s = 0; s < 2; ++s) S = __builtin_amdgcn_mfma_f32_32x32x16_bf16(k_frag(KBUF(buf), kb32 * 32 + r, m * 32 + 16 * s + 8 * hh), qf[m][s], S, 0, 0, 0);
                        if (!far) {
#pragma unroll
                            for (int i = 0; i < 16; ++i) {
                                const int c = 32 * kb32 + (i & 3) + 8 * (i >> 2);
                                const float bb = bp[-c];
                                float z = S[i] + bb;
                                z = (dbase - c >= 0) ? z : -INFINITY;
                                S[i] = z;
                            }
                        }
                        float ls = 0.f;
#pragma unroll
                        for (int i = 0; i < 16; ++i) { const float pv = __builtin_amdgcn_exp2f(S[i]); S[i] = pv; ls += pv; }
                        lrun[m] += ls;
                        const bf16x8 P0 = mk_frag(pk_bf16(S[0], S[1]), pk_bf16(S[2], S[3]), pk_bf16(S[4], S[5]), pk_bf16(S[6], S[7]));
                        const bf16x8 P1 = mk_frag(pk_bf16(S[8], S[9]), pk_bf16(S[10], S[11]), pk_bf16(S[12], S[13]), pk_bf16(S[14], S[15]));
#pragma unroll
                        for (int d = 0; d < 2; ++d) {
                            O[m][d] = __builtin_amdgcn_mfma_f32_32x32x16_bf16(v_frag(VBUF(buf), d * 32 + r, kb32 * 32 + 4 * hh), P0, O[m][d], 0, 0, 0);
                            O[m][d] = __builtin_amdgcn_mfma_f32_32x32x16_bf16(v_frag(VBUF(buf), d * 32 + r, kb32 * 32 + 16 + 4 * hh), P1, O[m][d], 0, 0, 0);
                        }
                    }
                }
            }
        }
        if (kt < ktop) st.store(KBUF(buf ^ 1), VBUF(buf ^ 1), tid);
        __syncthreads();
    }
    const int tid2 = otid(), hh2 = (tid2 & 63) >> 5, t2 = qb * 256 + (tid2 >> 6) * 32 + (tid2 & 31);
    const float* lp = p.da_lambda + (size_t)l * 128;
    float s1 = 0.f, s2 = 0.f;
    for (int i = 0; i < 32; ++i) { s1 += lp[i] * lp[32 + i]; s2 += lp[64 + i] * lp[96 + i]; }
    const float lam_init = 0.8f - 0.6f * expf(-0.3f * (float)l);
    const float lam = expf(s1) - expf(s2) + lam_init;
    const float l0 = lrun[0] + __shfl_xor(lrun[0], 32), l1 = lrun[1] + __shfl_xor(lrun[1], 32);
    const float i0 = 1.0f / l0, i1 = lam / l1;
    float ms = 0.f;
#pragma unroll
    for (int d = 0; d < 2; ++d)
#pragma unroll
        for (int i = 0; i < 16; ++i) { const float o = O[0][d][i] * i0 - O[1][d][i] * i1; O[0][d][i] = o; ms += o * o; }
    ms += __shfl_xor(ms, 32);
    const float rs = rsqrtf(ms * (1.0f / 64.0f) + 1e-5f) * (1.0f - lam_init);
    const float* sgn = p.da_subln + l * 64;
#pragma unroll
    for (int d = 0; d < 2; ++d)
#pragma unroll
        for (int i = 0; i < 16; ++i) O[0][d][i] *= rs * sgn[d * 32 + (i & 3) + 8 * (i >> 2) + 4 * hh2];
    store_ot((bf16_t*)(p.ws + WS_MIX) + (size_t)((bh >> 2) * SEQ + t2) * DM + 256 + (bh & 3) * 64, O[0][0], O[0][1], hh2);
}

__device__ __forceinline__ void bf8_to_f(const uint4& v, float (&o)[8]) {
    o[0] = __uint_as_float(v.x << 16); o[1] = __uint_as_float(v.x & 0xffff0000u); o[2] = __uint_as_float(v.y << 16); o[3] = __uint_as_float(v.y & 0xffff0000u);
    o[4] = __uint_as_float(v.z << 16); o[5] = __uint_as_float(v.z & 0xffff0000u); o[6] = __uint_as_float(v.w << 16); o[7] = __uint_as_float(v.w & 0xffff0000u);
}
__device__ __forceinline__ void conv_item(const Params& p, int l, int item) {
    const int tid = otid();
    const bf16_t* proj = (const bf16_t*)(p.ws + WS_PROJ); bf16_t* mix = (bf16_t*)(p.ws + WS_MIX);
    const float* cw = p.sc_conv + (size_t)l * 3 * 256;
    const int c8 = (tid & 31) * 8;
    float w0[8], w1[8], w2[8];
#pragma unroll
    for (int i = 0; i < 8; ++i) { w0[i] = cw[c8 + i]; w1[i] = cw[256 + c8 + i]; w2[i] = cw[512 + c8 + i]; }
#pragma unroll 4
    for (int k = 0; k < 16; ++k) {
        const int rr = (tid >> 5) + 16 * k;
        const size_t row = (size_t)item * 256 + rr; const int t = (int)(row & (SEQ - 1));
        const bf16_t* pr = proj + row * PINP + 1536 + c8;
        const uint4 zz = make_uint4(0u, 0u, 0u, 0u);
        const uint4 bv = *(const uint4*)pr, c2 = *(const uint4*)(pr + 256), h2 = *(const uint4*)(pr + 512);
        const uint4 c1 = t >= 1 ? *(const uint4*)(pr + 256 - PINP) : zz, h1 = t >= 1 ? *(const uint4*)(pr + 512 - PINP) : zz;
        const uint4 c0 = t >= 2 ? *(const uint4*)(pr + 256 - 2 * PINP) : zz, h0 = t >= 2 ? *(const uint4*)(pr + 512 - 2 * PINP) : zz;
        float fb[8], fc2[8], fh2[8], fc1[8], fh1[8], fc0[8], fh0[8], y[8];
        bf8_to_f(bv, fb); bf8_to_f(c2, fc2); bf8_to_f(h2, fh2); bf8_to_f(c1, fc1); bf8_to_f(h1, fh1); bf8_to_f(c0, fc0); bf8_to_f(h0, fh0);
#pragma unroll
        for (int i = 0; i < 8; ++i) y[i] = fb[i] * (w0[i] * (fc0[i] * fh0[i]) + w1[i] * (fc1[i] * fh1[i]) + w2[i] * (fc2[i] * fh2[i]));
        uint4 o; o.x = pk_bf16(y[0], y[1]); o.y = pk_bf16(y[2], y[3]); o.z = pk_bf16(y[4], y[5]); o.w = pk_bf16(y[6], y[7]);
        *(uint4*)(mix + row * DM + 512 + c8) = o;
    }
}

template <int CTRL> __device__ __forceinline__ float dpp_f(float v) { return __int_as_float(__builtin_amdgcn_update_dpp(0, __float_as_int(v), CTRL, 0xf, 0xf, true)); }
__device__ __forceinline__ float red16(float x) { x += dpp_f<0xB1>(x); x += dpp_f<0x4E>(x); x += dpp_f<0x141>(x); x += dpp_f<0x140>(x); return x; }
__device__ __forceinline__ float fsigmoid(float x) { return __builtin_amdgcn_rcpf(1.0f + __builtin_amdgcn_exp2f(-x * LOG2E)); }
__device__ __forceinline__ float ftanh(float x) { return 1.0f - 2.0f * __builtin_amdgcn_rcpf(1.0f + __builtin_amdgcn_exp2f(x * (2.0f * LOG2E))); }
#define MF16(a, b, c) __builtin_amdgcn_mfma_f32_16x16x32_bf16(a, b, c, 0, 0, 0)
__device__ __forceinline__ bf16x8 frag_lo(const f32x4& c) { return mk_frag(pk_bf16(c[0], c[1]), pk_bf16(c[2], c[3]), 0u, 0u); }
__device__ __forceinline__ bf16x8 frag_lo_hi(const f32x4& c, uint2 hi) { return mk_frag(pk_bf16(c[0], c[1]), pk_bf16(c[2], c[3]), hi.x, hi.y); }
__device__ __forceinline__ bf16x8 frag_u2(uint2 lo, uint2 hi) { return mk_frag(lo.x, lo.y, hi.x, hi.y); }
__device__ __forceinline__ f32x4 tt64(const bf16_t* arow, const bf16_t* brow, int g, f32x4 c) {
    c = MF16(*(const bf16x8*)(arow + 8 * g), *(const bf16x8*)(brow + 8 * g), c);
    c = MF16(*(const bf16x8*)(arow + 32 + 8 * g), *(const bf16x8*)(brow + 32 + 8 * g), c);
    return c;
}
#define RW_RS 72
#define RW_TS 20
struct RwPre { uint4 cu[3], pr[3]; };
__device__ __forceinline__ int rw_col(int gq, int h) { return gq < 8 ? h * 64 + gq * 8 : gq < 16 ? 256 + h * 64 + (gq - 8) * 8 : gq < 24 ? 512 + h * 64 + (gq - 16) * 8 : 768 + (gq - 24) * 8; }
__device__ __forceinline__ void rw_prefetch(RwPre& q, const bf16_t* proj, int t0, int h, int tid) {
#pragma unroll
    for (int k = 0; k < 3; ++k) {
        const int i = tid + k * NTHREADS;
        if (i < 1280) {
            const int tt = i / 40, gq = i % 40, t = t0 + tt, col = rw_col(gq, h);
            q.cu[k] = *(const uint4*)(proj + (size_t)t * PINP + col);
            q.pr[k] = (t > 0) ? *(const uint4*)(proj + (size_t)(t - 1) * PINP + col) : make_uint4(0u, 0u, 0u, 0u);
        }
    }
}
__device__ __forceinline__ void rwkv_item(const Params& p, int l, int bh, unsigned char* lds) {
    const int tid = otid(), b = bh >> 2, h = bh & 3;
    const int lane = tid & 63, wv = tid >> 6, n = lane & 15, g = lane >> 4;
    const bf16_t* proj = (const bf16_t*)(p.ws + WS_PROJ) + (size_t)b * SEQ * PINP + 2304;
    bf16_t* mix = (bf16_t*)(p.ws + WS_MIX) + (size_t)b * SEQ * DM + 768 + h * 64;
    const float* mu = p.rw_mu + (size_t)l * 896;
    const float* vecs = p.rw_vecs + (size_t)l * 7 * 256 + h * 64;
    float* Wup = (float*)lds; float* Aup = Wup + 2048; float* Gup = Aup + 2048;
    float* xr = Gup + 4096; float* xk = xr + 2048; float* xv = xk + 2048;
    float* xw = xv + 2048; float* xa = xw + 1024; float* xg = xa + 1024;
    float* lw = xg + 2048; float* ab = lw + 2048; float* kk = ab + 2048; float* gg = kk + 2048;
    float* yy = gg + 2048;
    float* bon = yy + 1024;
    bf16_t* KT = (bf16_t*)(bon + 64); bf16_t* BT = KT + 16 * RW_RS; bf16_t* KKb = BT + 16 * RW_RS; bf16_t* RT = KKb + 16 * RW_RS;
    bf16_t* BhT = RT + 16 * RW_RS; bf16_t* KhT = BhT + 64 * RW_TS; bf16_t* VT = KhT + 64 * RW_TS;
    bf16_t* AakA = VT + 64 * RW_TS; bf16_t* ArbA = AakA + 16 * RW_TS; bf16_t* ArkA = ArbA + 16 * RW_TS; bf16_t* TA = ArkA + 16 * RW_TS;
    float* GC = (float*)(TA + 16 * RW_TS);
    bf16_t* Sb0 = (bf16_t*)(GC + 64); bf16_t* Sb1 = Sb0 + 64 * RW_RS;
    __syncthreads();
    for (int i = tid; i < 2048; i += NTHREADS) { const int m = i >> 6, c = i & 63; Wup[i] = p.rw_w_up[(size_t)l * 32 * 256 + m * 256 + h * 64 + c]; Aup[i] = p.rw_a_up[(size_t)l * 32 * 256 + m * 256 + h * 64 + c]; }
    for (int i = tid; i < 4096; i += NTHREADS) { const int m = i >> 6, c = i & 63; Gup[i] = p.rw_g_up[(size_t)l * 64 * 256 + m * 256 + h * 64 + c]; }
    for (int i = tid; i < 64 * RW_RS / 2; i += NTHREADS) ((unsigned*)Sb0)[i] = 0u;
    const int ptt = tid >> 4, pc = (tid & 15) * 4;
    const float4 v_w0 = *(const float4*)(vecs + pc), v_a0 = *(const float4*)(vecs + 256 + pc), v_kk = *(const float4*)(vecs + 512 + pc), v_ka = *(const float4*)(vecs + 768 + pc),
                 v_rk = *(const float4*)(vecs + 1024 + pc), v_lg = *(const float4*)(vecs + 1280 + pc), v_lb = *(const float4*)(vecs + 1536 + pc);
    const int ib = wv & 3, jh = wv >> 2;
    f32x4 St0 = {0.f, 0.f, 0.f, 0.f}, St1 = {0.f, 0.f, 0.f, 0.f};
    int cur = 0;
    RwPre pre;
    rw_prefetch(pre, proj, 0, h, tid);
#pragma unroll 1
    for (int t0 = 0; t0 < SEQ; t0 += 32) {
        __syncthreads();
#pragma unroll
        for (int k = 0; k < 3; ++k) {
            const int i = tid + k * NTHREADS;
            if (i < 1280) {
                const int tt = i / 40, gq = i % 40; const int col = rw_col(gq, h);
                float* dst = gq < 8 ? xr + tt * 64 + gq * 8 : gq < 16 ? xk + tt * 64 + (gq - 8) * 8 : gq < 24 ? xv + tt * 64 + (gq - 16) * 8 : gq < 28 ? xw + tt * 32 + (gq - 24) * 8 : gq < 32 ? xa + tt * 32 + (gq - 28) * 8 : xg + tt * 64 + (gq - 32) * 8;
                const uint4 cu = pre.cu[k], pr = pre.pr[k];
                const float4 m0 = *(const float4*)(mu + col), m1 = *(const float4*)(mu + col + 4);
                float o[8];
                { float c, q;
                  c = __uint_as_float(cu.x << 16); q = __uint_as_float(pr.x << 16); o[0] = c + (q - c) * m0.x;
                  c = __uint_as_float(cu.x & 0xffff0000u); q = __uint_as_float(pr.x & 0xffff0000u); o[1] = c + (q - c) * m0.y;
                  c = __uint_as_float(cu.y << 16); q = __uint_as_float(pr.y << 16); o[2] = c + (q - c) * m0.z;
                  c = __uint_as_float(cu.y & 0xffff0000u); q = __uint_as_float(pr.y & 0xffff0000u); o[3] = c + (q - c) * m0.w;
                  c = __uint_as_float(cu.z << 16); q = __uint_as_float(pr.z << 16); o[4] = c + (q - c) * m1.x;
                  c = __uint_as_float(cu.z & 0xffff0000u); q = __uint_as_float(pr.z & 0xffff0000u); o[5] = c + (q - c) * m1.y;
                  c = __uint_as_float(cu.w << 16); q = __uint_as_float(pr.w << 16); o[6] = c + (q - c) * m1.z;
                  c = __uint_as_float(cu.w & 0xffff0000u); q = __uint_as_float(pr.w & 0xffff0000u); o[7] = c + (q - c) * m1.w; }
                if (gq >= 24 && gq < 28) {
#pragma unroll
                    for (int e = 0; e < 8; ++e) o[e] = ftanh(o[e]);
                } else if (gq >= 32) {
#pragma unroll
                    for (int e = 0; e < 8; ++e) o[e] = fsigmoid(o[e]);
                }
                *(float4*)dst = make_float4(o[0], o[1], o[2], o[3]); *(float4*)(dst + 4) = make_float4(o[4], o[5], o[6], o[7]);
            }
        }
        if (t0 + 32 < SEQ) rw_prefetch(pre, proj, t0 + 32, h, tid);
        __syncthreads();
        {
            float4 dec = v_w0, av = v_a0, gt = make_float4(0.f, 0.f, 0.f, 0.f);
#pragma unroll 4
            for (int m4 = 0; m4 < 8; ++m4) {
                const float4 xwv = *(const float4*)(xw + ptt * 32 + m4 * 4), xav = *(const float4*)(xa + ptt * 32 + m4 * 4);
                const float xs[4] = {xwv.x, xwv.y, xwv.z, xwv.w}, ys[4] = {xav.x, xav.y, xav.z, xav.w};
#pragma unroll
                for (int mm = 0; mm < 4; ++mm) {
                    const float4 wu = *(const float4*)(Wup + (m4 * 4 + mm) * 64 + pc), au = *(const float4*)(Aup + (m4 * 4 + mm) * 64 + pc);
                    dec.x += xs[mm] * wu.x; dec.y += xs[mm] * wu.y; dec.z += xs[mm] * wu.z; dec.w += xs[mm] * wu.w;
                    av.x += ys[mm] * au.x; av.y += ys[mm] * au.y; av.z += ys[mm] * au.z; av.w += ys[mm] * au.w;
                }
            }
#pragma unroll 4
            for (int m4 = 0; m4 < 16; ++m4) {
                const float4 xgv = *(const float4*)(xg + ptt * 64 + m4 * 4);
                const float xs[4] = {xgv.x, xgv.y, xgv.z, xgv.w};
#pragma unroll
                for (int mm = 0; mm < 4; ++mm) {
                    const float4 gu = *(const float4*)(Gup + (m4 * 4 + mm) * 64 + pc);
                    gt.x += xs[mm] * gu.x; gt.y += xs[mm] * gu.y; gt.z += xs[mm] * gu.z; gt.w += xs[mm] * gu.w;
                }
            }
            const int i = ptt * 64 + pc;
            const float4 kraw = *(const float4*)(xk + i), rv = *(const float4*)(xr + i);
            const float4 a = make_float4(fsigmoid(av.x), fsigmoid(av.y), fsigmoid(av.z), fsigmoid(av.w));
            const float4 kku = make_float4(kraw.x * v_kk.x, kraw.y * v_kk.y, kraw.z * v_kk.z, kraw.w * v_kk.w);
            const float4 kp = make_float4(kraw.x * (1.0f + (a.x - 1.0f) * v_ka.x), kraw.y * (1.0f + (a.y - 1.0f) * v_ka.y), kraw.z * (1.0f + (a.z - 1.0f) * v_ka.z), kraw.w * (1.0f + (a.w - 1.0f) * v_ka.w));
            const float n2 = red16((kku.x * kku.x + kku.y * kku.y) + (kku.z * kku.z + kku.w * kku.w));
            const float bo = red16((rv.x * kp.x * v_rk.x + rv.y * kp.y * v_rk.y) + (rv.z * kp.z * v_rk.z + rv.w * kp.w * v_rk.w));
            const float inv = 1.0f / fmaxf(sqrtf(n2), 1e-12f);
            const float4 kkn = make_float4(kku.x * inv, kku.y * inv, kku.z * inv, kku.w * inv);
            const float dk = -0.6065306597126334f * LOG2E;
            *(float4*)(lw + i) = make_float4(dk * fsigmoid(dec.x), dk * fsigmoid(dec.y), dk * fsigmoid(dec.z), dk * fsigmoid(dec.w));
            *(float4*)(gg + i) = gt;
            *(float4*)(kk + i) = kkn;
            *(float4*)(ab + i) = make_float4(kkn.x * a.x, kkn.y * a.y, kkn.z * a.z, kkn.w * a.w);
            *(float4*)(xk + i) = kp;
            if ((tid & 15) == 0) bon[ptt] = bo;
        }
        __syncthreads();
#pragma unroll 1
        for (int cb = 0; cb < 2; ++cb) {
            const int rb = cb * 16;
            {
                const int c3 = tid & 63, part = tid >> 6, ta = 2 * part;
                float cum = 0.f, cumA = 0.f, cumB = 0.f, lwA = 0.f, lwB = 0.f;
#pragma unroll
                for (int t = 0; t < 16; ++t) { const float lv = lw[(rb + t) * 64 + c3]; cum += lv; if (t == ta) { cumA = cum; lwA = lv; } if (t == ta + 1) { cumB = cum; lwB = lv; } }
                const int iA = (rb + ta) * 64 + c3, iB = iA + 64;
                const float GA = __builtin_amdgcn_exp2f(cumA), GiA = __builtin_amdgcn_exp2f(-cumA), GmA = __builtin_amdgcn_exp2f(cumA - lwA), GcA = __builtin_amdgcn_exp2f(cum - cumA);
                const float GB = __builtin_amdgcn_exp2f(cumB), GiB = __builtin_amdgcn_exp2f(-cumB), GmB = __builtin_amdgcn_exp2f(cumB - lwB), GcB = __builtin_amdgcn_exp2f(cum - cumB);
                const float kkA = kk[iA], kkB = kk[iB], bA = ab[iA], bB = ab[iB], kpA = xk[iA], kpB = xk[iB], rA = xr[iA], rB = xr[iB], vA = xv[iA], vB = xv[iB];
                KT[ta * RW_RS + c3] = f2bf(kkA * GmA); KT[(ta + 1) * RW_RS + c3] = f2bf(kkB * GmB);
                BT[ta * RW_RS + c3] = f2bf(bA * GiA); BT[(ta + 1) * RW_RS + c3] = f2bf(bB * GiB);
                KKb[ta * RW_RS + c3] = f2bf(kpA * GiA); KKb[(ta + 1) * RW_RS + c3] = f2bf(kpB * GiB);
                RT[ta * RW_RS + c3] = f2bf(rA * GA); RT[(ta + 1) * RW_RS + c3] = f2bf(rB * GB);
                ((unsigned*)BhT)[c3 * (RW_TS / 2) + part] = pk_bf16(bA * GcA, bB * GcB);
                ((unsigned*)KhT)[c3 * (RW_TS / 2) + part] = pk_bf16(kpA * GcA, kpB * GcB);
                ((unsigned*)VT)[c3 * (RW_TS / 2) + part] = pk_bf16(vA, vB);
                if (part == 0) GC[c3] = __builtin_amdgcn_exp2f(cum);
            }
            __syncthreads();
            if (wv < 4) {
                const f32x4 z4 = {0.f, 0.f, 0.f, 0.f};
                if (wv == 0) {
                    f32x4 cl = tt64(KT + n * RW_RS, BT + n * RW_RS, g, z4);
                    f32x4 clt = tt64(BT + n * RW_RS, KT + n * RW_RS, g, z4);
                    f32x4 U;
#pragma unroll
                    for (int r = 0; r < 4; ++r) { if (!(4 * g + r > n)) cl[r] = 0.f; if (!(n > 4 * g + r)) clt[r] = 0.f; U[r] = ((4 * g + r == n) ? 1.0f : 0.0f) - clt[r]; }
                    const f32x4 m2 = MF16(frag_lo(clt), frag_lo(cl), z4), m2t = MF16(frag_lo(cl), frag_lo(clt), z4);
                    U = MF16(frag_lo(m2), frag_lo(U), U);
                    const f32x4 m4 = MF16(frag_lo(m2t), frag_lo(m2), z4), m4t = MF16(frag_lo(m2), frag_lo(m2t), z4);
                    U = MF16(frag_lo(m4), frag_lo(U), U);
                    const f32x4 m8 = MF16(frag_lo(m4t), frag_lo(m4), z4);
                    U = MF16(frag_lo(m8), frag_lo(U), U);
                    uint2 w; w.x = pk_bf16(U[0], U[1]); w.y = pk_bf16(U[2], U[3]);
                    *(uint2*)(TA + n * RW_TS + 4 * g) = w;
                } else {
                    const bf16_t* ar = (wv == 2) ? BT : KKb; const bf16_t* br = (wv == 1) ? KT : RT; bf16_t* dst = (wv == 1) ? AakA : (wv == 2) ? ArbA : ArkA;
                    f32x4 c = tt64(ar + n * RW_RS, br + n * RW_RS, g, z4);
                    const int lim = (wv == 1) ? n : n + 1;
#pragma unroll
                    for (int r = 0; r < 4; ++r) if (!(4 * g + r < lim)) c[r] = 0.f;
                    uint2 w; w.x = pk_bf16(c[0], c[1]); w.y = pk_bf16(c[2], c[3]);
                    *(uint2*)(dst + n * RW_TS + 4 * g) = w;
                }
            }
            __syncthreads();
            {
                const bf16_t* Sold = cur ? Sb1 : Sb0; bf16_t* Snew = cur ? Sb0 : Sb1;
                const f32x4 z4 = {0.f, 0.f, 0.f, 0.f};
                const uint2 zz = make_uint2(0u, 0u);
                const bf16_t* srow = Sold + (ib * 16 + n) * RW_RS;
                f32x4 q = tt64(KT + n * RW_RS, srow, g, z4);
                const uint2 aak = *(const uint2*)(AakA + n * RW_TS + 4 * g), vt = *(const uint2*)(VT + (ib * 16 + n) * RW_TS + 4 * g);
                q = MF16(frag_u2(aak, zz), frag_u2(vt, zz), q);
                const uint2 ta = *(const uint2*)(TA + n * RW_TS + 4 * g);
                f32x4 sa = MF16(frag_u2(ta, zz), frag_lo(q), z4);
                sa = -sa;
                const bf16x8 a3 = frag_lo_hi(sa, vt);
                {
                    const int j0 = (2 * jh) * 16 + n, j1 = j0 + 16;
                    const uint2 bh0 = *(const uint2*)(BhT + j0 * RW_TS + 4 * g), kh0 = *(const uint2*)(KhT + j0 * RW_TS + 4 * g);
                    const uint2 bh1 = *(const uint2*)(BhT + j1 * RW_TS + 4 * g), kh1 = *(const uint2*)(KhT + j1 * RW_TS + 4 * g);
                    St0 = St0 * GC[j0]; St1 = St1 * GC[j1];
                    St0 = MF16(a3, frag_u2(bh0, kh0), St0);
                    St1 = MF16(a3, frag_u2(bh1, kh1), St1);
#pragma unroll
                    for (int r = 0; r < 4; ++r) { Snew[(ib * 16 + 4 * g + r) * RW_RS + j0] = f2bf(St0[r]); Snew[(ib * 16 + 4 * g + r) * RW_RS + j1] = f2bf(St1[r]); }
                }
                if (jh == 1) {
                    f32x4 y = tt64(RT + n * RW_RS, srow, g, z4);
                    const uint2 arb = *(const uint2*)(ArbA + n * RW_TS + 4 * g), ark = *(const uint2*)(ArkA + n * RW_TS + 4 * g);
                    y = MF16(frag_u2(arb, ark), a3, y);
#pragma unroll
                    for (int r = 0; r < 4; ++r) yy[(4 * g + r) * 64 + ib * 16 + n] = y[r];
                }
                cur ^= 1;
            }
            __syncthreads();
            if (tid < 256) {
                const int i = (rb + ptt) * 64 + pc;
                const float4 yv = *(const float4*)(yy + ptt * 64 + pc), vv = *(const float4*)(xv + i), gv = *(const float4*)(gg + i);
                const float mean = red16((yv.x + yv.y) + (yv.z + yv.w)) * (1.0f / 64.0f);
                const float4 d = make_float4(yv.x - mean, yv.y - mean, yv.z - mean, yv.w - mean);
                const float var = red16((d.x * d.x + d.y * d.y) + (d.z * d.z + d.w * d.w)) * (1.0f / 64.0f);
                const float rs = rsqrtf(var + 64e-5f), bo = bon[rb + ptt];
                uint2 w;
                w.x = pk_bf16((d.x * rs * v_lg.x + v_lb.x + bo * vv.x) * gv.x, (d.y * rs * v_lg.y + v_lb.y + bo * vv.y) * gv.y);
                w.y = pk_bf16((d.z * rs * v_lg.z + v_lb.z + bo * vv.z) * gv.z, (d.w * rs * v_lg.w + v_lb.w + bo * vv.w) * gv.w);
                *(uint2*)(mix + (size_t)(t0 + rb + ptt) * DM + pc) = w;
            }
        }
    }
}

__device__ __forceinline__ void phase_mixers(const Params& p, int l, unsigned char* lds) {
    unsigned* ctl = (unsigned*)(p.ws + WS_CTL);
    int* slot = (int*)(lds + LDS_BYTES - 64);
#ifndef NO_RW
    for (int it = obid(); it < 128; it += gridDim.x) rwkv_item(p, l, it, lds);
#endif
    for (;;) {
        __syncthreads();
        if (otid() == 0) *slot = (int)atomicAdd(&ctl[CW_QUEUE + l * 64], 1u);
        __syncthreads();
        const int it = *slot;
        if (it >= 1024 + 1024 + 256) break;
        if (it < 1024) {
#ifndef NO_DA
            dam_item(p, l, it & 127, 7 - (it >> 7), lds);
#endif
        } else if (it < 2048) {
#ifndef NO_SB
            const int j = it - 1024; sbm_item(p, j & 127, 7 - (j >> 7), lds);
#endif
        } else conv_item(p, l, it - 2048);
    }
}

__global__ void __launch_bounds__(NTHREADS, 2) fwd(Params p) {
    extern __shared__ __attribute__((aligned(16))) unsigned char lds_raw[];
    if (threadIdx.x == 0) { ((unsigned*)lds_raw)[0] = 0u; ((unsigned*)lds_raw)[1] = 0u; ((unsigned*)lds_raw)[2] = 0u; ((unsigned*)lds_raw)[3] = 0u; }
    __syncthreads();
    unsigned char* lds = lds_raw + 16;
    XcdBarrier bar = xcd_barrier_post((unsigned*)(p.ws + WS_CTL) + CW_BAR, (volatile LAS unsigned*)lds_raw);
#ifndef ONLY
#define ONLY -1
#endif
#define PH(k) (ONLY < 0 || ONLY == (k))
    if (PH(0)) prologue(p, lds);
    xcd_barrier(bar);
    for (int l = 0; l < NLAYER; ++l) {
        if (PH(1)) phase_inproj(p, l, lds);
        xcd_barrier(bar);
        if (PH(2)) phase_mixers(p, l, lds);
        xcd_barrier(bar);
        if (PH(3)) phase_outproj(p, l, lds);
        xcd_barrier(bar);
        if (PH(4)) phase_ln1_route(p, l, lds);
        xcd_barrier(bar);
        if (PH(5)) phase_moe_up(p, l, lds);
        xcd_barrier(bar);
        if (PH(6)) phase_moe_down(p, l, lds);
        xcd_barrier(bar);
        if (PH(7)) phase_ln2(p, l, lds);
        xcd_barrier(bar);
    }
}

extern "C" void kernel_launch(void* const* d_in, const int* in_sizes, int n_in, void* d_out, int out_size, void* d_ws, size_t ws_size, hipStream_t stream) {
    static int grid = 0;
    if (grid == 0) {
        if (n_in != 18 || in_sizes[0] != NTOK * DM || out_size != NTOK * DM || ws_size < WS_END) {
            fprintf(stderr, "kernel_launch: unexpected shapes: n_in %d in0 %d out %d ws %zu (need %llu)\n", n_in, n_in > 0 ? in_sizes[0] : -1, out_size, ws_size, (unsigned long long)WS_END);
            grid = -1; return;
        }
        int dev = 0, cus = 0, per_cu = 0;
        hipGetDevice(&dev);
        hipDeviceGetAttribute(&cus, hipDeviceAttributeMultiprocessorCount, dev);
        hipFuncSetAttribute((const void*)fwd, hipFuncAttributeMaxDynamicSharedMemorySize, LDS_BYTES);
        hipOccupancyMaxActiveBlocksPerMultiprocessor(&per_cu, (const void*)fwd, NTHREADS, LDS_BYTES);
        if (per_cu < 1) { fprintf(stderr, "kernel_launch: occupancy query says %d blocks per CU\n", per_cu); grid = -1; return; }
        grid = cus;
    }
    if (grid < 0) return;
    Params p{};
    p.x = (const float*)d_in[0]; p.w_in = (const float*)d_in[1]; p.w_out = (const float*)d_in[2]; p.da_lambda = (const float*)d_in[3]; p.da_subln = (const float*)d_in[4];
    p.sc_conv = (const float*)d_in[5]; p.rw_mu = (const float*)d_in[6]; p.rw_vecs = (const float*)d_in[7]; p.rw_w_up = (const float*)d_in[8]; p.rw_a_up = (const float*)d_in[9];
    p.rw_g_up = (const float*)d_in[10]; p.ln_gain = (const float*)d_in[11]; p.ln_bias = (const float*)d_in[12]; p.rel_bias = (const float*)d_in[13]; p.router_w = (const float*)d_in[14];
    p.router_b = (const float*)d_in[15]; p.moe_w_in = (const float*)d_in[16]; p.moe_w_down = (const float*)d_in[17];
    p.out = (float*)d_out; p.ws = (unsigned char*)d_ws;
    hipMemsetAsync((char*)d_ws + WS_CTL, 0, CTL_BYTES, stream);
    hipLaunchKernelGGL(fwd, dim3(grid), dim3(NTHREADS), LDS_BYTES, stream, p);
}
```

```cpp
#include <hip/hip_runtime.h>
#include <cstdio>
#include <cstdint>

typedef unsigned short bf16_t;
typedef short bf16x8 __attribute__((ext_vector_type(8)));
typedef float f32x4 __attribute__((ext_vector_type(4)));

#define NTOK 65536
#define SEQ 2048
#define DM 1024
#define PIN 3200
#define PINP 3328
#define NLAYER 4
#define NEXP 16
#define DEXP 256
#define NTHREADS 512
#define LDS_BYTES (152 * 1024)
#define ALPHA 1.6817928305074292f
#define LOG2E 1.4426950408889634f

#define WS_CTL 0ull
#define CTL_BYTES 65536ull
#define WS_BIASD (WS_CTL + CTL_BYTES)
#define WS_WIN (WS_BIASD + 4ull * 2048 * 4)
#define WS_WOUT (WS_WIN + 4ull * PINP * DM * 2)
#define WS_MWIN (WS_WOUT + 4ull * DM * DM * 2)
#define WS_MWDN (WS_MWIN + 4ull * 16 * 512 * 1024 * 2)
#define WS_XB (WS_MWDN + 4ull * 16 * 1024 * 256 * 2)
#define WS_MIX (WS_XB + (unsigned long long)NTOK * DM * 2)
#define WS_LTOK (WS_MIX + (unsigned long long)NTOK * DM * 2)
#define WS_LGATE (WS_LTOK + 16ull * NTOK * 4)
#define WS_PROJ (WS_LGATE + 16ull * NTOK * 4)
#define WS_YB WS_PROJ
#define WS_Y WS_PROJ
#define WS_H (WS_Y + (unsigned long long)(2 * NTOK + 256) * DM * 2)
#define WS_END (WS_PROJ + (unsigned long long)NTOK * PINP * 2)

#define CW_BAR 0
#define CW_CNT 4096
#define CW_QUEUE 8192

#define XB_TMO      128
#define XB_XCNT(j)  (256  + 64 * (j))
#define XB_XSUB(j)  (1280 + 64 * (j))
#define XB_XGEN(j)  (2304 + 64 * (j))
#define XB_TOP      3328
#define XB_TOPGEN   3392
#define XCD_BAR_WORDS 3456
#define XB_SPIN_CAP (1u << 22)
#define LAS __attribute__((address_space(3)))

__device__ __forceinline__ unsigned xb_ld(unsigned* p)              { return __hip_atomic_load(p, __ATOMIC_RELAXED, __HIP_MEMORY_SCOPE_AGENT); }
__device__ __forceinline__ unsigned xb_add(unsigned* p, unsigned v) { return __hip_atomic_fetch_add(p, v, __ATOMIC_RELAXED, __HIP_MEMORY_SCOPE_AGENT); }
__device__ __forceinline__ unsigned xb_xcc_id() { return (unsigned)__builtin_amdgcn_s_getreg((3 << 11) | 20) & 0xFu; }
#define XB_SPIN(cond, bar) do { unsigned _sp = 0; while (cond) { __builtin_amdgcn_s_sleep(1); \
    if ((++_sp & 255u) == 0u) { if (xb_ld(&(bar)[XB_TMO])) break; if (_sp > XB_SPIN_CAP) { atomicAdd(&(bar)[XB_TMO], 1u); break; } } } } while (0)

struct XcdBarrier { unsigned* bar; unsigned x; volatile LAS unsigned* st; };

__device__ __forceinline__ XcdBarrier xcd_barrier_post(unsigned* bar, volatile LAS unsigned* st) {
    XcdBarrier b; b.bar = bar; b.x = xb_xcc_id(); b.st = st;
    if (threadIdx.x == 0) (void)xb_add(&bar[XB_XCNT(b.x)], 1u);
    return b;
}
__device__ __forceinline__ void xcd_barrier_complete(unsigned* bar, unsigned x, unsigned& nloc, unsigned& nx) {
    const unsigned G = gridDim.x * gridDim.y * gridDim.z;
    unsigned sum, cnt, mine, sp = 0u;
    for (;;) {
        sum = 0u; cnt = 0u; mine = 0u;
#pragma unroll
        for (unsigned j = 0; j < 16; ++j) { const unsigned c = xb_ld(&bar[XB_XCNT(j)]); sum += c; cnt += (c > 0u) ? 1u : 0u; mine = (j == x) ? c : mine; }
        if (sum == G) break;
        __builtin_amdgcn_s_sleep(1);
        if ((++sp & 255u) == 0u) { if (xb_ld(&bar[XB_TMO])) break; if (sp > XB_SPIN_CAP) { atomicAdd(&bar[XB_TMO], 1u); break; } }
    }
    nloc = mine > 0u ? mine : 1u; nx = cnt > 0u ? cnt : 1u;
}
__device__ __forceinline__ void xcd_barrier(const XcdBarrier& b) {
    asm volatile("s_waitcnt vmcnt(0)" ::: "memory");
    __syncthreads();
    if (threadIdx.x == 0) {
        unsigned* bar = b.bar;
        __builtin_amdgcn_s_waitcnt(0);
        const unsigned bx = xb_xcc_id();
        unsigned nloc = b.st[0], nx = b.st[1];
        if (nloc == 0u) { xcd_barrier_complete(bar, bx, nloc, nx); b.st[0] = nloc; b.st[1] = nx; }
        const unsigned old = xb_add(&bar[XB_XSUB(bx)], 1u);
        const unsigned gen = old / nloc;
        if (old + 1u == (gen + 1u) * nloc) {
            __builtin_amdgcn_fence(__ATOMIC_RELEASE, "agent");
            asm volatile("s_waitcnt vmcnt(0)" ::: "memory");
            const unsigned og = xb_add(&bar[XB_TOP], 1u);
            const unsigned tg = og / nx;
            if (og + 1u == (tg + 1u) * nx) xb_add(&bar[XB_TOPGEN], 1u);
            else XB_SPIN(xb_ld(&bar[XB_TOPGEN]) == tg, bar);
            __builtin_amdgcn_fence(__ATOMIC_ACQUIRE, "agent");
            xb_add(&bar[XB_XGEN(bx)], 1u);
            asm volatile("s_waitcnt vmcnt(0)" ::: "memory");
        } else {
            XB_SPIN(xb_ld(&bar[XB_XGEN(bx)]) == gen, bar);
            __builtin_amdgcn_fence(__ATOMIC_ACQUIRE, "agent");
            asm volatile("s_waitcnt vmcnt(0)" ::: "memory");
        }
    }
    __syncthreads();
}

__device__ __forceinline__ int otid() { int t = threadIdx.x; asm volatile("" : "+v"(t)); return t; }
__device__ __forceinline__ int obid() { int t = blockIdx.x; asm volatile("" : "+s"(t)); return t; }
__device__ __forceinline__ float bf2f(bf16_t v) { return __uint_as_float(((unsigned)v) << 16); }
__device__ __forceinline__ bf16_t f2bf(float f) { unsigned u = __float_as_uint(f); u += 0x7fffu + ((u >> 16) & 1u); return (bf16_t)(u >> 16); }
__device__ __forceinline__ float sigmoidf_(float x) { return 1.0f / (1.0f + expf(-x)); }
__device__ __forceinline__ float wave_sum(float v) {
#pragma unroll
    for (int o = 32; o >= 1; o >>= 1) v += __shfl_xor(v, o);
    return v;
}

struct Params {
    const float* x; const float* w_in; const float* w_out; const float* da_lambda; const float* da_subln; const float* sc_conv;
    const float* rw_mu; const float* rw_vecs; const float* rw_w_up; const float* rw_a_up; const float* rw_g_up;
    const float* ln_gain; const float* ln_bias; const float* rel_bias; const float* router_w; const float* router_b;
    const float* moe_w_in; const float* moe_w_down;
    float* out; unsigned char* ws;
};

namespace pg8 {
#define PG8_LAS __attribute__((address_space(3)))
typedef unsigned short bf16_t;
typedef short bf16x8 __attribute__((ext_vector_type(8)));
typedef float f32x4 __attribute__((ext_vector_type(4)));
typedef unsigned u32x4 __attribute__((ext_vector_type(4)));
constexpr int BM = 256, BK = 64, HALF = 128, HTB = HALF * BK * 2  , STAGE_BYTES = 8 * HTB, NXCD = 8, WGM = 8;

__host__ __device__ __forceinline__ int lds_byte(int r, int c) { const int st = (r >> 4) * 2 + (c >> 5), rr = r & 15, cc = c & 31, ob = rr * 64 + cc * 2; return st * 1024 + (ob ^ (((ob >> 9) & 1) << 5)); }
__host__ __device__ __forceinline__ void stage_rc(int b, int& R, int& C) { const int st = b / 1024, sb = b % 1024, swz = sb ^ (((sb >> 9) & 1) << 5); R = (st >> 1) * 16 + swz / 64; C = (st & 1) * 32 + (swz % 64) / 2; }
__host__ __device__ __forceinline__ int perm32(int rho) { const int n = rho >> 4, i = rho & 15; return 8 * (i >> 2) + 4 * n + (i & 3); }

struct Unit { int pm, pn; };
struct Gemm { const bf16_t* A; const bf16_t* Bt; int M, N, K; };

struct StaticOrder {
    int nM, nN, nwg, G, c;
    __host__ __device__ void init(int M, int N, int G_, int c_) { nM = M / BM; nN = N / BM; nwg = nM * nN; G = G_; c = c_; }
    __host__ __device__ bool next(int i, Unit& u) const {
        const long L = (long)i * G + c; if (L >= nwg) return false;
        int wgid = (int)L; { const int q = nwg / NXCD, r = nwg % NXCD, xcd = wgid % NXCD, off = wgid / NXCD; wgid = (xcd < r ? xcd * (q + 1) : r * (q + 1) + (xcd - r) * q) + off; }
        const int nig = WGM * nN, gid = wgid / nig, fm = gid * WGM, gsz = (nM - fm) < WGM ? (nM - fm) : WGM;
        u.pm = fm + ((wgid % nig) % gsz); u.pn = (wgid % nig) / gsz; return true;
    }
    __device__ __forceinline__ void a_ready(const Unit&) const {}
    __device__ __forceinline__ void done(const Unit&) const {}
};
__device__ __forceinline__ unsigned cvt_pk_bf16(float lo, float hi) { unsigned r; asm volatile("v_cvt_pk_bf16_f32 %0, %1, %2" : "=v"(r) : "v"(lo), "v"(hi)); return r; }
template <class Epi, class Sched, bool ALIGN_EPI = false, bool SP2 = false>
__device__ __forceinline__ void gemm_phase(PG8_LAS unsigned char* lds, const Gemm g, const Sched& S, const Epi& E) {
    const int tid = otid(), wid = __builtin_amdgcn_readfirstlane(tid >> 6), lane = tid & 63, wr = wid >> 2, wc = wid & 3, fr = lane & 15, fq = lane >> 4;
    const int K = g.K, nt = K / BK;
    unsigned voffA[2], voffB[2];
#pragma unroll
    for (int i = 0; i < 2; ++i) { int R, C; stage_rc(tid * 16 + i * 8192, R, C); const int Rb = Epi::PERM ? ((R & ~31) + perm32(R & 31)) : R;
        voffA[i] = (unsigned)(R * K + C) * 2u; voffB[i] = (unsigned)(Rb * K + C) * 2u; }
    const size_t kstep = (size_t)(BK * 2);
    const size_t hstep = (size_t)HALF * K * 2;
    const size_t tstep = 2 * hstep;
    const unsigned ldsw = (unsigned)wid * 1024u;
    const int aoff = lds_byte(wr * 64 + fr, fq * 8), boff = lds_byte(wc * 32 + fr, fq * 8);
#define PG8_SA(b, h) (((b) * 2 + (h)) * HTB)
#define PG8_SB(b, h) ((4 + (b) * 2 + (h)) * HTB)
#define PG8_STAGE(bufoff, gbase, voff) do { _Pragma("unroll") for (int _i = 0; _i < 2; ++_i) \
        __builtin_amdgcn_global_load_lds((const unsigned*)((const char*)(gbase) + (voff)[_i]), (PG8_LAS unsigned*)(lds + (bufoff) + ldsw + _i * 8192), 16, 0, 0); } while (0)
#define PG8_LDA(dst, b, h) do { _Pragma("unroll") for (int m = 0; m < 4; ++m) _Pragma("unroll") for (int k = 0; k < 2; ++k) dst[m][k] = *(const PG8_LAS bf16x8*)(lds + PG8_SA(b, h) + aoff + m * 2048 + k * 1024); } while (0)
#define PG8_LDB(dst, b, h) do { _Pragma("unroll") for (int n = 0; n < 2; ++n) _Pragma("unroll") for (int k = 0; k < 2; ++k) dst[n][k] = *(const PG8_LAS bf16x8*)(lds + PG8_SB(b, h) + boff + n * 2048 + k * 1024); } while (0)
#define PG8_MMA(ai, bj, At, Bt) do { __builtin_amdgcn_s_setprio(1); _Pragma("unroll") for (int m = 0; m < 4; ++m) _Pragma("unroll") for (int n = 0; n < 2; ++n) _Pragma("unroll") for (int k = 0; k < 2; ++k) \
        acc[ai][bj][m][n] = __builtin_amdgcn_mfma_f32_16x16x32_bf16(Bt[n][k], At[m][k], acc[ai][bj][m][n], 0, 0, 0); __builtin_amdgcn_s_setprio(0); } while (0)
#define PG8_WAIT_V(n) asm volatile("s_waitcnt vmcnt(" #n ")" ::: "memory")
#define PG8_WAIT_L(n) asm volatile("s_waitcnt lgkmcnt(" #n ")" ::: "memory")
#define PG8_BAR __builtin_amdgcn_s_barrier()
#define PG8_SCHED __builtin_amdgcn_sched_barrier(0)
    Unit cur, nxt; int ui = 0;
    if (!S.next(0, cur)) return;
    f32x4 acc[2][2][4][2];
#pragma unroll
    for (int a = 0; a < 2; ++a)
#pragma unroll
        for (int b = 0; b < 2; ++b)
#pragma unroll
            for (int m = 0; m < 4; ++m)
#pragma unroll
                for (int n = 0; n < 2; ++n) acc[a][b][m][n] = (f32x4){0.f, 0.f, 0.f, 0.f};
    bf16x8 At[4][2], B0[2][2], B1[2][2];
    const char* cA = (const char*)g.A + (size_t)cur.pm * tstep; const char* cB = (const char*)g.Bt + (size_t)cur.pn * tstep;
    S.a_ready(cur);
    if constexpr (SP2) {
        PG8_STAGE(PG8_SB(0, 0), cB, voffB); PG8_STAGE(PG8_SB(0, 1), cB + hstep, voffB); PG8_STAGE(PG8_SA(0, 0), cA, voffA); PG8_STAGE(PG8_SA(0, 1), cA + hstep, voffA);
        if (wr == 1) PG8_BAR;
        PG8_WAIT_V(2); PG8_BAR;
        PG8_STAGE(PG8_SB(1, 0), cB + kstep, voffB); PG8_STAGE(PG8_SA(1, 0), cA + kstep, voffA); PG8_STAGE(PG8_SB(1, 1), cB + hstep + kstep, voffB);
        PG8_WAIT_V(6); PG8_BAR;
    } else {
        PG8_STAGE(PG8_SB(0, 0), cB, voffB); PG8_STAGE(PG8_SA(0, 0), cA, voffA); PG8_STAGE(PG8_SB(0, 1), cB + hstep, voffB); PG8_STAGE(PG8_SA(0, 1), cA + hstep, voffA);
        if (wr == 1) PG8_BAR;
        PG8_WAIT_V(4); PG8_BAR;
        PG8_STAGE(PG8_SB(1, 0), cB + kstep, voffB); PG8_STAGE(PG8_SA(1, 0), cA + kstep, voffA); PG8_STAGE(PG8_SB(1, 1), cB + hstep + kstep, voffB);
        PG8_WAIT_V(6); PG8_BAR;
    }
    for (;;) {
        const bool has_next = S.next(ui + 1, nxt);
        const char* nA = has_next ? (const char*)g.A + (size_t)nxt.pm * tstep : cA; const char* nB = has_next ? (const char*)g.Bt + (size_t)nxt.pn * tstep : cB;
        for (int t = 0; t < nt; t += 2) {
            const bool last = (t == nt - 2);
            const char* a1 = cA + (size_t)(t + 1) * kstep;
            const char* a2 = last ? nA : cA + (size_t)(t + 2) * kstep; const char* b2 = last ? nB : cB + (size_t)(t + 2) * kstep;
            const char* a3 = a2 + kstep; const char* b3 = b2 + kstep;
            if (last && has_next) S.a_ready(nxt);
            if constexpr (SP2) {
            PG8_LDB(B0, 0, 0); PG8_LDB(B1, 0, 1); PG8_SCHED; PG8_LDA(At, 0, 0); PG8_STAGE(PG8_SA(1, 1), a1 + hstep, voffA);
            PG8_WAIT_V(8); PG8_WAIT_L(0); PG8_BAR; PG8_MMA(0, 0, At, B0); PG8_MMA(0, 1, At, B1); PG8_BAR; PG8_SCHED;
            PG8_LDA(At, 0, 1); PG8_STAGE(PG8_SB(0, 0), b2, voffB); PG8_STAGE(PG8_SB(0, 1), b2 + hstep, voffB); PG8_STAGE(PG8_SA(0, 0), a2, voffA);
            PG8_WAIT_V(8); PG8_WAIT_L(0); PG8_BAR; PG8_MMA(1, 0, At, B0); PG8_MMA(1, 1, At, B1); PG8_BAR; PG8_SCHED;
            PG8_LDB(B0, 1, 0); PG8_LDB(B1, 1, 1); PG8_SCHED; PG8_LDA(At, 1, 0); PG8_STAGE(PG8_SA(0, 1), a2 + hstep, voffA);
            PG8_WAIT_V(8); PG8_WAIT_L(0); PG8_BAR; PG8_MMA(0, 0, At, B0); PG8_MMA(0, 1, At, B1); PG8_BAR; PG8_SCHED;
            PG8_LDA(At, 1, 1); PG8_STAGE(PG8_SB(1, 0), b3, voffB); PG8_STAGE(PG8_SB(1, 1), b3 + hstep, voffB); PG8_STAGE(PG8_SA(1, 0), a3, voffA);
            PG8_WAIT_V(8); PG8_WAIT_L(0); PG8_BAR; PG8_MMA(1, 0, At, B0); PG8_MMA(1, 1, At, B1); PG8_BAR; PG8_SCHED;
            } else {
            PG8_LDB(B0, 0, 0); PG8_SCHED; PG8_LDA(At, 0, 0); PG8_STAGE(PG8_SA(1, 1), a1 + hstep, voffA);
            PG8_WAIT_L(8); PG8_BAR; PG8_WAIT_L(0); PG8_MMA(0, 0, At, B0); PG8_BAR; PG8_SCHED;
            PG8_LDB(B1, 0, 1); PG8_STAGE(PG8_SB(0, 0), b2, voffB);
            PG8_BAR; PG8_WAIT_L(0); PG8_MMA(0, 1, At, B1); PG8_BAR;
            PG8_LDA(At, 0, 1); PG8_STAGE(PG8_SA(0, 0), a2, voffA);
            PG8_BAR; PG8_WAIT_L(0); PG8_MMA(1, 0, At, B0); PG8_BAR; PG8_SCHED;
            PG8_STAGE(PG8_SB(0, 1), b2 + hstep, voffB);
            PG8_WAIT_V(6); PG8_BAR; PG8_MMA(1, 1, At, B1); PG8_BAR;
            PG8_LDB(B0, 1, 0); PG8_SCHED; PG8_LDA(At, 1, 0); PG8_STAGE(PG8_SA(0, 1), a2 + hstep, voffA);
            PG8_WAIT_L(8); PG8_BAR; PG8_WAIT_L(0); PG8_MMA(0, 0, At, B0); PG8_BAR; PG8_SCHED;
            PG8_LDB(B1, 1, 1); PG8_STAGE(PG8_SB(1, 0), b3, voffB);
            PG8_BAR; PG8_WAIT_L(0); PG8_MMA(0, 1, At, B1); PG8_BAR;
            PG8_LDA(At, 1, 1); PG8_STAGE(PG8_SA(1, 0), a3, voffA);
            PG8_BAR; PG8_WAIT_L(0); PG8_MMA(1, 0, At, B0); PG8_BAR; PG8_SCHED;
            PG8_STAGE(PG8_SB(1, 1), b3 + hstep, voffB);
            PG8_WAIT_V(6); PG8_BAR; PG8_MMA(1, 1, At, B1); PG8_BAR;
            }
        }
        if constexpr (ALIGN_EPI) { if (wr == 0) PG8_BAR; }
        if constexpr (!Epi::AFTER_DRAIN) { E(acc, cur, wr, wc, fr, fq); S.done(cur); }
        if (!has_next) break;
#pragma unroll
        for (int a = 0; a < 2; ++a)
#pragma unroll
            for (int b = 0; b < 2; ++b)
#pragma unroll
                for (int m = 0; m < 4; ++m)
#pragma unroll
                    for (int n = 0; n < 2; ++n) acc[a][b][m][n] = (f32x4){0.f, 0.f, 0.f, 0.f};
        cur = nxt; cA = nA; cB = nB; ++ui;
        if constexpr (ALIGN_EPI) { if (wr == 1) PG8_BAR; }
    }
    PG8_WAIT_V(0);
    if constexpr (!ALIGN_EPI) { if (wr == 0) PG8_BAR; }
    PG8_BAR;
    if constexpr (Epi::AFTER_DRAIN) { E.fused(acc, cur, wr, wc, fr, fq, lds, wid, lane); S.done(cur); }
#undef PG8_SA
#undef PG8_SB
#undef PG8_STAGE
#undef PG8_LDA
#undef PG8_LDB
#undef PG8_MMA
#undef PG8_WAIT_V
#undef PG8_WAIT_L
#undef PG8_BAR
#undef PG8_SCHED
}
}

namespace pg8 {
template <class Epi, class Sched, bool GATHER>
__device__ __forceinline__ void gemm_phase_g(PG8_LAS unsigned char* lds, const int K, const Sched& S, const Epi& E) {
    typedef typename Sched::Unit UnitT;
    const int tid = otid(), wid = __builtin_amdgcn_readfirstlane(tid >> 6), lane = tid & 63, wr = wid >> 2, wc = wid & 3, fr = lane & 15, fq = lane >> 4;
    const int nt = K / BK;
    unsigned voffB[2];
#pragma unroll
    for (int i = 0; i < 2; ++i) { int R, C; stage_rc(tid * 16 + i * 8192, R, C); const int Rb = Epi::PERM ? ((R & ~31) + perm32(R & 31)) : R; voffB[i] = (unsigned)(Rb * K + C) * 2u; }
#define PG8_AOFF(unit, o0, o1) do { const int _tz = otid(); _Pragma("unroll") for (int _i = 0; _i < 2; ++_i) { int _R, _C; stage_rc(_tz * 16 + _i * 8192, _R, _C); \
        o0[_i] = S.arow_off(unit, _R) + (unsigned)_C * 2u; o1[_i] = S.arow_off(unit, HALF + _R) + (unsigned)_C * 2u; } } while (0)
    const size_t kstep = (size_t)(BK * 2);
    const size_t hstep = (size_t)HALF * K * 2;
    const unsigned ldsw = (unsigned)wid * 1024u;
    const int aoff = lds_byte(wr * 64 + fr, fq * 8), boff = lds_byte(wc * 32 + fr, fq * 8);
#define PG8_SA(b, h) (((b) * 2 + (h)) * HTB)
#define PG8_SB(b, h) ((4 + (b) * 2 + (h)) * HTB)
#define PG8_STAGE(bufoff, gbase, voff) do { _Pragma("unroll") for (int _i = 0; _i < 2; ++_i) \
        __builtin_amdgcn_global_load_lds((const unsigned*)((const char*)(gbase) + (voff)[_i]), (PG8_LAS unsigned*)(lds + (bufoff) + ldsw + _i * 8192), 16, 0, 0); } while (0)
#define PG8_LDA(dst, b, h) do { _Pragma("unroll") for (int m = 0; m < 4; ++m) _Pragma("unroll") for (int k = 0; k < 2; ++k) dst[m][k] = *(const PG8_LAS bf16x8*)(lds + PG8_SA(b, h) + aoff + m * 2048 + k * 1024); } while (0)
#define PG8_LDB(dst, b, h) do { _Pragma("unroll") for (int n = 0; n < 2; ++n) _Pragma("unroll") for (int k = 0; k < 2; ++k) dst[n][k] = *(const PG8_LAS bf16x8*)(lds + PG8_SB(b, h) + boff + n * 2048 + k * 1024); } while (0)
#define PG8_MMA(ai, bj, At, Bt) do { __builtin_amdgcn_s_setprio(1); _Pragma("unroll") for (int m = 0; m < 4; ++m) _Pragma("unroll") for (int n = 0; n < 2; ++n) _Pragma("unroll") for (int k = 0; k < 2; ++k) \
        acc[ai][bj][m][n] = __builtin_amdgcn_mfma_f32_16x16x32_bf16(Bt[n][k], At[m][k], acc[ai][bj][m][n], 0, 0, 0); __builtin_amdgcn_s_setprio(0); } while (0)
#define PG8_WAIT_V(n) asm volatile("s_waitcnt vmcnt(" #n ")" ::: "memory")
#define PG8_WAIT_L(n) asm volatile("s_waitcnt lgkmcnt(" #n ")" ::: "memory")
#define PG8_BAR __builtin_amdgcn_s_barrier()
#define PG8_SCHED __builtin_amdgcn_sched_barrier(0)
    UnitT cur, nxt; int ui = 0;
    if (!S.next(0, cur)) return;
    f32x4 acc[2][2][4][2];
#pragma unroll
    for (int a = 0; a < 2; ++a)
#pragma unroll
        for (int b = 0; b < 2; ++b)
#pragma unroll
            for (int m = 0; m < 4; ++m)
#pragma unroll
                for (int n = 0; n < 2; ++n) acc[a][b][m][n] = (f32x4){0.f, 0.f, 0.f, 0.f};
    bf16x8 At[4][2], B0[2][2], B1[2][2];
    unsigned cvo0[2], cvo1[2];
    PG8_AOFF(cur, cvo0, cvo1);
    const char* cA = S.abase(cur); const char* cB = S.bbase(cur);
    PG8_STAGE(PG8_SB(0, 0), cB, voffB); PG8_STAGE(PG8_SB(0, 1), cB + hstep, voffB); PG8_STAGE(PG8_SA(0, 0), cA, cvo0); PG8_STAGE(PG8_SA(0, 1), cA, cvo1);
    if (wr == 1) PG8_BAR;
    PG8_WAIT_V(2); PG8_BAR;
    PG8_STAGE(PG8_SB(1, 0), cB + kstep, voffB); PG8_STAGE(PG8_SA(1, 0), cA + kstep, cvo0); PG8_STAGE(PG8_SB(1, 1), cB + hstep + kstep, voffB);
    PG8_WAIT_V(6); PG8_BAR;
#pragma unroll 1
    for (;;) {
        const bool has_next = S.next(ui + 1, nxt);
        const char* nA = has_next ? S.abase(nxt) : cA; const char* nB = has_next ? S.bbase(nxt) : cB;
        unsigned nvo0[2], nvo1[2];
#pragma unroll 1
        for (int t = 0; t < nt; t += 2) {
            const bool last = (t == nt - 2);
            const char* a1 = cA + (size_t)(t + 1) * kstep;
            const char* a2 = last ? nA : cA + (size_t)(t + 2) * kstep; const char* b2 = last ? nB : cB + (size_t)(t + 2) * kstep;
            const char* a3 = a2 + kstep; const char* b3 = b2 + kstep;
            unsigned v20[2], v21[2];
            if constexpr (GATHER) {
                if (last && has_next) { PG8_AOFF(nxt, nvo0, nvo1); }
                else {
#pragma unroll
                    for (int i = 0; i < 2; ++i) { nvo0[i] = cvo0[i]; nvo1[i] = cvo1[i]; } }
#pragma unroll
                for (int i = 0; i < 2; ++i) { v20[i] = nvo0[i]; v21[i] = nvo1[i]; }
            } else {
#pragma unroll
                for (int i = 0; i < 2; ++i) { v20[i] = cvo0[i]; v21[i] = cvo1[i]; nvo0[i] = cvo0[i]; nvo1[i] = cvo1[i]; }
            }
            PG8_LDB(B0, 0, 0); PG8_LDB(B1, 0, 1); PG8_SCHED; PG8_LDA(At, 0, 0); PG8_STAGE(PG8_SA(1, 1), a1, cvo1);
            PG8_WAIT_V(8); PG8_WAIT_L(0); PG8_BAR; PG8_MMA(0, 0, At, B0); PG8_MMA(0, 1, At, B1); PG8_BAR; PG8_SCHED;
            PG8_LDA(At, 0, 1); PG8_STAGE(PG8_SB(0, 0), b2, voffB); PG8_STAGE(PG8_SB(0, 1), b2 + hstep, voffB); PG8_STAGE(PG8_SA(0, 0), a2, v20);
            PG8_WAIT_V(8); PG8_WAIT_L(0); PG8_BAR; PG8_MMA(1, 0, At, B0); PG8_MMA(1, 1, At, B1); PG8_BAR; PG8_SCHED;
            PG8_LDB(B0, 1, 0); PG8_LDB(B1, 1, 1); PG8_SCHED; PG8_LDA(At, 1, 0); PG8_STAGE(PG8_SA(0, 1), a2, v21);
            PG8_WAIT_V(8); PG8_WAIT_L(0); PG8_BAR; PG8_MMA(0, 0, At, B0); PG8_MMA(0, 1, At, B1); PG8_BAR; PG8_SCHED;
            PG8_LDA(At, 1, 1); PG8_STAGE(PG8_SB(1, 0), b3, voffB); PG8_STAGE(PG8_SB(1, 1), b3 + hstep, voffB); PG8_STAGE(PG8_SA(1, 0), a3, v20);
            PG8_WAIT_V(8); PG8_WAIT_L(0); PG8_BAR; PG8_MMA(1, 0, At, B0); PG8_MMA(1, 1, At, B1); PG8_BAR; PG8_SCHED;
        }
        if (wr == 0) PG8_BAR;
        E(acc, cur, wr, wc, fr, fq);
        if (!has_next) break;
#pragma unroll
        for (int a = 0; a < 2; ++a)
#pragma unroll
            for (int b = 0; b < 2; ++b)
#pragma unroll
                for (int m = 0; m < 4; ++m)
#pragma unroll
                    for (int n = 0; n < 2; ++n) acc[a][b][m][n] = (f32x4){0.f, 0.f, 0.f, 0.f};
        cur = nxt; cA = nA; cB = nB; ++ui;
#pragma unroll
        for (int i = 0; i < 2; ++i) { cvo0[i] = nvo0[i]; cvo1[i] = nvo1[i]; }
        if (wr == 1) PG8_BAR;
    }
    PG8_WAIT_V(0);
    PG8_BAR;
#undef PG8_AOFF
#undef PG8_SA
#undef PG8_SB
#undef PG8_STAGE
#undef PG8_LDA
#undef PG8_LDB
#undef PG8_MMA
#undef PG8_WAIT_V
#undef PG8_WAIT_L
#undef PG8_BAR
#undef PG8_SCHED
}
}

template <int MODE>
__device__ __forceinline__ void transpose_tile(const float* __restrict__ src, bf16_t* __restrict__ dst, int K, int N, int k0, int n0, float* tile  ) {
    const int tid = otid();
    const int c = tid & 63, r0 = tid >> 6;
    __syncthreads();
    if (n0 < N) {
#pragma unroll
        for (int i = 0; i < 8; ++i) { const int kk = r0 + i * 8; tile[kk * 65 + c] = src[(size_t)(k0 + kk) * N + n0 + c]; }
    } else {
#pragma unroll
        for (int i = 0; i < 8; ++i) { const int kk = r0 + i * 8; tile[kk * 65 + c] = 0.f; }
    }
    __syncthreads();
#pragma unroll
    for (int i = 0; i < 8; ++i) {
        const int nn = r0 + i * 8; int n = n0 + nn;
        if (MODE == 1) { const int j = n & 255; const int isu = n >> 8; n = (j >> 4) * 32 + isu * 16 + (j & 15); }
        dst[(size_t)n * K + k0 + c] = f2bf(tile[c * 65 + nn]);
    }
}

__device__ __forceinline__ void prologue(const Params& p, unsigned char* lds) {
    float* tile = (float*)lds;
    const int G = gridDim.x, w = obid(), tid = otid();
    bf16_t* win = (bf16_t*)(p.ws + WS_WIN); bf16_t* wout = (bf16_t*)(p.ws + WS_WOUT);
    bf16_t* mwin = (bf16_t*)(p.ws + WS_MWIN); bf16_t* mwdn = (bf16_t*)(p.ws + WS_MWDN);
    for (int it = w; it < 4 * 16 * 52; it += G) { const int l = it / (16 * 52), r = it % (16 * 52), kt = r / 52, nt = r % 52;
        transpose_tile<0>(p.w_in + (size_t)l * DM * PIN, win + (size_t)l * PINP * DM, DM, PIN, kt * 64, nt * 64, tile); }
    for (int it = w; it < 4 * 16 * 16; it += G) { const int l = it / 256, r = it % 256, kt = r / 16, nt = r % 16;
        transpose_tile<0>(p.w_out + (size_t)l * DM * DM, wout + (size_t)l * DM * DM, DM, DM, kt * 64, nt * 64, tile); }
    for (int it = w; it < 64 * 16 * 8; it += G) { const int le = it / 128, r = it % 128, kt = r / 8, nt = r % 8;
        transpose_tile<1>(p.moe_w_in + (size_t)le * 1024 * 512, mwin + (size_t)le * 512 * 1024, 1024, 512, kt * 64, nt * 64, tile); }
    for (int it = w; it < 64 * 4 * 16; it += G) { const int le = it / 64, r = it % 64, kt = r / 16, nt = r % 16;
        transpose_tile<0>(p.moe_w_down + (size_t)le * 256 * 1024, mwdn + (size_t)le * 1024 * 256, 256, 1024, kt * 64, nt * 64, tile); }
    {
        bf16_t* xb = (bf16_t*)(p.ws + WS_XB);
        const size_t n4 = (size_t)NTOK * DM / 4;
        for (size_t i = (size_t)w * NTHREADS + tid; i < n4; i += (size_t)G * NTHREADS) {
            const float4 v = ((const float4*)p.x)[i];
            ushort4 o; o.x = f2bf(v.x); o.y = f2bf(v.y); o.z = f2bf(v.z); o.w = f2bf(v.w);
            ((ushort4*)xb)[i] = o;
        }
    }
    {
        float* bd = (float*)(p.ws + WS_BIASD);
        for (int i = w * NTHREADS + tid; i < 4 * 2048; i += G * NTHREADS) {
            const int h = i >> 11, n = i & 2047;
            int bucket;
            if (n < 16) bucket = n;
            else { const float nf = (float)n; int lg = 16 + (int)(logf(nf / 16.0f) / 2.0794415416798357f * 16.0f); bucket = lg < 31 ? lg : 31; }
            bd[i] = p.rel_bias[bucket * 4 + h];
        }
    }
}

template <class ARow, class Epi>
__device__ __forceinline__ void gemm128(unsigned char* lds, const ARow& arow, const bf16_t* __restrict__ bt, int K, const Epi& epi) {
    const int tid = otid(), lane = tid & 63, wid = tid >> 6, wm = wid >> 1, wn = wid & 1;
    const int lr = tid >> 2, lc = (tid & 3) * 8;
    bf16_t* As = (bf16_t*)lds; bf16_t* Bs = (bf16_t*)(lds + 10240);
    const bf16_t* ap = arow(lr) + lc;
    const bf16_t* bp = bt + (size_t)lr * K + lc;
    f32x4 acc[2][4];
#pragma unroll
    for (int m = 0; m < 2; ++m)
#pragma unroll
        for (int n = 0; n < 4; ++n) acc[m][n] = (f32x4){0.f, 0.f, 0.f, 0.f};
    uint4 ra = *(const uint4*)ap, rb = *(const uint4*)bp;
    const int fr = lane & 15, fq = lane >> 4;
    for (int k0 = 0; k0 < K; k0 += 32) {
        __syncthreads();
        *(uint4*)(As + lr * 40 + lc) = ra;
        *(uint4*)(Bs + lr * 40 + lc) = rb;
        __syncthreads();
        if (k0 + 32 < K) { ra = *(const uint4*)(ap + k0 + 32); rb = *(const uint4*)(bp + k0 + 32); }
        bf16x8 a[2], b[4];
#pragma unroll
        for (int m = 0; m < 2; ++m) a[m] = *(const bf16x8*)(As + (wm * 32 + m * 16 + fr) * 40 + fq * 8);
#pragma unroll
        for (int n = 0; n < 4; ++n) b[n] = *(const bf16x8*)(Bs + (wn * 64 + n * 16 + fr) * 40 + fq * 8);
#pragma unroll
        for (int m = 0; m < 2; ++m)
#pragma unroll
            for (int n = 0; n < 4; ++n) acc[m][n] = __builtin_amdgcn_mfma_f32_16x16x32_bf16(a[m], b[n], acc[m][n], 0, 0, 0);
    }
    epi(acc, wm, wn, lane);
}

struct RowContig { const bf16_t* base; int ld; __device__ __forceinline__ const bf16_t* operator()(int r) const { return base + (size_t)r * ld; } };

struct EpiProjP {
    static constexpr bool PERM = true, AFTER_DRAIN = false;
    bf16_t* O;
    __device__ __forceinline__ void operator()(const pg8::f32x4 (&acc)[2][2][4][2], const pg8::Unit& u, int wr, int wc, int fr, int fq) const {
        const int row0 = u.pm * 256 + wr * 64 + fr, col0 = u.pn * 256 + wc * 32 + 8 * fq;
#pragma unroll
        for (int ai = 0; ai < 2; ++ai)
#pragma unroll
            for (int m = 0; m < 4; ++m) { bf16_t* rowp = O + (size_t)(row0 + ai * 128 + m * 16) * PINP + col0;
#pragma unroll
                for (int bj = 0; bj < 2; ++bj) { const pg8::f32x4 v0 = acc[ai][bj][m][0], v1 = acc[ai][bj][m][1];
                    pg8::u32x4 w; w.x = pg8::cvt_pk_bf16(v0[0], v0[1]); w.y = pg8::cvt_pk_bf16(v0[2], v0[3]); w.z = pg8::cvt_pk_bf16(v1[0], v1[1]); w.w = pg8::cvt_pk_bf16(v1[2], v1[3]);
                    *(pg8::u32x4*)(rowp + bj * 128) = w; } }
    }
};
__device__ __forceinline__ void phase_inproj(const Params& p, int l, unsigned char* lds) {
    pg8::Gemm g{(const bf16_t*)(p.ws + WS_XB), (const bf16_t*)(p.ws + WS_WIN) + (size_t)l * PINP * DM, NTOK, PINP, DM};
    pg8::StaticOrder S; S.init(NTOK, PINP, (int)gridDim.x, obid());
    EpiProjP E{(bf16_t*)(p.ws + WS_PROJ)};
    pg8::gemm_phase<EpiProjP, pg8::StaticOrder, true, true>((PG8_LAS unsigned char*)lds, g, S, E);
}

struct EpiOutP {
    static constexpr bool PERM = true, AFTER_DRAIN = false;
    const float* xf; const bf16_t* xh; bf16_t* out;
    __device__ __forceinline__ void operator()(const pg8::f32x4 (&acc)[2][2][4][2], const pg8::Unit& u, int wr, int wc, int fr, int fq) const {
        const int row0 = u.pm * 256 + wr * 64 + fr, col0 = u.pn * 256 + wc * 32 + 8 * fq;
#pragma unroll
        for (int ai = 0; ai < 2; ++ai)
#pragma unroll
            for (int m = 0; m < 4; ++m) { const size_t ro = (size_t)(row0 + ai * 128 + m * 16) * DM + col0;
#pragma unroll
                for (int bj = 0; bj < 2; ++bj) { const size_t o = ro + bj * 128;
                    float xv[8];
                    if (xf) { const pg8::f32x4 a = *(const pg8::f32x4*)(xf + o), b = *(const pg8::f32x4*)(xf + o + 4); xv[0] = a[0]; xv[1] = a[1]; xv[2] = a[2]; xv[3] = a[3]; xv[4] = b[0]; xv[5] = b[1]; xv[6] = b[2]; xv[7] = b[3]; }
                    else { const pg8::u32x4 r = *(const pg8::u32x4*)(xh + o); xv[0] = __uint_as_float(r.x << 16); xv[1] = __uint_as_float(r.x & 0xffff0000u); xv[2] = __uint_as_float(r.y << 16); xv[3] = __uint_as_float(r.y & 0xffff0000u);
                        xv[4] = __uint_as_float(r.z << 16); xv[5] = __uint_as_float(r.z & 0xffff0000u); xv[6] = __uint_as_float(r.w << 16); xv[7] = __uint_as_float(r.w & 0xffff0000u); }
                    const pg8::f32x4 v0 = acc[ai][bj][m][0], v1 = acc[ai][bj][m][1];
                    pg8::u32x4 w; w.x = pg8::cvt_pk_bf16(ALPHA * xv[0] + v0[0], ALPHA * xv[1] + v0[1]); w.y = pg8::cvt_pk_bf16(ALPHA * xv[2] + v0[2], ALPHA * xv[3] + v0[3]);
                    w.z = pg8::cvt_pk_bf16(ALPHA * xv[4] + v1[0], ALPHA * xv[5] + v1[1]); w.w = pg8::cvt_pk_bf16(ALPHA * xv[6] + v1[2], ALPHA * xv[7] + v1[3]);
                    *(pg8::u32x4*)(out + o) = w; } }
    }
};
__device__ __forceinline__ void phase_outproj(const Params& p, int l, unsigned char* lds) {
    pg8::Gemm g{(const bf16_t*)(p.ws + WS_MIX), (const bf16_t*)(p.ws + WS_WOUT) + (size_t)l * DM * DM, NTOK, DM, DM};
    pg8::StaticOrder S; S.init(NTOK, DM, (int)gridDim.x, obid());
    EpiOutP E{(l == 0) ? p.x : nullptr, (const bf16_t*)(p.ws + WS_XB), (bf16_t*)(p.ws + WS_YB)};
    pg8::gemm_phase<EpiOutP, pg8::StaticOrder, true, true>((PG8_LAS unsigned char*)lds, g, S, E);
}

__device__ __forceinline__ void ln_row(float (&v)[16], const float* gain, const float* bias, int lane) {
    float s = 0.f;
#pragma unroll
    for (int i = 0; i < 16; ++i) s += v[i];
    s = wave_sum(s);
    const float mean = s * (1.0f / 1024.0f);
    float q = 0.f;
#pragma unroll
    for (int i = 0; i < 16; ++i) { const float d = v[i] - mean; q += d * d; }
    q = wave_sum(q);
    const float rstd = rsqrtf(q * (1.0f / 1024.0f) + 1e-5f);
#pragma unroll
    for (int j = 0; j < 4; ++j) {
        const float4 g = *(const float4*)(gain + j * 256 + lane * 4), b = *(const float4*)(bias + j * 256 + lane * 4);
        v[j * 4 + 0] = (v[j * 4 + 0] - mean) * rstd * g.x + b.x; v[j * 4 + 1] = (v[j * 4 + 1] - mean) * rstd * g.y + b.y;
        v[j * 4 + 2] = (v[j * 4 + 2] - mean) * rstd * g.z + b.z; v[j * 4 + 3] = (v[j * 4 + 3] - mean) * rstd * g.w + b.w;
    }
}
__device__ __forceinline__ void load_row_bf(float (&v)[16], const bf16_t* src, int lane) {
#pragma unroll
    for (int j = 0; j < 4; ++j) { const ushort4 t = *(const ushort4*)(src + j * 256 + lane * 4); v[j * 4] = bf2f(t.x); v[j * 4 + 1] = bf2f(t.y); v[j * 4 + 2] = bf2f(t.z); v[j * 4 + 3] = bf2f(t.w); }
}
__device__ __forceinline__ void store_row_bf(const float (&v)[16], bf16_t* xbo, int lane) {
#pragma unroll
    for (int j = 0; j < 4; ++j) { ushort4 o; o.x = f2bf(v[j * 4]); o.y = f2bf(v[j * 4 + 1]); o.z = f2bf(v[j * 4 + 2]); o.w = f2bf(v[j * 4 + 3]); *(ushort4*)(xbo + j * 256 + lane * 4) = o; }
}
__device__ __forceinline__ void store_row(const float (&v)[16], float* xo, bf16_t* xbo, int lane) {
#pragma unroll
    for (int j = 0; j < 4; ++j) {
        *(float4*)(xo + j * 256 + lane * 4) = make_float4(v[j * 4], v[j * 4 + 1], v[j * 4 + 2], v[j * 4 + 3]);
        ushort4 o; o.x = f2bf(v[j * 4]); o.y = f2bf(v[j * 4 + 1]); o.z = f2bf(v[j * 4 + 2]); o.w = f2bf(v[j * 4 + 3]);
        *(ushort4*)(xbo + j * 256 + lane * 4) = o;
    }
}

__device__ __forceinline__ void route_pick(const float (&lg)[16], const float* rb, int& i1, int& i2, float& g1, float& g2) {
    float aff[16], sl[16];
#pragma unroll
    for (int e = 0; e < 16; ++e) { aff[e] = sigmoidf_(lg[e]); sl[e] = aff[e] + rb[e]; }
    float bestg = -INFINITY; int bg = 0;
#pragma unroll
    for (int g = 0; g < 4; ++g) {
        float m1 = -INFINITY, m2 = -INFINITY;
#pragma unroll
        for (int k = 0; k < 4; ++k) { const float s = sl[g * 4 + k]; if (s > m1) { m2 = m1; m1 = s; } else if (s > m2) m2 = s; }
        const float gs = m1 + m2;
        if (gs > bestg) { bestg = gs; bg = g; }
    }
    float b1 = -INFINITY; i1 = 0; float a1 = 0.f;
#pragma unroll
    for (int e = 0; e < 16; ++e) { const bool in = (e >> 2) == bg; if (in && sl[e] > b1) { b1 = sl[e]; i1 = e; a1 = aff[e]; } }
    float b2 = -INFINITY; i2 = 0; float a2 = 0.f;
#pragma unroll
    for (int e = 0; e < 16; ++e) { const bool in = ((e >> 2) == bg) && (e != i1); if (in && sl[e] > b2) { b2 = sl[e]; i2 = e; a2 = aff[e]; } }
    const float inv = 1.0f / (a1 + a2);
    g1 = a1 * inv; g2 = a2 * inv;
}
__device__ __forceinline__ void phase_ln1_route(const Params& p, int l, unsigned char* lds) {
    const int tid = otid(), lane = tid & 63, wid = tid >> 6;
    int* sel_e = (int*)lds;
    float* sel_g = (float*)(lds + 2048);
    int* rank = (int*)(lds + 4096);
    int* base = (int*)(lds + 6144);
    float* rwT = (float*)(lds + 8192);
    bf16_t* xb = (bf16_t*)(p.ws + WS_XB); const bf16_t* yb = (const bf16_t*)(p.ws + WS_YB);
    unsigned* ctl = (unsigned*)(p.ws + WS_CTL);
    int* ltok = (int*)(p.ws + WS_LTOK);
    const float* gain = p.ln_gain + (size_t)(l * 2 + 0) * DM; const float* bias = p.ln_bias + (size_t)(l * 2 + 0) * DM;
    __syncthreads();
    for (int i = tid; i < 16384; i += NTHREADS) { const int c = i >> 4, e = i & 15; rwT[e * 1024 + c] = p.router_w[i]; }
    for (int chunk = obid(); chunk < NTOK / 256; chunk += gridDim.x) {
        __syncthreads();
        for (int rr = 0; rr < 32; rr += 2) {
            const int lrow = wid * 32 + rr; const size_t row = (size_t)chunk * 256 + lrow;
            float v0[16], v1[16];
            load_row_bf(v0, yb + row * DM, lane); load_row_bf(v1, yb + (row + 1) * DM, lane);
            ln_row(v0, gain, bias, lane); ln_row(v1, gain, bias, lane);
            store_row_bf(v0, xb + row * DM, lane); store_row_bf(v1, xb + (row + 1) * DM, lane);
            float lg0[16], lg1[16];
#pragma unroll
            for (int e = 0; e < 16; ++e) {
                float s0 = 0.f, s1 = 0.f;
#pragma unroll
                for (int j = 0; j < 4; ++j) { const float4 w = *(const float4*)(rwT + e * 1024 + j * 256 + lane * 4);
                    s0 += v0[j * 4] * w.x + v0[j * 4 + 1] * w.y + v0[j * 4 + 2] * w.z + v0[j * 4 + 3] * w.w;
                    s1 += v1[j * 4] * w.x + v1[j * 4 + 1] * w.y + v1[j * 4 + 2] * w.z + v1[j * 4 + 3] * w.w; }
                lg0[e] = wave_sum(s0); lg1[e] = wave_sum(s1);
            }
            if (lane < 2) {
                int i1, i2; float g1, g2;
                if (lane == 0) route_pick(lg0, p.router_b, i1, i2, g1, g2); else route_pick(lg1, p.router_b, i1, i2, g1, g2);
                const int lr = lrow + lane;
                sel_e[lr * 2] = i1; sel_e[lr * 2 + 1] = i2; sel_g[lr * 2] = g1; sel_g[lr * 2 + 1] = g2;
            }
        }
        __syncthreads();
        if (tid < 16) {
            int c = 0;
            for (int i = 0; i < 512; ++i) if (sel_e[i] == tid) { rank[i] = c; ++c; }
            base[tid] = (int)atomicAdd(&ctl[CW_CNT + (l * 16 + tid) * 64], (unsigned)c);
        }
        __syncthreads();
        {
            const int e = sel_e[tid]; const int pos = base[e] + rank[tid];
            ltok[(size_t)e * NTOK + pos] = chunk * 256 + (tid >> 1);
            int* ti = (int*)(p.ws + WS_LGATE) + (size_t)(chunk * 256 + (tid >> 1)) * 4;
            ti[tid & 1] = (e << 17) | pos; ((float*)ti)[2 + (tid & 1)] = sel_g[tid];
        }
    }
}

#define MOE_TAB_OFF 131072
#define MOE_META_OFF (131072 + 4096)
struct MoeUnit { int e, rl, pn, n, ui, pb; };
__device__ __forceinline__ void moe_meta(const Params& p, int l, PG8_LAS int* meta) {
    if (otid() == 0) {
        unsigned* ctl = (unsigned*)(p.ws + WS_CTL);
        int tb = 0, pb = 0;
        for (int e = 0; e < 16; ++e) { const int c = (int)xb_ld(&ctl[CW_CNT + (l * 16 + e) * 64]); meta[e] = c; meta[16 + e] = tb; meta[33 + e] = pb; tb += (c + 255) >> 8; pb += c; }
        meta[32] = tb; meta[49] = pb;
    }
    __syncthreads();
}
template <int NCOL_LOG2>
struct MoeSchedBase {
    typedef MoeUnit Unit;
    PG8_LAS const int* meta; int G, c;
    __device__ __forceinline__ int mu(int idx) const { return __builtin_amdgcn_readfirstlane(meta[idx]); }
    __device__ __forceinline__ bool next(int i, MoeUnit& u) const {
        const int L = i * G + c; const int ntile = mu(32);
        if (L >= (ntile << NCOL_LOG2)) return false;
        const int rt = L >> NCOL_LOG2; u.pn = L & ((1 << NCOL_LOG2) - 1);
        int e = 0;
#pragma unroll
        for (int k = 1; k < 16; ++k) if (rt >= mu(16 + k)) e = k;
        u.e = e; u.rl = rt - mu(16 + e); u.n = mu(e) - u.rl * 256; u.pb = mu(33 + e) + u.rl * 256; u.ui = i; return true;
    }
};
struct MoeSchedUp : MoeSchedBase<1> {
    PG8_LAS const unsigned short* tok16; const char* xb; const char* wbase;
    __device__ __forceinline__ const char* abase(const MoeUnit&) const { return xb; }
    __device__ __forceinline__ unsigned arow_off(const MoeUnit& u, int r) const { return (unsigned)tok16[u.ui * 256 + r] * 2048u; }
    __device__ __forceinline__ const char* bbase(const MoeUnit& u) const { return wbase + ((size_t)u.e * 512 + u.pn * 256) * 2048; }
};
struct MoeSchedDown : MoeSchedBase<2> {
    const char* hb; const char* wbase;
    __device__ __forceinline__ const char* abase(const MoeUnit& u) const { return hb + (size_t)u.pb * 512; }
    __device__ __forceinline__ unsigned arow_off(const MoeUnit&, int r) const { return (unsigned)r * 512u; }
    __device__ __forceinline__ const char* bbase(const MoeUnit& u) const { return wbase + ((size_t)u.e * 1024 + u.pn * 256) * 512; }
};
struct EpiUp {
    static constexpr bool PERM = false, AFTER_DRAIN = false;
    bf16_t* H;
    __device__ __forceinline__ void operator()(const pg8::f32x4 (&acc)[2][2][4][2], const MoeUnit& u, int wr, int wc, int fr, int fq) const {
        bf16_t* hb = H + u.pn * 128 + wc * 16 + fq * 4;
#pragma unroll
        for (int ai = 0; ai < 2; ++ai)
#pragma unroll
            for (int m = 0; m < 4; ++m) {
                const int r = ai * 128 + wr * 64 + m * 16 + fr;
                const int rr = (r < u.n) ? (u.pb + r) : (2 * NTOK + r);
#pragma unroll
                for (int bj = 0; bj < 2; ++bj) {
                    const pg8::f32x4 g = acc[ai][bj][m][0], uu = acc[ai][bj][m][1];
                    float hv[4];
#pragma unroll
                    for (int i = 0; i < 4; ++i) hv[i] = g[i] * __builtin_amdgcn_rcpf(1.0f + __builtin_amdgcn_exp2f(-g[i] * LOG2E)) * uu[i];
                    uint2 w; w.x = pg8::cvt_pk_bf16(hv[0], hv[1]); w.y = pg8::cvt_pk_bf16(hv[2], hv[3]);
                    *(uint2*)(hb + (size_t)rr * DEXP + bj * 64) = w;
                }
            }
    }
};
struct EpiDown {
    static constexpr bool PERM = true, AFTER_DRAIN = false;
    bf16_t* Y;
    __device__ __forceinline__ void operator()(const pg8::f32x4 (&acc)[2][2][4][2], const MoeUnit& u, int wr, int wc, int fr, int fq) const {
        bf16_t* yb = Y + u.pn * 256 + wc * 32 + 8 * fq;
#pragma unroll
        for (int ai = 0; ai < 2; ++ai)
#pragma unroll
            for (int m = 0; m < 4; ++m) {
                const int r = ai * 128 + wr * 64 + m * 16 + fr;
                const int rr = (r < u.n) ? (u.pb + r) : (2 * NTOK + r);
#pragma unroll
                for (int bj = 0; bj < 2; ++bj) { const pg8::f32x4 v0 = acc[ai][bj][m][0], v1 = acc[ai][bj][m][1];
                    pg8::u32x4 w; w.x = pg8::cvt_pk_bf16(v0[0], v0[1]); w.y = pg8::cvt_pk_bf16(v0[2], v0[3]); w.z = pg8::cvt_pk_bf16(v1[0], v1[1]); w.w = pg8::cvt_pk_bf16(v1[2], v1[3]);
                    *(pg8::u32x4*)(yb + (size_t)rr * DM + bj * 128) = w; }
            }
    }
};
__device__ __forceinline__ void phase_moe_up(const Params& p, int l, unsigned char* lds) {
    PG8_LAS unsigned char* L = (PG8_LAS unsigned char*)lds;
    PG8_LAS int* meta = (PG8_LAS int*)(L + MOE_META_OFF);
    PG8_LAS unsigned short* tok16 = (PG8_LAS unsigned short*)(L + MOE_TAB_OFF);
    __syncthreads();
    moe_meta(p, l, meta);
    MoeSchedUp S; S.meta = meta; S.G = (int)gridDim.x; S.c = obid(); S.tok16 = tok16; S.xb = (const char*)(p.ws + WS_XB); S.wbase = (const char*)(p.ws + WS_MWIN) + (size_t)l * 16 * 512 * 2048;
    {
        const int* ltok = (const int*)(p.ws + WS_LTOK); const int tid = otid();
        MoeUnit u;
        for (int i = 0; i < 8 && S.next(i, u); ++i)
            if (tid < 256) tok16[i * 256 + tid] = (tid < u.n) ? (unsigned short)ltok[(size_t)u.e * NTOK + u.rl * 256 + tid] : (unsigned short)0;
    }
    __syncthreads();
    EpiUp E{(bf16_t*)(p.ws + WS_H)};
    pg8::gemm_phase_g<EpiUp, MoeSchedUp, true>(L, 1024, S, E);
}
__device__ __forceinline__ void phase_moe_down(const Params& p, int l, unsigned char* lds) {
    PG8_LAS unsigned char* L = (PG8_LAS unsigned char*)lds;
    PG8_LAS int* meta = (PG8_LAS int*)(L + MOE_META_OFF);
    __syncthreads();
    moe_meta(p, l, meta);
    MoeSchedDown S; S.meta = meta; S.G = (int)gridDim.x; S.c = obid(); S.hb = (const char*)(p.ws + WS_H); S.wbase = (const char*)(p.ws + WS_MWDN) + (size_t)l * 16 * 1024 * 512;
    EpiDown E{(bf16_t*)(p.ws + WS_Y)};
    pg8::gemm_phase_g<EpiDown, MoeSchedDown, false>(L, 256, S, E);
}

__device__ __forceinline__ void phase_ln2(const Params& p, int l, unsigned char* lds) {
    const int tid = otid(), lane = tid & 63, wid = tid >> 6;
    bf16_t* xb = (bf16_t*)(p.ws + WS_XB); const bf16_t* Y = (const bf16_t*)(p.ws + WS_Y);
    const float* gain = p.ln_gain + (size_t)(l * 2 + 1) * DM; const float* bias = p.ln_bias + (size_t)(l * 2 + 1) * DM;
    int* pbase = (int*)lds;
    __syncthreads();
    if (tid == 0) { unsigned* ctl = (unsigned*)(p.ws + WS_CTL); int pb = 0; for (int e = 0; e < 16; ++e) { pbase[e] = pb; pb += (int)xb_ld(&ctl[CW_CNT + (l * 16 + e) * 64]); } }
    __syncthreads();
    for (size_t row = (size_t)obid() * 8 + wid; row < NTOK; row += (size_t)gridDim.x * 8) {
        const int4 ti = *(const int4*)(p.ws + WS_LGATE + row * 16);
        const size_t p0 = (size_t)(pbase[ti.x >> 17] + (ti.x & 0x1ffff)), p1 = (size_t)(pbase[ti.y >> 17] + (ti.y & 0x1ffff));
        const float g0 = __int_as_float(ti.z), g1 = __int_as_float(ti.w);
        float v[16];
#pragma unroll
        for (int j = 0; j < 4; ++j) {
            const ushort4 t = *(const ushort4*)(xb + row * DM + j * 256 + lane * 4);
            const ushort4 y0 = *(const ushort4*)(Y + p0 * DM + j * 256 + lane * 4), y1 = *(const ushort4*)(Y + p1 * DM + j * 256 + lane * 4);
            v[j * 4 + 0] = ALPHA * bf2f(t.x) + g0 * bf2f(y0.x) + g1 * bf2f(y1.x); v[j * 4 + 1] = ALPHA * bf2f(t.y) + g0 * bf2f(y0.y) + g1 * bf2f(y1.y);
            v[j * 4 + 2] = ALPHA * bf2f(t.z) + g0 * bf2f(y0.z) + g1 * bf2f(y1.z); v[j * 4 + 3] = ALPHA * bf2f(t.w) + g0 * bf2f(y0.w) + g1 * bf2f(y1.w);
        }
        ln_row(v, gain, bias, lane);
        if (l == NLAYER - 1) store_row(v, p.out + row * DM, xb + row * DM, lane); else store_row_bf(v, xb + row * DM, lane);
    }
}

__device__ __forceinline__ void sb_item(const Params& p, int bh, int qc, unsigned char* lds) {
    const int tid = otid(), b = bh >> 2, h = bh & 3;
    const bf16_t* proj = (const bf16_t*)(p.ws + WS_PROJ) + (size_t)b * SEQ * PINP;
    bf16_t* mix = (bf16_t*)(p.ws + WS_MIX) + (size_t)b * SEQ * DM;
    float* Ks = (float*)lds; float* Vs = (float*)(lds + 16384);
    const int t = qc * 512 + tid; const int twmax = qc * 512 + (tid | 63);
    float q[64], acc[64];
#pragma unroll
    for (int d8 = 0; d8 < 8; ++d8) { const uint4 raw = *(const uint4*)(proj + (size_t)t * PINP + h * 64 + d8 * 8); const bf16_t* rp = (const bf16_t*)&raw;
#pragma unroll
        for (int i = 0; i < 8; ++i) q[d8 * 8 + i] = bf2f(rp[i]) * 0.125f; }
#pragma unroll
    for (int d = 0; d < 64; ++d) acc[d] = 0.f;
    float cs = 0.f;
    for (int kb = qc * 8 + 7; kb >= 0; --kb) {
        __syncthreads();
        { const int key = tid >> 3, d8 = tid & 7; const size_t ro = (size_t)(kb * 64 + key) * PINP + h * 64 + d8 * 8;
          const uint4 rk = *(const uint4*)(proj + ro + 256), rv = *(const uint4*)(proj + ro + 512); const bf16_t* pk = (const bf16_t*)&rk; const bf16_t* pv = (const bf16_t*)&rv;
#pragma unroll
          for (int i = 0; i < 8; ++i) { Ks[key * 64 + d8 * 8 + i] = bf2f(pk[i]); Vs[key * 64 + d8 * 8 + i] = bf2f(pv[i]); } }
        __syncthreads();
        if (kb * 64 < twmax) {
            for (int sl = 63; sl >= 0; --sl) {
                const int s = kb * 64 + sl;
                if (s < t) {
                    float z = 0.f;
#pragma unroll
                    for (int d4 = 0; d4 < 16; ++d4) { const float4 kv = *(const float4*)(Ks + sl * 64 + d4 * 4); z += q[d4 * 4] * kv.x + q[d4 * 4 + 1] * kv.y + q[d4 * 4 + 2] * kv.z + q[d4 * 4 + 3] * kv.w; }
                    const float sp = fmaxf(z, 0.f) + log1pf(expf(-fabsf(z)));
                    cs += sp;
                    const float w = expf(z - cs);
#pragma unroll
                    for (int d4 = 0; d4 < 16; ++d4) { const float4 vv = *(const float4*)(Vs + sl * 64 + d4 * 4); acc[d4 * 4] += w * vv.x; acc[d4 * 4 + 1] += w * vv.y; acc[d4 * 4 + 2] += w * vv.z; acc[d4 * 4 + 3] += w * vv.w; }
                }
            }
        }
    }
#pragma unroll
    for (int d8 = 0; d8 < 8; ++d8) { uint4 o; bf16_t* op = (bf16_t*)&o;
#pragma unroll
        for (int i = 0; i < 8; ++i) op[i] = f2bf(acc[d8 * 8 + i]);
        *(uint4*)(mix + (size_t)t * DM + h * 64 + d8 * 8) = o; }
}

__device__ __forceinline__ void da_item(const Params& p, int l, int bh, int qc, unsigned char* lds) {
    const int tid = otid(), b = bh >> 2, h = bh & 3, map = tid >> 8, row = tid & 255;
    const bf16_t* proj = (const bf16_t*)(p.ws + WS_PROJ) + (size_t)b * SEQ * PINP;
    bf16_t* mix = (bf16_t*)(p.ws + WS_MIX) + (size_t)b * SEQ * DM;
    const float* biasd = (const float*)(p.ws + WS_BIASD) + h * 2048;
    float* Ks = (float*)lds; float* Vs = (float*)(lds + 16384); float* Bd = (float*)(lds + 32768); float* Ex = (float*)(lds + 40960);
    const int t = qc * 256 + row; const int twmax = qc * 256 + (row | 63);
    __syncthreads();
    for (int i = tid; i < 2048; i += NTHREADS) Bd[i] = biasd[i];
    float q[32], O[64];
#pragma unroll
    for (int d8 = 0; d8 < 4; ++d8) { const uint4 raw = *(const uint4*)(proj + (size_t)t * PINP + 768 + h * 64 + map * 32 + d8 * 8); const bf16_t* rp = (const bf16_t*)&raw;
#pragma unroll
        for (int i = 0; i < 8; ++i) q[d8 * 8 + i] = bf2f(rp[i]) * 0.17677669529663687f; }
#pragma unroll
    for (int d = 0; d < 64; ++d) O[d] = 0.f;
    float mrun = -INFINITY, lsum = 0.f;
    for (int kb = 0; kb <= qc * 4 + 3; ++kb) {
        __syncthreads();
        { const int key = tid >> 3, d8 = tid & 7; const size_t ro = (size_t)(kb * 64 + key) * PINP + 768 + h * 64 + d8 * 8;
          const uint4 rk = *(const uint4*)(proj + ro + 256), rv = *(const uint4*)(proj + ro + 512); const bf16_t* pk = (const bf16_t*)&rk; const bf16_t* pv = (const bf16_t*)&rv;
#pragma unroll
          for (int i = 0; i < 8; ++i) { Ks[key * 64 + d8 * 8 + i] = bf2f(pk[i]); Vs[key * 64 + d8 * 8 + i] = bf2f(pv[i]); } }
        __syncthreads();
        if (kb * 64 <= twmax) {
            for (int sl = 0; sl < 64; ++sl) {
                const int s = kb * 64 + sl;
                if (s <= t) {
                    float z = Bd[t - s];
#pragma unroll
                    for (int d4 = 0; d4 < 8; ++d4) { const float4 kv = *(const float4*)(Ks + sl * 64 + map * 32 + d4 * 4); z += q[d4 * 4] * kv.x + q[d4 * 4 + 1] * kv.y + q[d4 * 4 + 2] * kv.z + q[d4 * 4 + 3] * kv.w; }
                    if (z > mrun) { const float sc = expf(mrun - z); lsum *= sc;
#pragma unroll
                        for (int d = 0; d < 64; ++d) O[d] *= sc;
                        mrun = z; }
                    const float pw = expf(z - mrun);
                    lsum += pw;
#pragma unroll
                    for (int d4 = 0; d4 < 16; ++d4) { const float4 vv = *(const float4*)(Vs + sl * 64 + d4 * 4); O[d4 * 4] += pw * vv.x; O[d4 * 4 + 1] += pw * vv.y; O[d4 * 4 + 2] += pw * vv.z; O[d4 * 4 + 3] += pw * vv.w; }
                }
            }
        }
    }
    const float il = 1.0f / lsum;
    __syncthreads();
    if (map == 1) {
#pragma unroll
        for (int d = 0; d < 64; ++d) Ex[d * 256 + row] = O[d] * il;
    }
    __syncthreads();
    if (map == 0) {
        const float* lp = p.da_lambda + (size_t)l * 128;
        float s1 = 0.f, s2 = 0.f;
        for (int i = 0; i < 32; ++i) { s1 += lp[i] * lp[32 + i]; s2 += lp[64 + i] * lp[96 + i]; }
        const float lam_init = 0.8f - 0.6f * expf(-0.3f * (float)l);
        const float lam = expf(s1) - expf(s2) + lam_init;
        float ms = 0.f;
#pragma unroll
        for (int d = 0; d < 64; ++d) { O[d] = O[d] * il - lam * Ex[d * 256 + row]; ms += O[d] * O[d]; }
        const float r = rsqrtf(ms * (1.0f / 64.0f) + 1e-5f) * (1.0f - lam_init);
        const float* sg = p.da_subln + l * 64;
#pragma unroll
        for (int d8 = 0; d8 < 8; ++d8) { uint4 o; bf16_t* op = (bf16_t*)&o;
#pragma unroll
            for (int i = 0; i < 8; ++i) op[i] = f2bf(O[d8 * 8 + i] * r * sg[d8 * 8 + i]);
            *(uint4*)(mix + (size_t)t * DM + 256 + h * 64 + d8 * 8) = o; }
    }
}

typedef float f32x16 __attribute__((ext_vector_type(16)));
typedef unsigned u32x4v __attribute__((ext_vector_type(4)));
typedef unsigned u32x2v __attribute__((ext_vector_type(2)));
#define AT_KSTR 72
#define AT_VSTR 68
#define AT_KBYTES (64 * AT_KSTR * 2)
#define AT_VBYTES (64 * AT_VSTR * 2)
typedef __bf16 bf16x2_t __attribute__((ext_vector_type(2)));
typedef float f32x2_t __attribute__((ext_vector_type(2)));
__device__ __forceinline__ unsigned pk_bf16(float lo, float hi) { const f32x2_t v = {lo, hi}; const bf16x2_t b = __builtin_convertvector(v, bf16x2_t); return __builtin_bit_cast(unsigned, b); }
__device__ __forceinline__ bf16x8 mk_frag(unsigned a, unsigned b, unsigned c, unsigned d) { u32x4v v; v.x = a; v.y = b; v.z = c; v.w = d; return __builtin_bit_cast(bf16x8, v); }
__device__ __forceinline__ bf16x8 scale_frag(uint4 raw, float sc) {
    return mk_frag(pk_bf16(__uint_as_float(raw.x << 16) * sc, __uint_as_float(raw.x & 0xffff0000u) * sc), pk_bf16(__uint_as_float(raw.y << 16) * sc, __uint_as_float(raw.y & 0xffff0000u) * sc),
                   pk_bf16(__uint_as_float(raw.z << 16) * sc, __uint_as_float(raw.z & 0xffff0000u) * sc), pk_bf16(__uint_as_float(raw.w << 16) * sc, __uint_as_float(raw.w & 0xffff0000u) * sc));
}
struct AtStage {
    uint4 rk; uint2 rv0, rv1;
    __device__ __forceinline__ void load(const bf16_t* kbase, const bf16_t* vbase, int kt, int tid) {
        const int skey = tid >> 3, sc8 = tid & 7, vkp = tid >> 4, vdg = tid & 15;
        rk = *(const uint4*)(kbase + (size_t)(kt * 64 + skey) * PINP + sc8 * 8);
        rv0 = *(const uint2*)(vbase + (size_t)(kt * 64 + 2 * vkp) * PINP + vdg * 4);
        rv1 = *(const uint2*)(vbase + (size_t)(kt * 64 + 2 * vkp + 1) * PINP + vdg * 4);
    }
    __device__ __forceinline__ void store(LAS unsigned char* kb, LAS unsigned char* vb, int tid) const {
        const int skey = tid >> 3, sc8 = tid & 7, vkp = tid >> 4, vdg = tid & 15;
        { u32x4v t_; t_.x = rk.x; t_.y = rk.y; t_.z = rk.z; t_.w = rk.w; *(LAS u32x4v*)(kb + (skey * AT_KSTR + sc8 * 8) * 2) = t_; }
        LAS unsigned* vt = (LAS unsigned*)vb;
        vt[(vdg * 4 + 0) * (AT_VSTR / 2) + vkp] = (rv0.x & 0xffffu) | (rv1.x << 16);
        vt[(vdg * 4 + 1) * (AT_VSTR / 2) + vkp] = (rv0.x >> 16) | (rv1.x & 0xffff0000u);
        vt[(vdg * 4 + 2) * (AT_VSTR / 2) + vkp] = (rv0.y & 0xffffu) | (rv1.y << 16);
        vt[(vdg * 4 + 3) * (AT_VSTR / 2) + vkp] = (rv0.y >> 16) | (rv1.y & 0xffff0000u);
    }
};
__device__ __forceinline__ bf16x8 k_frag(const LAS unsigned char* kb, int keyrow, int dcol) { return *(const LAS bf16x8*)(kb + (keyrow * AT_KSTR + dcol) * 2); }
__device__ __forceinline__ bf16x8 v_frag(const LAS unsigned char* vb, int drow, int keycol) {
    const u32x2v a = *(const LAS u32x2v*)(vb + (drow * AT_VSTR + keycol) * 2), b = *(const LAS u32x2v*)(vb + (drow * AT_VSTR + keycol + 8) * 2);
    return mk_frag(a.x, a.y, b.x, b.y);
}
__device__ __forceinline__ void store_ot(bf16_t* dst  , const f32x16& o0, const f32x16& o1, int hh) {
#pragma unroll
    for (int q = 0; q < 4; ++q) {
        uint2 w; w.x = pk_bf16(o0[4 * q], o0[4 * q + 1]); w.y = pk_bf16(o0[4 * q + 2], o0[4 * q + 3]);
        *(uint2*)(dst + 8 * q + 4 * hh) = w;
        uint2 w1; w1.x = pk_bf16(o1[4 * q], o1[4 * q + 1]); w1.y = pk_bf16(o1[4 * q + 2], o1[4 * q + 3]);
        *(uint2*)(dst + 32 + 8 * q + 4 * hh) = w1;
    }
}

#define SB_VSTR 36
#define SB_WBYTES (32 * AT_KSTR * 2 + 64 * SB_VSTR * 2)
struct SbStage {
    u32x4v rk[4]; u32x2v rv0[4], rv1[4];
    __device__ __forceinline__ void load(const bf16_t* kbase, const bf16_t* vbase, int kb, int lane) {
        const int rsub = lane >> 3, c8 = lane & 7, kps = lane >> 4, dg = lane & 15;
#pragma unroll
        for (int j = 0; j < 4; ++j) {
            rk[j] = *(const u32x4v*)(kbase + (size_t)(kb * 32 + 8 * j + rsub) * PINP + c8 * 8);
            const int kp = 4 * j + kps;
            rv0[j] = *(const u32x2v*)(vbase + (size_t)(kb * 32 + 2 * kp) * PINP + dg * 4);
            rv1[j] = *(const u32x2v*)(vbase + (size_t)(kb * 32 + 2 * kp + 1) * PINP + dg * 4);
        }
    }
    __device__ __forceinline__ void store(LAS unsigned char* kb_, LAS unsigned char* vb_, int lane) const {
        const int rsub = lane >> 3, c8 = lane & 7, kps = lane >> 4, dg = lane & 15;
        LAS unsigned* vt = (LAS unsigned*)vb_;
#pragma unroll
        for (int j = 0; j < 4; ++j) {
            *(LAS u32x4v*)(kb_ + ((8 * j + rsub) * AT_KSTR + c8 * 8) * 2) = rk[j];
            const int kp = 4 * j + kps;
            vt[(dg * 4 + 0) * (SB_VSTR / 2) + kp] = (rv0[j].x & 0xffffu) | (rv1[j].x << 16);
            vt[(dg * 4 + 1) * (SB_VSTR / 2) + kp] = (rv0[j].x >> 16) | (rv1[j].x & 0xffff0000u);
            vt[(dg * 4 + 2) * (SB_VSTR / 2) + kp] = (rv0[j].y & 0xffffu) | (rv1[j].y << 16);
            vt[(dg * 4 + 3) * (SB_VSTR / 2) + kp] = (rv0[j].y >> 16) | (rv1[j].y & 0xffff0000u);
        }
    }
};
__device__ __forceinline__ bf16x8 sbv_frag(const LAS unsigned char* vb, int drow, int keycol) {
    const u32x2v a = *(const LAS u32x2v*)(vb + (drow * SB_VSTR + keycol) * 2), b = *(const LAS u32x2v*)(vb + (drow * SB_VSTR + keycol + 8) * 2);
    return mk_frag(a.x, a.y, b.x, b.y);
}
__device__ __forceinline__ void sbm_item(const Params& p, int bh, int qb, unsigned char* lds) {
    const int tid = otid(), lane = tid & 63, wid = tid >> 6, r = lane & 31, hh = lane >> 5;
    const int b = bh >> 2, h = bh & 3;
    const bf16_t* proj = (const bf16_t*)(p.ws + WS_PROJ) + (size_t)b * SEQ * PINP;
    const bf16_t* kbase = proj + 256 + h * 64; const bf16_t* vbase = proj + 512 + h * 64;
    const int q0w = qb * 256 + wid * 32, t = q0w + r;
    LAS unsigned char* const KW = (LAS unsigned char*)lds + wid * SB_WBYTES; LAS unsigned char* const VW = KW + 32 * AT_KSTR * 2;
    bf16x8 qf[4];
#pragma unroll
    for (int s = 0; s < 4; ++s) qf[s] = scale_frag(*(const uint4*)(proj + (size_t)t * PINP + h * 64 + 16 * s + 8 * hh), 0.125f * LOG2E);
    f32x16 O0, O1;
#pragma unroll
    for (int i = 0; i < 16; ++i) { O0[i] = 0.f; O1[i] = 0.f; }
    float carry = 1.f;
    SbStage st;
    __syncthreads();
    if (q0w + 31 > 0) {
        int kb = (q0w + 30) >> 5;
        st.load(kbase, vbase, kb, lane);
#pragma unroll 1
        for (; kb >= 0; --kb) {
            st.store(KW, VW, lane);
            if (kb > 0) st.load(kbase, vbase, kb - 1, lane);
            const int kbs = 32 * kb;
            f32x16 S;
#pragma unroll
            for (int i = 0; i < 16; ++i) S[i] = 0.f;
#pragma unroll
            for (int s = 0; s < 4; ++s) S = __builtin_amdgcn_mfma_f32_32x32x16_bf16(k_frag(KW, r, 16 * s + 8 * hh), qf[s], S, 0, 0, 0);
            const bool needmask = (kbs + 31 >= q0w);
            float sg[16], G[4];
#pragma unroll
            for (int q = 0; q < 4; ++q) {
                float om[4];
#pragma unroll
                for (int i = 0; i < 4; ++i) {
                    const float z = S[4 * q + i];
                    const float e = __builtin_amdgcn_exp2f(-fabsf(z));
                    const float rr = __builtin_amdgcn_rcpf(1.0f + e);
                    const float er = e * rr;
                    float sgm = z >= 0.f ? rr : er, omm = z >= 0.f ? er : rr;
                    if (needmask) { const int key = kbs + i + 8 * q + 4 * hh; if (key >= t) { sgm = 0.f; omm = 1.f; } }
                    sg[4 * q + i] = sgm; om[i] = omm;
                }
                const float pp2 = om[3], pp1 = pp2 * om[2], pp0 = pp1 * om[1];
                G[q] = pp0 * om[0];
                sg[4 * q + 2] *= pp2; sg[4 * q + 1] *= pp1; sg[4 * q + 0] *= pp0;
            }
            float Gp[4];
#pragma unroll
            for (int q = 0; q < 4; ++q) Gp[q] = __shfl_xor(G[q], 32);
            const float T0 = G[0] * Gp[0], T1 = G[1] * Gp[1], T2 = G[2] * Gp[2], T3 = G[3] * Gp[3];
            const float U2 = T3, U1 = T3 * T2, U0 = U1 * T1;
            float E[4];
            E[3] = carry; E[2] = carry * U2; E[1] = carry * U1; E[0] = carry * U0;
            if (hh == 0) { E[3] *= Gp[3]; E[2] *= Gp[2]; E[1] *= Gp[1]; E[0] *= Gp[0]; }
            carry = carry * U0 * T0;
#pragma unroll
            for (int q = 0; q < 4; ++q) { sg[4 * q] *= E[q]; sg[4 * q + 1] *= E[q]; sg[4 * q + 2] *= E[q]; sg[4 * q + 3] *= E[q]; }
            const bf16x8 P0 = mk_frag(pk_bf16(sg[0], sg[1]), pk_bf16(sg[2], sg[3]), pk_bf16(sg[4], sg[5]), pk_bf16(sg[6], sg[7]));
            const bf16x8 P1 = mk_frag(pk_bf16(sg[8], sg[9]), pk_bf16(sg[10], sg[11]), pk_bf16(sg[12], sg[13]), pk_bf16(sg[14], sg[15]));
            O0 = __builtin_amdgcn_mfma_f32_32x32x16_bf16(sbv_frag(VW, r, 4 * hh), P0, O0, 0, 0, 0);
            O0 = __builtin_amdgcn_mfma_f32_32x32x16_bf16(sbv_frag(VW, r, 16 + 4 * hh), P1, O0, 0, 0, 0);
            O1 = __builtin_amdgcn_mfma_f32_32x32x16_bf16(sbv_frag(VW, 32 + r, 4 * hh), P0, O1, 0, 0, 0);
            O1 = __builtin_amdgcn_mfma_f32_32x32x16_bf16(sbv_frag(VW, 32 + r, 16 + 4 * hh), P1, O1, 0, 0, 0);
            if (__all(carry < 1e-30f)) break;
        }
    }
    { const int tid2 = otid(), hh2 = (tid2 & 63) >> 5, t2 = qb * 256 + (tid2 >> 6) * 32 + (tid2 & 31);
      store_ot((bf16_t*)(p.ws + WS_MIX) + (size_t)((bh >> 2) * SEQ + t2) * DM + (bh & 3) * 64, O0, O1, hh2); }
}

__device__ __forceinline__ void dam_item(const Params& p, int l, int bh, int qb, unsigned char* lds) {
    const int tid = otid(), lane = tid & 63, wid = tid >> 6, r = lane & 31, hh = lane >> 5;
    const int b = bh >> 2, h = bh & 3;
    const bf16_t* proj = (const bf16_t*)(p.ws + WS_PROJ) + (size_t)b * SEQ * PINP;
    const bf16_t* kbase = proj + 1024 + h * 64; const bf16_t* vbase = proj + 1280 + h * 64;
    const float* biasd = (const float*)(p.ws + WS_BIASD) + h * 2048;
    const int q0w = qb * 256 + wid * 32, t = q0w + r;
    LAS unsigned char* const L = (LAS unsigned char*)lds;
#define KBUF(b_) (L + (b_) * AT_KBYTES)
#define VBUF(b_) (L + 2 * AT_KBYTES + (b_) * AT_VBYTES)
    LAS float* Bd = (LAS float*)(L + 2 * AT_KBYTES + 2 * AT_VBYTES + 64);
    bf16x8 qf[2][2];
#pragma unroll
    for (int m = 0; m < 2; ++m)
#pragma unroll
        for (int s = 0; s < 2; ++s) qf[m][s] = scale_frag(*(const uint4*)(proj + (size_t)t * PINP + 768 + h * 64 + m * 32 + 16 * s + 8 * hh), 0.17677669529663687f * LOG2E);
    f32x16 O[2][2];
#pragma unroll
    for (int m = 0; m < 2; ++m)
#pragma unroll
        for (int d = 0; d < 2; ++d)
#pragma unroll
            for (int i = 0; i < 16; ++i) O[m][d][i] = 0.f;
    float lrun[2] = {0.f, 0.f};
    const float cfar = biasd[2047] * LOG2E;
    AtStage st;
    const int ktop = qb * 4 + 3;
    __syncthreads();
    if (tid < 320) Bd[tid] = tid >= 64 ? biasd[tid - 64] * LOG2E : 0.f;
    st.load(kbase, vbase, 0, tid); st.store(KBUF(0), VBUF(0), tid);
    __syncthreads();
#pragma unroll 1
    for (int kt = 0; kt <= ktop; ++kt) {
        const int buf = kt & 1;
        if (kt < ktop) st.load(kbase, vbase, kt + 1, tid);
        if (64 * kt <= q0w + 31) {
            const bool far = (q0w - (64 * kt + 63) >= 128);
            const int dbase = t - 64 * kt - 4 * hh;
            const LAS float* bp = Bd + 64 + dbase;
            const float sinit = far ? cfar : 0.f;
#pragma unroll
            for (int kb32 = 0; kb32 < 2; ++kb32) {
                if (64 * kt + 32 * kb32 <= q0w + 31) {
                    f32x16 S0, S1;
#pragma unroll
                    for (int i = 0; i < 16; ++i) { S0[i] = sinit; S1[i] = sinit; }
#pragma unroll
                    for (int s = 0; s < 2; ++s) {
                        S0 = __builtin_amdgcn_mfma_f32_32x32x16_bf16(k_frag(KBUF(buf), kb32 * 32 + r, 16 * s + 8 * hh), qf[0][s], S0, 0, 0, 0);
                        S1 = __builtin_amdgcn_mfma_f32_32x32x16_bf16(k_frag(KBUF(buf), kb32 * 32 + r, 32 + 16 * s + 8 * hh), qf[1][s], S1, 0, 0, 0);
                    }
                    if (!far) {
#pragma unroll
                        for (int i = 0; i < 16; ++i) {
                            const int c = 32 * kb32 + (i & 3) + 8 * (i >> 2);
                            const float bb = bp[-c];
                            const bool ok = (dbase - c >= 0);
                            S0[i] = ok ? S0[i] + bb : -INFINITY; S1[i] = ok ? S1[i] + bb : -INFINITY;
                        }
                    }
                    float ls0 = 0.f, ls1 = 0.f;
#pragma unroll
                    for (int i = 0; i < 16; ++i) { const float p0 = __builtin_amdgcn_exp2f(S0[i]), p1 = __builtin_amdgcn_exp2f(S1[i]); S0[i] = p0; S1[i] = p1; ls0 += p0; ls1 += p1; }
                    lrun[0] += ls0; lrun[1] += ls1;
                    const bf16x8 P00 = mk_frag(pk_bf16(S0[0], S0[1]), pk_bf16(S0[2], S0[3]), pk_bf16(S0[4], S0[5]), pk_bf16(S0[6], S0[7]));
                    const bf16x8 P01 = mk_frag(pk_bf16(S0[8], S0[9]), pk_bf16(S0[10], S0[11]), pk_bf16(S0[12], S0[13]), pk_bf16(S0[14], S0[15]));
                    const bf16x8 P10 = mk_frag(pk_bf16(S1[0], S1[1]), pk_bf16(S1[2], S1[3]), pk_bf16(S1[4], S1[5]), pk_bf16(S1[6], S1[7]));
                    const bf16x8 P11 = mk_frag(pk_bf16(S1[8], S1[9]), pk_bf16(S1[10], S1[11]), pk_bf16(S1[12], S1[13]), pk_bf16(S1[14], S1[15]));
#pragma unroll
                    for (int d = 0; d < 2; ++d) {
                        const bf16x8 va = v_frag(VBUF(buf), d * 32 + r, kb32 * 32 + 4 * hh), vb = v_frag(VBUF(buf), d * 32 + r, kb32 * 32 + 16 + 4 * hh);
                        O[0][d] = __builtin_amdgcn_mfma_f32_32x32x16_bf16(va, P00, O[0][d], 0, 0, 0);
                        O[1][d] = __builtin_amdgcn_mfma_f32_32x32x16_bf16(va, P10, O[1][d], 0, 0, 0);
                        O[0][d] = __builtin_amdgcn_mfma_f32_32x32x16_bf16(vb, P01, O[0][d], 0, 0, 0);
                        O[1][d] = __builtin_amdgcn_mfma_f32_32x32x16_bf16(vb, P11, O[1][d], 0, 0, 0);
                    }
                }
            }
        }
        if (kt < ktop) st.store(KBUF(buf ^ 1), VBUF(buf ^ 1), tid);
        __syncthreads();
    }
    const int tid2 = otid(), hh2 = (tid2 & 63) >> 5, t2 = qb * 256 + (tid2 >> 6) * 32 + (tid2 & 31);
    const float* lp = p.da_lambda + (size_t)l * 128;
    float s1 = 0.f, s2 = 0.f;
    for (int i = 0; i < 32; ++i) { s1 += lp[i] * lp[32 + i]; s2 += lp[64 + i] * lp[96 + i]; }
    const float lam_init = 0.8f - 0.6f * expf(-0.3f * (float)l);
    const float lam = expf(s1) - expf(s2) + lam_init;
    const float l0 = lrun[0] + __shfl_xor(lrun[0], 32), l1 = lrun[1] + __shfl_xor(lrun[1], 32);
    const float i0 = 1.0f / l0, i1 = lam / l1;
    float ms = 0.f;
#pragma unroll
    for (int d = 0; d < 2; ++d)
#pragma unroll
        for (int i = 0; i < 16; ++i) { const float o = O[0][d][i] * i0 - O[1][d][i] * i1; O[0][d][i] = o; ms += o * o; }
    ms += __shfl_xor(ms, 32);
    const float rs = rsqrtf(ms * (1.0f / 64.0f) + 1e-5f) * (1.0f - lam_init);
    const float* sgn = p.da_subln + l * 64;
#pragma unroll
    for (int d = 0; d < 2; ++d)
#pragma unroll
        for (int i = 0; i < 16; ++i) O[0][d][i] *= rs * sgn[d * 32 + (i & 3) + 8 * (i >> 2) + 4 * hh2];
    store_ot((bf16_t*)(p.ws + WS_MIX) + (size_t)((bh >> 2) * SEQ + t2) * DM + 256 + (bh & 3) * 64, O[0][0], O[0][1], hh2);
}

__device__ __forceinline__ void bf8_to_f(const uint4& v, float (&o)[8]) {
    o[0] = __uint_as_float(v.x << 16); o[1] = __uint_as_float(v.x & 0xffff0000u); o[2] = __uint_as_float(v.y << 16); o[3] = __uint_as_float(v.y & 0xffff0000u);
    o[4] = __uint_as_float(v.z << 16); o[5] = __uint_as_float(v.z & 0xffff0000u); o[6] = __uint_as_float(v.w << 16); o[7] = __uint_as_float(v.w & 0xffff0000u);
}
__device__ __forceinline__ void conv_item(const Params& p, int l, int item) {
    const int tid = otid();
    const bf16_t* proj = (const bf16_t*)(p.ws + WS_PROJ); bf16_t* mix = (bf16_t*)(p.ws + WS_MIX);
    const float* cw = p.sc_conv + (size_t)l * 3 * 256;
    const int c8 = (tid & 31) * 8;
    float w0[8], w1[8], w2[8];
#pragma unroll
    for (int i = 0; i < 8; ++i) { w0[i] = cw[c8 + i]; w1[i] = cw[256 + c8 + i]; w2[i] = cw[512 + c8 + i]; }
#pragma unroll 4
    for (int k = 0; k < 16; ++k) {
        const int rr = (tid >> 5) + 16 * k;
        const size_t row = (size_t)item * 256 + rr; const int t = (int)(row & (SEQ - 1));
        const bf16_t* pr = proj + row * PINP + 1536 + c8;
        const uint4 zz = make_uint4(0u, 0u, 0u, 0u);
        const uint4 bv = *(const uint4*)pr, c2 = *(const uint4*)(pr + 256), h2 = *(const uint4*)(pr + 512);
        const uint4 c1 = t >= 1 ? *(const uint4*)(pr + 256 - PINP) : zz, h1 = t >= 1 ? *(const uint4*)(pr + 512 - PINP) : zz;
        const uint4 c0 = t >= 2 ? *(const uint4*)(pr + 256 - 2 * PINP) : zz, h0 = t >= 2 ? *(const uint4*)(pr + 512 - 2 * PINP) : zz;
        float fb[8], fc2[8], fh2[8], fc1[8], fh1[8], fc0[8], fh0[8], y[8];
        bf8_to_f(bv, fb); bf8_to_f(c2, fc2); bf8_to_f(h2, fh2); bf8_to_f(c1, fc1); bf8_to_f(h1, fh1); bf8_to_f(c0, fc0); bf8_to_f(h0, fh0);
#pragma unroll
        for (int i = 0; i < 8; ++i) y[i] = fb[i] * (w0[i] * (fc0[i] * fh0[i]) + w1[i] * (fc1[i] * fh1[i]) + w2[i] * (fc2[i] * fh2[i]));
        uint4 o; o.x = pk_bf16(y[0], y[1]); o.y = pk_bf16(y[2], y[3]); o.z = pk_bf16(y[4], y[5]); o.w = pk_bf16(y[6], y[7]);
        *(uint4*)(mix + row * DM + 512 + c8) = o;
    }
}

template <int CTRL> __device__ __forceinline__ float dpp_f(float v) { return __int_as_float(__builtin_amdgcn_update_dpp(0, __float_as_int(v), CTRL, 0xf, 0xf, true)); }
__device__ __forceinline__ float red16(float x) { x += dpp_f<0xB1>(x); x += dpp_f<0x4E>(x); x += dpp_f<0x141>(x); x += dpp_f<0x140>(x); return x; }
__device__ __forceinline__ float fsigmoid(float x) { return __builtin_amdgcn_rcpf(1.0f + __builtin_amdgcn_exp2f(-x * LOG2E)); }
__device__ __forceinline__ float ftanh(float x) { return 1.0f - 2.0f * __builtin_amdgcn_rcpf(1.0f + __builtin_amdgcn_exp2f(x * (2.0f * LOG2E))); }
#define MF16(a, b, c) __builtin_amdgcn_mfma_f32_16x16x32_bf16(a, b, c, 0, 0, 0)
__device__ __forceinline__ bf16x8 frag_lo(const f32x4& c) { return mk_frag(pk_bf16(c[0], c[1]), pk_bf16(c[2], c[3]), 0u, 0u); }
__device__ __forceinline__ bf16x8 frag_lo_hi(const f32x4& c, uint2 hi) { return mk_frag(pk_bf16(c[0], c[1]), pk_bf16(c[2], c[3]), hi.x, hi.y); }
__device__ __forceinline__ bf16x8 frag_u2(uint2 lo, uint2 hi) { return mk_frag(lo.x, lo.y, hi.x, hi.y); }
__device__ __forceinline__ f32x4 tt64(const bf16_t* arow, const bf16_t* brow, int g, f32x4 c) {
    c = MF16(*(const bf16x8*)(arow + 8 * g), *(const bf16x8*)(brow + 8 * g), c);
    c = MF16(*(const bf16x8*)(arow + 32 + 8 * g), *(const bf16x8*)(brow + 32 + 8 * g), c);
    return c;
}
#define RW_RS 72
#define RW_TS 20
struct RwPre { uint4 cu[3], pr[3]; };
__device__ __forceinline__ int rw_col(int gq, int h) { return gq < 8 ? h * 64 + gq * 8 : gq < 16 ? 256 + h * 64 + (gq - 8) * 8 : gq < 24 ? 512 + h * 64 + (gq - 16) * 8 : 768 + (gq - 24) * 8; }
__device__ __forceinline__ void rw_prefetch(RwPre& q, const bf16_t* proj, int t0, int h, int tid) {
#pragma unroll
    for (int k = 0; k < 3; ++k) {
        const int i = tid + k * NTHREADS;
        if (i < 1280) {
            const int tt = i / 40, gq = i % 40, t = t0 + tt, col = rw_col(gq, h);
            q.cu[k] = *(const uint4*)(proj + (size_t)t * PINP + col);
            q.pr[k] = (t > 0) ? *(const uint4*)(proj + (size_t)(t - 1) * PINP + col) : make_uint4(0u, 0u, 0u, 0u);
        }
    }
}
__device__ __forceinline__ void rwkv_item(const Params& p, int l, int bh, unsigned char* lds) {
    const int tid = otid(), b = bh >> 2, h = bh & 3;
    const int lane = tid & 63, wv = tid >> 6, n = lane & 15, g = lane >> 4;
    const bf16_t* proj = (const bf16_t*)(p.ws + WS_PROJ) + (size_t)b * SEQ * PINP + 2304;
    bf16_t* mix = (bf16_t*)(p.ws + WS_MIX) + (size_t)b * SEQ * DM + 768 + h * 64;
    const float* mu = p.rw_mu + (size_t)l * 896;
    const float* vecs = p.rw_vecs + (size_t)l * 7 * 256 + h * 64;
    bf16_t* WupT = (bf16_t*)lds; bf16_t* AupT = WupT + 64 * 40; bf16_t* GupT = AupT + 64 * 40;
    float* xr = (float*)(GupT + 64 * RW_RS); float* xk = xr + 2048; float* xv = xk + 2048;
    bf16_t* XW = (bf16_t*)(xv + 2048); bf16_t* XA = XW + 32 * 40; bf16_t* XG = XA + 32 * 40;
    float* lw = (float*)(XG + 32 * RW_RS); float* ab = lw + 2048; float* kk = ab + 2048; float* gg = kk + 2048;
    float* yy = gg + 2048;
    float* pn2 = yy + 2048; float* pbo = pn2 + 128;
    bf16_t* CS = (bf16_t*)(pbo + 128);
#define RW_SET (4 * 16 * RW_RS + 3 * 64 * RW_TS + 4 * 16 * RW_TS + 128)
#define RW_KT(s_) (CS + (s_) * RW_SET)
#define RW_BT(s_) (RW_KT(s_) + 16 * RW_RS)
#define RW_KK(s_) (RW_BT(s_) + 16 * RW_RS)
#define RW_RT(s_) (RW_KK(s_) + 16 * RW_RS)
#define RW_BH(s_) (RW_RT(s_) + 16 * RW_RS)
#define RW_KH(s_) (RW_BH(s_) + 64 * RW_TS)
#define RW_VT(s_) (RW_KH(s_) + 64 * RW_TS)
#define RW_AAK(s_) (RW_VT(s_) + 64 * RW_TS)
#define RW_ARB(s_) (RW_AAK(s_) + 16 * RW_TS)
#define RW_ARK(s_) (RW_ARB(s_) + 16 * RW_TS)
#define RW_TA(s_) (RW_ARK(s_) + 16 * RW_TS)
#define RW_GC(s_) ((float*)(RW_TA(s_) + 16 * RW_TS))
    bf16_t* Sb0 = CS + 2 * RW_SET; bf16_t* Sb1 = Sb0 + 64 * RW_RS;
    __syncthreads();
    for (int i = tid; i < 2048; i += NTHREADS) { const int m = i >> 6, c = i & 63; WupT[c * 40 + m] = f2bf(p.rw_w_up[(size_t)l * 32 * 256 + m * 256 + h * 64 + c]); AupT[c * 40 + m] = f2bf(p.rw_a_up[(size_t)l * 32 * 256 + m * 256 + h * 64 + c]); }
    for (int i = tid; i < 4096; i += NTHREADS) { const int m = i >> 6, c = i & 63; GupT[c * RW_RS + m] = f2bf(p.rw_g_up[(size_t)l * 64 * 256 + m * 256 + h * 64 + c]); }
    for (int i = tid; i < 64 * RW_RS / 2; i += NTHREADS) ((unsigned*)Sb0)[i] = 0u;
    const int ptt = (tid & 255) >> 4, pc = (tid & 15) * 4, pset = tid >> 8;
    const float4 v_lg = *(const float4*)(vecs + 1280 + pc), v_lb = *(const float4*)(vecs + 1536 + pc);
    const int s2mt = wv & 1, s2c = (wv >> 1) * 16 + n;
    const float c_w0 = vecs[s2c], c_a0 = vecs[256 + s2c], c_kk = vecs[512 + s2c], c_ka = vecs[768 + s2c], c_rk = vecs[1024 + s2c];
    const int ib = wv & 3, jh = wv >> 2;
    f32x4 St0 = {0.f, 0.f, 0.f, 0.f}, St1 = {0.f, 0.f, 0.f, 0.f};
    int cur = 0;
    RwPre pre;
    rw_prefetch(pre, proj, 0, h, tid);
#pragma unroll 1
    for (int t0 = 0; t0 < SEQ; t0 += 32) {
        __syncthreads();
#pragma unroll
        for (int k = 0; k < 3; ++k) {
            const int i = tid + k * NTHREADS;
            if (i < 1280) {
                const int tt = i / 40, gq = i % 40; const int col = rw_col(gq, h);
                const uint4 cu = pre.cu[k], pr = pre.pr[k];
                const float4 m0 = *(const float4*)(mu + col), m1 = *(const float4*)(mu + col + 4);
                float o[8];
                { float c, q;
                  c = __uint_as_float(cu.x << 16); q = __uint_as_float(pr.x << 16); o[0] = c + (q - c) * m0.x;
                  c = __uint_as_float(cu.x & 0xffff0000u); q = __uint_as_float(pr.x & 0xffff0000u); o[1] = c + (q - c) * m0.y;
                  c = __uint_as_float(cu.y << 16); q = __uint_as_float(pr.y << 16); o[2] = c + (q - c) * m0.z;
                  c = __uint_as_float(cu.y & 0xffff0000u); q = __uint_as_float(pr.y & 0xffff0000u); o[3] = c + (q - c) * m0.w;
                  c = __uint_as_float(cu.z << 16); q = __uint_as_float(pr.z << 16); o[4] = c + (q - c) * m1.x;
                  c = __uint_as_float(cu.z & 0xffff0000u); q = __uint_as_float(pr.z & 0xffff0000u); o[5] = c + (q - c) * m1.y;
                  c = __uint_as_float(cu.w << 16); q = __uint_as_float(pr.w << 16); o[6] = c + (q - c) * m1.z;
                  c = __uint_as_float(cu.w & 0xffff0000u); q = __uint_as_float(pr.w & 0xffff0000u); o[7] = c + (q - c) * m1.w; }
                if (gq < 24) {
                    float* dst = gq < 8 ? xr + tt * 64 + gq * 8 : gq < 16 ? xk + tt * 64 + (gq - 8) * 8 : xv + tt * 64 + (gq - 16) * 8;
                    *(float4*)dst = make_float4(o[0], o[1], o[2], o[3]); *(float4*)(dst + 4) = make_float4(o[4], o[5], o[6], o[7]);
                } else {
                    if (gq < 28) {
#pragma unroll
                        for (int e = 0; e < 8; ++e) o[e] = ftanh(o[e]);
                    } else if (gq >= 32) {
#pragma unroll
                        for (int e = 0; e < 8; ++e) o[e] = fsigmoid(o[e]);
                    }
                    bf16_t* dst = gq < 28 ? XW + tt * 40 + (gq - 24) * 8 : gq < 32 ? XA + tt * 40 + (gq - 28) * 8 : XG + tt * RW_RS + (gq - 32) * 8;
                    uint4 w; w.x = pk_bf16(o[0], o[1]); w.y = pk_bf16(o[2], o[3]); w.z = pk_bf16(o[4], o[5]); w.w = pk_bf16(o[6], o[7]);
                    *(uint4*)dst = w;
                }
            }
        }
        if (t0 + 32 < SEQ) rw_prefetch(pre, proj, t0 + 32, h, tid);
        __syncthreads();
        {
            const f32x4 z4 = {0.f, 0.f, 0.f, 0.f};
            const int arow = s2mt * 16 + n;
            const f32x4 dec = MF16(*(const bf16x8*)(XW + arow * 40 + 8 * g), *(const bf16x8*)(WupT + s2c * 40 + 8 * g), z4);
            const f32x4 av = MF16(*(const bf16x8*)(XA + arow * 40 + 8 * g), *(const bf16x8*)(AupT + s2c * 40 + 8 * g), z4);
            const f32x4 gt = tt64(XG + arow * RW_RS, GupT + s2c * RW_RS, g, z4);
            const float dk = -0.6065306597126334f * LOG2E;
#pragma unroll
            for (int r = 0; r < 4; ++r) {
                const int tt = s2mt * 16 + 4 * g + r, i = tt * 64 + s2c;
                const float a = fsigmoid(av[r] + c_a0);
                const float kraw = xk[i], rv = xr[i];
                const float kku = kraw * c_kk, kp = kraw * (1.0f + (a - 1.0f) * c_ka);
                const float n2 = red16(kku * kku), bo = red16(rv * kp * c_rk);
                lw[i] = dk * fsigmoid(dec[r] + c_w0); gg[i] = gt[r]; kk[i] = kku; ab[i] = a; xk[i] = kp;
                if (n == 0) { pn2[tt * 4 + (wv >> 1)] = n2; pbo[tt * 4 + (wv >> 1)] = bo; }
            }
        }
        __syncthreads();
        {
            const int c3 = tid & 63, part = tid >> 6, ta = 2 * part;
#pragma unroll
            for (int cb = 0; cb < 2; ++cb) {
                const int rb = cb * 16;
                float cum = 0.f, cumA = 0.f, cumB = 0.f, lwA = 0.f, lwB = 0.f;
#pragma unroll
                for (int t = 0; t < 16; ++t) { const float lv = lw[(rb + t) * 64 + c3]; cum += lv; if (t == ta) { cumA = cum; lwA = lv; } if (t == ta + 1) { cumB = cum; lwB = lv; } }
                const int iA = (rb + ta) * 64 + c3, iB = iA + 64;
                const float4 nA = *(const float4*)(pn2 + (rb + ta) * 4), nB = *(const float4*)(pn2 + (rb + ta + 1) * 4);
                const float invA = 1.0f / fmaxf(sqrtf((nA.x + nA.y) + (nA.z + nA.w)), 1e-12f), invB = 1.0f / fmaxf(sqrtf((nB.x + nB.y) + (nB.z + nB.w)), 1e-12f);
                const float GA = __builtin_amdgcn_exp2f(cumA), GiA = __builtin_amdgcn_exp2f(-cumA), GmA = __builtin_amdgcn_exp2f(cumA - lwA), GcA = __builtin_amdgcn_exp2f(cum - cumA);
                const float GB = __builtin_amdgcn_exp2f(cumB), GiB = __builtin_amdgcn_exp2f(-cumB), GmB = __builtin_amdgcn_exp2f(cumB - lwB), GcB = __builtin_amdgcn_exp2f(cum - cumB);
                const float kkA = kk[iA] * invA, kkB = kk[iB] * invB, bA = kkA * ab[iA], bB = kkB * ab[iB], kpA = xk[iA], kpB = xk[iB], rA = xr[iA], rB = xr[iB], vA = xv[iA], vB = xv[iB];
                bf16_t* KT = RW_KT(cb);
                KT[ta * RW_RS + c3] = f2bf(kkA * GmA); KT[(ta + 1) * RW_RS + c3] = f2bf(kkB * GmB);
                RW_BT(cb)[ta * RW_RS + c3] = f2bf(bA * GiA); RW_BT(cb)[(ta + 1) * RW_RS + c3] = f2bf(bB * GiB);
                RW_KK(cb)[ta * RW_RS + c3] = f2bf(kpA * GiA); RW_KK(cb)[(ta + 1) * RW_RS + c3] = f2bf(kpB * GiB);
                RW_RT(cb)[ta * RW_RS + c3] = f2bf(rA * GA); RW_RT(cb)[(ta + 1) * RW_RS + c3] = f2bf(rB * GB);
                ((unsigned*)RW_BH(cb))[c3 * (RW_TS / 2) + part] = pk_bf16(bA * GcA, bB * GcB);
                ((unsigned*)RW_KH(cb))[c3 * (RW_TS / 2) + part] = pk_bf16(kpA * GcA, kpB * GcB);
                ((unsigned*)RW_VT(cb))[c3 * (RW_TS / 2) + part] = pk_bf16(vA, vB);
                if (part == 0) RW_GC(cb)[c3] = __builtin_amdgcn_exp2f(cum);
            }
        }
        __syncthreads();
        {
            const f32x4 z4 = {0.f, 0.f, 0.f, 0.f};
            const int role = wv & 3, cs = wv >> 2;
            const bf16_t* KT = RW_KT(cs); const bf16_t* BT = RW_BT(cs); const bf16_t* KKb = RW_KK(cs); const bf16_t* RT = RW_RT(cs);
            if (role == 0) {
                f32x4 cl = tt64(KT + n * RW_RS, BT + n * RW_RS, g, z4);
                f32x4 clt = tt64(BT + n * RW_RS, KT + n * RW_RS, g, z4);
                f32x4 U;
#pragma unroll
                for (int r = 0; r < 4; ++r) { if (!(4 * g + r > n)) cl[r] = 0.f; if (!(n > 4 * g + r)) clt[r] = 0.f; U[r] = ((4 * g + r == n) ? 1.0f : 0.0f) - clt[r]; }
                const f32x4 m2 = MF16(frag_lo(clt), frag_lo(cl), z4), m2t = MF16(frag_lo(cl), frag_lo(clt), z4);
                U = MF16(frag_lo(m2), frag_lo(U), U);
                const f32x4 m4 = MF16(frag_lo(m2t), frag_lo(m2), z4), m4t = MF16(frag_lo(m2), frag_lo(m2t), z4);
                U = MF16(frag_lo(m4), frag_lo(U), U);
                const f32x4 m8 = MF16(frag_lo(m4t), frag_lo(m4), z4);
                U = MF16(frag_lo(m8), frag_lo(U), U);
                uint2 w; w.x = pk_bf16(U[0], U[1]); w.y = pk_bf16(U[2], U[3]);
                *(uint2*)(RW_TA(cs) + n * RW_TS + 4 * g) = w;
            } else {
                const bf16_t* ar = (role == 2) ? BT : KKb; const bf16_t* br = (role == 1) ? KT : RT; bf16_t* dst = (role == 1) ? RW_AAK(cs) : (role == 2) ? RW_ARB(cs) : RW_ARK(cs);
                f32x4 c = tt64(ar + n * RW_RS, br + n * RW_RS, g, z4);
                const int lim = (role == 1) ? n : n + 1;
#pragma unroll
                for (int r = 0; r < 4; ++r) if (!(4 * g + r < lim)) c[r] = 0.f;
                uint2 w; w.x = pk_bf16(c[0], c[1]); w.y = pk_bf16(c[2], c[3]);
                *(uint2*)(dst + n * RW_TS + 4 * g) = w;
            }
        }
        __syncthreads();
#pragma unroll
        for (int cb = 0; cb < 2; ++cb) {
            const bf16_t* Sold = cur ? Sb1 : Sb0; bf16_t* Snew = cur ? Sb0 : Sb1;
            const f32x4 z4 = {0.f, 0.f, 0.f, 0.f};
            const uint2 zz = make_uint2(0u, 0u);
            const bf16_t* srow = Sold + (ib * 16 + n) * RW_RS;
            f32x4 q = tt64(RW_KT(cb) + n * RW_RS, srow, g, z4);
            const uint2 aak = *(const uint2*)(RW_AAK(cb) + n * RW_TS + 4 * g), vt = *(const uint2*)(RW_VT(cb) + (ib * 16 + n) * RW_TS + 4 * g);
            q = MF16(frag_u2(aak, zz), frag_u2(vt, zz), q);
            const uint2 ta = *(const uint2*)(RW_TA(cb) + n * RW_TS + 4 * g);
            f32x4 sa = MF16(frag_u2(ta, zz), frag_lo(q), z4);
            sa = -sa;
            const bf16x8 a3 = frag_lo_hi(sa, vt);
            {
                const int j0 = (2 * jh) * 16 + n, j1 = j0 + 16;
                const uint2 bh0 = *(const uint2*)(RW_BH(cb) + j0 * RW_TS + 4 * g), kh0 = *(const uint2*)(RW_KH(cb) + j0 * RW_TS + 4 * g);
                const uint2 bh1 = *(const uint2*)(RW_BH(cb) + j1 * RW_TS + 4 * g), kh1 = *(const uint2*)(RW_KH(cb) + j1 * RW_TS + 4 * g);
                St0 = St0 * RW_GC(cb)[j0]; St1 = St1 * RW_GC(cb)[j1];
                St0 = MF16(a3, frag_u2(bh0, kh0), St0);
                St1 = MF16(a3, frag_u2(bh1, kh1), St1);
#pragma unroll
                for (int r = 0; r < 4; ++r) { Snew[(ib * 16 + 4 * g + r) * RW_RS + j0] = f2bf(St0[r]); Snew[(ib * 16 + 4 * g + r) * RW_RS + j1] = f2bf(St1[r]); }
            }
            if (jh == 1) {
                f32x4 y = tt64(RW_RT(cb) + n * RW_RS, srow, g, z4);
                const uint2 arb = *(const uint2*)(RW_ARB(cb) + n * RW_TS + 4 * g), ark = *(const uint2*)(RW_ARK(cb) + n * RW_TS + 4 * g);
                y = MF16(frag_u2(arb, ark), a3, y);
#pragma unroll
                for (int r = 0; r < 4; ++r) yy[cb * 1024 + (4 * g + r) * 64 + ib * 16 + n] = y[r];
            }
            cur ^= 1;
            __syncthreads();
        }
        {
            const int tok = pset * 16 + ptt, i = tok * 64 + pc;
            const float4 yv = *(const float4*)(yy + pset * 1024 + ptt * 64 + pc), vv = *(const float4*)(xv + i), gv = *(const float4*)(gg + i), b4 = *(const float4*)(pbo + tok * 4);
            const float mean = red16((yv.x + yv.y) + (yv.z + yv.w)) * (1.0f / 64.0f);
            const float4 d = make_float4(yv.x - mean, yv.y - mean, yv.z - mean, yv.w - mean);
            const float var = red16((d.x * d.x + d.y * d.y) + (d.z * d.z + d.w * d.w)) * (1.0f / 64.0f);
            const float rs = rsqrtf(var + 64e-5f), bo = (b4.x + b4.y) + (b4.z + b4.w);
            uint2 w;
            w.x = pk_bf16((d.x * rs * v_lg.x + v_lb.x + bo * vv.x) * gv.x, (d.y * rs * v_lg.y + v_lb.y + bo * vv.y) * gv.y);
            w.y = pk_bf16((d.z * rs * v_lg.z + v_lb.z + bo * vv.z) * gv.z, (d.w * rs * v_lg.w + v_lb.w + bo * vv.w) * gv.w);
            *(uint2*)(mix + (size_t)(t0 + tok) * DM + pc) = w;
        }
    }
}

__device__ __forceinline__ void phase_mixers(const Params& p, int l, unsigned char* lds) {
    unsigned* ctl = (unsigned*)(p.ws + WS_CTL);
    int* slot = (int*)(lds + LDS_BYTES - 64);
#ifndef NO_RW
    for (int it = obid(); it < 128; it += gridDim.x) rwkv_item(p, l, it, lds);
#endif
    for (;;) {
        __syncthreads();
        if (otid() == 0) *slot = (int)atomicAdd(&ctl[CW_QUEUE + l * 64], 1u);
        __syncthreads();
        const int it = *slot;
        if (it >= 1024 + 1024 + 256) break;
        if (it < 1024) {
#ifndef NO_DA
            dam_item(p, l, it & 127, 7 - (it >> 7), lds);
#endif
        } else if (it < 2048) {
#ifndef NO_SB
            const int j = it - 1024; sbm_item(p, j & 127, 7 - (j >> 7), lds);
#endif
        } else conv_item(p, l, it - 2048);
    }
}

__global__ void __launch_bounds__(NTHREADS, 2) fwd(Params p) {
    extern __shared__ __attribute__((aligned(16))) unsigned char lds_raw[];
    if (threadIdx.x == 0) { ((unsigned*)lds_raw)[0] = 0u; ((unsigned*)lds_raw)[1] = 0u; ((unsigned*)lds_raw)[2] = 0u; ((unsigned*)lds_raw)[3] = 0u; }
    __syncthreads();
    unsigned char* lds = lds_raw + 16;
    XcdBarrier bar = xcd_barrier_post((unsigned*)(p.ws + WS_CTL) + CW_BAR, (volatile LAS unsigned*)lds_raw);
#ifndef ONLY
#define ONLY -1
#endif
#define PH(k) (ONLY < 0 || ONLY == (k))
    if (PH(0)) prologue(p, lds);
    xcd_barrier(bar);
    for (int l = 0; l < NLAYER; ++l) {
        if (PH(1)) phase_inproj(p, l, lds);
        xcd_barrier(bar);
        if (PH(2)) phase_mixers(p, l, lds);
        xcd_barrier(bar);
        if (PH(3)) phase_outproj(p, l, lds);
        xcd_barrier(bar);
        if (PH(4)) phase_ln1_route(p, l, lds);
        xcd_barrier(bar);
        if (PH(5)) phase_moe_up(p, l, lds);
        xcd_barrier(bar);
        if (PH(6)) phase_moe_down(p, l, lds);
        xcd_barrier(bar);
        if (PH(7)) phase_ln2(p, l, lds);
        xcd_barrier(bar);
    }
}

extern "C" void kernel_launch(void* const* d_in, const int* in_sizes, int n_in, void* d_out, int out_size, void* d_ws, size_t ws_size, hipStream_t stream) {
    static int grid = 0;
    if (grid == 0) {
        if (n_in != 18 || in_sizes[0] != NTOK * DM || out_size != NTOK * DM || ws_size < WS_END) {
            fprintf(stderr, "kernel_launch: unexpected shapes: n_in %d in0 %d out %d ws %zu (need %llu)\n", n_in, n_in > 0 ? in_sizes[0] : -1, out_size, ws_size, (unsigned long long)WS_END);
            grid = -1; return;
        }
        int dev = 0, cus = 0, per_cu = 0;
        hipGetDevice(&dev);
        hipDeviceGetAttribute(&cus, hipDeviceAttributeMultiprocessorCount, dev);
        hipFuncSetAttribute((const void*)fwd, hipFuncAttributeMaxDynamicSharedMemorySize, LDS_BYTES);
        hipOccupancyMaxActiveBlocksPerMultiprocessor(&per_cu, (const void*)fwd, NTHREADS, LDS_BYTES);
        if (per_cu < 1) { fprintf(stderr, "kernel_launch: occupancy query says %d blocks per CU\n", per_cu); grid = -1; return; }
        grid = cus;
    }
    if (grid < 0) return;
    Params p{};
    p.x = (const float*)d_in[0]; p.w_in = (const float*)d_in[1]; p.w_out = (const float*)d_in[2]; p.da_lambda = (const float*)d_in[3]; p.da_subln = (const float*)d_in[4];
    p.sc_conv = (const float*)d_in[5]; p.rw_mu = (const float*)d_in[6]; p.rw_vecs = (const float*)d_in[7]; p.rw_w_up = (const float*)d_in[8]; p.rw_a_up = (const float*)d_in[9];
    p.rw_g_up = (const float*)d_in[10]; p.ln_gain = (const float*)d_in[11]; p.ln_bias = (const float*)d_in[12]; p.rel_bias = (const float*)d_in[13]; p.router_w = (const float*)d_in[14];
    p.router_b = (const float*)d_in[15]; p.moe_w_in = (const float*)d_in[16]; p.moe_w_down = (const float*)d_in[17];
    p.out = (float*)d_out; p.ws = (unsigned char*)d_ws;
    hipMemsetAsync((char*)d_ws + WS_CTL, 0, CTL_BYTES, stream);
    hipLaunchKernelGGL(fwd, dim3(grid), dim3(NTHREADS), LDS_BYTES, stream, p);
}
```

```cpp
#include <hip/hip_runtime.h>
#include <cstdio>
#include <cstdint>

typedef unsigned short bf16_t;
typedef short bf16x8 __attribute__((ext_vector_type(8)));
typedef float f32x4 __attribute__((ext_vector_type(4)));

#define NTOK 65536
#define SEQ 2048
#define DM 1024
#define PIN 3200
#define PINP 3328
#define NLAYER 4
#define NEXP 16
#define DEXP 256
#define NTHREADS 512
#define LDS_BYTES (152 * 1024)
#define ALPHA 1.6817928305074292f
#define LOG2E 1.4426950408889634f

#define WS_CTL 0ull
#define CTL_BYTES 65536ull
#define WS_BIASD (WS_CTL + CTL_BYTES)
#define WS_WIN (WS_BIASD + 4ull * 2048 * 4)
#define WS_WOUT (WS_WIN + 4ull * PINP * DM * 2)
#define WS_MWIN (WS_WOUT + 4ull * DM * DM * 2)
#define WS_MWDN (WS_MWIN + 4ull * 16 * 512 * 1024 * 2)
#define WS_XB (WS_MWDN + 4ull * 16 * 1024 * 256 * 2)
#define WS_MIX (WS_XB + (unsigned long long)NTOK * DM * 2)
#define WS_LTOK (WS_MIX + (unsigned long long)NTOK * DM * 2)
#define WS_LGATE (WS_LTOK + 16ull * NTOK * 4)
#define WS_PROJ (WS_LGATE + 16ull * NTOK * 4)
#define WS_YB WS_PROJ
#define WS_Y WS_PROJ
#define WS_H (WS_Y + (unsigned long long)(2 * NTOK + 256) * DM * 2)
#define WS_END (WS_PROJ + (unsigned long long)NTOK * PINP * 2)

#define CW_BAR 0
#define CW_CNT 4096
#define CW_QUEUE 8192

#define XB_TMO      128
#define XB_XCNT(j)  (256  + 64 * (j))
#define XB_XSUB(j)  (1280 + 64 * (j))
#define XB_XGEN(j)  (2304 + 64 * (j))
#define XB_TOP      3328
#define XB_TOPGEN   3392
#define XCD_BAR_WORDS 3456
#define XB_SPIN_CAP (1u << 22)
#define LAS __attribute__((address_space(3)))

__device__ __forceinline__ unsigned xb_ld(unsigned* p)              { return __hip_atomic_load(p, __ATOMIC_RELAXED, __HIP_MEMORY_SCOPE_AGENT); }
__device__ __forceinline__ unsigned xb_add(unsigned* p, unsigned v) { return __hip_atomic_fetch_add(p, v, __ATOMIC_RELAXED, __HIP_MEMORY_SCOPE_AGENT); }
__device__ __forceinline__ unsigned xb_xcc_id() { return (unsigned)__builtin_amdgcn_s_getreg((3 << 11) | 20) & 0xFu; }
#define XB_SPIN(cond, bar) do { unsigned _sp = 0; while (cond) { __builtin_amdgcn_s_sleep(1); \
    if ((++_sp & 255u) == 0u) { if (xb_ld(&(bar)[XB_TMO])) break; if (_sp > XB_SPIN_CAP) { atomicAdd(&(bar)[XB_TMO], 1u); break; } } } } while (0)

struct XcdBarrier { unsigned* bar; unsigned x; volatile LAS unsigned* st; };

__device__ __forceinline__ XcdBarrier xcd_barrier_post(unsigned* bar, volatile LAS unsigned* st) {
    XcdBarrier b; b.bar = bar; b.x = xb_xcc_id(); b.st = st;
    if (threadIdx.x == 0) (void)xb_add(&bar[XB_XCNT(b.x)], 1u);
    return b;
}
__device__ __forceinline__ void xcd_barrier_complete(unsigned* bar, unsigned x, unsigned& nloc, unsigned& nx) {
    const unsigned G = gridDim.x * gridDim.y * gridDim.z;
    unsigned sum, cnt, mine, sp = 0u;
    for (;;) {
        sum = 0u; cnt = 0u; mine = 0u;
#pragma unroll
        for (unsigned j = 0; j < 16; ++j) { const unsigned c = xb_ld(&bar[XB_XCNT(j)]); sum += c; cnt += (c > 0u) ? 1u : 0u; mine = (j == x) ? c : mine; }
        if (sum == G) break;
        __builtin_amdgcn_s_sleep(1);
        if ((++sp & 255u) == 0u) { if (xb_ld(&bar[XB_TMO])) break; if (sp > XB_SPIN_CAP) { atomicAdd(&bar[XB_TMO], 1u); break; } }
    }
    nloc = mine > 0u ? mine : 1u; nx = cnt > 0u ? cnt : 1u;
}
__device__ __forceinline__ void xcd_barrier(const XcdBarrier& b) {
    asm volatile("s_waitcnt vmcnt(0)" ::: "memory");
    __syncthreads();
    if (threadIdx.x == 0) {
        unsigned* bar = b.bar;
        __builtin_amdgcn_s_waitcnt(0);
        const unsigned bx = xb_xcc_id();
        unsigned nloc = b.st[0], nx = b.st[1];
        if (nloc == 0u) { xcd_barrier_complete(bar, bx, nloc, nx); b.st[0] = nloc; b.st[1] = nx; }
        const unsigned old = xb_add(&bar[XB_XSUB(bx)], 1u);
        const unsigned gen = old / nloc;
        if (old + 1u == (gen + 1u) * nloc) {
            __builtin_amdgcn_fence(__ATOMIC_RELEASE, "agent");
            asm volatile("s_waitcnt vmcnt(0)" ::: "memory");
            const unsigned og = xb_add(&bar[XB_TOP], 1u);
            const unsigned tg = og / nx;
            if (og + 1u == (tg + 1u) * nx) xb_add(&bar[XB_TOPGEN], 1u);
            else XB_SPIN(xb_ld(&bar[XB_TOPGEN]) == tg, bar);
            __builtin_amdgcn_fence(__ATOMIC_ACQUIRE, "agent");
            xb_add(&bar[XB_XGEN(bx)], 1u);
            asm volatile("s_waitcnt vmcnt(0)" ::: "memory");
        } else {
            XB_SPIN(xb_ld(&bar[XB_XGEN(bx)]) == gen, bar);
            __builtin_amdgcn_fence(__ATOMIC_ACQUIRE, "agent");
            asm volatile("s_waitcnt vmcnt(0)" ::: "memory");
        }
    }
    __syncthreads();
}

__device__ __forceinline__ int otid() { int t = threadIdx.x; asm volatile("" : "+v"(t)); return t; }
__device__ __forceinline__ int obid() { int t = blockIdx.x; asm volatile("" : "+s"(t)); return t; }
__device__ __forceinline__ float bf2f(bf16_t v) { return __uint_as_float(((unsigned)v) << 16); }
__device__ __forceinline__ bf16_t f2bf(float f) { unsigned u = __float_as_uint(f); u += 0x7fffu + ((u >> 16) & 1u); return (bf16_t)(u >> 16); }
__device__ __forceinline__ float sigmoidf_(float x) { return 1.0f / (1.0f + expf(-x)); }
template <int CTRL> __device__ __forceinline__ float dppw_f(float v) { return __int_as_float(__builtin_amdgcn_update_dpp(0, __float_as_int(v), CTRL, 0xf, 0xf, true)); }
__device__ __forceinline__ float wave_sum(float v) {
    v += dppw_f<0xB1>(v); v += dppw_f<0x4E>(v); v += dppw_f<0x141>(v); v += dppw_f<0x140>(v);
    const float r0 = __int_as_float(__builtin_amdgcn_readlane(__float_as_int(v), 0)), r1 = __int_as_float(__builtin_amdgcn_readlane(__float_as_int(v), 16));
    const float r2 = __int_as_float(__builtin_amdgcn_readlane(__float_as_int(v), 32)), r3 = __int_as_float(__builtin_amdgcn_readlane(__float_as_int(v), 48));
    return (r0 + r1) + (r2 + r3);
}

struct Params {
    const float* x; const float* w_in; const float* w_out; const float* da_lambda; const float* da_subln; const float* sc_conv;
    const float* rw_mu; const float* rw_vecs; const float* rw_w_up; const float* rw_a_up; const float* rw_g_up;
    const float* ln_gain; const float* ln_bias; const float* rel_bias; const float* router_w; const float* router_b;
    const float* moe_w_in; const float* moe_w_down;
    float* out; unsigned char* ws;
};

namespace pg8 {
#define PG8_LAS __attribute__((address_space(3)))
typedef unsigned short bf16_t;
typedef short bf16x8 __attribute__((ext_vector_type(8)));
typedef float f32x4 __attribute__((ext_vector_type(4)));
typedef unsigned u32x4 __attribute__((ext_vector_type(4)));
constexpr int BM = 256, BK = 64, HALF = 128, HTB = HALF * BK * 2  , STAGE_BYTES = 8 * HTB, NXCD = 8, WGM = 8;

__host__ __device__ __forceinline__ int lds_byte(int r, int c) { const int st = (r >> 4) * 2 + (c >> 5), rr = r & 15, cc = c & 31, ob = rr * 64 + cc * 2; return st * 1024 + (ob ^ (((ob >> 9) & 1) << 5)); }
__host__ __device__ __forceinline__ void stage_rc(int b, int& R, int& C) { const int st = b / 1024, sb = b % 1024, swz = sb ^ (((sb >> 9) & 1) << 5); R = (st >> 1) * 16 + swz / 64; C = (st & 1) * 32 + (swz % 64) / 2; }
__host__ __device__ __forceinline__ int perm32(int rho) { const int n = rho >> 4, i = rho & 15; return 8 * (i >> 2) + 4 * n + (i & 3); }

struct Unit { int pm, pn; };
struct Gemm { const bf16_t* A; const bf16_t* Bt; int M, N, K; };

struct StaticOrder {
    int nM, nN, nwg, G, c;
    __host__ __device__ void init(int M, int N, int G_, int c_) { nM = M / BM; nN = N / BM; nwg = nM * nN; G = G_; c = c_; }
    __host__ __device__ bool next(int i, Unit& u) const {
        const long L = (long)i * G + c; if (L >= nwg) return false;
        int wgid = (int)L; { const int q = nwg / NXCD, r = nwg % NXCD, xcd = wgid % NXCD, off = wgid / NXCD; wgid = (xcd < r ? xcd * (q + 1) : r * (q + 1) + (xcd - r) * q) + off; }
        const int nig = WGM * nN, gid = wgid / nig, fm = gid * WGM, gsz = (nM - fm) < WGM ? (nM - fm) : WGM;
        u.pm = fm + ((wgid % nig) % gsz); u.pn = (wgid % nig) / gsz; return true;
    }
    __device__ __forceinline__ void a_ready(const Unit&) const {}
    __device__ __forceinline__ void done(const Unit&) const {}
};
__device__ __forceinline__ unsigned cvt_pk_bf16(float lo, float hi) { unsigned r; asm volatile("v_cvt_pk_bf16_f32 %0, %1, %2" : "=v"(r) : "v"(lo), "v"(hi)); return r; }
template <class Epi, class Sched, bool ALIGN_EPI = false, bool SP2 = false>
__device__ __forceinline__ void gemm_phase(PG8_LAS unsigned char* lds, const Gemm g, const Sched& S, const Epi& E) {
    const int tid = otid(), wid = __builtin_amdgcn_readfirstlane(tid >> 6), lane = tid & 63, wr = wid >> 2, wc = wid & 3, fr = lane & 15, fq = lane >> 4;
    const int K = g.K, nt = K / BK;
    unsigned voffA[2], voffB[2];
#pragma unroll
    for (int i = 0; i < 2; ++i) { int R, C; stage_rc(tid * 16 + i * 8192, R, C); const int Rb = Epi::PERM ? ((R & ~31) + perm32(R & 31)) : R;
        voffA[i] = (unsigned)(R * K + C) * 2u; voffB[i] = (unsigned)(Rb * K + C) * 2u; }
    const size_t kstep = (size_t)(BK * 2);
    const size_t hstep = (size_t)HALF * K * 2;
    const size_t tstep = 2 * hstep;
    const unsigned ldsw = (unsigned)wid * 1024u;
    const int aoff = lds_byte(wr * 64 + fr, fq * 8), boff = lds_byte(wc * 32 + fr, fq * 8);
#define PG8_SA(b, h) (((b) * 2 + (h)) * HTB)
#define PG8_SB(b, h) ((4 + (b) * 2 + (h)) * HTB)
#define PG8_STAGE(bufoff, gbase, voff) do { _Pragma("unroll") for (int _i = 0; _i < 2; ++_i) \
        __builtin_amdgcn_global_load_lds((const unsigned*)((const char*)(gbase) + (voff)[_i]), (PG8_LAS unsigned*)(lds + (bufoff) + ldsw + _i * 8192), 16, 0, 0); } while (0)
#define PG8_LDA(dst, b, h) do { _Pragma("unroll") for (int m = 0; m < 4; ++m) _Pragma("unroll") for (int k = 0; k < 2; ++k) dst[m][k] = *(const PG8_LAS bf16x8*)(lds + PG8_SA(b, h) + aoff + m * 2048 + k * 1024); } while (0)
#define PG8_LDB(dst, b, h) do { _Pragma("unroll") for (int n = 0; n < 2; ++n) _Pragma("unroll") for (int k = 0; k < 2; ++k) dst[n][k] = *(const PG8_LAS bf16x8*)(lds + PG8_SB(b, h) + boff + n * 2048 + k * 1024); } while (0)
#define PG8_MMA(ai, bj, At, Bt) do { __builtin_amdgcn_s_setprio(1); _Pragma("unroll") for (int m = 0; m < 4; ++m) _Pragma("unroll") for (int n = 0; n < 2; ++n) _Pragma("unroll") for (int k = 0; k < 2; ++k) \
        acc[ai][bj][m][n] = __builtin_amdgcn_mfma_f32_16x16x32_bf16(Bt[n][k], At[m][k], acc[ai][bj][m][n], 0, 0, 0); __builtin_amdgcn_s_setprio(0); } while (0)
#define PG8_WAIT_V(n) asm volatile("s_waitcnt vmcnt(" #n ")" ::: "memory")
#define PG8_WAIT_L(n) asm volatile("s_waitcnt lgkmcnt(" #n ")" ::: "memory")
#define PG8_BAR __builtin_amdgcn_s_barrier()
#define PG8_SCHED __builtin_amdgcn_sched_barrier(0)
    Unit cur, nxt; int ui = 0;
    if (!S.next(0, cur)) return;
    f32x4 acc[2][2][4][2];
#pragma unroll
    for (int a = 0; a < 2; ++a)
#pragma unroll
        for (int b = 0; b < 2; ++b)
#pragma unroll
            for (int m = 0; m < 4; ++m)
#pragma unroll
                for (int n = 0; n < 2; ++n) acc[a][b][m][n] = (f32x4){0.f, 0.f, 0.f, 0.f};
    bf16x8 At[4][2], B0[2][2], B1[2][2];
    const char* cA = (const char*)g.A + (size_t)cur.pm * tstep; const char* cB = (const char*)g.Bt + (size_t)cur.pn * tstep;
    S.a_ready(cur);
    if constexpr (SP2) {
        PG8_STAGE(PG8_SB(0, 0), cB, voffB); PG8_STAGE(PG8_SB(0, 1), cB + hstep, voffB); PG8_STAGE(PG8_SA(0, 0), cA, voffA); PG8_STAGE(PG8_SA(0, 1), cA + hstep, voffA);
        if (wr == 1) PG8_BAR;
        PG8_WAIT_V(2); PG8_BAR;
        PG8_STAGE(PG8_SB(1, 0), cB + kstep, voffB); PG8_STAGE(PG8_SA(1, 0), cA + kstep, voffA); PG8_STAGE(PG8_SB(1, 1), cB + hstep + kstep, voffB);
        PG8_WAIT_V(6); PG8_BAR;
    } else {
        PG8_STAGE(PG8_SB(0, 0), cB, voffB); PG8_STAGE(PG8_SA(0, 0), cA, voffA); PG8_STAGE(PG8_SB(0, 1), cB + hstep, voffB); PG8_STAGE(PG8_SA(0, 1), cA + hstep, voffA);
        if (wr == 1) PG8_BAR;
        PG8_WAIT_V(4); PG8_BAR;
        PG8_STAGE(PG8_SB(1, 0), cB + kstep, voffB); PG8_STAGE(PG8_SA(1, 0), cA + kstep, voffA); PG8_STAGE(PG8_SB(1, 1), cB + hstep + kstep, voffB);
        PG8_WAIT_V(6); PG8_BAR;
    }
    for (;;) {
        const bool has_next = S.next(ui + 1, nxt);
        const char* nA = has_next ? (const char*)g.A + (size_t)nxt.pm * tstep : cA; const char* nB = has_next ? (const char*)g.Bt + (size_t)nxt.pn * tstep : cB;
        for (int t = 0; t < nt; t += 2) {
            const bool last = (t == nt - 2);
            const char* a1 = cA + (size_t)(t + 1) * kstep;
            const char* a2 = last ? nA : cA + (size_t)(t + 2) * kstep; const char* b2 = last ? nB : cB + (size_t)(t + 2) * kstep;
            const char* a3 = a2 + kstep; const char* b3 = b2 + kstep;
            if (last && has_next) S.a_ready(nxt);
            if constexpr (SP2) {
            PG8_LDB(B0, 0, 0); PG8_LDB(B1, 0, 1); PG8_SCHED; PG8_LDA(At, 0, 0); PG8_STAGE(PG8_SA(1, 1), a1 + hstep, voffA);
            PG8_WAIT_V(8); PG8_WAIT_L(0); PG8_BAR; PG8_MMA(0, 0, At, B0); PG8_MMA(0, 1, At, B1); PG8_BAR; PG8_SCHED;
            PG8_LDA(At, 0, 1); PG8_STAGE(PG8_SB(0, 0), b2, voffB); PG8_STAGE(PG8_SB(0, 1), b2 + hstep, voffB); PG8_STAGE(PG8_SA(0, 0), a2, voffA);
            PG8_WAIT_V(8); PG8_WAIT_L(0); PG8_BAR; PG8_MMA(1, 0, At, B0); PG8_MMA(1, 1, At, B1); PG8_BAR; PG8_SCHED;
            PG8_LDB(B0, 1, 0); PG8_LDB(B1, 1, 1); PG8_SCHED; PG8_LDA(At, 1, 0); PG8_STAGE(PG8_SA(0, 1), a2 + hstep, voffA);
            PG8_WAIT_V(8); PG8_WAIT_L(0); PG8_BAR; PG8_MMA(0, 0, At, B0); PG8_MMA(0, 1, At, B1); PG8_BAR; PG8_SCHED;
            PG8_LDA(At, 1, 1); PG8_STAGE(PG8_SB(1, 0), b3, voffB); PG8_STAGE(PG8_SB(1, 1), b3 + hstep, voffB); PG8_STAGE(PG8_SA(1, 0), a3, voffA);
            PG8_WAIT_V(8); PG8_WAIT_L(0); PG8_BAR; PG8_MMA(1, 0, At, B0); PG8_MMA(1, 1, At, B1); PG8_BAR; PG8_SCHED;
            } else {
            PG8_LDB(B0, 0, 0); PG8_SCHED; PG8_LDA(At, 0, 0); PG8_STAGE(PG8_SA(1, 1), a1 + hstep, voffA);
            PG8_WAIT_L(8); PG8_BAR; PG8_WAIT_L(0); PG8_MMA(0, 0, At, B0); PG8_BAR; PG8_SCHED;
            PG8_LDB(B1, 0, 1); PG8_STAGE(PG8_SB(0, 0), b2, voffB);
            PG8_BAR; PG8_WAIT_L(0); PG8_MMA(0, 1, At, B1); PG8_BAR;
            PG8_LDA(At, 0, 1); PG8_STAGE(PG8_SA(0, 0), a2, voffA);
            PG8_BAR; PG8_WAIT_L(0); PG8_MMA(1, 0, At, B0); PG8_BAR; PG8_SCHED;
            PG8_STAGE(PG8_SB(0, 1), b2 + hstep, voffB);
            PG8_WAIT_V(6); PG8_BAR; PG8_MMA(1, 1, At, B1); PG8_BAR;
            PG8_LDB(B0, 1, 0); PG8_SCHED; PG8_LDA(At, 1, 0); PG8_STAGE(PG8_SA(0, 1), a2 + hstep, voffA);
            PG8_WAIT_L(8); PG8_BAR; PG8_WAIT_L(0); PG8_MMA(0, 0, At, B0); PG8_BAR; PG8_SCHED;
            PG8_LDB(B1, 1, 1); PG8_STAGE(PG8_SB(1, 0), b3, voffB);
            PG8_BAR; PG8_WAIT_L(0); PG8_MMA(0, 1, At, B1); PG8_BAR;
            PG8_LDA(At, 1, 1); PG8_STAGE(PG8_SA(1, 0), a3, voffA);
            PG8_BAR; PG8_WAIT_L(0); PG8_MMA(1, 0, At, B0); PG8_BAR; PG8_SCHED;
            PG8_STAGE(PG8_SB(1, 1), b3 + hstep, voffB);
            PG8_WAIT_V(6); PG8_BAR; PG8_MMA(1, 1, At, B1); PG8_BAR;
            }
        }
        if constexpr (ALIGN_EPI) { if (wr == 0) PG8_BAR; }
        if constexpr (!Epi::AFTER_DRAIN) { E(acc, cur, wr, wc, fr, fq); S.done(cur); }
        if (!has_next) break;
#pragma unroll
        for (int a = 0; a < 2; ++a)
#pragma unroll
            for (int b = 0; b < 2; ++b)
#pragma unroll
                for (int m = 0; m < 4; ++m)
#pragma unroll
                    for (int n = 0; n < 2; ++n) acc[a][b][m][n] = (f32x4){0.f, 0.f, 0.f, 0.f};
        cur = nxt; cA = nA; cB = nB; ++ui;
        if constexpr (ALIGN_EPI) { if (wr == 1) PG8_BAR; }
    }
    PG8_WAIT_V(0);
    if constexpr (!ALIGN_EPI) { if (wr == 0) PG8_BAR; }
    PG8_BAR;
    if constexpr (Epi::AFTER_DRAIN) { E.fused(acc, cur, wr, wc, fr, fq, lds, wid, lane); S.done(cur); }
#undef PG8_SA
#undef PG8_SB
#undef PG8_STAGE
#undef PG8_LDA
#undef PG8_LDB
#undef PG8_MMA
#undef PG8_WAIT_V
#undef PG8_WAIT_L
#undef PG8_BAR
#undef PG8_SCHED
}
}

namespace pg8 {
template <class Epi, class Sched, bool GATHER>
__device__ __forceinline__ void gemm_phase_g(PG8_LAS unsigned char* lds, const int K, const Sched& S, const Epi& E) {
    typedef typename Sched::Unit UnitT;
    const int tid = otid(), wid = __builtin_amdgcn_readfirstlane(tid >> 6), lane = tid & 63, wr = wid >> 2, wc = wid & 3, fr = lane & 15, fq = lane >> 4;
    const int nt = K / BK;
    unsigned voffB[2];
#pragma unroll
    for (int i = 0; i < 2; ++i) { int R, C; stage_rc(tid * 16 + i * 8192, R, C); const int Rb = Epi::PERM ? ((R & ~31) + perm32(R & 31)) : R; voffB[i] = (unsigned)(Rb * K + C) * 2u; }
#define PG8_AOFF(unit, o0, o1) do { const int _tz = otid(); _Pragma("unroll") for (int _i = 0; _i < 2; ++_i) { int _R, _C; stage_rc(_tz * 16 + _i * 8192, _R, _C); \
        o0[_i] = S.arow_off(unit, _R) + (unsigned)_C * 2u; o1[_i] = S.arow_off(unit, HALF + _R) + (unsigned)_C * 2u; } } while (0)
    const size_t kstep = (size_t)(BK * 2);
    const size_t hstep = (size_t)HALF * K * 2;
    const unsigned ldsw = (unsigned)wid * 1024u;
    const int aoff = lds_byte(wr * 64 + fr, fq * 8), boff = lds_byte(wc * 32 + fr, fq * 8);
#define PG8_SA(b, h) (((b) * 2 + (h)) * HTB)
#define PG8_SB(b, h) ((4 + (b) * 2 + (h)) * HTB)
#define PG8_STAGE(bufoff, gbase, voff) do { _Pragma("unroll") for (int _i = 0; _i < 2; ++_i) \
        __builtin_amdgcn_global_load_lds((const unsigned*)((const char*)(gbase) + (voff)[_i]), (PG8_LAS unsigned*)(lds + (bufoff) + ldsw + _i * 8192), 16, 0, 0); } while (0)
#define PG8_LDA(dst, b, h) do { _Pragma("unroll") for (int m = 0; m < 4; ++m) _Pragma("unroll") for (int k = 0; k < 2; ++k) dst[m][k] = *(const PG8_LAS bf16x8*)(lds + PG8_SA(b, h) + aoff + m * 2048 + k * 1024); } while (0)
#define PG8_LDB(dst, b, h) do { _Pragma("unroll") for (int n = 0; n < 2; ++n) _Pragma("unroll") for (int k = 0; k < 2; ++k) dst[n][k] = *(const PG8_LAS bf16x8*)(lds + PG8_SB(b, h) + boff + n * 2048 + k * 1024); } while (0)
#define PG8_MMA(ai, bj, At, Bt) do { __builtin_amdgcn_s_setprio(1); _Pragma("unroll") for (int m = 0; m < 4; ++m) _Pragma("unroll") for (int n = 0; n < 2; ++n) _Pragma("unroll") for (int k = 0; k < 2; ++k) \
        acc[ai][bj][m][n] = __builtin_amdgcn_mfma_f32_16x16x32_bf16(Bt[n][k], At[m][k], acc[ai][bj][m][n], 0, 0, 0); __builtin_amdgcn_s_setprio(0); } while (0)
#define PG8_WAIT_V(n) asm volatile("s_waitcnt vmcnt(" #n ")" ::: "memory")
#define PG8_WAIT_L(n) asm volatile("s_waitcnt lgkmcnt(" #n ")" ::: "memory")
#define PG8_BAR __builtin_amdgcn_s_barrier()
#define PG8_SCHED __builtin_amdgcn_sched_barrier(0)
    UnitT cur, nxt; int ui = 0;
    if (!S.next(0, cur)) return;
    f32x4 acc[2][2][4][2];
#pragma unroll
    for (int a = 0; a < 2; ++a)
#pragma unroll
        for (int b = 0; b < 2; ++b)
#pragma unroll
            for (int m = 0; m < 4; ++m)
#pragma unroll
                for (int n = 0; n < 2; ++n) acc[a][b][m][n] = (f32x4){0.f, 0.f, 0.f, 0.f};
    bf16x8 At[4][2], B0[2][2], B1[2][2];
    unsigned cvo0[2], cvo1[2];
    PG8_AOFF(cur, cvo0, cvo1);
    const char* cA = S.abase(cur); const char* cB = S.bbase(cur);
    PG8_STAGE(PG8_SB(0, 0), cB, voffB); PG8_STAGE(PG8_SB(0, 1), cB + hstep, voffB); PG8_STAGE(PG8_SA(0, 0), cA, cvo0); PG8_STAGE(PG8_SA(0, 1), cA, cvo1);
    if (wr == 1) PG8_BAR;
    PG8_WAIT_V(2); PG8_BAR;
    PG8_STAGE(PG8_SB(1, 0), cB + kstep, voffB); PG8_STAGE(PG8_SA(1, 0), cA + kstep, cvo0); PG8_STAGE(PG8_SB(1, 1), cB + hstep + kstep, voffB);
    PG8_WAIT_V(6); PG8_BAR;
#pragma unroll 1
    for (;;) {
        const bool has_next = S.next(ui + 1, nxt);
        const char* nA = has_next ? S.abase(nxt) : cA; const char* nB = has_next ? S.bbase(nxt) : cB;
        unsigned v20[2], v21[2];
#pragma unroll 1
        for (int t = 0; t < nt; t += 2) {
            const bool last = (t == nt - 2);
            const char* a1 = cA + (size_t)(t + 1) * kstep;
            const char* a2 = last ? nA : cA + (size_t)(t + 2) * kstep; const char* b2 = last ? nB : cB + (size_t)(t + 2) * kstep;
            const char* a3 = a2 + kstep; const char* b3 = b2 + kstep;
            if (GATHER && last && has_next) { PG8_AOFF(nxt, v20, v21); }
            else {
#pragma unroll
                for (int i = 0; i < 2; ++i) { v20[i] = cvo0[i]; v21[i] = cvo1[i]; } }
            PG8_LDB(B0, 0, 0); PG8_LDB(B1, 0, 1); PG8_SCHED; PG8_LDA(At, 0, 0); PG8_STAGE(PG8_SA(1, 1), a1, cvo1);
            PG8_WAIT_V(8); PG8_WAIT_L(0); PG8_BAR; PG8_MMA(0, 0, At, B0); PG8_MMA(0, 1, At, B1); PG8_BAR; PG8_SCHED;
            PG8_LDA(At, 0, 1); PG8_STAGE(PG8_SB(0, 0), b2, voffB); PG8_STAGE(PG8_SB(0, 1), b2 + hstep, voffB); PG8_STAGE(PG8_SA(0, 0), a2, v20);
            PG8_WAIT_V(8); PG8_WAIT_L(0); PG8_BAR; PG8_MMA(1, 0, At, B0); PG8_MMA(1, 1, At, B1); PG8_BAR; PG8_SCHED;
            PG8_LDB(B0, 1, 0); PG8_LDB(B1, 1, 1); PG8_SCHED; PG8_LDA(At, 1, 0); PG8_STAGE(PG8_SA(0, 1), a2, v21);
            PG8_WAIT_V(8); PG8_WAIT_L(0); PG8_BAR; PG8_MMA(0, 0, At, B0); PG8_MMA(0, 1, At, B1); PG8_BAR; PG8_SCHED;
            PG8_LDA(At, 1, 1); PG8_STAGE(PG8_SB(1, 0), b3, voffB); PG8_STAGE(PG8_SB(1, 1), b3 + hstep, voffB); PG8_STAGE(PG8_SA(1, 0), a3, v20);
            PG8_WAIT_V(8); PG8_WAIT_L(0); PG8_BAR; PG8_MMA(1, 0, At, B0); PG8_MMA(1, 1, At, B1); PG8_BAR; PG8_SCHED;
        }
        if (wr == 0) PG8_BAR;
        E(acc, cur, wr, wc, fr, fq);
        if (!has_next) break;
#pragma unroll
        for (int a = 0; a < 2; ++a)
#pragma unroll
            for (int b = 0; b < 2; ++b)
#pragma unroll
                for (int m = 0; m < 4; ++m)
#pragma unroll
                    for (int n = 0; n < 2; ++n) acc[a][b][m][n] = (f32x4){0.f, 0.f, 0.f, 0.f};
        cur = nxt; cA = nA; cB = nB; ++ui;
#pragma unroll
        for (int i = 0; i < 2; ++i) { cvo0[i] = v20[i]; cvo1[i] = v21[i]; }
        if (wr == 1) PG8_BAR;
    }
    PG8_WAIT_V(0);
    PG8_BAR;
#undef PG8_AOFF
#undef PG8_SA
#undef PG8_SB
#undef PG8_STAGE
#undef PG8_LDA
#undef PG8_LDB
#undef PG8_MMA
#undef PG8_WAIT_V
#undef PG8_WAIT_L
#undef PG8_BAR
#undef PG8_SCHED
}
}

template <int MODE>
__device__ __forceinline__ void transpose_tile(const float* __restrict__ src, bf16_t* __restrict__ dst, int K, int N, int k0, int n0, float* tile  ) {
    const int tid = otid();
    const int c = tid & 63, r0 = tid >> 6;
    __syncthreads();
    if (n0 < N) {
#pragma unroll
        for (int i = 0; i < 8; ++i) { const int kk = r0 + i * 8; tile[kk * 65 + c] = src[(size_t)(k0 + kk) * N + n0 + c]; }
    } else {
#pragma unroll
        for (int i = 0; i < 8; ++i) { const int kk = r0 + i * 8; tile[kk * 65 + c] = 0.f; }
    }
    __syncthreads();
#pragma unroll
    for (int i = 0; i < 8; ++i) {
        const int nn = r0 + i * 8; int n = n0 + nn;
        if (MODE == 1) { const int j = n & 255; const int isu = n >> 8; n = (j >> 4) * 32 + isu * 16 + (j & 15); }
        dst[(size_t)n * K + k0 + c] = f2bf(tile[c * 65 + nn]);
    }
}

__device__ __forceinline__ void prologue(const Params& p, unsigned char* lds) {
    float* tile = (float*)lds;
    const int G = gridDim.x, w = obid(), tid = otid();
    bf16_t* win = (bf16_t*)(p.ws + WS_WIN); bf16_t* wout = (bf16_t*)(p.ws + WS_WOUT);
    bf16_t* mwin = (bf16_t*)(p.ws + WS_MWIN); bf16_t* mwdn = (bf16_t*)(p.ws + WS_MWDN);
    for (int it = w; it < 4 * 16 * 52; it += G) { const int l = it / (16 * 52), r = it % (16 * 52), kt = r / 52, nt = r % 52;
        transpose_tile<0>(p.w_in + (size_t)l * DM * PIN, win + (size_t)l * PINP * DM, DM, PIN, kt * 64, nt * 64, tile); }
    for (int it = w; it < 4 * 16 * 16; it += G) { const int l = it / 256, r = it % 256, kt = r / 16, nt = r % 16;
        transpose_tile<0>(p.w_out + (size_t)l * DM * DM, wout + (size_t)l * DM * DM, DM, DM, kt * 64, nt * 64, tile); }
    for (int it = w; it < 64 * 16 * 8; it += G) { const int le = it / 128, r = it % 128, kt = r / 8, nt = r % 8;
        transpose_tile<1>(p.moe_w_in + (size_t)le * 1024 * 512, mwin + (size_t)le * 512 * 1024, 1024, 512, kt * 64, nt * 64, tile); }
    for (int it = w; it < 64 * 4 * 16; it += G) { const int le = it / 64, r = it % 64, kt = r / 16, nt = r % 16;
        transpose_tile<0>(p.moe_w_down + (size_t)le * 256 * 1024, mwdn + (size_t)le * 1024 * 256, 256, 1024, kt * 64, nt * 64, tile); }
    {
        bf16_t* xb = (bf16_t*)(p.ws + WS_XB);
        const size_t n4 = (size_t)NTOK * DM / 4;
        for (size_t i = (size_t)w * NTHREADS + tid; i < n4; i += (size_t)G * NTHREADS) {
            const float4 v = ((const float4*)p.x)[i];
            ushort4 o; o.x = f2bf(v.x); o.y = f2bf(v.y); o.z = f2bf(v.z); o.w = f2bf(v.w);
            ((ushort4*)xb)[i] = o;
        }
    }
    {
        float* bd = (float*)(p.ws + WS_BIASD);
        for (int i = w * NTHREADS + tid; i < 4 * 2048; i += G * NTHREADS) {
            const int h = i >> 11, n = i & 2047;
            int bucket;
            if (n < 16) bucket = n;
            else { const float nf = (float)n; int lg = 16 + (int)(logf(nf / 16.0f) / 2.0794415416798357f * 16.0f); bucket = lg < 31 ? lg : 31; }
            bd[i] = p.rel_bias[bucket * 4 + h];
        }
    }
}

template <class ARow, class Epi>
__device__ __forceinline__ void gemm128(unsigned char* lds, const ARow& arow, const bf16_t* __restrict__ bt, int K, const Epi& epi) {
    const int tid = otid(), lane = tid & 63, wid = tid >> 6, wm = wid >> 1, wn = wid & 1;
    const int lr = tid >> 2, lc = (tid & 3) * 8;
    bf16_t* As = (bf16_t*)lds; bf16_t* Bs = (bf16_t*)(lds + 10240);
    const bf16_t* ap = arow(lr) + lc;
    const bf16_t* bp = bt + (size_t)lr * K + lc;
    f32x4 acc[2][4];
#pragma unroll
    for (int m = 0; m < 2; ++m)
#pragma unroll
        for (int n = 0; n < 4; ++n) acc[m][n] = (f32x4){0.f, 0.f, 0.f, 0.f};
    uint4 ra = *(const uint4*)ap, rb = *(const uint4*)bp;
    const int fr = lane & 15, fq = lane >> 4;
    for (int k0 = 0; k0 < K; k0 += 32) {
        __syncthreads();
        *(uint4*)(As + lr * 40 + lc) = ra;
        *(uint4*)(Bs + lr * 40 + lc) = rb;
        __syncthreads();
        if (k0 + 32 < K) { ra = *(const uint4*)(ap + k0 + 32); rb = *(const uint4*)(bp + k0 + 32); }
        bf16x8 a[2], b[4];
#pragma unroll
        for (int m = 0; m < 2; ++m) a[m] = *(const bf16x8*)(As + (wm * 32 + m * 16 + fr) * 40 + fq * 8);
#pragma unroll
        for (int n = 0; n < 4; ++n) b[n] = *(const bf16x8*)(Bs + (wn * 64 + n * 16 + fr) * 40 + fq * 8);
#pragma unroll
        for (int m = 0; m < 2; ++m)
#pragma unroll
            for (int n = 0; n < 4; ++n) acc[m][n] = __builtin_amdgcn_mfma_f32_16x16x32_bf16(a[m], b[n], acc[m][n], 0, 0, 0);
    }
    epi(acc, wm, wn, lane);
}

struct RowContig { const bf16_t* base; int ld; __device__ __forceinline__ const bf16_t* operator()(int r) const { return base + (size_t)r * ld; } };

struct EpiProjP {
    static constexpr bool PERM = true, AFTER_DRAIN = false;
    bf16_t* O;
    __device__ __forceinline__ void operator()(const pg8::f32x4 (&acc)[2][2][4][2], const pg8::Unit& u, int wr, int wc, int fr, int fq) const {
        const int row0 = u.pm * 256 + wr * 64 + fr, col0 = u.pn * 256 + wc * 32 + 8 * fq;
#pragma unroll
        for (int ai = 0; ai < 2; ++ai)
#pragma unroll
            for (int m = 0; m < 4; ++m) { bf16_t* rowp = O + (size_t)(row0 + ai * 128 + m * 16) * PINP + col0;
#pragma unroll
                for (int bj = 0; bj < 2; ++bj) { const pg8::f32x4 v0 = acc[ai][bj][m][0], v1 = acc[ai][bj][m][1];
                    pg8::u32x4 w; w.x = pg8::cvt_pk_bf16(v0[0], v0[1]); w.y = pg8::cvt_pk_bf16(v0[2], v0[3]); w.z = pg8::cvt_pk_bf16(v1[0], v1[1]); w.w = pg8::cvt_pk_bf16(v1[2], v1[3]);
                    *(pg8::u32x4*)(rowp + bj * 128) = w; } }
    }
};
__device__ __forceinline__ void phase_inproj(const Params& p, int l, unsigned char* lds) {
    pg8::Gemm g{(const bf16_t*)(p.ws + WS_XB), (const bf16_t*)(p.ws + WS_WIN) + (size_t)l * PINP * DM, NTOK, PINP, DM};
    pg8::StaticOrder S; S.init(NTOK, PINP, (int)gridDim.x, obid());
    EpiProjP E{(bf16_t*)(p.ws + WS_PROJ)};
    pg8::gemm_phase<EpiProjP, pg8::StaticOrder, true, true>((PG8_LAS unsigned char*)lds, g, S, E);
}

struct EpiOutP {
    static constexpr bool PERM = true, AFTER_DRAIN = false;
    const float* xf; const bf16_t* xh; bf16_t* out;
    __device__ __forceinline__ void operator()(const pg8::f32x4 (&acc)[2][2][4][2], const pg8::Unit& u, int wr, int wc, int fr, int fq) const {
        const int row0 = u.pm * 256 + wr * 64 + fr, col0 = u.pn * 256 + wc * 32 + 8 * fq;
#pragma unroll
        for (int ai = 0; ai < 2; ++ai)
#pragma unroll
            for (int m = 0; m < 4; ++m) { const size_t ro = (size_t)(row0 + ai * 128 + m * 16) * DM + col0;
#pragma unroll
                for (int bj = 0; bj < 2; ++bj) { const size_t o = ro + bj * 128;
                    float xv[8];
                    if (xf) { const pg8::f32x4 a = *(const pg8::f32x4*)(xf + o), b = *(const pg8::f32x4*)(xf + o + 4); xv[0] = a[0]; xv[1] = a[1]; xv[2] = a[2]; xv[3] = a[3]; xv[4] = b[0]; xv[5] = b[1]; xv[6] = b[2]; xv[7] = b[3]; }
                    else { const pg8::u32x4 r = *(const pg8::u32x4*)(xh + o); xv[0] = __uint_as_float(r.x << 16); xv[1] = __uint_as_float(r.x & 0xffff0000u); xv[2] = __uint_as_float(r.y << 16); xv[3] = __uint_as_float(r.y & 0xffff0000u);
                        xv[4] = __uint_as_float(r.z << 16); xv[5] = __uint_as_float(r.z & 0xffff0000u); xv[6] = __uint_as_float(r.w << 16); xv[7] = __uint_as_float(r.w & 0xffff0000u); }
                    const pg8::f32x4 v0 = acc[ai][bj][m][0], v1 = acc[ai][bj][m][1];
                    pg8::u32x4 w; w.x = pg8::cvt_pk_bf16(ALPHA * xv[0] + v0[0], ALPHA * xv[1] + v0[1]); w.y = pg8::cvt_pk_bf16(ALPHA * xv[2] + v0[2], ALPHA * xv[3] + v0[3]);
                    w.z = pg8::cvt_pk_bf16(ALPHA * xv[4] + v1[0], ALPHA * xv[5] + v1[1]); w.w = pg8::cvt_pk_bf16(ALPHA * xv[6] + v1[2], ALPHA * xv[7] + v1[3]);
                    *(pg8::u32x4*)(out + o) = w; } }
    }
};
__device__ __forceinline__ void phase_outproj(const Params& p, int l, unsigned char* lds) {
    pg8::Gemm g{(const bf16_t*)(p.ws + WS_MIX), (const bf16_t*)(p.ws + WS_WOUT) + (size_t)l * DM * DM, NTOK, DM, DM};
    pg8::StaticOrder S; S.init(NTOK, DM, (int)gridDim.x, obid());
    EpiOutP E{(l == 0) ? p.x : nullptr, (const bf16_t*)(p.ws + WS_XB), (bf16_t*)(p.ws + WS_YB)};
    pg8::gemm_phase<EpiOutP, pg8::StaticOrder, true, true>((PG8_LAS unsigned char*)lds, g, S, E);
}

__device__ __forceinline__ void ln_row(float (&v)[16], const float* gain, const float* bias, int lane) {
    float s = 0.f;
#pragma unroll
    for (int i = 0; i < 16; ++i) s += v[i];
    s = wave_sum(s);
    const float mean = s * (1.0f / 1024.0f);
    float q = 0.f;
#pragma unroll
    for (int i = 0; i < 16; ++i) { const float d = v[i] - mean; q += d * d; }
    q = wave_sum(q);
    const float rstd = rsqrtf(q * (1.0f / 1024.0f) + 1e-5f);
#pragma unroll
    for (int j = 0; j < 4; ++j) {
        const float4 g = *(const float4*)(gain + j * 256 + lane * 4), b = *(const float4*)(bias + j * 256 + lane * 4);
        v[j * 4 + 0] = (v[j * 4 + 0] - mean) * rstd * g.x + b.x; v[j * 4 + 1] = (v[j * 4 + 1] - mean) * rstd * g.y + b.y;
        v[j * 4 + 2] = (v[j * 4 + 2] - mean) * rstd * g.z + b.z; v[j * 4 + 3] = (v[j * 4 + 3] - mean) * rstd * g.w + b.w;
    }
}
__device__ __forceinline__ void load_row_bf(float (&v)[16], const bf16_t* src, int lane) {
#pragma unroll
    for (int j = 0; j < 4; ++j) { const ushort4 t = *(const ushort4*)(src + j * 256 + lane * 4); v[j * 4] = bf2f(t.x); v[j * 4 + 1] = bf2f(t.y); v[j * 4 + 2] = bf2f(t.z); v[j * 4 + 3] = bf2f(t.w); }
}
__device__ __forceinline__ void store_row_bf(const float (&v)[16], bf16_t* xbo, int lane) {
#pragma unroll
    for (int j = 0; j < 4; ++j) { ushort4 o; o.x = f2bf(v[j * 4]); o.y = f2bf(v[j * 4 + 1]); o.z = f2bf(v[j * 4 + 2]); o.w = f2bf(v[j * 4 + 3]); *(ushort4*)(xbo + j * 256 + lane * 4) = o; }
}
__device__ __forceinline__ void store_row(const float (&v)[16], float* xo, bf16_t* xbo, int lane) {
#pragma unroll
    for (int j = 0; j < 4; ++j) {
        *(float4*)(xo + j * 256 + lane * 4) = make_float4(v[j * 4], v[j * 4 + 1], v[j * 4 + 2], v[j * 4 + 3]);
        ushort4 o; o.x = f2bf(v[j * 4]); o.y = f2bf(v[j * 4 + 1]); o.z = f2bf(v[j * 4 + 2]); o.w = f2bf(v[j * 4 + 3]);
        *(ushort4*)(xbo + j * 256 + lane * 4) = o;
    }
}

__device__ __forceinline__ void route_pick(const float (&lg)[16], const float* rb, int& i1, int& i2, float& g1, float& g2) {
    float aff[16], sl[16];
#pragma unroll
    for (int e = 0; e < 16; ++e) { aff[e] = sigmoidf_(lg[e]); sl[e] = aff[e] + rb[e]; }
    float bestg = -INFINITY; int bg = 0;
#pragma unroll
    for (int g = 0; g < 4; ++g) {
        float m1 = -INFINITY, m2 = -INFINITY;
#pragma unroll
        for (int k = 0; k < 4; ++k) { const float s = sl[g * 4 + k]; if (s > m1) { m2 = m1; m1 = s; } else if (s > m2) m2 = s; }
        const float gs = m1 + m2;
        if (gs > bestg) { bestg = gs; bg = g; }
    }
    float b1 = -INFINITY; i1 = 0; float a1 = 0.f;
#pragma unroll
    for (int e = 0; e < 16; ++e) { const bool in = (e >> 2) == bg; if (in && sl[e] > b1) { b1 = sl[e]; i1 = e; a1 = aff[e]; } }
    float b2 = -INFINITY; i2 = 0; float a2 = 0.f;
#pragma unroll
    for (int e = 0; e < 16; ++e) { const bool in = ((e >> 2) == bg) && (e != i1); if (in && sl[e] > b2) { b2 = sl[e]; i2 = e; a2 = aff[e]; } }
    const float inv = 1.0f / (a1 + a2);
    g1 = a1 * inv; g2 = a2 * inv;
}
__device__ __forceinline__ float rs16(const float (&v)[16], int lane) {
    float a8[8];
    const bool b0 = lane & 1, b1 = lane & 2, b2 = lane & 4, b3 = lane & 8;
#pragma unroll
    for (int i = 0; i < 8; ++i) { const float keep = b0 ? v[i + 8] : v[i], give = b0 ? v[i] : v[i + 8]; a8[i] = keep + dppw_f<0xB1>(give); }
    float a4[4];
#pragma unroll
    for (int i = 0; i < 4; ++i) { const float keep = b1 ? a8[i + 4] : a8[i], give = b1 ? a8[i] : a8[i + 4]; a4[i] = keep + dppw_f<0x4E>(give); }
    float a2[2];
#pragma unroll
    for (int i = 0; i < 2; ++i) { const float keep = b2 ? a4[i + 2] : a4[i], give = b2 ? a4[i] : a4[i + 2]; a2[i] = keep + __shfl_xor(give, 4); }
    const float keep = b3 ? a2[1] : a2[0], give = b3 ? a2[0] : a2[1];
    return keep + __shfl_xor(give, 8);
}
__device__ __forceinline__ void phase_ln1_route(const Params& p, int l, unsigned char* lds) {
    const int tid = otid(), lane = tid & 63, wid = tid >> 6;
    int* sel_e = (int*)lds;
    float* sel_g = (float*)(lds + 2048);
    int* rank = (int*)(lds + 4096);
    int* base = (int*)(lds + 6144);
    float* rwT = (float*)(lds + 8192);
    float* lgs = (float*)(lds + 8192 + 65536);
    bf16_t* xb = (bf16_t*)(p.ws + WS_XB); const bf16_t* yb = (const bf16_t*)(p.ws + WS_YB);
    unsigned* ctl = (unsigned*)(p.ws + WS_CTL);
    int* ltok = (int*)(p.ws + WS_LTOK);
    const float* gain = p.ln_gain + (size_t)(l * 2 + 0) * DM; const float* bias = p.ln_bias + (size_t)(l * 2 + 0) * DM;
    __syncthreads();
    for (int i = tid; i < 16384; i += NTHREADS) { const int c = i >> 4, e = i & 15; rwT[e * 1024 + c] = p.router_w[i]; }
    for (int chunk = obid(); chunk < NTOK / 256; chunk += gridDim.x) {
        __syncthreads();
        float v0[16], v1[16];
        { const size_t row = (size_t)chunk * 256 + wid * 32; load_row_bf(v0, yb + row * DM, lane); load_row_bf(v1, yb + (row + 1) * DM, lane); }
#pragma unroll 1
        for (int rr = 0; rr < 32; rr += 2) {
            const int lrow = wid * 32 + rr; const size_t row = (size_t)chunk * 256 + lrow;
            float n0[16], n1[16];
            if (rr + 2 < 32) { load_row_bf(n0, yb + (row + 2) * DM, lane); load_row_bf(n1, yb + (row + 3) * DM, lane); }
            ln_row(v0, gain, bias, lane); ln_row(v1, gain, bias, lane);
            store_row_bf(v0, xb + row * DM, lane); store_row_bf(v1, xb + (row + 1) * DM, lane);
            float lg0[16], lg1[16];
#pragma unroll
            for (int e = 0; e < 16; ++e) {
                float s0 = 0.f, s1 = 0.f;
#pragma unroll
                for (int j = 0; j < 4; ++j) { const float4 w = *(const float4*)(rwT + e * 1024 + j * 256 + lane * 4);
                    s0 += v0[j * 4] * w.x + v0[j * 4 + 1] * w.y + v0[j * 4 + 2] * w.z + v0[j * 4 + 3] * w.w;
                    s1 += v1[j * 4] * w.x + v1[j * 4 + 1] * w.y + v1[j * 4 + 2] * w.z + v1[j * 4 + 3] * w.w; }
                lg0[e] = s0; lg1[e] = s1;
            }
            float r0 = rs16(lg0, lane), r1 = rs16(lg1, lane);
            r0 += __shfl_xor(r0, 16); r0 += __shfl_xor(r0, 32); r1 += __shfl_xor(r1, 16); r1 += __shfl_xor(r1, 32);
            if (lane < 16) { const int e = 8 * (lane & 1) + 4 * ((lane >> 1) & 1) + 2 * ((lane >> 2) & 1) + ((lane >> 3) & 1); lgs[lrow * 16 + e] = r0; lgs[(lrow + 1) * 16 + e] = r1; }
#pragma unroll
            for (int i = 0; i < 16; ++i) { v0[i] = n0[i]; v1[i] = n1[i]; }
        }
        __syncthreads();
        if (tid < 256) {
            float lg[16];
#pragma unroll
            for (int q = 0; q < 4; ++q) { const float4 t = *(const float4*)(lgs + tid * 16 + q * 4); lg[q * 4] = t.x; lg[q * 4 + 1] = t.y; lg[q * 4 + 2] = t.z; lg[q * 4 + 3] = t.w; }
            int i1, i2; float g1, g2;
            route_pick(lg, p.router_b, i1, i2, g1, g2);
            sel_e[tid * 2] = i1; sel_e[tid * 2 + 1] = i2; sel_g[tid * 2] = g1; sel_g[tid * 2 + 1] = g2;
        }
        __syncthreads();
        int my_e, my_rank;
        {
            my_e = sel_e[tid]; my_rank = 0;
            const unsigned long long lt = (1ull << lane) - 1ull;
#pragma unroll
            for (int e = 0; e < 16; ++e) {
                const unsigned long long m = __ballot(my_e == e);
                if (my_e == e) my_rank = __popcll(m & lt);
                if (lane == 0) rank[wid * 16 + e] = __popcll(m);
            }
        }
        __syncthreads();
        if (tid < 16) {
            int c = 0;
#pragma unroll
            for (int w = 0; w < 8; ++w) { const int t = rank[w * 16 + tid]; rank[w * 16 + tid] = c; c += t; }
            base[tid] = (int)atomicAdd(&ctl[CW_CNT + (l * 16 + tid) * 64], (unsigned)c);
        }
        __syncthreads();
        {
            const int e = my_e; const int pos = base[e] + rank[wid * 16 + e] + my_rank;
            ltok[(size_t)e * NTOK + pos] = chunk * 256 + (tid >> 1);
            int* ti = (int*)(p.ws + WS_LGATE) + (size_t)(chunk * 256 + (tid >> 1)) * 4;
            ti[tid & 1] = (e << 17) | pos; ((float*)ti)[2 + (tid & 1)] = sel_g[tid];
        }
    }
}

#define MOE_TAB_OFF 131072
#define MOE_META_OFF (131072 + 4096)
struct MoeUnit { int e, rl, pn, n, ui, pb; };
__device__ __forceinline__ void moe_meta(const Params& p, int l, PG8_LAS int* meta) {
    if (otid() == 0) {
        unsigned* ctl = (unsigned*)(p.ws + WS_CTL);
        int tb = 0, pb = 0;
        for (int e = 0; e < 16; ++e) { const int c = (int)xb_ld(&ctl[CW_CNT + (l * 16 + e) * 64]); meta[e] = c; meta[16 + e] = tb; meta[33 + e] = pb; tb += (c + 255) >> 8; pb += c; }
        meta[32] = tb; meta[49] = pb;
    }
    __syncthreads();
}
template <int NCOL_LOG2>
struct MoeSchedBase {
    typedef MoeUnit Unit;
    PG8_LAS const int* meta; int G, c;
    __device__ __forceinline__ int mu(int idx) const { return __builtin_amdgcn_readfirstlane(meta[idx]); }
    __device__ __forceinline__ bool next(int i, MoeUnit& u) const {
        const int L = i * G + c; const int ntile = mu(32);
        if (L >= (ntile << NCOL_LOG2)) return false;
        const int rt = L >> NCOL_LOG2; u.pn = L & ((1 << NCOL_LOG2) - 1);
        int e = 0;
#pragma unroll
        for (int k = 1; k < 16; ++k) if (rt >= mu(16 + k)) e = k;
        u.e = e; u.rl = rt - mu(16 + e); u.n = mu(e) - u.rl * 256; u.pb = mu(33 + e) + u.rl * 256; u.ui = i; return true;
    }
};
struct MoeSchedUp : MoeSchedBase<1> {
    PG8_LAS const unsigned short* tok16; const char* xb; const char* wbase;
    __device__ __forceinline__ const char* abase(const MoeUnit&) const { return xb; }
    __device__ __forceinline__ unsigned arow_off(const MoeUnit& u, int r) const { return (unsigned)tok16[u.ui * 256 + r] * 2048u; }
    __device__ __forceinline__ const char* bbase(const MoeUnit& u) const { return wbase + ((size_t)u.e * 512 + u.pn * 256) * 2048; }
};
struct MoeSchedDown : MoeSchedBase<2> {
    const char* hb; const char* wbase;
    __device__ __forceinline__ const char* abase(const MoeUnit& u) const { return hb + (size_t)u.pb * 512; }
    __device__ __forceinline__ unsigned arow_off(const MoeUnit&, int r) const { return (unsigned)r * 512u; }
    __device__ __forceinline__ const char* bbase(const MoeUnit& u) const { return wbase + ((size_t)u.e * 1024 + u.pn * 256) * 512; }
};
struct EpiUp {
    static constexpr bool PERM = false, AFTER_DRAIN = false;
    bf16_t* H;
    __device__ __forceinline__ void operator()(const pg8::f32x4 (&acc)[2][2][4][2], const MoeUnit& u, int wr, int wc, int fr, int fq) const {
        bf16_t* hb = H + u.pn * 128 + wc * 16 + fq * 4;
#pragma unroll
        for (int ai = 0; ai < 2; ++ai)
#pragma unroll
            for (int m = 0; m < 4; ++m) {
                const int r = ai * 128 + wr * 64 + m * 16 + fr;
                const int rr = (r < u.n) ? (u.pb + r) : (2 * NTOK + r);
#pragma unroll
                for (int bj = 0; bj < 2; ++bj) {
                    const pg8::f32x4 g = acc[ai][bj][m][0], uu = acc[ai][bj][m][1];
                    float hv[4];
#pragma unroll
                    for (int i = 0; i < 4; ++i) hv[i] = g[i] * __builtin_amdgcn_rcpf(1.0f + __builtin_amdgcn_exp2f(-g[i] * LOG2E)) * uu[i];
                    uint2 w; w.x = pg8::cvt_pk_bf16(hv[0], hv[1]); w.y = pg8::cvt_pk_bf16(hv[2], hv[3]);
                    *(uint2*)(hb + (size_t)rr * DEXP + bj * 64) = w;
                }
            }
    }
};
struct EpiDown {
    static constexpr bool PERM = true, AFTER_DRAIN = false;
    bf16_t* Y;
    __device__ __forceinline__ void operator()(const pg8::f32x4 (&acc)[2][2][4][2], const MoeUnit& u, int wr, int wc, int fr, int fq) const {
        bf16_t* yb = Y + u.pn * 256 + wc * 32 + 8 * fq;
#pragma unroll
        for (int ai = 0; ai < 2; ++ai)
#pragma unroll
            for (int m = 0; m < 4; ++m) {
                const int r = ai * 128 + wr * 64 + m * 16 + fr;
                const int rr = (r < u.n) ? (u.pb + r) : (2 * NTOK + r);
#pragma unroll
                for (int bj = 0; bj < 2; ++bj) { const pg8::f32x4 v0 = acc[ai][bj][m][0], v1 = acc[ai][bj][m][1];
                    pg8::u32x4 w; w.x = pg8::cvt_pk_bf16(v0[0], v0[1]); w.y = pg8::cvt_pk_bf16(v0[2], v0[3]); w.z = pg8::cvt_pk_bf16(v1[0], v1[1]); w.w = pg8::cvt_pk_bf16(v1[2], v1[3]);
                    *(pg8::u32x4*)(yb + (size_t)rr * DM + bj * 128) = w; }
            }
    }
};
__device__ __forceinline__ void phase_moe_up(const Params& p, int l, unsigned char* lds) {
    PG8_LAS unsigned char* L = (PG8_LAS unsigned char*)lds;
    PG8_LAS int* meta = (PG8_LAS int*)(L + MOE_META_OFF);
    PG8_LAS unsigned short* tok16 = (PG8_LAS unsigned short*)(L + MOE_TAB_OFF);
    __syncthreads();
    moe_meta(p, l, meta);
    MoeSchedUp S; S.meta = meta; S.G = (int)gridDim.x; S.c = obid(); S.tok16 = tok16; S.xb = (const char*)(p.ws + WS_XB); S.wbase = (const char*)(p.ws + WS_MWIN) + (size_t)l * 16 * 512 * 2048;
    {
        const int* ltok = (const int*)(p.ws + WS_LTOK); const int tid = otid();
        MoeUnit u;
        for (int i = 0; i < 8 && S.next(i, u); ++i)
            if (tid < 256) tok16[i * 256 + tid] = (tid < u.n) ? (unsigned short)ltok[(size_t)u.e * NTOK + u.rl * 256 + tid] : (unsigned short)0;
    }
    __syncthreads();
    EpiUp E{(bf16_t*)(p.ws + WS_H)};
    pg8::gemm_phase_g<EpiUp, MoeSchedUp, true>(L, 1024, S, E);
}
__device__ __forceinline__ void phase_moe_down(const Params& p, int l, unsigned char* lds) {
    PG8_LAS unsigned char* L = (PG8_LAS unsigned char*)lds;
    PG8_LAS int* meta = (PG8_LAS int*)(L + MOE_META_OFF);
    __syncthreads();
    moe_meta(p, l, meta);
    MoeSchedDown S; S.meta = meta; S.G = (int)gridDim.x; S.c = obid(); S.hb = (const char*)(p.ws + WS_H); S.wbase = (const char*)(p.ws + WS_MWDN) + (size_t)l * 16 * 1024 * 512;
    EpiDown E{(bf16_t*)(p.ws + WS_Y)};
    pg8::gemm_phase_g<EpiDown, MoeSchedDown, false>(L, 256, S, E);
}

__device__ __forceinline__ void phase_ln2(const Params& p, int l, unsigned char* lds) {
    const int tid = otid(), lane = tid & 63, wid = tid >> 6;
    bf16_t* xb = (bf16_t*)(p.ws + WS_XB); const bf16_t* Y = (const bf16_t*)(p.ws + WS_Y);
    const float* gain = p.ln_gain + (size_t)(l * 2 + 1) * DM; const float* bias = p.ln_bias + (size_t)(l * 2 + 1) * DM;
    int* pbase = (int*)lds;
    __syncthreads();
    if (tid == 0) { unsigned* ctl = (unsigned*)(p.ws + WS_CTL); int pb = 0; for (int e = 0; e < 16; ++e) { pbase[e] = pb; pb += (int)xb_ld(&ctl[CW_CNT + (l * 16 + e) * 64]); } }
    __syncthreads();
    const size_t rstep = (size_t)gridDim.x * 8;
    size_t row = (size_t)obid() * 8 + wid;
    ushort4 cx[4], c0[4], c1[4]; float g0 = 0.f, g1 = 0.f;
    if (row < NTOK) {
        const int4 ti = *(const int4*)(p.ws + WS_LGATE + row * 16);
        const size_t p0 = (size_t)(pbase[ti.x >> 17] + (ti.x & 0x1ffff)), p1 = (size_t)(pbase[ti.y >> 17] + (ti.y & 0x1ffff));
        g0 = __int_as_float(ti.z); g1 = __int_as_float(ti.w);
#pragma unroll
        for (int j = 0; j < 4; ++j) { cx[j] = *(const ushort4*)(xb + row * DM + j * 256 + lane * 4); c0[j] = *(const ushort4*)(Y + p0 * DM + j * 256 + lane * 4); c1[j] = *(const ushort4*)(Y + p1 * DM + j * 256 + lane * 4); }
    }
#pragma unroll 1
    for (; row < NTOK; row += rstep) {
        const size_t nrow = row + rstep;
        ushort4 nx[4], n0[4], n1[4]; float ng0 = 0.f, ng1 = 0.f;
        if (nrow < NTOK) {
            const int4 ti = *(const int4*)(p.ws + WS_LGATE + nrow * 16);
            const size_t p0 = (size_t)(pbase[ti.x >> 17] + (ti.x & 0x1ffff)), p1 = (size_t)(pbase[ti.y >> 17] + (ti.y & 0x1ffff));
            ng0 = __int_as_float(ti.z); ng1 = __int_as_float(ti.w);
#pragma unroll
            for (int j = 0; j < 4; ++j) { nx[j] = *(const ushort4*)(xb + nrow * DM + j * 256 + lane * 4); n0[j] = *(const ushort4*)(Y + p0 * DM + j * 256 + lane * 4); n1[j] = *(const ushort4*)(Y + p1 * DM + j * 256 + lane * 4); }
        }
        float v[16];
#pragma unroll
        for (int j = 0; j < 4; ++j) {
            v[j * 4 + 0] = ALPHA * bf2f(cx[j].x) + g0 * bf2f(c0[j].x) + g1 * bf2f(c1[j].x); v[j * 4 + 1] = ALPHA * bf2f(cx[j].y) + g0 * bf2f(c0[j].y) + g1 * bf2f(c1[j].y);
            v[j * 4 + 2] = ALPHA * bf2f(cx[j].z) + g0 * bf2f(c0[j].z) + g1 * bf2f(c1[j].z); v[j * 4 + 3] = ALPHA * bf2f(cx[j].w) + g0 * bf2f(c0[j].w) + g1 * bf2f(c1[j].w);
        }
        ln_row(v, gain, bias, lane);
        if (l == NLAYER - 1) store_row(v, p.out + row * DM, xb + row * DM, lane); else store_row_bf(v, xb + row * DM, lane);
#pragma unroll
        for (int j = 0; j < 4; ++j) { cx[j] = nx[j]; c0[j] = n0[j]; c1[j] = n1[j]; }
        g0 = ng0; g1 = ng1;
    }
}

__device__ __forceinline__ void sb_item(const Params& p, int bh, int qc, unsigned char* lds) {
    const int tid = otid(), b = bh >> 2, h = bh & 3;
    const bf16_t* proj = (const bf16_t*)(p.ws + WS_PROJ) + (size_t)b * SEQ * PINP;
    bf16_t* mix = (bf16_t*)(p.ws + WS_MIX) + (size_t)b * SEQ * DM;
    float* Ks = (float*)lds; float* Vs = (float*)(lds + 16384);
    const int t = qc * 512 + tid; const int twmax = qc * 512 + (tid | 63);
    float q[64], acc[64];
#pragma unroll
    for (int d8 = 0; d8 < 8; ++d8) { const uint4 raw = *(const uint4*)(proj + (size_t)t * PINP + h * 64 + d8 * 8); const bf16_t* rp = (const bf16_t*)&raw;
#pragma unroll
        for (int i = 0; i < 8; ++i) q[d8 * 8 + i] = bf2f(rp[i]) * 0.125f; }
#pragma unroll
    for (int d = 0; d < 64; ++d) acc[d] = 0.f;
    float cs = 0.f;
    for (int kb = qc * 8 + 7; kb >= 0; --kb) {
        __syncthreads();
        { const int key = tid >> 3, d8 = tid & 7; const size_t ro = (size_t)(kb * 64 + key) * PINP + h * 64 + d8 * 8;
          const uint4 rk = *(const uint4*)(proj + ro + 256), rv = *(const uint4*)(proj + ro + 512); const bf16_t* pk = (const bf16_t*)&rk; const bf16_t* pv = (const bf16_t*)&rv;
#pragma unroll
          for (int i = 0; i < 8; ++i) { Ks[key * 64 + d8 * 8 + i] = bf2f(pk[i]); Vs[key * 64 + d8 * 8 + i] = bf2f(pv[i]); } }
        __syncthreads();
        if (kb * 64 < twmax) {
            for (int sl = 63; sl >= 0; --sl) {
                const int s = kb * 64 + sl;
                if (s < t) {
                    float z = 0.f;
#pragma unroll
                    for (int d4 = 0; d4 < 16; ++d4) { const float4 kv = *(const float4*)(Ks + sl * 64 + d4 * 4); z += q[d4 * 4] * kv.x + q[d4 * 4 + 1] * kv.y + q[d4 * 4 + 2] * kv.z + q[d4 * 4 + 3] * kv.w; }
                    const float sp = fmaxf(z, 0.f) + log1pf(expf(-fabsf(z)));
                    cs += sp;
                    const float w = expf(z - cs);
#pragma unroll
                    for (int d4 = 0; d4 < 16; ++d4) { const float4 vv = *(const float4*)(Vs + sl * 64 + d4 * 4); acc[d4 * 4] += w * vv.x; acc[d4 * 4 + 1] += w * vv.y; acc[d4 * 4 + 2] += w * vv.z; acc[d4 * 4 + 3] += w * vv.w; }
                }
            }
        }
    }
#pragma unroll
    for (int d8 = 0; d8 < 8; ++d8) { uint4 o; bf16_t* op = (bf16_t*)&o;
#pragma unroll
        for (int i = 0; i < 8; ++i) op[i] = f2bf(acc[d8 * 8 + i]);
        *(uint4*)(mix + (size_t)t * DM + h * 64 + d8 * 8) = o; }
}

__device__ __forceinline__ void da_item(const Params& p, int l, int bh, int qc, unsigned char* lds) {
    const int tid = otid(), b = bh >> 2, h = bh & 3, map = tid >> 8, row = tid & 255;
    const bf16_t* proj = (const bf16_t*)(p.ws + WS_PROJ) + (size_t)b * SEQ * PINP;
    bf16_t* mix = (bf16_t*)(p.ws + WS_MIX) + (size_t)b * SEQ * DM;
    const float* biasd = (const float*)(p.ws + WS_BIASD) + h * 2048;
    float* Ks = (float*)lds; float* Vs = (float*)(lds + 16384); float* Bd = (float*)(lds + 32768); float* Ex = (float*)(lds + 40960);
    const int t = qc * 256 + row; const int twmax = qc * 256 + (row | 63);
    __syncthreads();
    for (int i = tid; i < 2048; i += NTHREADS) Bd[i] = biasd[i];
    float q[32], O[64];
#pragma unroll
    for (int d8 = 0; d8 < 4; ++d8) { const uint4 raw = *(const uint4*)(proj + (size_t)t * PINP + 768 + h * 64 + map * 32 + d8 * 8); const bf16_t* rp = (const bf16_t*)&raw;
#pragma unroll
        for (int i = 0; i < 8; ++i) q[d8 * 8 + i] = bf2f(rp[i]) * 0.17677669529663687f; }
#pragma unroll
    for (int d = 0; d < 64; ++d) O[d] = 0.f;
    float mrun = -INFINITY, lsum = 0.f;
    for (int kb = 0; kb <= qc * 4 + 3; ++kb) {
        __syncthreads();
        { const int key = tid >> 3, d8 = tid & 7; const size_t ro = (size_t)(kb * 64 + key) * PINP + 768 + h * 64 + d8 * 8;
          const uint4 rk = *(const uint4*)(proj + ro + 256), rv = *(const uint4*)(proj + ro + 512); const bf16_t* pk = (const bf16_t*)&rk; const bf16_t* pv = (const bf16_t*)&rv;
#pragma unroll
          for (int i = 0; i < 8; ++i) { Ks[key * 64 + d8 * 8 + i] = bf2f(pk[i]); Vs[key * 64 + d8 * 8 + i] = bf2f(pv[i]); } }
        __syncthreads();
        if (kb * 64 <= twmax) {
            for (int sl = 0; sl < 64; ++sl) {
                const int s = kb * 64 + sl;
                if (s <= t) {
                    float z = Bd[t - s];
#pragma unroll
                    for (int d4 = 0; d4 < 8; ++d4) { const float4 kv = *(const float4*)(Ks + sl * 64 + map * 32 + d4 * 4); z += q[d4 * 4] * kv.x + q[d4 * 4 + 1] * kv.y + q[d4 * 4 + 2] * kv.z + q[d4 * 4 + 3] * kv.w; }
                    if (z > mrun) { const float sc = expf(mrun - z); lsum *= sc;
#pragma unroll
                        for (int d = 0; d < 64; ++d) O[d] *= sc;
                        mrun = z; }
                    const float pw = expf(z - mrun);
                    lsum += pw;
#pragma unroll
                    for (int d4 = 0; d4 < 16; ++d4) { const float4 vv = *(const float4*)(Vs + sl * 64 + d4 * 4); O[d4 * 4] += pw * vv.x; O[d4 * 4 + 1] += pw * vv.y; O[d4 * 4 + 2] += pw * vv.z; O[d4 * 4 + 3] += pw * vv.w; }
                }
            }
        }
    }
    const float il = 1.0f / lsum;
    __syncthreads();
    if (map == 1) {
#pragma unroll
        for (int d = 0; d < 64; ++d) Ex[d * 256 + row] = O[d] * il;
    }
    __syncthreads();
    if (map == 0) {
        const float* lp = p.da_lambda + (size_t)l * 128;
        float s1 = 0.f, s2 = 0.f;
        for (int i = 0; i < 32; ++i) { s1 += lp[i] * lp[32 + i]; s2 += lp[64 + i] * lp[96 + i]; }
        const float lam_init = 0.8f - 0.6f * expf(-0.3f * (float)l);
        const float lam = expf(s1) - expf(s2) + lam_init;
        float ms = 0.f;
#pragma unroll
        for (int d = 0; d < 64; ++d) { O[d] = O[d] * il - lam * Ex[d * 256 + row]; ms += O[d] * O[d]; }
        const float r = rsqrtf(ms * (1.0f / 64.0f) + 1e-5f) * (1.0f - lam_init);
        const float* sg = p.da_subln + l * 64;
#pragma unroll
        for (int d8 = 0; d8 < 8; ++d8) { uint4 o; bf16_t* op = (bf16_t*)&o;
#pragma unroll
            for (int i = 0; i < 8; ++i) op[i] = f2bf(O[d8 * 8 + i] * r * sg[d8 * 8 + i]);
            *(uint4*)(mix + (size_t)t * DM + 256 + h * 64 + d8 * 8) = o; }
    }
}

typedef float f32x16 __attribute__((ext_vector_type(16)));
typedef unsigned u32x4v __attribute__((ext_vector_type(4)));
typedef unsigned u32x2v __attribute__((ext_vector_type(2)));
#define AT_KSTR 72
#define AT_VSTR 68
#define AT_KBYTES (64 * AT_KSTR * 2)
#define AT_VBYTES (64 * AT_VSTR * 2)
typedef __bf16 bf16x2_t __attribute__((ext_vector_type(2)));
typedef float f32x2_t __attribute__((ext_vector_type(2)));
__device__ __forceinline__ unsigned pk_bf16(float lo, float hi) { const f32x2_t v = {lo, hi}; const bf16x2_t b = __builtin_convertvector(v, bf16x2_t); return __builtin_bit_cast(unsigned, b); }
__device__ __forceinline__ bf16x8 mk_frag(unsigned a, unsigned b, unsigned c, unsigned d) { u32x4v v; v.x = a; v.y = b; v.z = c; v.w = d; return __builtin_bit_cast(bf16x8, v); }
__device__ __forceinline__ bf16x8 scale_frag(uint4 raw, float sc) {
    return mk_frag(pk_bf16(__uint_as_float(raw.x << 16) * sc, __uint_as_float(raw.x & 0xffff0000u) * sc), pk_bf16(__uint_as_float(raw.y << 16) * sc, __uint_as_float(raw.y & 0xffff0000u) * sc),
                   pk_bf16(__uint_as_float(raw.z << 16) * sc, __uint_as_float(raw.z & 0xffff0000u) * sc), pk_bf16(__uint_as_float(raw.w << 16) * sc, __uint_as_float(raw.w & 0xffff0000u) * sc));
}
struct AtStage {
    uint4 rk; uint2 rv0, rv1;
    __device__ __forceinline__ void load(const bf16_t* kbase, const bf16_t* vbase, int kt, int tid) {
        const int skey = tid >> 3, sc8 = tid & 7, vkp = tid >> 4, vdg = tid & 15;
        rk = *(const uint4*)(kbase + (size_t)(kt * 64 + skey) * PINP + sc8 * 8);
        rv0 = *(const uint2*)(vbase + (size_t)(kt * 64 + 2 * vkp) * PINP + vdg * 4);
        rv1 = *(const uint2*)(vbase + (size_t)(kt * 64 + 2 * vkp + 1) * PINP + vdg * 4);
    }
    __device__ __forceinline__ void store(LAS unsigned char* kb, LAS unsigned char* vb, int tid) const {
        const int skey = tid >> 3, sc8 = tid & 7, vkp = tid >> 4, vdg = tid & 15;
        { u32x4v t_; t_.x = rk.x; t_.y = rk.y; t_.z = rk.z; t_.w = rk.w; *(LAS u32x4v*)(kb + (skey * AT_KSTR + sc8 * 8) * 2) = t_; }
        LAS unsigned* vt = (LAS unsigned*)vb;
        vt[(vdg * 4 + 0) * (AT_VSTR / 2) + vkp] = (rv0.x & 0xffffu) | (rv1.x << 16);
        vt[(vdg * 4 + 1) * (AT_VSTR / 2) + vkp] = (rv0.x >> 16) | (rv1.x & 0xffff0000u);
        vt[(vdg * 4 + 2) * (AT_VSTR / 2) + vkp] = (rv0.y & 0xffffu) | (rv1.y << 16);
        vt[(vdg * 4 + 3) * (AT_VSTR / 2) + vkp] = (rv0.y >> 16) | (rv1.y & 0xffff0000u);
    }
};
__device__ __forceinline__ bf16x8 k_frag(const LAS unsigned char* kb, int keyrow, int dcol) { return *(const LAS bf16x8*)(kb + (keyrow * AT_KSTR + dcol) * 2); }
__device__ __forceinline__ bf16x8 v_frag(const LAS unsigned char* vb, int drow, int keycol) {
    const u32x2v a = *(const LAS u32x2v*)(vb + (drow * AT_VSTR + keycol) * 2), b = *(const LAS u32x2v*)(vb + (drow * AT_VSTR + keycol + 8) * 2);
    return mk_frag(a.x, a.y, b.x, b.y);
}
__device__ __forceinline__ void store_ot(bf16_t* dst  , const f32x16& o0, const f32x16& o1, int hh) {
#pragma unroll
    for (int q = 0; q < 4; ++q) {
        uint2 w; w.x = pk_bf16(o0[4 * q], o0[4 * q + 1]); w.y = pk_bf16(o0[4 * q + 2], o0[4 * q + 3]);
        *(uint2*)(dst + 8 * q + 4 * hh) = w;
        uint2 w1; w1.x = pk_bf16(o1[4 * q], o1[4 * q + 1]); w1.y = pk_bf16(o1[4 * q + 2], o1[4 * q + 3]);
        *(uint2*)(dst + 32 + 8 * q + 4 * hh) = w1;
    }
}

#define SB_VSTR 36
#define SB_WBYTES (32 * AT_KSTR * 2 + 64 * SB_VSTR * 2)
struct SbStage {
    u32x4v rk[4]; u32x2v rv0[4], rv1[4];
    __device__ __forceinline__ void load(const bf16_t* kbase, const bf16_t* vbase, int kb, int lane) {
        const int rsub = lane >> 3, c8 = lane & 7, kps = lane >> 4, dg = lane & 15;
#pragma unroll
        for (int j = 0; j < 4; ++j) {
            rk[j] = *(const u32x4v*)(kbase + (size_t)(kb * 32 + 8 * j + rsub) * PINP + c8 * 8);
            const int kp = 4 * j + kps;
            rv0[j] = *(const u32x2v*)(vbase + (size_t)(kb * 32 + 2 * kp) * PINP + dg * 4);
            rv1[j] = *(const u32x2v*)(vbase + (size_t)(kb * 32 + 2 * kp + 1) * PINP + dg * 4);
        }
    }
    __device__ __forceinline__ void store(LAS unsigned char* kb_, LAS unsigned char* vb_, int lane) const {
        const int rsub = lane >> 3, c8 = lane & 7, kps = lane >> 4, dg = lane & 15;
        LAS unsigned* vt = (LAS unsigned*)vb_;
#pragma unroll
        for (int j = 0; j < 4; ++j) {
            *(LAS u32x4v*)(kb_ + ((8 * j + rsub) * AT_KSTR + c8 * 8) * 2) = rk[j];
            const int kp = 4 * j + kps;
            vt[(dg * 4 + 0) * (SB_VSTR / 2) + kp] = (rv0[j].x & 0xffffu) | (rv1[j].x << 16);
            vt[(dg * 4 + 1) * (SB_VSTR / 2) + kp] = (rv0[j].x >> 16) | (rv1[j].x & 0xffff0000u);
            vt[(dg * 4 + 2) * (SB_VSTR / 2) + kp] = (rv0[j].y & 0xffffu) | (rv1[j].y << 16);
            vt[(dg * 4 + 3) * (SB_VSTR / 2) + kp] = (rv0[j].y >> 16) | (rv1[j].y & 0xffff0000u);
        }
    }
};
__device__ __forceinline__ bf16x8 sbv_frag(const LAS unsigned char* vb, int drow, int keycol) {
    const u32x2v a = *(const LAS u32x2v*)(vb + (drow * SB_VSTR + keycol) * 2), b = *(const LAS u32x2v*)(vb + (drow * SB_VSTR + keycol + 8) * 2);
    return mk_frag(a.x, a.y, b.x, b.y);
}
__device__ __forceinline__ void sbm_item(const Params& p, int bh, int qb, unsigned char* lds) {
    const int tid = otid(), lane = tid & 63, wid = tid >> 6, r = lane & 31, hh = lane >> 5;
    const int b = bh >> 2, h = bh & 3;
    const bf16_t* proj = (const bf16_t*)(p.ws + WS_PROJ) + (size_t)b * SEQ * PINP;
    const bf16_t* kbase = proj + 256 + h * 64; const bf16_t* vbase = proj + 512 + h * 64;
    const int q0w = qb * 256 + wid * 32, t = q0w + r;
    LAS unsigned char* const KW = (LAS unsigned char*)lds + wid * SB_WBYTES; LAS unsigned char* const VW = KW + 32 * AT_KSTR * 2;
    bf16x8 qf[4];
#pragma unroll
    for (int s = 0; s < 4; ++s) qf[s] = scale_frag(*(const uint4*)(proj + (size_t)t * PINP + h * 64 + 16 * s + 8 * hh), 0.125f * LOG2E);
    f32x16 O0, O1;
#pragma unroll
    for (int i = 0; i < 16; ++i) { O0[i] = 0.f; O1[i] = 0.f; }
    float carry = 1.f;
    SbStage st;
    __syncthreads();
    if (q0w + 31 > 0) {
        int kb = (q0w + 30) >> 5;
        st.load(kbase, vbase, kb, lane);
#pragma unroll 1
        for (; kb >= 0; --kb) {
            st.store(KW, VW, lane);
            if (kb > 0) st.load(kbase, vbase, kb - 1, lane);
            const int kbs = 32 * kb;
            f32x16 S;
#pragma unroll
            for (int i = 0; i < 16; ++i) S[i] = 0.f;
#pragma unroll
            for (int s = 0; s < 4; ++s) S = __builtin_amdgcn_mfma_f32_32x32x16_bf16(k_frag(KW, r, 16 * s + 8 * hh), qf[s], S, 0, 0, 0);
            const bool needmask = (kbs + 31 >= q0w);
            float sg[16], G[4];
#pragma unroll
            for (int q = 0; q < 4; ++q) {
                float om[4];
#pragma unroll
                for (int i = 0; i < 4; ++i) {
                    const float z = S[4 * q + i];
                    const float e = __builtin_amdgcn_exp2f(-fabsf(z));
                    const float rr = __builtin_amdgcn_rcpf(1.0f + e);
                    const float er = e * rr;
                    float sgm = z >= 0.f ? rr : er, omm = z >= 0.f ? er : rr;
                    if (needmask) { const int key = kbs + i + 8 * q + 4 * hh; if (key >= t) { sgm = 0.f; omm = 1.f; } }
                    sg[4 * q + i] = sgm; om[i] = omm;
                }
                const float pp2 = om[3], pp1 = pp2 * om[2], pp0 = pp1 * om[1];
                G[q] = pp0 * om[0];
                sg[4 * q + 2] *= pp2; sg[4 * q + 1] *= pp1; sg[4 * q + 0] *= pp0;
            }
            float Gp[4];
#pragma unroll
            for (int q = 0; q < 4; ++q) Gp[q] = __shfl_xor(G[q], 32);
            const float T0 = G[0] * Gp[0], T1 = G[1] * Gp[1], T2 = G[2] * Gp[2], T3 = G[3] * Gp[3];
            const float U2 = T3, U1 = T3 * T2, U0 = U1 * T1;
            float E[4];
            E[3] = carry; E[2] = carry * U2; E[1] = carry * U1; E[0] = carry * U0;
            if (hh == 0) { E[3] *= Gp[3]; E[2] *= Gp[2]; E[1] *= Gp[1]; E[0] *= Gp[0]; }
            carry = carry * U0 * T0;
#pragma unroll
            for (int q = 0; q < 4; ++q) { sg[4 * q] *= E[q]; sg[4 * q + 1] *= E[q]; sg[4 * q + 2] *= E[q]; sg[4 * q + 3] *= E[q]; }
            const bf16x8 P0 = mk_frag(pk_bf16(sg[0], sg[1]), pk_bf16(sg[2], sg[3]), pk_bf16(sg[4], sg[5]), pk_bf16(sg[6], sg[7]));
            const bf16x8 P1 = mk_frag(pk_bf16(sg[8], sg[9]), pk_bf16(sg[10], sg[11]), pk_bf16(sg[12], sg[13]), pk_bf16(sg[14], sg[15]));
            O0 = __builtin_amdgcn_mfma_f32_32x32x16_bf16(sbv_frag(VW, r, 4 * hh), P0, O0, 0, 0, 0);
            O0 = __builtin_amdgcn_mfma_f32_32x32x16_bf16(sbv_frag(VW, r, 16 + 4 * hh), P1, O0, 0, 0, 0);
            O1 = __builtin_amdgcn_mfma_f32_32x32x16_bf16(sbv_frag(VW, 32 + r, 4 * hh), P0, O1, 0, 0, 0);
            O1 = __builtin_amdgcn_mfma_f32_32x32x16_bf16(sbv_frag(VW, 32 + r, 16 + 4 * hh), P1, O1, 0, 0, 0);
            if (__all(carry < 1e-30f)) break;
        }
    }
    { const int tid2 = otid(), hh2 = (tid2 & 63) >> 5, t2 = qb * 256 + (tid2 >> 6) * 32 + (tid2 & 31);
      store_ot((bf16_t*)(p.ws + WS_MIX) + (size_t)((bh >> 2) * SEQ + t2) * DM + (bh & 3) * 64, O0, O1, hh2); }
}

__device__ __forceinline__ void dam_item(const Params& p, int l, int bh, int qb, unsigned char* lds) {
    const int tid = otid(), lane = tid & 63, wid = tid >> 6, r = lane & 31, hh = lane >> 5;
    const int b = bh >> 2, h = bh & 3;
    const bf16_t* proj = (const bf16_t*)(p.ws + WS_PROJ) + (size_t)b * SEQ * PINP;
    const bf16_t* kbase = proj + 1024 + h * 64; const bf16_t* vbase = proj + 1280 + h * 64;
    const float* biasd = (const float*)(p.ws + WS_BIASD) + h * 2048;
    const int q0w = qb * 256 + wid * 32, t = q0w + r;
    LAS unsigned char* const L = (LAS unsigned char*)lds;
#define KBUF(b_) (L + (b_) * AT_KBYTES)
#define VBUF(b_) (L + 2 * AT_KBYTES + (b_) * AT_VBYTES)
    LAS float* Bd = (LAS float*)(L + 2 * AT_KBYTES + 2 * AT_VBYTES + 64);
    bf16x8 qf[2][2];
#pragma unroll
    for (int m = 0; m < 2; ++m)
#pragma unroll
        for (int s = 0; s < 2; ++s) qf[m][s] = scale_frag(*(const uint4*)(proj + (size_t)t * PINP + 768 + h * 64 + m * 32 + 16 * s + 8 * hh), 0.17677669529663687f * LOG2E);
    f32x16 O[2][2];
#pragma unroll
    for (int m = 0; m < 2; ++m)
#pragma unroll
        for (int d = 0; d < 2; ++d)
#pragma unroll
            for (int i = 0; i < 16; ++i) O[m][d][i] = 0.f;
    float lrun[2] = {0.f, 0.f};
    const float cfar = biasd[2047] * LOG2E;
    AtStage st;
    const int ktop = qb * 4 + 3;
    __syncthreads();
    if (tid < 320) Bd[tid] = tid >= 64 ? biasd[tid - 64] * LOG2E : 0.f;
    st.load(kbase, vbase, 0, tid); st.store(KBUF(0), VBUF(0), tid);
    __syncthreads();
#pragma unroll 1
    for (int kt = 0; kt <= ktop; ++kt) {
        const int buf = kt & 1;
        if (kt < ktop) st.load(kbase, vbase, kt + 1, tid);
        if (64 * kt <= q0w + 31) {
            const bool far = (q0w - (64 * kt + 63) >= 128);
            const int dbase = t - 64 * kt - 4 * hh;
            const LAS float* bp = Bd + 64 + dbase;
            const float sinit = far ? cfar : 0.f;
#pragma unroll
            for (int kb32 = 0; kb32 < 2; ++kb32) {
                if (64 * kt + 32 * kb32 <= q0w + 31) {
                    f32x16 S0, S1;
#pragma unroll
                    for (int i = 0; i < 16; ++i) { S0[i] = sinit; S1[i] = sinit; }
#pragma unroll
                    for (int s = 0; s < 2; ++s) {
                        S0 = __builtin_amdgcn_mfma_f32_32x32x16_bf16(k_frag(KBUF(buf), kb32 * 32 + r, 16 * s + 8 * hh), qf[0][s], S0, 0, 0, 0);
                        S1 = __builtin_amdgcn_mfma_f32_32x32x16_bf16(k_frag(KBUF(buf), kb32 * 32 + r, 32 + 16 * s + 8 * hh), qf[1][s], S1, 0, 0, 0);
                    }
                    if (!far) {
#pragma unroll
                        for (int i = 0; i < 16; ++i) {
                            const int c = 32 * kb32 + (i & 3) + 8 * (i >> 2);
                            const float bb = bp[-c];
                            const bool ok = (dbase - c >= 0);
                            S0[i] = ok ? S0[i] + bb : -INFINITY; S1[i] = ok ? S1[i] + bb : -INFINITY;
                        }
                    }
                    float ls0 = 0.f, ls1 = 0.f;
#pragma unroll
                    for (int i = 0; i < 16; ++i) { const float p0 = __builtin_amdgcn_exp2f(S0[i]), p1 = __builtin_amdgcn_exp2f(S1[i]); S0[i] = p0; S1[i] = p1; ls0 += p0; ls1 += p1; }
                    lrun[0] += ls0; lrun[1] += ls1;
                    const bf16x8 P00 = mk_frag(pk_bf16(S0[0], S0[1]), pk_bf16(S0[2], S0[3]), pk_bf16(S0[4], S0[5]), pk_bf16(S0[6], S0[7]));
                    const bf16x8 P01 = mk_frag(pk_bf16(S0[8], S0[9]), pk_bf16(S0[10], S0[11]), pk_bf16(S0[12], S0[13]), pk_bf16(S0[14], S0[15]));
                    const bf16x8 P10 = mk_frag(pk_bf16(S1[0], S1[1]), pk_bf16(S1[2], S1[3]), pk_bf16(S1[4], S1[5]), pk_bf16(S1[6], S1[7]));
                    const bf16x8 P11 = mk_frag(pk_bf16(S1[8], S1[9]), pk_bf16(S1[10], S1[11]), pk_bf16(S1[12], S1[13]), pk_bf16(S1[14], S1[15]));
#pragma unroll
                    for (int d = 0; d < 2; ++d) {
                        const bf16x8 va = v_frag(VBUF(buf), d * 32 + r, kb32 * 32 + 4 * hh), vb = v_frag(VBUF(buf), d * 32 + r, kb32 * 32 + 16 + 4 * hh);
                        O[0][d] = __builtin_amdgcn_mfma_f32_32x32x16_bf16(va, P00, O[0][d], 0, 0, 0);
                        O[1][d] = __builtin_amdgcn_mfma_f32_32x32x16_bf16(va, P10, O[1][d], 0, 0, 0);
                        O[0][d] = __builtin_amdgcn_mfma_f32_32x32x16_bf16(vb, P01, O[0][d], 0, 0, 0);
                        O[1][d] = __builtin_amdgcn_mfma_f32_32x32x16_bf16(vb, P11, O[1][d], 0, 0, 0);
                    }
                }
            }
        }
        if (kt < ktop) st.store(KBUF(buf ^ 1), VBUF(buf ^ 1), tid);
        __syncthreads();
    }
    const int tid2 = otid(), hh2 = (tid2 & 63) >> 5, t2 = qb * 256 + (tid2 >> 6) * 32 + (tid2 & 31);
    const float* lp = p.da_lambda + (size_t)l * 128;
    float s1 = 0.f, s2 = 0.f;
    for (int i = 0; i < 32; ++i) { s1 += lp[i] * lp[32 + i]; s2 += lp[64 + i] * lp[96 + i]; }
    const float lam_init = 0.8f - 0.6f * expf(-0.3f * (float)l);
    const float lam = expf(s1) - expf(s2) + lam_init;
    const float l0 = lrun[0] + __shfl_xor(lrun[0], 32), l1 = lrun[1] + __shfl_xor(lrun[1], 32);
    const float i0 = 1.0f / l0, i1 = lam / l1;
    float ms = 0.f;
#pragma unroll
    for (int d = 0; d < 2; ++d)
#pragma unroll
        for (int i = 0; i < 16; ++i) { const float o = O[0][d][i] * i0 - O[1][d][i] * i1; O[0][d][i] = o; ms += o * o; }
    ms += __shfl_xor(ms, 32);
    const float rs = rsqrtf(ms * (1.0f / 64.0f) + 1e-5f) * (1.0f - lam_init);
    const float* sgn = p.da_subln + l * 64;
#pragma unroll
    for (int d = 0; d < 2; ++d)
#pragma unroll
        for (int i = 0; i < 16; ++i) O[0][d][i] *= rs * sgn[d * 32 + (i & 3) + 8 * (i >> 2) + 4 * hh2];
    store_ot((bf16_t*)(p.ws + WS_MIX) + (size_t)((bh >> 2) * SEQ + t2) * DM + 256 + (bh & 3) * 64, O[0][0], O[0][1], hh2);
}

__device__ __forceinline__ void bf8_to_f(const uint4& v, float (&o)[8]) {
    o[0] = __uint_as_float(v.x << 16); o[1] = __uint_as_float(v.x & 0xffff0000u); o[2] = __uint_as_float(v.y << 16); o[3] = __uint_as_float(v.y & 0xffff0000u);
    o[4] = __uint_as_float(v.z << 16); o[5] = __uint_as_float(v.z & 0xffff0000u); o[6] = __uint_as_float(v.w << 16); o[7] = __uint_as_float(v.w & 0xffff0000u);
}
__device__ __forceinline__ void conv_item(const Params& p, int l, int item) {
    const int tid = otid();
    const bf16_t* proj = (const bf16_t*)(p.ws + WS_PROJ); bf16_t* mix = (bf16_t*)(p.ws + WS_MIX);
    const float* cw = p.sc_conv + (size_t)l * 3 * 256;
    const int c8 = (tid & 31) * 8;
    float w0[8], w1[8], w2[8];
#pragma unroll
    for (int i = 0; i < 8; ++i) { w0[i] = cw[c8 + i]; w1[i] = cw[256 + c8 + i]; w2[i] = cw[512 + c8 + i]; }
#pragma unroll 4
    for (int k = 0; k < 16; ++k) {
        const int rr = (tid >> 5) + 16 * k;
        const size_t row = (size_t)item * 256 + rr; const int t = (int)(row & (SEQ - 1));
        const bf16_t* pr = proj + row * PINP + 1536 + c8;
        const uint4 zz = make_uint4(0u, 0u, 0u, 0u);
        const uint4 bv = *(const uint4*)pr, c2 = *(const uint4*)(pr + 256), h2 = *(const uint4*)(pr + 512);
        const uint4 c1 = t >= 1 ? *(const uint4*)(pr + 256 - PINP) : zz, h1 = t >= 1 ? *(const uint4*)(pr + 512 - PINP) : zz;
        const uint4 c0 = t >= 2 ? *(const uint4*)(pr + 256 - 2 * PINP) : zz, h0 = t >= 2 ? *(const uint4*)(pr + 512 - 2 * PINP) : zz;
        float fb[8], fc2[8], fh2[8], fc1[8], fh1[8], fc0[8], fh0[8], y[8];
        bf8_to_f(bv, fb); bf8_to_f(c2, fc2); bf8_to_f(h2, fh2); bf8_to_f(c1, fc1); bf8_to_f(h1, fh1); bf8_to_f(c0, fc0); bf8_to_f(h0, fh0);
#pragma unroll
        for (int i = 0; i < 8; ++i) y[i] = fb[i] * (w0[i] * (fc0[i] * fh0[i]) + w1[i] * (fc1[i] * fh1[i]) + w2[i] * (fc2[i] * fh2[i]));
        uint4 o; o.x = pk_bf16(y[0], y[1]); o.y = pk_bf16(y[2], y[3]); o.z = pk_bf16(y[4], y[5]); o.w = pk_bf16(y[6], y[7]);
        *(uint4*)(mix + row * DM + 512 + c8) = o;
    }
}

template <int CTRL> __device__ __forceinline__ float dpp_f(float v) { return __int_as_float(__builtin_amdgcn_update_dpp(0, __float_as_int(v), CTRL, 0xf, 0xf, true)); }
__device__ __forceinline__ float red16(float x) { x += dpp_f<0xB1>(x); x += dpp_f<0x4E>(x); x += dpp_f<0x141>(x); x += dpp_f<0x140>(x); return x; }
__device__ __forceinline__ float fsigmoid(float x) { return __builtin_amdgcn_rcpf(1.0f + __builtin_amdgcn_exp2f(-x * LOG2E)); }
__device__ __forceinline__ float ftanh(float x) { return 1.0f - 2.0f * __builtin_amdgcn_rcpf(1.0f + __builtin_amdgcn_exp2f(x * (2.0f * LOG2E))); }
#define MF16(a, b, c) __builtin_amdgcn_mfma_f32_16x16x32_bf16(a, b, c, 0, 0, 0)
__device__ __forceinline__ bf16x8 frag_lo(const f32x4& c) { return mk_frag(pk_bf16(c[0], c[1]), pk_bf16(c[2], c[3]), 0u, 0u); }
__device__ __forceinline__ bf16x8 frag_lo_hi(const f32x4& c, uint2 hi) { return mk_frag(pk_bf16(c[0], c[1]), pk_bf16(c[2], c[3]), hi.x, hi.y); }
__device__ __forceinline__ bf16x8 frag_u2(uint2 lo, uint2 hi) { return mk_frag(lo.x, lo.y, hi.x, hi.y); }
__device__ __forceinline__ f32x4 tt64(const bf16_t* arow, const bf16_t* brow, int g, f32x4 c) {
    c = MF16(*(const bf16x8*)(arow + 8 * g), *(const bf16x8*)(brow + 8 * g), c);
    c = MF16(*(const bf16x8*)(arow + 32 + 8 * g), *(const bf16x8*)(brow + 32 + 8 * g), c);
    return c;
}
#define RW_RS 72
#define RW_TS 20
struct RwPre { uint4 cu[3], pr[3]; };
__device__ __forceinline__ int rw_col(int gq, int h) { return gq < 8 ? h * 64 + gq * 8 : gq < 16 ? 256 + h * 64 + (gq - 8) * 8 : gq < 24 ? 512 + h * 64 + (gq - 16) * 8 : 768 + (gq - 24) * 8; }
__device__ __forceinline__ void rw_prefetch(RwPre& q, const bf16_t* proj, int t0, int h, int tid) {
#pragma unroll
    for (int k = 0; k < 3; ++k) {
        const int i = tid + k * NTHREADS;
        if (i < 1280) {
            const int tt = i / 40, gq = i % 40, t = t0 + tt, col = rw_col(gq, h);
            q.cu[k] = *(const uint4*)(proj + (size_t)t * PINP + col);
            q.pr[k] = (t > 0) ? *(const uint4*)(proj + (size_t)(t - 1) * PINP + col) : make_uint4(0u, 0u, 0u, 0u);
        }
    }
}
__device__ __forceinline__ void rwkv_item(const Params& p, int l, int bh, unsigned char* lds) {
    const int tid = otid(), b = bh >> 2, h = bh & 3;
    const int lane = tid & 63, wv = tid >> 6, n = lane & 15, g = lane >> 4;
    const bf16_t* proj = (const bf16_t*)(p.ws + WS_PROJ) + (size_t)b * SEQ * PINP + 2304;
    bf16_t* mix = (bf16_t*)(p.ws + WS_MIX) + (size_t)b * SEQ * DM + 768 + h * 64;
    const float* mu = p.rw_mu + (size_t)l * 896;
    const float* vecs = p.rw_vecs + (size_t)l * 7 * 256 + h * 64;
    bf16_t* WupT = (bf16_t*)lds; bf16_t* AupT = WupT + 64 * 40; bf16_t* GupT = AupT + 64 * 40;
    float* xr = (float*)(GupT + 64 * RW_RS); float* xk = xr + 2048; float* xv = xk + 2048;
    bf16_t* XW = (bf16_t*)(xv + 2048); bf16_t* XA = XW + 32 * 40; bf16_t* XG = XA + 32 * 40;
    float* lw = (float*)(XG + 32 * RW_RS); float* ab = lw + 2048; float* kk = ab + 2048; float* gg = kk + 2048;
    float* yy = gg + 2048;
    float* pn2 = yy + 2048; float* pbo = pn2 + 128;
    bf16_t* CS = (bf16_t*)(pbo + 128);
#define RW_SET (4 * 16 * RW_RS + 3 * 64 * RW_TS + 4 * 16 * RW_TS + 128)
#define RW_KT(s_) (CS + (s_) * RW_SET)
#define RW_BT(s_) (RW_KT(s_) + 16 * RW_RS)
#define RW_KK(s_) (RW_BT(s_) + 16 * RW_RS)
#define RW_RT(s_) (RW_KK(s_) + 16 * RW_RS)
#define RW_BH(s_) (RW_RT(s_) + 16 * RW_RS)
#define RW_KH(s_) (RW_BH(s_) + 64 * RW_TS)
#define RW_VT(s_) (RW_KH(s_) + 64 * RW_TS)
#define RW_AAK(s_) (RW_VT(s_) + 64 * RW_TS)
#define RW_ARB(s_) (RW_AAK(s_) + 16 * RW_TS)
#define RW_ARK(s_) (RW_ARB(s_) + 16 * RW_TS)
#define RW_TA(s_) (RW_ARK(s_) + 16 * RW_TS)
#define RW_GC(s_) ((float*)(RW_TA(s_) + 16 * RW_TS))
    bf16_t* Sb0 = CS + 2 * RW_SET; bf16_t* Sb1 = Sb0 + 64 * RW_RS;
    __syncthreads();
    for (int i = tid; i < 2048; i += NTHREADS) { const int m = i >> 6, c = i & 63; WupT[c * 40 + m] = f2bf(p.rw_w_up[(size_t)l * 32 * 256 + m * 256 + h * 64 + c]); AupT[c * 40 + m] = f2bf(p.rw_a_up[(size_t)l * 32 * 256 + m * 256 + h * 64 + c]); }
    for (int i = tid; i < 4096; i += NTHREADS) { const int m = i >> 6, c = i & 63; GupT[c * RW_RS + m] = f2bf(p.rw_g_up[(size_t)l * 64 * 256 + m * 256 + h * 64 + c]); }
    for (int i = tid; i < 64 * RW_RS / 2; i += NTHREADS) ((unsigned*)Sb0)[i] = 0u;
    const int ptt = (tid & 255) >> 4, pc = (tid & 15) * 4, pset = tid >> 8;
    const float4 v_lg = *(const float4*)(vecs + 1280 + pc), v_lb = *(const float4*)(vecs + 1536 + pc);
    const int s2mt = wv & 1, s2c = (wv >> 1) * 16 + n;
    const float c_w0 = vecs[s2c], c_a0 = vecs[256 + s2c], c_kk = vecs[512 + s2c], c_ka = vecs[768 + s2c], c_rk = vecs[1024 + s2c];
    const int ib = wv & 3, jh = wv >> 2;
    f32x4 St0 = {0.f, 0.f, 0.f, 0.f}, St1 = {0.f, 0.f, 0.f, 0.f};
    int cur = 0;
    RwPre pre;
    rw_prefetch(pre, proj, 0, h, tid);
#pragma unroll 1
    for (int t0 = 0; t0 < SEQ; t0 += 32) {
        __syncthreads();
#pragma unroll
        for (int k = 0; k < 3; ++k) {
            const int i = tid + k * NTHREADS;
            if (i < 1280) {
                const int tt = i / 40, gq = i % 40; const int col = rw_col(gq, h);
                const uint4 cu = pre.cu[k], pr = pre.pr[k];
                const float4 m0 = *(const float4*)(mu + col), m1 = *(const float4*)(mu + col + 4);
                float o[8];
                { float c, q;
                  c = __uint_as_float(cu.x << 16); q = __uint_as_float(pr.x << 16); o[0] = c + (q - c) * m0.x;
                  c = __uint_as_float(cu.x & 0xffff0000u); q = __uint_as_float(pr.x & 0xffff0000u); o[1] = c + (q - c) * m0.y;
                  c = __uint_as_float(cu.y << 16); q = __uint_as_float(pr.y << 16); o[2] = c + (q - c) * m0.z;
                  c = __uint_as_float(cu.y & 0xffff0000u); q = __uint_as_float(pr.y & 0xffff0000u); o[3] = c + (q - c) * m0.w;
                  c = __uint_as_float(cu.z << 16); q = __uint_as_float(pr.z << 16); o[4] = c + (q - c) * m1.x;
                  c = __uint_as_float(cu.z & 0xffff0000u); q = __uint_as_float(pr.z & 0xffff0000u); o[5] = c + (q - c) * m1.y;
                  c = __uint_as_float(cu.w << 16); q = __uint_as_float(pr.w << 16); o[6] = c + (q - c) * m1.z;
                  c = __uint_as_float(cu.w & 0xffff0000u); q = __uint_as_float(pr.w & 0xffff0000u); o[7] = c + (q - c) * m1.w; }
                if (gq < 24) {
                    float* dst = gq < 8 ? xr + tt * 64 + gq * 8 : gq < 16 ? xk + tt * 64 + (gq - 8) * 8 : xv + tt * 64 + (gq - 16) * 8;
                    *(float4*)dst = make_float4(o[0], o[1], o[2], o[3]); *(float4*)(dst + 4) = make_float4(o[4], o[5], o[6], o[7]);
                } else {
                    if (gq < 28) {
#pragma unroll
                        for (int e = 0; e < 8; ++e) o[e] = ftanh(o[e]);
                    } else if (gq >= 32) {
#pragma unroll
                        for (int e = 0; e < 8; ++e) o[e] = fsigmoid(o[e]);
                    }
                    bf16_t* dst = gq < 28 ? XW + tt * 40 + (gq - 24) * 8 : gq < 32 ? XA + tt * 40 + (gq - 28) * 8 : XG + tt * RW_RS + (gq - 32) * 8;
                    uint4 w; w.x = pk_bf16(o[0], o[1]); w.y = pk_bf16(o[2], o[3]); w.z = pk_bf16(o[4], o[5]); w.w = pk_bf16(o[6], o[7]);
                    *(uint4*)dst = w;
                }
            }
        }
        if (t0 + 32 < SEQ) rw_prefetch(pre, proj, t0 + 32, h, tid);
        __syncthreads();
        {
            const f32x4 z4 = {0.f, 0.f, 0.f, 0.f};
            const int arow = s2mt * 16 + n;
            const f32x4 dec = MF16(*(const bf16x8*)(XW + arow * 40 + 8 * g), *(const bf16x8*)(WupT + s2c * 40 + 8 * g), z4);
            const f32x4 av = MF16(*(const bf16x8*)(XA + arow * 40 + 8 * g), *(const bf16x8*)(AupT + s2c * 40 + 8 * g), z4);
            const f32x4 gt = tt64(XG + arow * RW_RS, GupT + s2c * RW_RS, g, z4);
            const float dk = -0.6065306597126334f * LOG2E;
#pragma unroll
            for (int r = 0; r < 4; ++r) {
                const int tt = s2mt * 16 + 4 * g + r, i = tt * 64 + s2c;
                const float a = fsigmoid(av[r] + c_a0);
                const float kraw = xk[i], rv = xr[i];
                const float kku = kraw * c_kk, kp = kraw * (1.0f + (a - 1.0f) * c_ka);
                const float n2 = red16(kku * kku), bo = red16(rv * kp * c_rk);
                lw[i] = dk * fsigmoid(dec[r] + c_w0); gg[i] = gt[r]; kk[i] = kku; ab[i] = a; xk[i] = kp;
                if (n == 0) { pn2[tt * 4 + (wv >> 1)] = n2; pbo[tt * 4 + (wv >> 1)] = bo; }
            }
        }
        __syncthreads();
        {
            const int c3 = tid & 63, part = tid >> 6, ta = 2 * part;
#pragma unroll 1
            for (int cb = 0; cb < 2; ++cb) {
                const int rb = cb * 16;
                float cum = 0.f, cumA = 0.f, cumB = 0.f, lwA = 0.f, lwB = 0.f;
#pragma unroll
                for (int t = 0; t < 16; ++t) { const float lv = lw[(rb + t) * 64 + c3]; cum += lv; if (t == ta) { cumA = cum; lwA = lv; } if (t == ta + 1) { cumB = cum; lwB = lv; } }
                const int iA = (rb + ta) * 64 + c3, iB = iA + 64;
                const float4 nA = *(const float4*)(pn2 + (rb + ta) * 4), nB = *(const float4*)(pn2 + (rb + ta + 1) * 4);
                const float invA = 1.0f / fmaxf(sqrtf((nA.x + nA.y) + (nA.z + nA.w)), 1e-12f), invB = 1.0f / fmaxf(sqrtf((nB.x + nB.y) + (nB.z + nB.w)), 1e-12f);
                const float GA = __builtin_amdgcn_exp2f(cumA), GiA = __builtin_amdgcn_exp2f(-cumA), GmA = __builtin_amdgcn_exp2f(cumA - lwA), GcA = __builtin_amdgcn_exp2f(cum - cumA);
                const float GB = __builtin_amdgcn_exp2f(cumB), GiB = __builtin_amdgcn_exp2f(-cumB), GmB = __builtin_amdgcn_exp2f(cumB - lwB), GcB = __builtin_amdgcn_exp2f(cum - cumB);
                const float kkA = kk[iA] * invA, kkB = kk[iB] * invB, bA = kkA * ab[iA], bB = kkB * ab[iB], kpA = xk[iA], kpB = xk[iB], rA = xr[iA], rB = xr[iB], vA = xv[iA], vB = xv[iB];
                bf16_t* KT = RW_KT(cb);
                KT[ta * RW_RS + c3] = f2bf(kkA * GmA); KT[(ta + 1) * RW_RS + c3] = f2bf(kkB * GmB);
                RW_BT(cb)[ta * RW_RS + c3] = f2bf(bA * GiA); RW_BT(cb)[(ta + 1) * RW_RS + c3] = f2bf(bB * GiB);
                RW_KK(cb)[ta * RW_RS + c3] = f2bf(kpA * GiA); RW_KK(cb)[(ta + 1) * RW_RS + c3] = f2bf(kpB * GiB);
                RW_RT(cb)[ta * RW_RS + c3] = f2bf(rA * GA); RW_RT(cb)[(ta + 1) * RW_RS + c3] = f2bf(rB * GB);
                ((unsigned*)RW_BH(cb))[c3 * (RW_TS / 2) + part] = pk_bf16(bA * GcA, bB * GcB);
                ((unsigned*)RW_KH(cb))[c3 * (RW_TS / 2) + part] = pk_bf16(kpA * GcA, kpB * GcB);
                ((unsigned*)RW_VT(cb))[c3 * (RW_TS / 2) + part] = pk_bf16(vA, vB);
                if (part == 0) RW_GC(cb)[c3] = __builtin_amdgcn_exp2f(cum);
            }
        }
        __syncthreads();
        {
            const f32x4 z4 = {0.f, 0.f, 0.f, 0.f};
            const int role = wv & 3, cs = wv >> 2;
            const bf16_t* KT = RW_KT(cs); const bf16_t* BT = RW_BT(cs); const bf16_t* KKb = RW_KK(cs); const bf16_t* RT = RW_RT(cs);
            if (role == 0) {
                f32x4 cl = tt64(KT + n * RW_RS, BT + n * RW_RS, g, z4);
                f32x4 clt = tt64(BT + n * RW_RS, KT + n * RW_RS, g, z4);
                f32x4 U;
#pragma unroll
                for (int r = 0; r < 4; ++r) { if (!(4 * g + r > n)) cl[r] = 0.f; if (!(n > 4 * g + r)) clt[r] = 0.f; U[r] = ((4 * g + r == n) ? 1.0f : 0.0f) - clt[r]; }
                const f32x4 m2 = MF16(frag_lo(clt), frag_lo(cl), z4), m2t = MF16(frag_lo(cl), frag_lo(clt), z4);
                U = MF16(frag_lo(m2), frag_lo(U), U);
                const f32x4 m4 = MF16(frag_lo(m2t), frag_lo(m2), z4), m4t = MF16(frag_lo(m2), frag_lo(m2t), z4);
                U = MF16(frag_lo(m4), frag_lo(U), U);
                const f32x4 m8 = MF16(frag_lo(m4t), frag_lo(m4), z4);
                U = MF16(frag_lo(m8), frag_lo(U), U);
                uint2 w; w.x = pk_bf16(U[0], U[1]); w.y = pk_bf16(U[2], U[3]);
                *(uint2*)(RW_TA(cs) + n * RW_TS + 4 * g) = w;
            } else {
                const bf16_t* ar = (role == 2) ? BT : KKb; const bf16_t* br = (role == 1) ? KT : RT; bf16_t* dst = (role == 1) ? RW_AAK(cs) : (role == 2) ? RW_ARB(cs) : RW_ARK(cs);
                f32x4 c = tt64(ar + n * RW_RS, br + n * RW_RS, g, z4);
                const int lim = (role == 1) ? n : n + 1;
#pragma unroll
                for (int r = 0; r < 4; ++r) if (!(4 * g + r < lim)) c[r] = 0.f;
                uint2 w; w.x = pk_bf16(c[0], c[1]); w.y = pk_bf16(c[2], c[3]);
                *(uint2*)(dst + n * RW_TS + 4 * g) = w;
            }
        }
        __syncthreads();
#pragma unroll 1
        for (int cb = 0; cb < 2; ++cb) {
            const bf16_t* Sold = cur ? Sb1 : Sb0; bf16_t* Snew = cur ? Sb0 : Sb1;
            const f32x4 z4 = {0.f, 0.f, 0.f, 0.f};
            const uint2 zz = make_uint2(0u, 0u);
            const bf16_t* srow = Sold + (ib * 16 + n) * RW_RS;
            f32x4 q = tt64(RW_KT(cb) + n * RW_RS, srow, g, z4);
            const uint2 aak = *(const uint2*)(RW_AAK(cb) + n * RW_TS + 4 * g), vt = *(const uint2*)(RW_VT(cb) + (ib * 16 + n) * RW_TS + 4 * g);
            q = MF16(frag_u2(aak, zz), frag_u2(vt, zz), q);
            const uint2 ta = *(const uint2*)(RW_TA(cb) + n * RW_TS + 4 * g);
            f32x4 sa = MF16(frag_u2(ta, zz), frag_lo(q), z4);
            sa = -sa;
            const bf16x8 a3 = frag_lo_hi(sa, vt);
            {
                const int j0 = (2 * jh) * 16 + n, j1 = j0 + 16;
                const uint2 bh0 = *(const uint2*)(RW_BH(cb) + j0 * RW_TS + 4 * g), kh0 = *(const uint2*)(RW_KH(cb) + j0 * RW_TS + 4 * g);
                const uint2 bh1 = *(const uint2*)(RW_BH(cb) + j1 * RW_TS + 4 * g), kh1 = *(const uint2*)(RW_KH(cb) + j1 * RW_TS + 4 * g);
                St0 = St0 * RW_GC(cb)[j0]; St1 = St1 * RW_GC(cb)[j1];
                St0 = MF16(a3, frag_u2(bh0, kh0), St0);
                St1 = MF16(a3, frag_u2(bh1, kh1), St1);
#pragma unroll
                for (int r = 0; r < 4; ++r) { Snew[(ib * 16 + 4 * g + r) * RW_RS + j0] = f2bf(St0[r]); Snew[(ib * 16 + 4 * g + r) * RW_RS + j1] = f2bf(St1[r]); }
            }
            if (jh == 1) {
                f32x4 y = tt64(RW_RT(cb) + n * RW_RS, srow, g, z4);
                const uint2 arb = *(const uint2*)(RW_ARB(cb) + n * RW_TS + 4 * g), ark = *(const uint2*)(RW_ARK(cb) + n * RW_TS + 4 * g);
                y = MF16(frag_u2(arb, ark), a3, y);
#pragma unroll
                for (int r = 0; r < 4; ++r) yy[cb * 1024 + (4 * g + r) * 64 + ib * 16 + n] = y[r];
            }
            cur ^= 1;
            __syncthreads();
        }
        {
            const int tok = pset * 16 + ptt, i = tok * 64 + pc;
            const float4 yv = *(const float4*)(yy + pset * 1024 + ptt * 64 + pc), vv = *(const float4*)(xv + i), gv = *(const float4*)(gg + i), b4 = *(const float4*)(pbo + tok * 4);
            const float mean = red16((yv.x + yv.y) + (yv.z + yv.w)) * (1.0f / 64.0f);
            const float4 d = make_float4(yv.x - mean, yv.y - mean, yv.z - mean, yv.w - mean);
            const float var = red16((d.x * d.x + d.y * d.y) + (d.z * d.z + d.w * d.w)) * (1.0f / 64.0f);
            const float rs = rsqrtf(var + 64e-5f), bo = (b4.x + b4.y) + (b4.z + b4.w);
            uint2 w;
            w.x = pk_bf16((d.x * rs * v_lg.x + v_lb.x + bo * vv.x) * gv.x, (d.y * rs * v_lg.y + v_lb.y + bo * vv.y) * gv.y);
            w.y = pk_bf16((d.z * rs * v_lg.z + v_lb.z + bo * vv.z) * gv.z, (d.w * rs * v_lg.w + v_lb.w + bo * vv.w) * gv.w);
            *(uint2*)(mix + (size_t)(t0 + tok) * DM + pc) = w;
        }
    }
}

__device__ __forceinline__ void phase_mixers(const Params& p, int l, unsigned char* lds) {
    unsigned* ctl = (unsigned*)(p.ws + WS_CTL);
    int* slot = (int*)(lds + LDS_BYTES - 64);
#ifndef NO_RW
    for (int it = obid(); it < 128; it += gridDim.x) rwkv_item(p, l, it, lds);
#endif
    for (;;) {
        __syncthreads();
        if (otid() == 0) *slot = (int)atomicAdd(&ctl[CW_QUEUE + l * 64], 1u);
        __syncthreads();
        const int it = *slot;
        if (it >= 1024 + 1024 + 256) break;
        if (it < 1024) {
#ifndef NO_DA
            dam_item(p, l, it & 127, 7 - (it >> 7), lds);
#endif
        } else if (it < 2048) {
#ifndef NO_SB
            const int j = it - 1024; sbm_item(p, j & 127, 7 - (j >> 7), lds);
#endif
        } else conv_item(p, l, it - 2048);
    }
}

__global__ void __launch_bounds__(NTHREADS, 2) fwd(Params p) {
    extern __shared__ __attribute__((aligned(16))) unsigned char lds_raw[];
    if (threadIdx.x == 0) { ((unsigned*)lds_raw)[0] = 0u; ((unsigned*)lds_raw)[1] = 0u; ((unsigned*)lds_raw)[2] = 0u; ((unsigned*)lds_raw)[3] = 0u; }
    __syncthreads();
    unsigned char* lds = lds_raw + 16;
    XcdBarrier bar = xcd_barrier_post((unsigned*)(p.ws + WS_CTL) + CW_BAR, (volatile LAS unsigned*)lds_raw);
#ifndef ONLY
#define ONLY -1
#endif
#define PH(k) (ONLY < 0 || ONLY == (k))
    if (PH(0)) prologue(p, lds);
    xcd_barrier(bar);
    for (int l = 0; l < NLAYER; ++l) {
        if (PH(1)) phase_inproj(p, l, lds);
        xcd_barrier(bar);
        if (PH(2)) phase_mixers(p, l, lds);
        xcd_barrier(bar);
        if (PH(3)) phase_outproj(p, l, lds);
        xcd_barrier(bar);
        if (PH(4)) phase_ln1_route(p, l, lds);
        xcd_barrier(bar);
        if (PH(5)) phase_moe_up(p, l, lds);
        xcd_barrier(bar);
        if (PH(6)) phase_moe_down(p, l, lds);
        xcd_barrier(bar);
        if (PH(7)) phase_ln2(p, l, lds);
        xcd_barrier(bar);
    }
}

extern "C" void kernel_launch(void* const* d_in, const int* in_sizes, int n_in, void* d_out, int out_size, void* d_ws, size_t ws_size, hipStream_t stream) {
    static int grid = 0;
    if (grid == 0) {
        if (n_in != 18 || in_sizes[0] != NTOK * DM || out_size != NTOK * DM || ws_size < WS_END) {
            fprintf(stderr, "kernel_launch: unexpected shapes: n_in %d in0 %d out %d ws %zu (need %llu)\n", n_in, n_in > 0 ? in_sizes[0] : -1, out_size, ws_size, (unsigned long long)WS_END);
            grid = -1; return;
        }
        int dev = 0, cus = 0, per_cu = 0;
        hipGetDevice(&dev);
        hipDeviceGetAttribute(&cus, hipDeviceAttributeMultiprocessorCount, dev);
        hipFuncSetAttribute((const void*)fwd, hipFuncAttributeMaxDynamicSharedMemorySize, LDS_BYTES);
        hipOccupancyMaxActiveBlocksPerMultiprocessor(&per_cu, (const void*)fwd, NTHREADS, LDS_BYTES);
        if (per_cu < 1) { fprintf(stderr, "kernel_launch: occupancy query says %d blocks per CU\n", per_cu); grid = -1; return; }
        grid = cus;
    }
    if (grid < 0) return;
    Params p{};
    p.x = (const float*)d_in[0]; p.w_in = (const float*)d_in[1]; p.w_out = (const float*)d_in[2]; p.da_lambda = (const float*)d_in[3]; p.da_subln = (const float*)d_in[4];
    p.sc_conv = (const float*)d_in[5]; p.rw_mu = (const float*)d_in[6]; p.rw_vecs = (const float*)d_in[7]; p.rw_w_up = (const float*)d_in[8]; p.rw_a_up = (const float*)d_in[9];
    p.rw_g_up = (const float*)d_in[10]; p.ln_gain = (const float*)d_in[11]; p.ln_bias = (const float*)d_in[12]; p.rel_bias = (const float*)d_in[13]; p.router_w = (const float*)d_in[14];
    p.router_b = (const float*)d_in[15]; p.moe_w_in = (const float*)d_in[16]; p.moe_w_down = (const float*)d_in[17];
    p.out = (float*)d_out; p.ws = (unsigned char*)d_ws;
    hipMemsetAsync((char*)d_ws + WS_CTL, 0, CTL_BYTES, stream);
    hipLaunchKernelGGL(fwd, dim3(grid), dim3(NTHREADS), LDS_BYTES, stream, p);
}
```

```cpp
#include <hip/hip_runtime.h>
#include <cstdio>
#include <cstdint>

typedef unsigned short bf16_t;
typedef short bf16x8 __attribute__((ext_vector_type(8)));
typedef float f32x4 __attribute__((ext_vector_type(4)));

#define NTOK 65536
#define SEQ 2048
#define DM 1024
#define PIN 3200
#define PINP 3328
#define NLAYER 4
#define NEXP 16
#define DEXP 256
#define NTHREADS 512
#define LDS_BYTES (152 * 1024)
#define ALPHA 1.6817928305074292f
#define LOG2E 1.4426950408889634f

#define WS_CTL 0ull
#define CTL_BYTES 65536ull
#define WS_BIASD (WS_CTL + CTL_BYTES)
#define WS_WIN (WS_BIASD + 4ull * 2048 * 4)
#define WS_WOUT (WS_WIN + 4ull * PINP * DM * 2)
#define WS_MWIN (WS_WOUT + 4ull * DM * DM * 2)
#define WS_MWDN (WS_MWIN + 4ull * 16 * 512 * 1024 * 2)
#define WS_XB (WS_MWDN + 4ull * 16 * 1024 * 256 * 2)
#define WS_MIX (WS_XB + (unsigned long long)NTOK * DM * 2)
#define WS_LTOK (WS_MIX + (unsigned long long)NTOK * DM * 2)
#define WS_LGATE (WS_LTOK + 16ull * NTOK * 4)
#define WS_PROJ (WS_LGATE + 16ull * NTOK * 4)
#define WS_YB WS_PROJ
#define WS_Y WS_PROJ
#define WS_H (WS_Y + (unsigned long long)(2 * NTOK + 256) * DM * 2)
#define WS_END (WS_PROJ + (unsigned long long)NTOK * PINP * 2)

#define CW_BAR 0
#define CW_CNT 4096
#define CW_QUEUE 8192

#define XB_TMO      128
#define XB_XCNT(j)  (256  + 64 * (j))
#define XB_XSUB(j)  (1280 + 64 * (j))
#define XB_XGEN(j)  (2304 + 64 * (j))
#define XB_TOP      3328
#define XB_TOPGEN   3392
#define XCD_BAR_WORDS 3456
#define XB_SPIN_CAP (1u << 22)
#define LAS __attribute__((address_space(3)))

__device__ __forceinline__ unsigned xb_ld(unsigned* p)              { return __hip_atomic_load(p, __ATOMIC_RELAXED, __HIP_MEMORY_SCOPE_AGENT); }
__device__ __forceinline__ unsigned xb_add(unsigned* p, unsigned v) { return __hip_atomic_fetch_add(p, v, __ATOMIC_RELAXED, __HIP_MEMORY_SCOPE_AGENT); }
__device__ __forceinline__ unsigned xb_xcc_id() { return (unsigned)__builtin_amdgcn_s_getreg((3 << 11) | 20) & 0xFu; }
#define XB_SPIN(cond, bar) do { unsigned _sp = 0; while (cond) { __builtin_amdgcn_s_sleep(1); \
    if ((++_sp & 255u) == 0u) { if (xb_ld(&(bar)[XB_TMO])) break; if (_sp > XB_SPIN_CAP) { atomicAdd(&(bar)[XB_TMO], 1u); break; } } } } while (0)

struct XcdBarrier { unsigned* bar; unsigned x; volatile LAS unsigned* st; };

__device__ __forceinline__ XcdBarrier xcd_barrier_post(unsigned* bar, volatile LAS unsigned* st) {
    XcdBarrier b; b.bar = bar; b.x = xb_xcc_id(); b.st = st;
    if (threadIdx.x == 0) (void)xb_add(&bar[XB_XCNT(b.x)], 1u);
    return b;
}
__device__ __forceinline__ void xcd_barrier_complete(unsigned* bar, unsigned x, unsigned& nloc, unsigned& nx) {
    const unsigned G = gridDim.x * gridDim.y * gridDim.z;
    unsigned sum, cnt, mine, sp = 0u;
    for (;;) {
        sum = 0u; cnt = 0u; mine = 0u;
#pragma unroll
        for (unsigned j = 0; j < 16; ++j) { const unsigned c = xb_ld(&bar[XB_XCNT(j)]); sum += c; cnt += (c > 0u) ? 1u : 0u; mine = (j == x) ? c : mine; }
        if (sum == G) break;
        __builtin_amdgcn_s_sleep(1);
        if ((++sp & 255u) == 0u) { if (xb_ld(&bar[XB_TMO])) break; if (sp > XB_SPIN_CAP) { atomicAdd(&bar[XB_TMO], 1u); break; } }
    }
    nloc = mine > 0u ? mine : 1u; nx = cnt > 0u ? cnt : 1u;
}
__device__ __forceinline__ void xcd_barrier(const XcdBarrier& b) {
    asm volatile("s_waitcnt vmcnt(0)" ::: "memory");
    __syncthreads();
    if (threadIdx.x == 0) {
        unsigned* bar = b.bar;
        __builtin_amdgcn_s_waitcnt(0);
        const unsigned bx = xb_xcc_id();
        unsigned nloc = b.st[0], nx = b.st[1];
        if (nloc == 0u) { xcd_barrier_complete(bar, bx, nloc, nx); b.st[0] = nloc; b.st[1] = nx; }
        const unsigned old = xb_add(&bar[XB_XSUB(bx)], 1u);
        const unsigned gen = old / nloc;
        if (old + 1u == (gen + 1u) * nloc) {
            __builtin_amdgcn_fence(__ATOMIC_RELEASE, "agent");
            asm volatile("s_waitcnt vmcnt(0)" ::: "memory");
            const unsigned og = xb_add(&bar[XB_TOP], 1u);
            const unsigned tg = og / nx;
            if (og + 1u == (tg + 1u) * nx) xb_add(&bar[XB_TOPGEN], 1u);
            else XB_SPIN(xb_ld(&bar[XB_TOPGEN]) == tg, bar);
            __builtin_amdgcn_fence(__ATOMIC_ACQUIRE, "agent");
            xb_add(&bar[XB_XGEN(bx)], 1u);
            asm volatile("s_waitcnt vmcnt(0)" ::: "memory");
        } else {
            XB_SPIN(xb_ld(&bar[XB_XGEN(bx)]) == gen, bar);
            __builtin_amdgcn_fence(__ATOMIC_ACQUIRE, "agent");
            asm volatile("s_waitcnt vmcnt(0)" ::: "memory");
        }
    }
    __syncthreads();
}

__device__ __forceinline__ int otid() { int t = threadIdx.x; asm volatile("" : "+v"(t)); return t; }
__device__ __forceinline__ int obid() { int t = blockIdx.x; asm volatile("" : "+s"(t)); return t; }
__device__ __forceinline__ float bf2f(bf16_t v) { return __uint_as_float(((unsigned)v) << 16); }
__device__ __forceinline__ bf16_t f2bf(float f) { unsigned u = __float_as_uint(f); u += 0x7fffu + ((u >> 16) & 1u); return (bf16_t)(u >> 16); }
__device__ __forceinline__ float sigmoidf_(float x) { return 1.0f / (1.0f + expf(-x)); }
template <int CTRL> __device__ __forceinline__ float dppw_f(float v) { return __int_as_float(__builtin_amdgcn_update_dpp(0, __float_as_int(v), CTRL, 0xf, 0xf, true)); }
__device__ __forceinline__ float wave_sum(float v) {
    v += dppw_f<0xB1>(v); v += dppw_f<0x4E>(v); v += dppw_f<0x141>(v); v += dppw_f<0x140>(v);
    const float r0 = __int_as_float(__builtin_amdgcn_readlane(__float_as_int(v), 0)), r1 = __int_as_float(__builtin_amdgcn_readlane(__float_as_int(v), 16));
    const float r2 = __int_as_float(__builtin_amdgcn_readlane(__float_as_int(v), 32)), r3 = __int_as_float(__builtin_amdgcn_readlane(__float_as_int(v), 48));
    return (r0 + r1) + (r2 + r3);
}

struct Params {
    const float* x; const float* w_in; const float* w_out; const float* da_lambda; const float* da_subln; const float* sc_conv;
    const float* rw_mu; const float* rw_vecs; const float* rw_w_up; const float* rw_a_up; const float* rw_g_up;
    const float* ln_gain; const float* ln_bias; const float* rel_bias; const float* router_w; const float* router_b;
    const float* moe_w_in; const float* moe_w_down;
    float* out; unsigned char* ws;
};

namespace pg8 {
#define PG8_LAS __attribute__((address_space(3)))
typedef unsigned short bf16_t;
typedef short bf16x8 __attribute__((ext_vector_type(8)));
typedef float f32x4 __attribute__((ext_vector_type(4)));
typedef unsigned u32x4 __attribute__((ext_vector_type(4)));
constexpr int BM = 256, BK = 64, HALF = 128, HTB = HALF * BK * 2  , STAGE_BYTES = 8 * HTB, NXCD = 8, WGM = 8;

__host__ __device__ __forceinline__ int lds_byte(int r, int c) { const int st = (r >> 4) * 2 + (c >> 5), rr = r & 15, cc = c & 31, ob = rr * 64 + cc * 2; return st * 1024 + (ob ^ (((ob >> 9) & 1) << 5)); }
__host__ __device__ __forceinline__ void stage_rc(int b, int& R, int& C) { const int st = b / 1024, sb = b % 1024, swz = sb ^ (((sb >> 9) & 1) << 5); R = (st >> 1) * 16 + swz / 64; C = (st & 1) * 32 + (swz % 64) / 2; }
__host__ __device__ __forceinline__ int perm32(int rho) { const int n = rho >> 4, i = rho & 15; return 8 * (i >> 2) + 4 * n + (i & 3); }

struct Unit { int pm, pn; };
struct Gemm { const bf16_t* A; const bf16_t* Bt; int M, N, K; };

struct StaticOrder {
    int nM, nN, nwg, G, c;
    __host__ __device__ void init(int M, int N, int G_, int c_) { nM = M / BM; nN = N / BM; nwg = nM * nN; G = G_; c = c_; }
    __host__ __device__ bool next(int i, Unit& u) const {
        const long L = (long)i * G + c; if (L >= nwg) return false;
        int wgid = (int)L; { const int q = nwg / NXCD, r = nwg % NXCD, xcd = wgid % NXCD, off = wgid / NXCD; wgid = (xcd < r ? xcd * (q + 1) : r * (q + 1) + (xcd - r) * q) + off; }
        const int nig = WGM * nN, gid = wgid / nig, fm = gid * WGM, gsz = (nM - fm) < WGM ? (nM - fm) : WGM;
        u.pm = fm + ((wgid % nig) % gsz); u.pn = (wgid % nig) / gsz; return true;
    }
    __device__ __forceinline__ void a_ready(const Unit&) const {}
    __device__ __forceinline__ void done(const Unit&) const {}
};
__device__ __forceinline__ unsigned cvt_pk_bf16(float lo, float hi) { unsigned r; asm volatile("v_cvt_pk_bf16_f32 %0, %1, %2" : "=v"(r) : "v"(lo), "v"(hi)); return r; }
template <class Epi, class Sched, bool ALIGN_EPI = false, bool SP2 = false>
__device__ __forceinline__ void gemm_phase(PG8_LAS unsigned char* lds, const Gemm g, const Sched& S, const Epi& E) {
    const int tid = otid(), wid = __builtin_amdgcn_readfirstlane(tid >> 6), lane = tid & 63, wr = wid >> 2, wc = wid & 3, fr = lane & 15, fq = lane >> 4;
    const int K = g.K, nt = K / BK;
    unsigned voffA[2], voffB[2];
#pragma unroll
    for (int i = 0; i < 2; ++i) { int R, C; stage_rc(tid * 16 + i * 8192, R, C); const int Rb = Epi::PERM ? ((R & ~31) + perm32(R & 31)) : R;
        voffA[i] = (unsigned)(R * K + C) * 2u; voffB[i] = (unsigned)(Rb * K + C) * 2u; }
    const size_t kstep = (size_t)(BK * 2);
    const size_t hstep = (size_t)HALF * K * 2;
    const size_t tstep = 2 * hstep;
    const unsigned ldsw = (unsigned)wid * 1024u;
    const int aoff = lds_byte(wr * 64 + fr, fq * 8), boff = lds_byte(wc * 32 + fr, fq * 8);
#define PG8_SA(b, h) (((b) * 2 + (h)) * HTB)
#define PG8_SB(b, h) ((4 + (b) * 2 + (h)) * HTB)
#define PG8_STAGE(bufoff, gbase, voff) do { _Pragma("unroll") for (int _i = 0; _i < 2; ++_i) \
        __builtin_amdgcn_global_load_lds((const unsigned*)((const char*)(gbase) + (voff)[_i]), (PG8_LAS unsigned*)(lds + (bufoff) + ldsw + _i * 8192), 16, 0, 0); } while (0)
#define PG8_LDA(dst, b, h) do { _Pragma("unroll") for (int m = 0; m < 4; ++m) _Pragma("unroll") for (int k = 0; k < 2; ++k) dst[m][k] = *(const PG8_LAS bf16x8*)(lds + PG8_SA(b, h) + aoff + m * 2048 + k * 1024); } while (0)
#define PG8_LDB(dst, b, h) do { _Pragma("unroll") for (int n = 0; n < 2; ++n) _Pragma("unroll") for (int k = 0; k < 2; ++k) dst[n][k] = *(const PG8_LAS bf16x8*)(lds + PG8_SB(b, h) + boff + n * 2048 + k * 1024); } while (0)
#define PG8_MMA(ai, bj, At, Bt) do { __builtin_amdgcn_s_setprio(1); _Pragma("unroll") for (int m = 0; m < 4; ++m) _Pragma("unroll") for (int n = 0; n < 2; ++n) _Pragma("unroll") for (int k = 0; k < 2; ++k) \
        acc[ai][bj][m][n] = __builtin_amdgcn_mfma_f32_16x16x32_bf16(Bt[n][k], At[m][k], acc[ai][bj][m][n], 0, 0, 0); __builtin_amdgcn_s_setprio(0); } while (0)
#define PG8_WAIT_V(n) asm volatile("s_waitcnt vmcnt(" #n ")" ::: "memory")
#define PG8_WAIT_L(n) asm volatile("s_waitcnt lgkmcnt(" #n ")" ::: "memory")
#define PG8_BAR __builtin_amdgcn_s_barrier()
#define PG8_SCHED __builtin_amdgcn_sched_barrier(0)
    Unit cur, nxt; int ui = 0;
    if (!S.next(0, cur)) return;
    f32x4 acc[2][2][4][2];
#pragma unroll
    for (int a = 0; a < 2; ++a)
#pragma unroll
        for (int b = 0; b < 2; ++b)
#pragma unroll
            for (int m = 0; m < 4; ++m)
#pragma unroll
                for (int n = 0; n < 2; ++n) acc[a][b][m][n] = (f32x4){0.f, 0.f, 0.f, 0.f};
    bf16x8 At[4][2], B0[2][2], B1[2][2];
    const char* cA = (const char*)g.A + (size_t)cur.pm * tstep; const char* cB = (const char*)g.Bt + (size_t)cur.pn * tstep;
    S.a_ready(cur);
    if constexpr (SP2) {
        PG8_STAGE(PG8_SB(0, 0), cB, voffB); PG8_STAGE(PG8_SB(0, 1), cB + hstep, voffB); PG8_STAGE(PG8_SA(0, 0), cA, voffA); PG8_STAGE(PG8_SA(0, 1), cA + hstep, voffA);
        if (wr == 1) PG8_BAR;
        PG8_WAIT_V(2); PG8_BAR;
        PG8_STAGE(PG8_SB(1, 0), cB + kstep, voffB); PG8_STAGE(PG8_SA(1, 0), cA + kstep, voffA); PG8_STAGE(PG8_SB(1, 1), cB + hstep + kstep, voffB);
        PG8_WAIT_V(6); PG8_BAR;
    } else {
        PG8_STAGE(PG8_SB(0, 0), cB, voffB); PG8_STAGE(PG8_SA(0, 0), cA, voffA); PG8_STAGE(PG8_SB(0, 1), cB + hstep, voffB); PG8_STAGE(PG8_SA(0, 1), cA + hstep, voffA);
        if (wr == 1) PG8_BAR;
        PG8_WAIT_V(4); PG8_BAR;
        PG8_STAGE(PG8_SB(1, 0), cB + kstep, voffB); PG8_STAGE(PG8_SA(1, 0), cA + kstep, voffA); PG8_STAGE(PG8_SB(1, 1), cB + hstep + kstep, voffB);
        PG8_WAIT_V(6); PG8_BAR;
    }
    for (;;) {
        const bool has_next = S.next(ui + 1, nxt);
        const char* nA = has_next ? (const char*)g.A + (size_t)nxt.pm * tstep : cA; const char* nB = has_next ? (const char*)g.Bt + (size_t)nxt.pn * tstep : cB;
        for (int t = 0; t < nt; t += 2) {
            const bool last = (t == nt - 2);
            const char* a1 = cA + (size_t)(t + 1) * kstep;
            const char* a2 = last ? nA : cA + (size_t)(t + 2) * kstep; const char* b2 = last ? nB : cB + (size_t)(t + 2) * kstep;
            const char* a3 = a2 + kstep; const char* b3 = b2 + kstep;
            if (last && has_next) S.a_ready(nxt);
            if constexpr (SP2) {
            PG8_LDB(B0, 0, 0); PG8_LDB(B1, 0, 1); PG8_SCHED; PG8_LDA(At, 0, 0); PG8_STAGE(PG8_SA(1, 1), a1 + hstep, voffA);
            PG8_WAIT_V(8); PG8_WAIT_L(0); PG8_BAR; PG8_MMA(0, 0, At, B0); PG8_MMA(0, 1, At, B1); PG8_BAR; PG8_SCHED;
            PG8_LDA(At, 0, 1); PG8_STAGE(PG8_SB(0, 0), b2, voffB); PG8_STAGE(PG8_SB(0, 1), b2 + hstep, voffB); PG8_STAGE(PG8_SA(0, 0), a2, voffA);
            PG8_WAIT_V(8); PG8_WAIT_L(0); PG8_BAR; PG8_MMA(1, 0, At, B0); PG8_MMA(1, 1, At, B1); PG8_BAR; PG8_SCHED;
            PG8_LDB(B0, 1, 0); PG8_LDB(B1, 1, 1); PG8_SCHED; PG8_LDA(At, 1, 0); PG8_STAGE(PG8_SA(0, 1), a2 + hstep, voffA);
            PG8_WAIT_V(8); PG8_WAIT_L(0); PG8_BAR; PG8_MMA(0, 0, At, B0); PG8_MMA(0, 1, At, B1); PG8_BAR; PG8_SCHED;
            PG8_LDA(At, 1, 1); PG8_STAGE(PG8_SB(1, 0), b3, voffB); PG8_STAGE(PG8_SB(1, 1), b3 + hstep, voffB); PG8_STAGE(PG8_SA(1, 0), a3, voffA);
            PG8_WAIT_V(8); PG8_WAIT_L(0); PG8_BAR; PG8_MMA(1, 0, At, B0); PG8_MMA(1, 1, At, B1); PG8_BAR; PG8_SCHED;
            } else {
            PG8_LDB(B0, 0, 0); PG8_SCHED; PG8_LDA(At, 0, 0); PG8_STAGE(PG8_SA(1, 1), a1 + hstep, voffA);
            PG8_WAIT_L(8); PG8_BAR; PG8_WAIT_L(0); PG8_MMA(0, 0, At, B0); PG8_BAR; PG8_SCHED;
            PG8_LDB(B1, 0, 1); PG8_STAGE(PG8_SB(0, 0), b2, voffB);
            PG8_BAR; PG8_WAIT_L(0); PG8_MMA(0, 1, At, B1); PG8_BAR;
            PG8_LDA(At, 0, 1); PG8_STAGE(PG8_SA(0, 0), a2, voffA);
            PG8_BAR; PG8_WAIT_L(0); PG8_MMA(1, 0, At, B0); PG8_BAR; PG8_SCHED;
            PG8_STAGE(PG8_SB(0, 1), b2 + hstep, voffB);
            PG8_WAIT_V(6); PG8_BAR; PG8_MMA(1, 1, At, B1); PG8_BAR;
            PG8_LDB(B0, 1, 0); PG8_SCHED; PG8_LDA(At, 1, 0); PG8_STAGE(PG8_SA(0, 1), a2 + hstep, voffA);
            PG8_WAIT_L(8); PG8_BAR; PG8_WAIT_L(0); PG8_MMA(0, 0, At, B0); PG8_BAR; PG8_SCHED;
            PG8_LDB(B1, 1, 1); PG8_STAGE(PG8_SB(1, 0), b3, voffB);
            PG8_BAR; PG8_WAIT_L(0); PG8_MMA(0, 1, At, B1); PG8_BAR;
            PG8_LDA(At, 1, 1); PG8_STAGE(PG8_SA(1, 0), a3, voffA);
            PG8_BAR; PG8_WAIT_L(0); PG8_MMA(1, 0, At, B0); PG8_BAR; PG8_SCHED;
            PG8_STAGE(PG8_SB(1, 1), b3 + hstep, voffB);
            PG8_WAIT_V(6); PG8_BAR; PG8_MMA(1, 1, At, B1); PG8_BAR;
            }
        }
        if constexpr (ALIGN_EPI) { if (wr == 0) PG8_BAR; }
        if constexpr (!Epi::AFTER_DRAIN) { E(acc, cur, wr, wc, fr, fq); S.done(cur); }
        if (!has_next) break;
#pragma unroll
        for (int a = 0; a < 2; ++a)
#pragma unroll
            for (int b = 0; b < 2; ++b)
#pragma unroll
                for (int m = 0; m < 4; ++m)
#pragma unroll
                    for (int n = 0; n < 2; ++n) acc[a][b][m][n] = (f32x4){0.f, 0.f, 0.f, 0.f};
        cur = nxt; cA = nA; cB = nB; ++ui;
        if constexpr (ALIGN_EPI) { if (wr == 1) PG8_BAR; }
    }
    PG8_WAIT_V(0);
    if constexpr (!ALIGN_EPI) { if (wr == 0) PG8_BAR; }
    PG8_BAR;
    if constexpr (Epi::AFTER_DRAIN) { E.fused(acc, cur, wr, wc, fr, fq, lds, wid, lane); S.done(cur); }
#undef PG8_SA
#undef PG8_SB
#undef PG8_STAGE
#undef PG8_LDA
#undef PG8_LDB
#undef PG8_MMA
#undef PG8_WAIT_V
#undef PG8_WAIT_L
#undef PG8_BAR
#undef PG8_SCHED
}
}

namespace pg8 {
template <class Epi, class Sched, bool GATHER>
__device__ __forceinline__ void gemm_phase_g(PG8_LAS unsigned char* lds, const int K, const Sched& S, const Epi& E) {
    typedef typename Sched::Unit UnitT;
    const int tid = otid(), wid = __builtin_amdgcn_readfirstlane(tid >> 6), lane = tid & 63, wr = wid >> 2, wc = wid & 3, fr = lane & 15, fq = lane >> 4;
    const int nt = K / BK;
    unsigned voffB[2];
#pragma unroll
    for (int i = 0; i < 2; ++i) { int R, C; stage_rc(tid * 16 + i * 8192, R, C); const int Rb = Epi::PERM ? ((R & ~31) + perm32(R & 31)) : R; voffB[i] = (unsigned)(Rb * K + C) * 2u; }
#define PG8_AOFF(unit, o0, o1) do { const int _tz = otid(); _Pragma("unroll") for (int _i = 0; _i < 2; ++_i) { int _R, _C; stage_rc(_tz * 16 + _i * 8192, _R, _C); \
        o0[_i] = S.arow_off(unit, _R) + (unsigned)_C * 2u; o1[_i] = S.arow_off(unit, HALF + _R) + (unsigned)_C * 2u; } } while (0)
    const size_t kstep = (size_t)(BK * 2);
    const size_t hstep = (size_t)HALF * K * 2;
    const unsigned ldsw = (unsigned)wid * 1024u;
    const int aoff = lds_byte(wr * 64 + fr, fq * 8), boff = lds_byte(wc * 32 + fr, fq * 8);
#define PG8_SA(b, h) (((b) * 2 + (h)) * HTB)
#define PG8_SB(b, h) ((4 + (b) * 2 + (h)) * HTB)
#define PG8_STAGE(bufoff, gbase, voff) do { _Pragma("unroll") for (int _i = 0; _i < 2; ++_i) \
        __builtin_amdgcn_global_load_lds((const unsigned*)((const char*)(gbase) + (voff)[_i]), (PG8_LAS unsigned*)(lds + (bufoff) + ldsw + _i * 8192), 16, 0, 0); } while (0)
#define PG8_LDA(dst, b, h) do { _Pragma("unroll") for (int m = 0; m < 4; ++m) _Pragma("unroll") for (int k = 0; k < 2; ++k) dst[m][k] = *(const PG8_LAS bf16x8*)(lds + PG8_SA(b, h) + aoff + m * 2048 + k * 1024); } while (0)
#define PG8_LDB(dst, b, h) do { _Pragma("unroll") for (int n = 0; n < 2; ++n) _Pragma("unroll") for (int k = 0; k < 2; ++k) dst[n][k] = *(const PG8_LAS bf16x8*)(lds + PG8_SB(b, h) + boff + n * 2048 + k * 1024); } while (0)
#define PG8_MMA(ai, bj, At, Bt) do { __builtin_amdgcn_s_setprio(1); _Pragma("unroll") for (int m = 0; m < 4; ++m) _Pragma("unroll") for (int n = 0; n < 2; ++n) _Pragma("unroll") for (int k = 0; k < 2; ++k) \
        acc[ai][bj][m][n] = __builtin_amdgcn_mfma_f32_16x16x32_bf16(Bt[n][k], At[m][k], acc[ai][bj][m][n], 0, 0, 0); __builtin_amdgcn_s_setprio(0); } while (0)
#define PG8_WAIT_V(n) asm volatile("s_waitcnt vmcnt(" #n ")" ::: "memory")
#define PG8_WAIT_L(n) asm volatile("s_waitcnt lgkmcnt(" #n ")" ::: "memory")
#define PG8_BAR __builtin_amdgcn_s_barrier()
#define PG8_SCHED __builtin_amdgcn_sched_barrier(0)
    UnitT cur, nxt; int ui = 0;
    if (!S.next(0, cur)) return;
    f32x4 acc[2][2][4][2];
#pragma unroll
    for (int a = 0; a < 2; ++a)
#pragma unroll
        for (int b = 0; b < 2; ++b)
#pragma unroll
            for (int m = 0; m < 4; ++m)
#pragma unroll
                for (int n = 0; n < 2; ++n) acc[a][b][m][n] = (f32x4){0.f, 0.f, 0.f, 0.f};
    bf16x8 At[4][2], B0[2][2], B1[2][2];
    unsigned cvo0[2], cvo1[2];
    PG8_AOFF(cur, cvo0, cvo1);
    const char* cA = S.abase(cur); const char* cB = S.bbase(cur);
    PG8_STAGE(PG8_SB(0, 0), cB, voffB); PG8_STAGE(PG8_SB(0, 1), cB + hstep, voffB); PG8_STAGE(PG8_SA(0, 0), cA, cvo0); PG8_STAGE(PG8_SA(0, 1), cA, cvo1);
    if (wr == 1) PG8_BAR;
    PG8_WAIT_V(2); PG8_BAR;
    PG8_STAGE(PG8_SB(1, 0), cB + kstep, voffB); PG8_STAGE(PG8_SA(1, 0), cA + kstep, cvo0); PG8_STAGE(PG8_SB(1, 1), cB + hstep + kstep, voffB);
    PG8_WAIT_V(6); PG8_BAR;
#pragma unroll 1
    for (;;) {
        const bool has_next = S.next(ui + 1, nxt);
        const char* nA = has_next ? S.abase(nxt) : cA; const char* nB = has_next ? S.bbase(nxt) : cB;
        unsigned v20[2], v21[2];
#pragma unroll 1
        for (int t = 0; t < nt; t += 2) {
            const bool last = (t == nt - 2);
            const char* a1 = cA + (size_t)(t + 1) * kstep;
            const char* a2 = last ? nA : cA + (size_t)(t + 2) * kstep; const char* b2 = last ? nB : cB + (size_t)(t + 2) * kstep;
            const char* a3 = a2 + kstep; const char* b3 = b2 + kstep;
            if (GATHER && last && has_next) { PG8_AOFF(nxt, v20, v21); }
            else {
#pragma unroll
                for (int i = 0; i < 2; ++i) { v20[i] = cvo0[i]; v21[i] = cvo1[i]; } }
            PG8_LDB(B0, 0, 0); PG8_LDB(B1, 0, 1); PG8_SCHED; PG8_LDA(At, 0, 0); PG8_STAGE(PG8_SA(1, 1), a1, cvo1);
            PG8_WAIT_V(8); PG8_WAIT_L(0); PG8_BAR; PG8_MMA(0, 0, At, B0); PG8_MMA(0, 1, At, B1); PG8_BAR; PG8_SCHED;
            PG8_LDA(At, 0, 1); PG8_STAGE(PG8_SB(0, 0), b2, voffB); PG8_STAGE(PG8_SB(0, 1), b2 + hstep, voffB); PG8_STAGE(PG8_SA(0, 0), a2, v20);
            PG8_WAIT_V(8); PG8_WAIT_L(0); PG8_BAR; PG8_MMA(1, 0, At, B0); PG8_MMA(1, 1, At, B1); PG8_BAR; PG8_SCHED;
            PG8_LDB(B0, 1, 0); PG8_LDB(B1, 1, 1); PG8_SCHED; PG8_LDA(At, 1, 0); PG8_STAGE(PG8_SA(0, 1), a2, v21);
            PG8_WAIT_V(8); PG8_WAIT_L(0); PG8_BAR; PG8_MMA(0, 0, At, B0); PG8_MMA(0, 1, At, B1); PG8_BAR; PG8_SCHED;
            PG8_LDA(At, 1, 1); PG8_STAGE(PG8_SB(1, 0), b3, voffB); PG8_STAGE(PG8_SB(1, 1), b3 + hstep, voffB); PG8_STAGE(PG8_SA(1, 0), a3, v20);
            PG8_WAIT_V(8); PG8_WAIT_L(0); PG8_BAR; PG8_MMA(1, 0, At, B0); PG8_MMA(1, 1, At, B1); PG8_BAR; PG8_SCHED;
        }
        if (wr == 0) PG8_BAR;
        E(acc, cur, wr, wc, fr, fq);
        if (!has_next) break;
#pragma unroll
        for (int a = 0; a < 2; ++a)
#pragma unroll
            for (int b = 0; b < 2; ++b)
#pragma unroll
                for (int m = 0; m < 4; ++m)
#pragma unroll
                    for (int n = 0; n < 2; ++n) acc[a][b][m][n] = (f32x4){0.f, 0.f, 0.f, 0.f};
        cur = nxt; cA = nA; cB = nB; ++ui;
#pragma unroll
        for (int i = 0; i < 2; ++i) { cvo0[i] = v20[i]; cvo1[i] = v21[i]; }
        if (wr == 1) PG8_BAR;
    }
    PG8_WAIT_V(0);
    PG8_BAR;
#undef PG8_AOFF
#undef PG8_SA
#undef PG8_SB
#undef PG8_STAGE
#undef PG8_LDA
#undef PG8_LDB
#undef PG8_MMA
#undef PG8_WAIT_V
#undef PG8_WAIT_L
#undef PG8_BAR
#undef PG8_SCHED
}
}

struct TrTile { const float* src; bf16_t* dst; int K, N, k0, n0, mode; };
__device__ __forceinline__ TrTile tr_desc(const Params& p, int it) {
    TrTile t;
    bf16_t* win = (bf16_t*)(p.ws + WS_WIN); bf16_t* wout = (bf16_t*)(p.ws + WS_WOUT); bf16_t* mwin = (bf16_t*)(p.ws + WS_MWIN); bf16_t* mwdn = (bf16_t*)(p.ws + WS_MWDN);
    if (it < 3328) { const int l = it / 832, r = it % 832; t.src = p.w_in + (size_t)l * DM * PIN; t.dst = win + (size_t)l * PINP * DM; t.K = DM; t.N = PIN; t.k0 = (r / 52) * 64; t.n0 = (r % 52) * 64; t.mode = 0; }
    else if (it < 4352) { const int j = it - 3328, l = j / 256, r = j % 256; t.src = p.w_out + (size_t)l * DM * DM; t.dst = wout + (size_t)l * DM * DM; t.K = DM; t.N = DM; t.k0 = (r / 16) * 64; t.n0 = (r % 16) * 64; t.mode = 0; }
    else if (it < 12544) { const int j = it - 4352, le = j / 128, r = j % 128; t.src = p.moe_w_in + (size_t)le * 1024 * 512; t.dst = mwin + (size_t)le * 512 * 1024; t.K = 1024; t.N = 512; t.k0 = (r / 8) * 64; t.n0 = (r % 8) * 64; t.mode = 1; }
    else { const int j = it - 12544, le = j / 64, r = j % 64; t.src = p.moe_w_down + (size_t)le * 256 * 1024; t.dst = mwdn + (size_t)le * 1024 * 256; t.K = 256; t.N = 1024; t.k0 = (r / 16) * 64; t.n0 = (r % 16) * 64; t.mode = 0; }
    return t;
}
__device__ __forceinline__ void tr_load(const TrTile& t, float (&v)[8], int tid) {
    const int c = tid & 63, r0 = tid >> 6;
    if (t.n0 < t.N) {
#pragma unroll
        for (int i = 0; i < 8; ++i) v[i] = t.src[(size_t)(t.k0 + r0 + i * 8) * t.N + t.n0 + c];
    } else {
#pragma unroll
        for (int i = 0; i < 8; ++i) v[i] = 0.f;
    }
}
__device__ __forceinline__ void prologue(const Params& p, unsigned char* lds) {
    float* tile = (float*)lds;
    const int G = gridDim.x, w = obid(), tid = otid();
    {
        bf16_t* xb = (bf16_t*)(p.ws + WS_XB);
        const size_t n4 = (size_t)NTOK * DM / 4, stride = (size_t)G * NTHREADS;
        size_t i = (size_t)w * NTHREADS + tid;
        for (; i + 3 * stride < n4; i += 4 * stride) {
            float4 v[4];
#pragma unroll
            for (int k = 0; k < 4; ++k) v[k] = ((const float4*)p.x)[i + k * stride];
#pragma unroll
            for (int k = 0; k < 4; ++k) { uint2 o; o.x = pg8::cvt_pk_bf16(v[k].x, v[k].y); o.y = pg8::cvt_pk_bf16(v[k].z, v[k].w); ((uint2*)xb)[i + k * stride] = o; }
        }
        for (; i < n4; i += stride) { const float4 v = ((const float4*)p.x)[i]; uint2 o; o.x = pg8::cvt_pk_bf16(v.x, v.y); o.y = pg8::cvt_pk_bf16(v.z, v.w); ((uint2*)xb)[i] = o; }
    }
    {
        const int c = tid & 63, r0 = tid >> 6, nn = tid >> 3, kg = tid & 7;
        int it = w;
        float v[8];
        TrTile cur = tr_desc(p, it < 16640 ? it : 0);
        if (it < 16640) tr_load(cur, v, tid);
#pragma unroll 1
        for (; it < 16640; it += G) {
            __syncthreads();
#pragma unroll
            for (int i = 0; i < 8; ++i) tile[(r0 + i * 8) * 65 + c] = v[i];
            const int nit = it + G;
            TrTile nxt = tr_desc(p, nit < 16640 ? nit : 0);
            if (nit < 16640) tr_load(nxt, v, tid);
            __syncthreads();
            int n = cur.n0 + nn;
            if (cur.mode == 1) { const int j = n & 255; const int isu = n >> 8; n = (j >> 4) * 32 + isu * 16 + (j & 15); }
            float f[8];
#pragma unroll
            for (int i = 0; i < 8; ++i) f[i] = tile[(kg * 8 + i) * 65 + nn];
            pg8::u32x4 o; o.x = pg8::cvt_pk_bf16(f[0], f[1]); o.y = pg8::cvt_pk_bf16(f[2], f[3]); o.z = pg8::cvt_pk_bf16(f[4], f[5]); o.w = pg8::cvt_pk_bf16(f[6], f[7]);
            *(pg8::u32x4*)(cur.dst + (size_t)n * cur.K + cur.k0 + kg * 8) = o;
            cur = nxt;
        }
    }
    {
        float* bd = (float*)(p.ws + WS_BIASD);
        for (int i = w * NTHREADS + tid; i < 4 * 2048; i += G * NTHREADS) {
            const int h = i >> 11, n = i & 2047;
            int bucket;
            if (n < 16) bucket = n;
            else { const float nf = (float)n; int lg = 16 + (int)(logf(nf / 16.0f) / 2.0794415416798357f * 16.0f); bucket = lg < 31 ? lg : 31; }
            bd[i] = p.rel_bias[bucket * 4 + h];
        }
    }
}

template <class ARow, class Epi>
__device__ __forceinline__ void gemm128(unsigned char* lds, const ARow& arow, const bf16_t* __restrict__ bt, int K, const Epi& epi) {
    const int tid = otid(), lane = tid & 63, wid = tid >> 6, wm = wid >> 1, wn = wid & 1;
    const int lr = tid >> 2, lc = (tid & 3) * 8;
    bf16_t* As = (bf16_t*)lds; bf16_t* Bs = (bf16_t*)(lds + 10240);
    const bf16_t* ap = arow(lr) + lc;
    const bf16_t* bp = bt + (size_t)lr * K + lc;
    f32x4 acc[2][4];
#pragma unroll
    for (int m = 0; m < 2; ++m)
#pragma unroll
        for (int n = 0; n < 4; ++n) acc[m][n] = (f32x4){0.f, 0.f, 0.f, 0.f};
    uint4 ra = *(const uint4*)ap, rb = *(const uint4*)bp;
    const int fr = lane & 15, fq = lane >> 4;
    for (int k0 = 0; k0 < K; k0 += 32) {
        __syncthreads();
        *(uint4*)(As + lr * 40 + lc) = ra;
        *(uint4*)(Bs + lr * 40 + lc) = rb;
        __syncthreads();
        if (k0 + 32 < K) { ra = *(const uint4*)(ap + k0 + 32); rb = *(const uint4*)(bp + k0 + 32); }
        bf16x8 a[2], b[4];
#pragma unroll
        for (int m = 0; m < 2; ++m) a[m] = *(const bf16x8*)(As + (wm * 32 + m * 16 + fr) * 40 + fq * 8);
#pragma unroll
        for (int n = 0; n < 4; ++n) b[n] = *(const bf16x8*)(Bs + (wn * 64 + n * 16 + fr) * 40 + fq * 8);
#pragma unroll
        for (int m = 0; m < 2; ++m)
#pragma unroll
            for (int n = 0; n < 4; ++n) acc[m][n] = __builtin_amdgcn_mfma_f32_16x16x32_bf16(a[m], b[n], acc[m][n], 0, 0, 0);
    }
    epi(acc, wm, wn, lane);
}

struct RowContig { const bf16_t* base; int ld; __device__ __forceinline__ const bf16_t* operator()(int r) const { return base + (size_t)r * ld; } };

struct EpiProjP {
    static constexpr bool PERM = true, AFTER_DRAIN = false;
    bf16_t* O;
    __device__ __forceinline__ void operator()(const pg8::f32x4 (&acc)[2][2][4][2], const pg8::Unit& u, int wr, int wc, int fr, int fq) const {
        const int row0 = u.pm * 256 + wr * 64 + fr, col0 = u.pn * 256 + wc * 32 + 8 * fq;
#pragma unroll
        for (int ai = 0; ai < 2; ++ai)
#pragma unroll
            for (int m = 0; m < 4; ++m) { bf16_t* rowp = O + (size_t)(row0 + ai * 128 + m * 16) * PINP + col0;
#pragma unroll
                for (int bj = 0; bj < 2; ++bj) { const pg8::f32x4 v0 = acc[ai][bj][m][0], v1 = acc[ai][bj][m][1];
                    pg8::u32x4 w; w.x = pg8::cvt_pk_bf16(v0[0], v0[1]); w.y = pg8::cvt_pk_bf16(v0[2], v0[3]); w.z = pg8::cvt_pk_bf16(v1[0], v1[1]); w.w = pg8::cvt_pk_bf16(v1[2], v1[3]);
                    *(pg8::u32x4*)(rowp + bj * 128) = w; } }
    }
};
__device__ __forceinline__ void phase_inproj(const Params& p, int l, unsigned char* lds) {
    pg8::Gemm g{(const bf16_t*)(p.ws + WS_XB), (const bf16_t*)(p.ws + WS_WIN) + (size_t)l * PINP * DM, NTOK, PINP, DM};
    pg8::StaticOrder S; S.init(NTOK, PINP, (int)gridDim.x, obid());
    EpiProjP E{(bf16_t*)(p.ws + WS_PROJ)};
    pg8::gemm_phase<EpiProjP, pg8::StaticOrder, true, true>((PG8_LAS unsigned char*)lds, g, S, E);
}

struct EpiOutP {
    static constexpr bool PERM = true, AFTER_DRAIN = false;
    const float* xf; const bf16_t* xh; bf16_t* out;
    __device__ __forceinline__ void operator()(const pg8::f32x4 (&acc)[2][2][4][2], const pg8::Unit& u, int wr, int wc, int fr, int fq) const {
        const int row0 = u.pm * 256 + wr * 64 + fr, col0 = u.pn * 256 + wc * 32 + 8 * fq;
#pragma unroll
        for (int ai = 0; ai < 2; ++ai)
#pragma unroll
            for (int m = 0; m < 4; ++m) { const size_t ro = (size_t)(row0 + ai * 128 + m * 16) * DM + col0;
#pragma unroll
                for (int bj = 0; bj < 2; ++bj) { const size_t o = ro + bj * 128;
                    float xv[8];
                    if (xf) { const pg8::f32x4 a = *(const pg8::f32x4*)(xf + o), b = *(const pg8::f32x4*)(xf + o + 4); xv[0] = a[0]; xv[1] = a[1]; xv[2] = a[2]; xv[3] = a[3]; xv[4] = b[0]; xv[5] = b[1]; xv[6] = b[2]; xv[7] = b[3]; }
                    else { const pg8::u32x4 r = *(const pg8::u32x4*)(xh + o); xv[0] = __uint_as_float(r.x << 16); xv[1] = __uint_as_float(r.x & 0xffff0000u); xv[2] = __uint_as_float(r.y << 16); xv[3] = __uint_as_float(r.y & 0xffff0000u);
                        xv[4] = __uint_as_float(r.z << 16); xv[5] = __uint_as_float(r.z & 0xffff0000u); xv[6] = __uint_as_float(r.w << 16); xv[7] = __uint_as_float(r.w & 0xffff0000u); }
                    const pg8::f32x4 v0 = acc[ai][bj][m][0], v1 = acc[ai][bj][m][1];
                    pg8::u32x4 w; w.x = pg8::cvt_pk_bf16(ALPHA * xv[0] + v0[0], ALPHA * xv[1] + v0[1]); w.y = pg8::cvt_pk_bf16(ALPHA * xv[2] + v0[2], ALPHA * xv[3] + v0[3]);
                    w.z = pg8::cvt_pk_bf16(ALPHA * xv[4] + v1[0], ALPHA * xv[5] + v1[1]); w.w = pg8::cvt_pk_bf16(ALPHA * xv[6] + v1[2], ALPHA * xv[7] + v1[3]);
                    *(pg8::u32x4*)(out + o) = w; } }
    }
};
__device__ __forceinline__ void phase_outproj(const Params& p, int l, unsigned char* lds) {
    pg8::Gemm g{(const bf16_t*)(p.ws + WS_MIX), (const bf16_t*)(p.ws + WS_WOUT) + (size_t)l * DM * DM, NTOK, DM, DM};
    pg8::StaticOrder S; S.init(NTOK, DM, (int)gridDim.x, obid());
    EpiOutP E{(l == 0) ? p.x : nullptr, (const bf16_t*)(p.ws + WS_XB), (bf16_t*)(p.ws + WS_YB)};
    pg8::gemm_phase<EpiOutP, pg8::StaticOrder, true, true>((PG8_LAS unsigned char*)lds, g, S, E);
}

__device__ __forceinline__ void ln_row(float (&v)[16], const float* gain, const float* bias, int lane) {
    float s = 0.f;
#pragma unroll
    for (int i = 0; i < 16; ++i) s += v[i];
    s = wave_sum(s);
    const float mean = s * (1.0f / 1024.0f);
    float q = 0.f;
#pragma unroll
    for (int i = 0; i < 16; ++i) { const float d = v[i] - mean; q += d * d; }
    q = wave_sum(q);
    const float rstd = rsqrtf(q * (1.0f / 1024.0f) + 1e-5f);
#pragma unroll
    for (int j = 0; j < 4; ++j) {
        const float4 g = *(const float4*)(gain + j * 256 + lane * 4), b = *(const float4*)(bias + j * 256 + lane * 4);
        v[j * 4 + 0] = (v[j * 4 + 0] - mean) * rstd * g.x + b.x; v[j * 4 + 1] = (v[j * 4 + 1] - mean) * rstd * g.y + b.y;
        v[j * 4 + 2] = (v[j * 4 + 2] - mean) * rstd * g.z + b.z; v[j * 4 + 3] = (v[j * 4 + 3] - mean) * rstd * g.w + b.w;
    }
}
__device__ __forceinline__ void load_row_bf(float (&v)[16], const bf16_t* src, int lane) {
#pragma unroll
    for (int j = 0; j < 4; ++j) { const ushort4 t = *(const ushort4*)(src + j * 256 + lane * 4); v[j * 4] = bf2f(t.x); v[j * 4 + 1] = bf2f(t.y); v[j * 4 + 2] = bf2f(t.z); v[j * 4 + 3] = bf2f(t.w); }
}
__device__ __forceinline__ void store_row_bf(const float (&v)[16], bf16_t* xbo, int lane) {
#pragma unroll
    for (int j = 0; j < 4; ++j) { ushort4 o; o.x = f2bf(v[j * 4]); o.y = f2bf(v[j * 4 + 1]); o.z = f2bf(v[j * 4 + 2]); o.w = f2bf(v[j * 4 + 3]); *(ushort4*)(xbo + j * 256 + lane * 4) = o; }
}
__device__ __forceinline__ void store_row(const float (&v)[16], float* xo, bf16_t* xbo, int lane) {
#pragma unroll
    for (int j = 0; j < 4; ++j) {
        *(float4*)(xo + j * 256 + lane * 4) = make_float4(v[j * 4], v[j * 4 + 1], v[j * 4 + 2], v[j * 4 + 3]);
        ushort4 o; o.x = f2bf(v[j * 4]); o.y = f2bf(v[j * 4 + 1]); o.z = f2bf(v[j * 4 + 2]); o.w = f2bf(v[j * 4 + 3]);
        *(ushort4*)(xbo + j * 256 + lane * 4) = o;
    }
}

__device__ __forceinline__ void route_pick(const float (&lg)[16], const float* rb, int& i1, int& i2, float& g1, float& g2) {
    float aff[16], sl[16];
#pragma unroll
    for (int e = 0; e < 16; ++e) { aff[e] = sigmoidf_(lg[e]); sl[e] = aff[e] + rb[e]; }
    float bestg = -INFINITY; int bg = 0;
#pragma unroll
    for (int g = 0; g < 4; ++g) {
        float m1 = -INFINITY, m2 = -INFINITY;
#pragma unroll
        for (int k = 0; k < 4; ++k) { const float s = sl[g * 4 + k]; if (s > m1) { m2 = m1; m1 = s; } else if (s > m2) m2 = s; }
        const float gs = m1 + m2;
        if (gs > bestg) { bestg = gs; bg = g; }
    }
    float b1 = -INFINITY; i1 = 0; float a1 = 0.f;
#pragma unroll
    for (int e = 0; e < 16; ++e) { const bool in = (e >> 2) == bg; if (in && sl[e] > b1) { b1 = sl[e]; i1 = e; a1 = aff[e]; } }
    float b2 = -INFINITY; i2 = 0; float a2 = 0.f;
#pragma unroll
    for (int e = 0; e < 16; ++e) { const bool in = ((e >> 2) == bg) && (e != i1); if (in && sl[e] > b2) { b2 = sl[e]; i2 = e; a2 = aff[e]; } }
    const float inv = 1.0f / (a1 + a2);
    g1 = a1 * inv; g2 = a2 * inv;
}
__device__ __forceinline__ float rs16(const float (&v)[16], int lane) {
    float a8[8];
    const bool b0 = lane & 1, b1 = lane & 2, b2 = lane & 4, b3 = lane & 8;
#pragma unroll
    for (int i = 0; i < 8; ++i) { const float keep = b0 ? v[i + 8] : v[i], give = b0 ? v[i] : v[i + 8]; a8[i] = keep + dppw_f<0xB1>(give); }
    float a4[4];
#pragma unroll
    for (int i = 0; i < 4; ++i) { const float keep = b1 ? a8[i + 4] : a8[i], give = b1 ? a8[i] : a8[i + 4]; a4[i] = keep + dppw_f<0x4E>(give); }
    float a2[2];
#pragma unroll
    for (int i = 0; i < 2; ++i) { const float keep = b2 ? a4[i + 2] : a4[i], give = b2 ? a4[i] : a4[i + 2]; a2[i] = keep + __shfl_xor(give, 4); }
    const float keep = b3 ? a2[1] : a2[0], give = b3 ? a2[0] : a2[1];
    return keep + __shfl_xor(give, 8);
}
__device__ __forceinline__ void phase_ln1_route(const Params& p, int l, unsigned char* lds) {
    const int tid = otid(), lane = tid & 63, wid = tid >> 6;
    int* sel_e = (int*)lds;
    float* sel_g = (float*)(lds + 2048);
    int* rank = (int*)(lds + 4096);
    int* base = (int*)(lds + 6144);
    float* rwT = (float*)(lds + 8192);
    float* lgs = (float*)(lds + 8192 + 65536);
    bf16_t* xb = (bf16_t*)(p.ws + WS_XB); const bf16_t* yb = (const bf16_t*)(p.ws + WS_YB);
    unsigned* ctl = (unsigned*)(p.ws + WS_CTL);
    int* ltok = (int*)(p.ws + WS_LTOK);
    const float* gain = p.ln_gain + (size_t)(l * 2 + 0) * DM; const float* bias = p.ln_bias + (size_t)(l * 2 + 0) * DM;
    __syncthreads();
    for (int i = tid; i < 16384; i += NTHREADS) { const int c = i >> 4, e = i & 15; rwT[e * 1024 + c] = p.router_w[i]; }
    for (int chunk = obid(); chunk < NTOK / 256; chunk += gridDim.x) {
        __syncthreads();
        float v0[16], v1[16];
        { const size_t row = (size_t)chunk * 256 + wid * 32; load_row_bf(v0, yb + row * DM, lane); load_row_bf(v1, yb + (row + 1) * DM, lane); }
#pragma unroll 1
        for (int rr = 0; rr < 32; rr += 2) {
            const int lrow = wid * 32 + rr; const size_t row = (size_t)chunk * 256 + lrow;
            float n0[16], n1[16];
            if (rr + 2 < 32) { load_row_bf(n0, yb + (row + 2) * DM, lane); load_row_bf(n1, yb + (row + 3) * DM, lane); }
            ln_row(v0, gain, bias, lane); ln_row(v1, gain, bias, lane);
            store_row_bf(v0, xb + row * DM, lane); store_row_bf(v1, xb + (row + 1) * DM, lane);
            float lg0[16], lg1[16];
#pragma unroll
            for (int e = 0; e < 16; ++e) {
                float s0 = 0.f, s1 = 0.f;
#pragma unroll
                for (int j = 0; j < 4; ++j) { const float4 w = *(const float4*)(rwT + e * 1024 + j * 256 + lane * 4);
                    s0 += v0[j * 4] * w.x + v0[j * 4 + 1] * w.y + v0[j * 4 + 2] * w.z + v0[j * 4 + 3] * w.w;
                    s1 += v1[j * 4] * w.x + v1[j * 4 + 1] * w.y + v1[j * 4 + 2] * w.z + v1[j * 4 + 3] * w.w; }
                lg0[e] = s0; lg1[e] = s1;
            }
            float r0 = rs16(lg0, lane), r1 = rs16(lg1, lane);
            r0 += __shfl_xor(r0, 16); r0 += __shfl_xor(r0, 32); r1 += __shfl_xor(r1, 16); r1 += __shfl_xor(r1, 32);
            if (lane < 16) { const int e = 8 * (lane & 1) + 4 * ((lane >> 1) & 1) + 2 * ((lane >> 2) & 1) + ((lane >> 3) & 1); lgs[lrow * 16 + e] = r0; lgs[(lrow + 1) * 16 + e] = r1; }
#pragma unroll
            for (int i = 0; i < 16; ++i) { v0[i] = n0[i]; v1[i] = n1[i]; }
        }
        __syncthreads();
        if (tid < 256) {
            float lg[16];
#pragma unroll
            for (int q = 0; q < 4; ++q) { const float4 t = *(const float4*)(lgs + tid * 16 + q * 4); lg[q * 4] = t.x; lg[q * 4 + 1] = t.y; lg[q * 4 + 2] = t.z; lg[q * 4 + 3] = t.w; }
            int i1, i2; float g1, g2;
            route_pick(lg, p.router_b, i1, i2, g1, g2);
            sel_e[tid * 2] = i1; sel_e[tid * 2 + 1] = i2; sel_g[tid * 2] = g1; sel_g[tid * 2 + 1] = g2;
        }
        __syncthreads();
        int my_e, my_rank;
        {
            my_e = sel_e[tid]; my_rank = 0;
            const unsigned long long lt = (1ull << lane) - 1ull;
#pragma unroll
            for (int e = 0; e < 16; ++e) {
                const unsigned long long m = __ballot(my_e == e);
                if (my_e == e) my_rank = __popcll(m & lt);
                if (lane == 0) rank[wid * 16 + e] = __popcll(m);
            }
        }
        __syncthreads();
        if (tid < 16) {
            int c = 0;
#pragma unroll
            for (int w = 0; w < 8; ++w) { const int t = rank[w * 16 + tid]; rank[w * 16 + tid] = c; c += t; }
            base[tid] = (int)atomicAdd(&ctl[CW_CNT + (l * 16 + tid) * 64], (unsigned)c);
        }
        __syncthreads();
        {
            const int e = my_e; const int pos = base[e] + rank[wid * 16 + e] + my_rank;
            ltok[(size_t)e * NTOK + pos] = chunk * 256 + (tid >> 1);
            int* ti = (int*)(p.ws + WS_LGATE) + (size_t)(chunk * 256 + (tid >> 1)) * 4;
            ti[tid & 1] = (e << 17) | pos; ((float*)ti)[2 + (tid & 1)] = sel_g[tid];
        }
    }
}

#define MOE_TAB_OFF 131072
#define MOE_META_OFF (131072 + 4096)
struct MoeUnit { int e, rl, pn, n, ui, pb; };
__device__ __forceinline__ void moe_meta(const Params& p, int l, PG8_LAS int* meta) {
    if (otid() == 0) {
        unsigned* ctl = (unsigned*)(p.ws + WS_CTL);
        int tb = 0, pb = 0;
        for (int e = 0; e < 16; ++e) { const int c = (int)xb_ld(&ctl[CW_CNT + (l * 16 + e) * 64]); meta[e] = c; meta[16 + e] = tb; meta[33 + e] = pb; tb += (c + 255) >> 8; pb += c; }
        meta[32] = tb; meta[49] = pb;
    }
    __syncthreads();
}
template <int NCOL_LOG2>
struct MoeSchedBase {
    typedef MoeUnit Unit;
    PG8_LAS const int* meta; int G, c;
    __device__ __forceinline__ int mu(int idx) const { return __builtin_amdgcn_readfirstlane(meta[idx]); }
    __device__ __forceinline__ bool next(int i, MoeUnit& u) const {
        const int L = i * G + c; const int ntile = mu(32);
        if (L >= (ntile << NCOL_LOG2)) return false;
        const int rt = L >> NCOL_LOG2; u.pn = L & ((1 << NCOL_LOG2) - 1);
        int e = 0;
#pragma unroll
        for (int k = 1; k < 16; ++k) if (rt >= mu(16 + k)) e = k;
        u.e = e; u.rl = rt - mu(16 + e); u.n = mu(e) - u.rl * 256; u.pb = mu(33 + e) + u.rl * 256; u.ui = i; return true;
    }
};
struct MoeSchedUp : MoeSchedBase<1> {
    PG8_LAS const unsigned short* tok16; const char* xb; const char* wbase;
    __device__ __forceinline__ const char* abase(const MoeUnit&) const { return xb; }
    __device__ __forceinline__ unsigned arow_off(const MoeUnit& u, int r) const { return (unsigned)tok16[u.ui * 256 + r] * 2048u; }
    __device__ __forceinline__ const char* bbase(const MoeUnit& u) const { return wbase + ((size_t)u.e * 512 + u.pn * 256) * 2048; }
};
struct MoeSchedDown : MoeSchedBase<2> {
    const char* hb; const char* wbase;
    __device__ __forceinline__ const char* abase(const MoeUnit& u) const { return hb + (size_t)u.pb * 512; }
    __device__ __forceinline__ unsigned arow_off(const MoeUnit&, int r) const { return (unsigned)r * 512u; }
    __device__ __forceinline__ const char* bbase(const MoeUnit& u) const { return wbase + ((size_t)u.e * 1024 + u.pn * 256) * 512; }
};
struct EpiUp {
    static constexpr bool PERM = false, AFTER_DRAIN = false;
    bf16_t* H;
    __device__ __forceinline__ void operator()(const pg8::f32x4 (&acc)[2][2][4][2], const MoeUnit& u, int wr, int wc, int fr, int fq) const {
        bf16_t* hb = H + u.pn * 128 + wc * 16 + fq * 4;
#pragma unroll
        for (int ai = 0; ai < 2; ++ai)
#pragma unroll
            for (int m = 0; m < 4; ++m) {
                const int r = ai * 128 + wr * 64 + m * 16 + fr;
                const int rr = (r < u.n) ? (u.pb + r) : (2 * NTOK + r);
#pragma unroll
                for (int bj = 0; bj < 2; ++bj) {
                    const pg8::f32x4 g = acc[ai][bj][m][0], uu = acc[ai][bj][m][1];
                    float hv[4];
#pragma unroll
                    for (int i = 0; i < 4; ++i) hv[i] = g[i] * __builtin_amdgcn_rcpf(1.0f + __builtin_amdgcn_exp2f(-g[i] * LOG2E)) * uu[i];
                    uint2 w; w.x = pg8::cvt_pk_bf16(hv[0], hv[1]); w.y = pg8::cvt_pk_bf16(hv[2], hv[3]);
                    *(uint2*)(hb + (size_t)rr * DEXP + bj * 64) = w;
                }
            }
    }
};
struct EpiDown {
    static constexpr bool PERM = true, AFTER_DRAIN = false;
    bf16_t* Y;
    __device__ __forceinline__ void operator()(const pg8::f32x4 (&acc)[2][2][4][2], const MoeUnit& u, int wr, int wc, int fr, int fq) const {
        bf16_t* yb = Y + u.pn * 256 + wc * 32 + 8 * fq;
#pragma unroll
        for (int ai = 0; ai < 2; ++ai)
#pragma unroll
            for (int m = 0; m < 4; ++m) {
                const int r = ai * 128 + wr * 64 + m * 16 + fr;
                const int rr = (r < u.n) ? (u.pb + r) : (2 * NTOK + r);
#pragma unroll
                for (int bj = 0; bj < 2; ++bj) { const pg8::f32x4 v0 = acc[ai][bj][m][0], v1 = acc[ai][bj][m][1];
                    pg8::u32x4 w; w.x = pg8::cvt_pk_bf16(v0[0], v0[1]); w.y = pg8::cvt_pk_bf16(v0[2], v0[3]); w.z = pg8::cvt_pk_bf16(v1[0], v1[1]); w.w = pg8::cvt_pk_bf16(v1[2], v1[3]);
                    *(pg8::u32x4*)(yb + (size_t)rr * DM + bj * 128) = w; }
            }
    }
};
__device__ __forceinline__ void phase_moe_up(const Params& p, int l, unsigned char* lds) {
    PG8_LAS unsigned char* L = (PG8_LAS unsigned char*)lds;
    PG8_LAS int* meta = (PG8_LAS int*)(L + MOE_META_OFF);
    PG8_LAS unsigned short* tok16 = (PG8_LAS unsigned short*)(L + MOE_TAB_OFF);
    __syncthreads();
    moe_meta(p, l, meta);
    MoeSchedUp S; S.meta = meta; S.G = (int)gridDim.x; S.c = obid(); S.tok16 = tok16; S.xb = (const char*)(p.ws + WS_XB); S.wbase = (const char*)(p.ws + WS_MWIN) + (size_t)l * 16 * 512 * 2048;
    {
        const int* ltok = (const int*)(p.ws + WS_LTOK); const int tid = otid();
        MoeUnit u;
        for (int i = 0; i < 8 && S.next(i, u); ++i)
            if (tid < 256) tok16[i * 256 + tid] = (tid < u.n) ? (unsigned short)ltok[(size_t)u.e * NTOK + u.rl * 256 + tid] : (unsigned short)0;
    }
    __syncthreads();
    EpiUp E{(bf16_t*)(p.ws + WS_H)};
    pg8::gemm_phase_g<EpiUp, MoeSchedUp, true>(L, 1024, S, E);
}
__device__ __forceinline__ void phase_moe_down(const Params& p, int l, unsigned char* lds) {
    PG8_LAS unsigned char* L = (PG8_LAS unsigned char*)lds;
    PG8_LAS int* meta = (PG8_LAS int*)(L + MOE_META_OFF);
    __syncthreads();
    moe_meta(p, l, meta);
    MoeSchedDown S; S.meta = meta; S.G = (int)gridDim.x; S.c = obid(); S.hb = (const char*)(p.ws + WS_H); S.wbase = (const char*)(p.ws + WS_MWDN) + (size_t)l * 16 * 1024 * 512;
    EpiDown E{(bf16_t*)(p.ws + WS_Y)};
    pg8::gemm_phase_g<EpiDown, MoeSchedDown, false>(L, 256, S, E);
}

__device__ __forceinline__ void phase_ln2(const Params& p, int l, unsigned char* lds) {
    const int tid = otid(), lane = tid & 63, wid = tid >> 6;
    bf16_t* xb = (bf16_t*)(p.ws + WS_XB); const bf16_t* Y = (const bf16_t*)(p.ws + WS_Y);
    const float* gain = p.ln_gain + (size_t)(l * 2 + 1) * DM; const float* bias = p.ln_bias + (size_t)(l * 2 + 1) * DM;
    int* pbase = (int*)lds;
    __syncthreads();
    if (tid == 0) { unsigned* ctl = (unsigned*)(p.ws + WS_CTL); int pb = 0; for (int e = 0; e < 16; ++e) { pbase[e] = pb; pb += (int)xb_ld(&ctl[CW_CNT + (l * 16 + e) * 64]); } }
    __syncthreads();
    const size_t rstep = (size_t)gridDim.x * 8;
    size_t row = (size_t)obid() * 8 + wid;
    ushort4 cx[4], c0[4], c1[4]; float g0 = 0.f, g1 = 0.f;
    if (row < NTOK) {
        const int4 ti = *(const int4*)(p.ws + WS_LGATE + row * 16);
        const size_t p0 = (size_t)(pbase[ti.x >> 17] + (ti.x & 0x1ffff)), p1 = (size_t)(pbase[ti.y >> 17] + (ti.y & 0x1ffff));
        g0 = __int_as_float(ti.z); g1 = __int_as_float(ti.w);
#pragma unroll
        for (int j = 0; j < 4; ++j) { cx[j] = *(const ushort4*)(xb + row * DM + j * 256 + lane * 4); c0[j] = *(const ushort4*)(Y + p0 * DM + j * 256 + lane * 4); c1[j] = *(const ushort4*)(Y + p1 * DM + j * 256 + lane * 4); }
    }
#pragma unroll 1
    for (; row < NTOK; row += rstep) {
        const size_t nrow = row + rstep;
        ushort4 nx[4], n0[4], n1[4]; float ng0 = 0.f, ng1 = 0.f;
        if (nrow < NTOK) {
            const int4 ti = *(const int4*)(p.ws + WS_LGATE + nrow * 16);
            const size_t p0 = (size_t)(pbase[ti.x >> 17] + (ti.x & 0x1ffff)), p1 = (size_t)(pbase[ti.y >> 17] + (ti.y & 0x1ffff));
            ng0 = __int_as_float(ti.z); ng1 = __int_as_float(ti.w);
#pragma unroll
            for (int j = 0; j < 4; ++j) { nx[j] = *(const ushort4*)(xb + nrow * DM + j * 256 + lane * 4); n0[j] = *(const ushort4*)(Y + p0 * DM + j * 256 + lane * 4); n1[j] = *(const ushort4*)(Y + p1 * DM + j * 256 + lane * 4); }
        }
        float v[16];
#pragma unroll
        for (int j = 0; j < 4; ++j) {
            v[j * 4 + 0] = ALPHA * bf2f(cx[j].x) + g0 * bf2f(c0[j].x) + g1 * bf2f(c1[j].x); v[j * 4 + 1] = ALPHA * bf2f(cx[j].y) + g0 * bf2f(c0[j].y) + g1 * bf2f(c1[j].y);
            v[j * 4 + 2] = ALPHA * bf2f(cx[j].z) + g0 * bf2f(c0[j].z) + g1 * bf2f(c1[j].z); v[j * 4 + 3] = ALPHA * bf2f(cx[j].w) + g0 * bf2f(c0[j].w) + g1 * bf2f(c1[j].w);
        }
        ln_row(v, gain, bias, lane);
        if (l == NLAYER - 1) store_row(v, p.out + row * DM, xb + row * DM, lane); else store_row_bf(v, xb + row * DM, lane);
#pragma unroll
        for (int j = 0; j < 4; ++j) { cx[j] = nx[j]; c0[j] = n0[j]; c1[j] = n1[j]; }
        g0 = ng0; g1 = ng1;
    }
}

__device__ __forceinline__ void sb_item(const Params& p, int bh, int qc, unsigned char* lds) {
    const int tid = otid(), b = bh >> 2, h = bh & 3;
    const bf16_t* proj = (const bf16_t*)(p.ws + WS_PROJ) + (size_t)b * SEQ * PINP;
    bf16_t* mix = (bf16_t*)(p.ws + WS_MIX) + (size_t)b * SEQ * DM;
    float* Ks = (float*)lds; float* Vs = (float*)(lds + 16384);
    const int t = qc * 512 + tid; const int twmax = qc * 512 + (tid | 63);
    float q[64], acc[64];
#pragma unroll
    for (int d8 = 0; d8 < 8; ++d8) { const uint4 raw = *(const uint4*)(proj + (size_t)t * PINP + h * 64 + d8 * 8); const bf16_t* rp = (const bf16_t*)&raw;
#pragma unroll
        for (int i = 0; i < 8; ++i) q[d8 * 8 + i] = bf2f(rp[i]) * 0.125f; }
#pragma unroll
    for (int d = 0; d < 64; ++d) acc[d] = 0.f;
    float cs = 0.f;
    for (int kb = qc * 8 + 7; kb >= 0; --kb) {
        __syncthreads();
        { const int key = tid >> 3, d8 = tid & 7; const size_t ro = (size_t)(kb * 64 + key) * PINP + h * 64 + d8 * 8;
          const uint4 rk = *(const uint4*)(proj + ro + 256), rv = *(const uint4*)(proj + ro + 512); const bf16_t* pk = (const bf16_t*)&rk; const bf16_t* pv = (const bf16_t*)&rv;
#pragma unroll
          for (int i = 0; i < 8; ++i) { Ks[key * 64 + d8 * 8 + i] = bf2f(pk[i]); Vs[key * 64 + d8 * 8 + i] = bf2f(pv[i]); } }
        __syncthreads();
        if (kb * 64 < twmax) {
            for (int sl = 63; sl >= 0; --sl) {
                const int s = kb * 64 + sl;
                if (s < t) {
                    float z = 0.f;
#pragma unroll
                    for (int d4 = 0; d4 < 16; ++d4) { const float4 kv = *(const float4*)(Ks + sl * 64 + d4 * 4); z += q[d4 * 4] * kv.x + q[d4 * 4 + 1] * kv.y + q[d4 * 4 + 2] * kv.z + q[d4 * 4 + 3] * kv.w; }
                    const float sp = fmaxf(z, 0.f) + log1pf(expf(-fabsf(z)));
                    cs += sp;
                    const float w = expf(z - cs);
#pragma unroll
                    for (int d4 = 0; d4 < 16; ++d4) { const float4 vv = *(const float4*)(Vs + sl * 64 + d4 * 4); acc[d4 * 4] += w * vv.x; acc[d4 * 4 + 1] += w * vv.y; acc[d4 * 4 + 2] += w * vv.z; acc[d4 * 4 + 3] += w * vv.w; }
                }
            }
        }
    }
#pragma unroll
    for (int d8 = 0; d8 < 8; ++d8) { uint4 o; bf16_t* op = (bf16_t*)&o;
#pragma unroll
        for (int i = 0; i < 8; ++i) op[i] = f2bf(acc[d8 * 8 + i]);
        *(uint4*)(mix + (size_t)t * DM + h * 64 + d8 * 8) = o; }
}

__device__ __forceinline__ void da_item(const Params& p, int l, int bh, int qc, unsigned char* lds) {
    const int tid = otid(), b = bh >> 2, h = bh & 3, map = tid >> 8, row = tid & 255;
    const bf16_t* proj = (const bf16_t*)(p.ws + WS_PROJ) + (size_t)b * SEQ * PINP;
    bf16_t* mix = (bf16_t*)(p.ws + WS_MIX) + (size_t)b * SEQ * DM;
    const float* biasd = (const float*)(p.ws + WS_BIASD) + h * 2048;
    float* Ks = (float*)lds; float* Vs = (float*)(lds + 16384); float* Bd = (float*)(lds + 32768); float* Ex = (float*)(lds + 40960);
    const int t = qc * 256 + row; const int twmax = qc * 256 + (row | 63);
    __syncthreads();
    for (int i = tid; i < 2048; i += NTHREADS) Bd[i] = biasd[i];
    float q[32], O[64];
#pragma unroll
    for (int d8 = 0; d8 < 4; ++d8) { const uint4 raw = *(const uint4*)(proj + (size_t)t * PINP + 768 + h * 64 + map * 32 + d8 * 8); const bf16_t* rp = (const bf16_t*)&raw;
#pragma unroll
        for (int i = 0; i < 8; ++i) q[d8 * 8 + i] = bf2f(rp[i]) * 0.17677669529663687f; }
#pragma unroll
    for (int d = 0; d < 64; ++d) O[d] = 0.f;
    float mrun = -INFINITY, lsum = 0.f;
    for (int kb = 0; kb <= qc * 4 + 3; ++kb) {
        __syncthreads();
        { const int key = tid >> 3, d8 = tid & 7; const size_t ro = (size_t)(kb * 64 + key) * PINP + 768 + h * 64 + d8 * 8;
          const uint4 rk = *(const uint4*)(proj + ro + 256), rv = *(const uint4*)(proj + ro + 512); const bf16_t* pk = (const bf16_t*)&rk; const bf16_t* pv = (const bf16_t*)&rv;
#pragma unroll
          for (int i = 0; i < 8; ++i) { Ks[key * 64 + d8 * 8 + i] = bf2f(pk[i]); Vs[key * 64 + d8 * 8 + i] = bf2f(pv[i]); } }
        __syncthreads();
        if (kb * 64 <= twmax) {
            for (int sl = 0; sl < 64; ++sl) {
                const int s = kb * 64 + sl;
                if (s <= t) {
                    float z = Bd[t - s];
#pragma unroll
                    for (int d4 = 0; d4 < 8; ++d4) { const float4 kv = *(const float4*)(Ks + sl * 64 + map * 32 + d4 * 4); z += q[d4 * 4] * kv.x + q[d4 * 4 + 1] * kv.y + q[d4 * 4 + 2] * kv.z + q[d4 * 4 + 3] * kv.w; }
                    if (z > mrun) { const float sc = expf(mrun - z); lsum *= sc;
#pragma unroll
                        for (int d = 0; d < 64; ++d) O[d] *= sc;
                        mrun = z; }
                    const float pw = expf(z - mrun);
                    lsum += pw;
#pragma unroll
                    for (int d4 = 0; d4 < 16; ++d4) { const float4 vv = *(const float4*)(Vs + sl * 64 + d4 * 4); O[d4 * 4] += pw * vv.x; O[d4 * 4 + 1] += pw * vv.y; O[d4 * 4 + 2] += pw * vv.z; O[d4 * 4 + 3] += pw * vv.w; }
                }
            }
        }
    }
    const float il = 1.0f / lsum;
    __syncthreads();
    if (map == 1) {
#pragma unroll
        for (int d = 0; d < 64; ++d) Ex[d * 256 + row] = O[d] * il;
    }
    __syncthreads();
    if (map == 0) {
        const float* lp = p.da_lambda + (size_t)l * 128;
        float s1 = 0.f, s2 = 0.f;
        for (int i = 0; i < 32; ++i) { s1 += lp[i] * lp[32 + i]; s2 += lp[64 + i] * lp[96 + i]; }
        const float lam_init = 0.8f - 0.6f * expf(-0.3f * (float)l);
        const float lam = expf(s1) - expf(s2) + lam_init;
        float ms = 0.f;
#pragma unroll
        for (int d = 0; d < 64; ++d) { O[d] = O[d] * il - lam * Ex[d * 256 + row]; ms += O[d] * O[d]; }
        const float r = rsqrtf(ms * (1.0f / 64.0f) + 1e-5f) * (1.0f - lam_init);
        const float* sg = p.da_subln + l * 64;
#pragma unroll
        for (int d8 = 0; d8 < 8; ++d8) { uint4 o; bf16_t* op = (bf16_t*)&o;
#pragma unroll
            for (int i = 0; i < 8; ++i) op[i] = f2bf(O[d8 * 8 + i] * r * sg[d8 * 8 + i]);
            *(uint4*)(mix + (size_t)t * DM + 256 + h * 64 + d8 * 8) = o; }
    }
}

typedef float f32x16 __attribute__((ext_vector_type(16)));
typedef unsigned u32x4v __attribute__((ext_vector_type(4)));
typedef unsigned u32x2v __attribute__((ext_vector_type(2)));
#define AT_KSTR 72
#define AT_VSTR 68
#define AT_KBYTES (64 * AT_KSTR * 2)
#define AT_VBYTES (64 * AT_VSTR * 2)
typedef __bf16 bf16x2_t __attribute__((ext_vector_type(2)));
typedef float f32x2_t __attribute__((ext_vector_type(2)));
__device__ __forceinline__ unsigned pk_bf16(float lo, float hi) { const f32x2_t v = {lo, hi}; const bf16x2_t b = __builtin_convertvector(v, bf16x2_t); return __builtin_bit_cast(unsigned, b); }
__device__ __forceinline__ bf16x8 mk_frag(unsigned a, unsigned b, unsigned c, unsigned d) { u32x4v v; v.x = a; v.y = b; v.z = c; v.w = d; return __builtin_bit_cast(bf16x8, v); }
__device__ __forceinline__ bf16x8 scale_frag(uint4 raw, float sc) {
    return mk_frag(pk_bf16(__uint_as_float(raw.x << 16) * sc, __uint_as_float(raw.x & 0xffff0000u) * sc), pk_bf16(__uint_as_float(raw.y << 16) * sc, __uint_as_float(raw.y & 0xffff0000u) * sc),
                   pk_bf16(__uint_as_float(raw.z << 16) * sc, __uint_as_float(raw.z & 0xffff0000u) * sc), pk_bf16(__uint_as_float(raw.w << 16) * sc, __uint_as_float(raw.w & 0xffff0000u) * sc));
}
struct AtStage {
    uint4 rk; uint2 rv0, rv1;
    __device__ __forceinline__ void load(const bf16_t* kbase, const bf16_t* vbase, int kt, int tid) {
        const int skey = tid >> 3, sc8 = tid & 7, vkp = tid >> 4, vdg = tid & 15;
        rk = *(const uint4*)(kbase + (size_t)(kt * 64 + skey) * PINP + sc8 * 8);
        rv0 = *(const uint2*)(vbase + (size_t)(kt * 64 + 2 * vkp) * PINP + vdg * 4);
        rv1 = *(const uint2*)(vbase + (size_t)(kt * 64 + 2 * vkp + 1) * PINP + vdg * 4);
    }
    __device__ __forceinline__ void store(LAS unsigned char* kb, LAS unsigned char* vb, int tid) const {
        const int skey = tid >> 3, sc8 = tid & 7, vkp = tid >> 4, vdg = tid & 15;
        { u32x4v t_; t_.x = rk.x; t_.y = rk.y; t_.z = rk.z; t_.w = rk.w; *(LAS u32x4v*)(kb + (skey * AT_KSTR + sc8 * 8) * 2) = t_; }
        LAS unsigned* vt = (LAS unsigned*)vb;
        vt[(vdg * 4 + 0) * (AT_VSTR / 2) + vkp] = (rv0.x & 0xffffu) | (rv1.x << 16);
        vt[(vdg * 4 + 1) * (AT_VSTR / 2) + vkp] = (rv0.x >> 16) | (rv1.x & 0xffff0000u);
        vt[(vdg * 4 + 2) * (AT_VSTR / 2) + vkp] = (rv0.y & 0xffffu) | (rv1.y << 16);
        vt[(vdg * 4 + 3) * (AT_VSTR / 2) + vkp] = (rv0.y >> 16) | (rv1.y & 0xffff0000u);
    }
};
__device__ __forceinline__ bf16x8 k_frag(const LAS unsigned char* kb, int keyrow, int dcol) { return *(const LAS bf16x8*)(kb + (keyrow * AT_KSTR + dcol) * 2); }
__device__ __forceinline__ bf16x8 v_frag(const LAS unsigned char* vb, int drow, int keycol) {
    const u32x2v a = *(const LAS u32x2v*)(vb + (drow * AT_VSTR + keycol) * 2), b = *(const LAS u32x2v*)(vb + (drow * AT_VSTR + keycol + 8) * 2);
    return mk_frag(a.x, a.y, b.x, b.y);
}
__device__ __forceinline__ void store_ot(bf16_t* dst  , const f32x16& o0, const f32x16& o1, int hh) {
#pragma unroll
    for (int q = 0; q < 4; ++q) {
        uint2 w; w.x = pk_bf16(o0[4 * q], o0[4 * q + 1]); w.y = pk_bf16(o0[4 * q + 2], o0[4 * q + 3]);
        *(uint2*)(dst + 8 * q + 4 * hh) = w;
        uint2 w1; w1.x = pk_bf16(o1[4 * q], o1[4 * q + 1]); w1.y = pk_bf16(o1[4 * q + 2], o1[4 * q + 3]);
        *(uint2*)(dst + 32 + 8 * q + 4 * hh) = w1;
    }
}

#define SB_VSTR 36
#define SB_WBYTES (32 * AT_KSTR * 2 + 64 * SB_VSTR * 2)
struct SbStage {
    u32x4v rk[4]; u32x2v rv0[4], rv1[4];
    __device__ __forceinline__ void load(const bf16_t* kbase, const bf16_t* vbase, int kb, int lane) {
        const int rsub = lane >> 3, c8 = lane & 7, kps = lane >> 4, dg = lane & 15;
#pragma unroll
        for (int j = 0; j < 4; ++j) {
            rk[j] = *(const u32x4v*)(kbase + (size_t)(kb * 32 + 8 * j + rsub) * PINP + c8 * 8);
            const int kp = 4 * j + kps;
            rv0[j] = *(const u32x2v*)(vbase + (size_t)(kb * 32 + 2 * kp) * PINP + dg * 4);
            rv1[j] = *(const u32x2v*)(vbase + (size_t)(kb * 32 + 2 * kp + 1) * PINP + dg * 4);
        }
    }
    __device__ __forceinline__ void store(LAS unsigned char* kb_, LAS unsigned char* vb_, int lane) const {
        const int rsub = lane >> 3, c8 = lane & 7, kps = lane >> 4, dg = lane & 15;
        LAS unsigned* vt = (LAS unsigned*)vb_;
#pragma unroll
        for (int j = 0; j < 4; ++j) {
            *(LAS u32x4v*)(kb_ + ((8 * j + rsub) * AT_KSTR + c8 * 8) * 2) = rk[j];
            const int kp = 4 * j + kps;
            vt[(dg * 4 + 0) * (SB_VSTR / 2) + kp] = (rv0[j].x & 0xffffu) | (rv1[j].x << 16);
            vt[(dg * 4 + 1) * (SB_VSTR / 2) + kp] = (rv0[j].x >> 16) | (rv1[j].x & 0xffff0000u);
            vt[(dg * 4 + 2) * (SB_VSTR / 2) + kp] = (rv0[j].y & 0xffffu) | (rv1[j].y << 16);
            vt[(dg * 4 + 3) * (SB_VSTR / 2) + kp] = (rv0[j].y >> 16) | (rv1[j].y & 0xffff0000u);
        }
    }
};
__device__ __forceinline__ bf16x8 sbv_frag(const LAS unsigned char* vb, int drow, int keycol) {
    const u32x2v a = *(const LAS u32x2v*)(vb + (drow * SB_VSTR + keycol) * 2), b = *(const LAS u32x2v*)(vb + (drow * SB_VSTR + keycol + 8) * 2);
    return mk_frag(a.x, a.y, b.x, b.y);
}
__device__ __forceinline__ void sbm_item(const Params& p, int bh, int qb, unsigned char* lds) {
    const int tid = otid(), lane = tid & 63, wid = tid >> 6, r = lane & 31, hh = lane >> 5;
    const int b = bh >> 2, h = bh & 3;
    const bf16_t* proj = (const bf16_t*)(p.ws + WS_PROJ) + (size_t)b * SEQ * PINP;
    const bf16_t* kbase = proj + 256 + h * 64; const bf16_t* vbase = proj + 512 + h * 64;
    const int q0w = qb * 256 + wid * 32, t = q0w + r;
    LAS unsigned char* const KW = (LAS unsigned char*)lds + wid * SB_WBYTES; LAS unsigned char* const VW = KW + 32 * AT_KSTR * 2;
    bf16x8 qf[4];
#pragma unroll
    for (int s = 0; s < 4; ++s) qf[s] = scale_frag(*(const uint4*)(proj + (size_t)t * PINP + h * 64 + 16 * s + 8 * hh), 0.125f * LOG2E);
    f32x16 O0, O1;
#pragma unroll
    for (int i = 0; i < 16; ++i) { O0[i] = 0.f; O1[i] = 0.f; }
    float carry = 1.f;
    SbStage st;
    __syncthreads();
    if (q0w + 31 > 0) {
        int kb = (q0w + 30) >> 5;
        st.load(kbase, vbase, kb, lane);
#pragma unroll 1
        for (; kb >= 0; --kb) {
            st.store(KW, VW, lane);
            if (kb > 0) st.load(kbase, vbase, kb - 1, lane);
            const int kbs = 32 * kb;
            f32x16 S;
#pragma unroll
            for (int i = 0; i < 16; ++i) S[i] = 0.f;
#pragma unroll
            for (int s = 0; s < 4; ++s) S = __builtin_amdgcn_mfma_f32_32x32x16_bf16(k_frag(KW, r, 16 * s + 8 * hh), qf[s], S, 0, 0, 0);
            const bool needmask = (kbs + 31 >= q0w);
            float sg[16], G[4];
#pragma unroll
            for (int q = 0; q < 4; ++q) {
                float om[4];
#pragma unroll
                for (int i = 0; i < 4; ++i) {
                    const float z = S[4 * q + i];
                    const float e = __builtin_amdgcn_exp2f(-fabsf(z));
                    const float rr = __builtin_amdgcn_rcpf(1.0f + e);
                    const float er = e * rr;
                    float sgm = z >= 0.f ? rr : er, omm = z >= 0.f ? er : rr;
                    if (needmask) { const int key = kbs + i + 8 * q + 4 * hh; if (key >= t) { sgm = 0.f; omm = 1.f; } }
                    sg[4 * q + i] = sgm; om[i] = omm;
                }
                const float pp2 = om[3], pp1 = pp2 * om[2], pp0 = pp1 * om[1];
                G[q] = pp0 * om[0];
                sg[4 * q + 2] *= pp2; sg[4 * q + 1] *= pp1; sg[4 * q + 0] *= pp0;
            }
            float Gp[4];
#pragma unroll
            for (int q = 0; q < 4; ++q) Gp[q] = __shfl_xor(G[q], 32);
            const float T0 = G[0] * Gp[0], T1 = G[1] * Gp[1], T2 = G[2] * Gp[2], T3 = G[3] * Gp[3];
            const float U2 = T3, U1 = T3 * T2, U0 = U1 * T1;
            float E[4];
            E[3] = carry; E[2] = carry * U2; E[1] = carry * U1; E[0] = carry * U0;
            if (hh == 0) { E[3] *= Gp[3]; E[2] *= Gp[2]; E[1] *= Gp[1]; E[0] *= Gp[0]; }
            carry = carry * U0 * T0;
#pragma unroll
            for (int q = 0; q < 4; ++q) { sg[4 * q] *= E[q]; sg[4 * q + 1] *= E[q]; sg[4 * q + 2] *= E[q]; sg[4 * q + 3] *= E[q]; }
            const bf16x8 P0 = mk_frag(pk_bf16(sg[0], sg[1]), pk_bf16(sg[2], sg[3]), pk_bf16(sg[4], sg[5]), pk_bf16(sg[6], sg[7]));
            const bf16x8 P1 = mk_frag(pk_bf16(sg[8], sg[9]), pk_bf16(sg[10], sg[11]), pk_bf16(sg[12], sg[13]), pk_bf16(sg[14], sg[15]));
            O0 = __builtin_amdgcn_mfma_f32_32x32x16_bf16(sbv_frag(VW, r, 4 * hh), P0, O0, 0, 0, 0);
            O0 = __builtin_amdgcn_mfma_f32_32x32x16_bf16(sbv_frag(VW, r, 16 + 4 * hh), P1, O0, 0, 0, 0);
            O1 = __builtin_amdgcn_mfma_f32_32x32x16_bf16(sbv_frag(VW, 32 + r, 4 * hh), P0, O1, 0, 0, 0);
            O1 = __builtin_amdgcn_mfma_f32_32x32x16_bf16(sbv_frag(VW, 32 + r, 16 + 4 * hh), P1, O1, 0, 0, 0);
            if (__all(carry < 1e-30f)) break;
        }
    }
    { const int tid2 = otid(), hh2 = (tid2 & 63) >> 5, t2 = qb * 256 + (tid2 >> 6) * 32 + (tid2 & 31);
      store_ot((bf16_t*)(p.ws + WS_MIX) + (size_t)((bh >> 2) * SEQ + t2) * DM + (bh & 3) * 64, O0, O1, hh2); }
}

__device__ __forceinline__ void dam_item(const Params& p, int l, int bh, int qb, unsigned char* lds) {
    const int tid = otid(), lane = tid & 63, wid = tid >> 6, r = lane & 31, hh = lane >> 5;
    const int b = bh >> 2, h = bh & 3;
    const bf16_t* proj = (const bf16_t*)(p.ws + WS_PROJ) + (size_t)b * SEQ * PINP;
    const bf16_t* kbase = proj + 1024 + h * 64; const bf16_t* vbase = proj + 1280 + h * 64;
    const float* biasd = (const float*)(p.ws + WS_BIASD) + h * 2048;
    const int q0w = qb * 256 + wid * 32, t = q0w + r;
    LAS unsigned char* const L = (LAS unsigned char*)lds;
#define KBUF(b_) (L + (b_) * AT_KBYTES)
#define VBUF(b_) (L + 2 * AT_KBYTES + (b_) * AT_VBYTES)
    LAS float* Bd = (LAS float*)(L + 2 * AT_KBYTES + 2 * AT_VBYTES + 64);
    bf16x8 qf[2][2];
#pragma unroll
    for (int m = 0; m < 2; ++m)
#pragma unroll
        for (int s = 0; s < 2; ++s) qf[m][s] = scale_frag(*(const uint4*)(proj + (size_t)t * PINP + 768 + h * 64 + m * 32 + 16 * s + 8 * hh), 0.17677669529663687f * LOG2E);
    f32x16 O[2][2];
#pragma unroll
    for (int m = 0; m < 2; ++m)
#pragma unroll
        for (int d = 0; d < 2; ++d)
#pragma unroll
            for (int i = 0; i < 16; ++i) O[m][d][i] = 0.f;
    float lrun[2] = {0.f, 0.f};
    const float cfar = biasd[2047] * LOG2E;
    AtStage st;
    const int ktop = qb * 4 + 3;
    __syncthreads();
    if (tid < 320) Bd[tid] = tid >= 64 ? biasd[tid - 64] * LOG2E : 0.f;
    st.load(kbase, vbase, 0, tid); st.store(KBUF(0), VBUF(0), tid);
    __syncthreads();
#pragma unroll 1
    for (int kt = 0; kt <= ktop; ++kt) {
        const int buf = kt & 1;
        if (kt < ktop) st.load(kbase, vbase, kt + 1, tid);
        if (64 * kt <= q0w + 31) {
            const bool far = (q0w - (64 * kt + 63) >= 128);
            const int dbase = t - 64 * kt - 4 * hh;
            const LAS float* bp = Bd + 64 + dbase;
            const float sinit = far ? cfar : 0.f;
#pragma unroll
            for (int kb32 = 0; kb32 < 2; ++kb32) {
                if (64 * kt + 32 * kb32 <= q0w + 31) {
                    f32x16 S0, S1;
#pragma unroll
                    for (int i = 0; i < 16; ++i) { S0[i] = sinit; S1[i] = sinit; }
                    {
                        const bf16x8 k00 = k_frag(KBUF(buf), kb32 * 32 + r, 8 * hh), k01 = k_frag(KBUF(buf), kb32 * 32 + r, 16 + 8 * hh);
                        const bf16x8 k10 = k_frag(KBUF(buf), kb32 * 32 + r, 32 + 8 * hh), k11 = k_frag(KBUF(buf), kb32 * 32 + r, 48 + 8 * hh);
                        S0 = __builtin_amdgcn_mfma_f32_32x32x16_bf16(k00, qf[0][0], S0, 0, 0, 0);
                        S1 = __builtin_amdgcn_mfma_f32_32x32x16_bf16(k10, qf[1][0], S1, 0, 0, 0);
                        S0 = __builtin_amdgcn_mfma_f32_32x32x16_bf16(k01, qf[0][1], S0, 0, 0, 0);
                        S1 = __builtin_amdgcn_mfma_f32_32x32x16_bf16(k11, qf[1][1], S1, 0, 0, 0);
                    }
                    const bf16x8 va0 = v_frag(VBUF(buf), r, kb32 * 32 + 4 * hh), vb0 = v_frag(VBUF(buf), r, kb32 * 32 + 16 + 4 * hh);
                    const bf16x8 va1 = v_frag(VBUF(buf), 32 + r, kb32 * 32 + 4 * hh), vb1 = v_frag(VBUF(buf), 32 + r, kb32 * 32 + 16 + 4 * hh);
                    if (!far) {
                        asm volatile("; near-diagonal tile: bias by distance + causal mask" ::: "memory");
#pragma unroll
                        for (int i = 0; i < 16; ++i) {
                            const int c = 32 * kb32 + (i & 3) + 8 * (i >> 2);
                            const float bb = bp[-c];
                            const bool ok = (dbase - c >= 0);
                            S0[i] = ok ? S0[i] + bb : -INFINITY; S1[i] = ok ? S1[i] + bb : -INFINITY;
                        }
                    }
                    float ls0 = 0.f, ls1 = 0.f;
#pragma unroll
                    for (int i = 0; i < 16; ++i) { const float p0 = __builtin_amdgcn_exp2f(S0[i]), p1 = __builtin_amdgcn_exp2f(S1[i]); S0[i] = p0; S1[i] = p1; ls0 += p0; ls1 += p1; }
                    lrun[0] += ls0; lrun[1] += ls1;
                    const bf16x8 P00 = mk_frag(pk_bf16(S0[0], S0[1]), pk_bf16(S0[2], S0[3]), pk_bf16(S0[4], S0[5]), pk_bf16(S0[6], S0[7]));
                    const bf16x8 P01 = mk_frag(pk_bf16(S0[8], S0[9]), pk_bf16(S0[10], S0[11]), pk_bf16(S0[12], S0[13]), pk_bf16(S0[14], S0[15]));
                    const bf16x8 P10 = mk_frag(pk_bf16(S1[0], S1[1]), pk_bf16(S1[2], S1[3]), pk_bf16(S1[4], S1[5]), pk_bf16(S1[6], S1[7]));
                    const bf16x8 P11 = mk_frag(pk_bf16(S1[8], S1[9]), pk_bf16(S1[10], S1[11]), pk_bf16(S1[12], S1[13]), pk_bf16(S1[14], S1[15]));
                    O[0][0] = __builtin_amdgcn_mfma_f32_32x32x16_bf16(va0, P00, O[0][0], 0, 0, 0);
                    O[1][0] = __builtin_amdgcn_mfma_f32_32x32x16_bf16(va0, P10, O[1][0], 0, 0, 0);
                    O[0][1] = __builtin_amdgcn_mfma_f32_32x32x16_bf16(va1, P00, O[0][1], 0, 0, 0);
                    O[1][1] = __builtin_amdgcn_mfma_f32_32x32x16_bf16(va1, P10, O[1][1], 0, 0, 0);
                    O[0][0] = __builtin_amdgcn_mfma_f32_32x32x16_bf16(vb0, P01, O[0][0], 0, 0, 0);
                    O[1][0] = __builtin_amdgcn_mfma_f32_32x32x16_bf16(vb0, P11, O[1][0], 0, 0, 0);
                    O[0][1] = __builtin_amdgcn_mfma_f32_32x32x16_bf16(vb1, P01, O[0][1], 0, 0, 0);
                    O[1][1] = __builtin_amdgcn_mfma_f32_32x32x16_bf16(vb1, P11, O[1][1], 0, 0, 0);
                }
            }
        }
        if (kt < ktop) st.store(KBUF(buf ^ 1), VBUF(buf ^ 1), tid);
        __syncthreads();
    }
    const int tid2 = otid(), hh2 = (tid2 & 63) >> 5, t2 = qb * 256 + (tid2 >> 6) * 32 + (tid2 & 31);
    const float* lp = p.da_lambda + (size_t)l * 128;
    float s1 = 0.f, s2 = 0.f;
    for (int i = 0; i < 32; ++i) { s1 += lp[i] * lp[32 + i]; s2 += lp[64 + i] * lp[96 + i]; }
    const float lam_init = 0.8f - 0.6f * expf(-0.3f * (float)l);
    const float lam = expf(s1) - expf(s2) + lam_init;
    const float l0 = lrun[0] + __shfl_xor(lrun[0], 32), l1 = lrun[1] + __shfl_xor(lrun[1], 32);
    const float i0 = 1.0f / l0, i1 = lam / l1;
    float ms = 0.f;
#pragma unroll
    for (int d = 0; d < 2; ++d)
#pragma unroll
        for (int i = 0; i < 16; ++i) { const float o = O[0][d][i] * i0 - O[1][d][i] * i1; O[0][d][i] = o; ms += o * o; }
    ms += __shfl_xor(ms, 32);
    const float rs = rsqrtf(ms * (1.0f / 64.0f) + 1e-5f) * (1.0f - lam_init);
    const float* sgn = p.da_subln + l * 64;
#pragma unroll
    for (int d = 0; d < 2; ++d)
#pragma unroll
        for (int i = 0; i < 16; ++i) O[0][d][i] *= rs * sgn[d * 32 + (i & 3) + 8 * (i >> 2) + 4 * hh2];
    store_ot((bf16_t*)(p.ws + WS_MIX) + (size_t)((bh >> 2) * SEQ + t2) * DM + 256 + (bh & 3) * 64, O[0][0], O[0][1], hh2);
}

__device__ __forceinline__ void bf8_to_f(const uint4& v, float (&o)[8]) {
    o[0] = __uint_as_float(v.x << 16); o[1] = __uint_as_float(v.x & 0xffff0000u); o[2] = __uint_as_float(v.y << 16); o[3] = __uint_as_float(v.y & 0xffff0000u);
    o[4] = __uint_as_float(v.z << 16); o[5] = __uint_as_float(v.z & 0xffff0000u); o[6] = __uint_as_float(v.w << 16); o[7] = __uint_as_float(v.w & 0xffff0000u);
}
__device__ __forceinline__ void conv_item(const Params& p, int l, int item) {
    const int tid = otid();
    const bf16_t* proj = (const bf16_t*)(p.ws + WS_PROJ); bf16_t* mix = (bf16_t*)(p.ws + WS_MIX);
    const float* cw = p.sc_conv + (size_t)l * 3 * 256;
    const int c8 = (tid & 31) * 8;
    float w0[8], w1[8], w2[8];
#pragma unroll
    for (int i = 0; i < 8; ++i) { w0[i] = cw[c8 + i]; w1[i] = cw[256 + c8 + i]; w2[i] = cw[512 + c8 + i]; }
#pragma unroll 4
    for (int k = 0; k < 16; ++k) {
        const int rr = (tid >> 5) + 16 * k;
        const size_t row = (size_t)item * 256 + rr; const int t = (int)(row & (SEQ - 1));
        const bf16_t* pr = proj + row * PINP + 1536 + c8;
        const uint4 zz = make_uint4(0u, 0u, 0u, 0u);
        const uint4 bv = *(const uint4*)pr, c2 = *(const uint4*)(pr + 256), h2 = *(const uint4*)(pr + 512);
        const uint4 c1 = t >= 1 ? *(const uint4*)(pr + 256 - PINP) : zz, h1 = t >= 1 ? *(const uint4*)(pr + 512 - PINP) : zz;
        const uint4 c0 = t >= 2 ? *(const uint4*)(pr + 256 - 2 * PINP) : zz, h0 = t >= 2 ? *(const uint4*)(pr + 512 - 2 * PINP) : zz;
        float fb[8], fc2[8], fh2[8], fc1[8], fh1[8], fc0[8], fh0[8], y[8];
        bf8_to_f(bv, fb); bf8_to_f(c2, fc2); bf8_to_f(h2, fh2); bf8_to_f(c1, fc1); bf8_to_f(h1, fh1); bf8_to_f(c0, fc0); bf8_to_f(h0, fh0);
#pragma unroll
        for (int i = 0; i < 8; ++i) y[i] = fb[i] * (w0[i] * (fc0[i] * fh0[i]) + w1[i] * (fc1[i] * fh1[i]) + w2[i] * (fc2[i] * fh2[i]));
        uint4 o; o.x = pk_bf16(y[0], y[1]); o.y = pk_bf16(y[2], y[3]); o.z = pk_bf16(y[4], y[5]); o.w = pk_bf16(y[6], y[7]);
        *(uint4*)(mix + row * DM + 512 + c8) = o;
    }
}

template <int CTRL> __device__ __forceinline__ float dpp_f(float v) { return __int_as_float(__builtin_amdgcn_update_dpp(0, __float_as_int(v), CTRL, 0xf, 0xf, true)); }
__device__ __forceinline__ float red16(float x) { x += dpp_f<0xB1>(x); x += dpp_f<0x4E>(x); x += dpp_f<0x141>(x); x += dpp_f<0x140>(x); return x; }
__device__ __forceinline__ float fsigmoid(float x) { return __builtin_amdgcn_rcpf(1.0f + __builtin_amdgcn_exp2f(-x * LOG2E)); }
__device__ __forceinline__ float ftanh(float x) { return 1.0f - 2.0f * __builtin_amdgcn_rcpf(1.0f + __builtin_amdgcn_exp2f(x * (2.0f * LOG2E))); }
#define MF16(a, b, c) __builtin_amdgcn_mfma_f32_16x16x32_bf16(a, b, c, 0, 0, 0)
__device__ __forceinline__ bf16x8 frag_lo(const f32x4& c) { return mk_frag(pk_bf16(c[0], c[1]), pk_bf16(c[2], c[3]), 0u, 0u); }
__device__ __forceinline__ bf16x8 frag_lo_hi(const f32x4& c, uint2 hi) { return mk_frag(pk_bf16(c[0], c[1]), pk_bf16(c[2], c[3]), hi.x, hi.y); }
__device__ __forceinline__ bf16x8 frag_u2(uint2 lo, uint2 hi) { return mk_frag(lo.x, lo.y, hi.x, hi.y); }
__device__ __forceinline__ f32x4 tt64(const bf16_t* arow, const bf16_t* brow, int g, f32x4 c) {
    c = MF16(*(const bf16x8*)(arow + 8 * g), *(const bf16x8*)(brow + 8 * g), c);
    c = MF16(*(const bf16x8*)(arow + 32 + 8 * g), *(const bf16x8*)(brow + 32 + 8 * g), c);
    return c;
}
#define RW_RS 72
#define RW_TS 20
struct RwPre { uint4 cu[3], pr[3]; };
__device__ __forceinline__ int rw_col(int gq, int h) { return gq < 8 ? h * 64 + gq * 8 : gq < 16 ? 256 + h * 64 + (gq - 8) * 8 : gq < 24 ? 512 + h * 64 + (gq - 16) * 8 : 768 + (gq - 24) * 8; }
__device__ __forceinline__ void rw_prefetch(RwPre& q, const bf16_t* proj, int t0, int h, int tid) {
#pragma unroll
    for (int k = 0; k < 3; ++k) {
        const int i = tid + k * NTHREADS;
        if (i < 1280) {
            const int tt = i / 40, gq = i % 40, t = t0 + tt, col = rw_col(gq, h);
            q.cu[k] = *(const uint4*)(proj + (size_t)t * PINP + col);
            q.pr[k] = (t > 0) ? *(const uint4*)(proj + (size_t)(t - 1) * PINP + col) : make_uint4(0u, 0u, 0u, 0u);
        }
    }
}
__device__ __forceinline__ void rwkv_item(const Params& p, int l, int bh, unsigned char* lds) {
    const int tid = otid(), b = bh >> 2, h = bh & 3;
    const int lane = tid & 63, wv = tid >> 6, n = lane & 15, g = lane >> 4;
    const bf16_t* proj = (const bf16_t*)(p.ws + WS_PROJ) + (size_t)b * SEQ * PINP + 2304;
    bf16_t* mix = (bf16_t*)(p.ws + WS_MIX) + (size_t)b * SEQ * DM + 768 + h * 64;
    const float* mu = p.rw_mu + (size_t)l * 896;
    const float* vecs = p.rw_vecs + (size_t)l * 7 * 256 + h * 64;
    bf16_t* WupT = (bf16_t*)lds; bf16_t* AupT = WupT + 64 * 40; bf16_t* GupT = AupT + 64 * 40;
    float* xr = (float*)(GupT + 64 * RW_RS); float* xk = xr + 2048; float* xv = xk + 2048;
    bf16_t* XW = (bf16_t*)(xv + 2048); bf16_t* XA = XW + 32 * 40; bf16_t* XG = XA + 32 * 40;
    float* lw = (float*)(XG + 32 * RW_RS); float* ab = lw + 2048; float* kk = ab + 2048; float* gg = kk + 2048;
    float* yy = gg + 2048;
    float* pn2 = yy + 2048; float* pbo = pn2 + 128;
    bf16_t* CS = (bf16_t*)(pbo + 128);
#define RW_SET (4 * 16 * RW_RS + 3 * 64 * RW_TS + 4 * 16 * RW_TS + 128)
#define RW_KT(s_) (CS + (s_) * RW_SET)
#define RW_BT(s_) (RW_KT(s_) + 16 * RW_RS)
#define RW_KK(s_) (RW_BT(s_) + 16 * RW_RS)
#define RW_RT(s_) (RW_KK(s_) + 16 * RW_RS)
#define RW_BH(s_) (RW_RT(s_) + 16 * RW_RS)
#define RW_KH(s_) (RW_BH(s_) + 64 * RW_TS)
#define RW_VT(s_) (RW_KH(s_) + 64 * RW_TS)
#define RW_AAK(s_) (RW_VT(s_) + 64 * RW_TS)
#define RW_ARB(s_) (RW_AAK(s_) + 16 * RW_TS)
#define RW_ARK(s_) (RW_ARB(s_) + 16 * RW_TS)
#define RW_TA(s_) (RW_ARK(s_) + 16 * RW_TS)
#define RW_GC(s_) ((float*)(RW_TA(s_) + 16 * RW_TS))
    bf16_t* Sb0 = CS + 2 * RW_SET; bf16_t* Sb1 = Sb0 + 64 * RW_RS;
    __syncthreads();
    for (int i = tid; i < 2048; i += NTHREADS) { const int m = i >> 6, c = i & 63; WupT[c * 40 + m] = f2bf(p.rw_w_up[(size_t)l * 32 * 256 + m * 256 + h * 64 + c]); AupT[c * 40 + m] = f2bf(p.rw_a_up[(size_t)l * 32 * 256 + m * 256 + h * 64 + c]); }
    for (int i = tid; i < 4096; i += NTHREADS) { const int m = i >> 6, c = i & 63; GupT[c * RW_RS + m] = f2bf(p.rw_g_up[(size_t)l * 64 * 256 + m * 256 + h * 64 + c]); }
    for (int i = tid; i < 64 * RW_RS / 2; i += NTHREADS) ((unsigned*)Sb0)[i] = 0u;
    const int ptt = (tid & 255) >> 4, pc = (tid & 15) * 4, pset = tid >> 8;
    const float4 v_lg = *(const float4*)(vecs + 1280 + pc), v_lb = *(const float4*)(vecs + 1536 + pc);
    const int s2mt = wv & 1, s2c = (wv >> 1) * 16 + n;
    const float c_w0 = vecs[s2c], c_a0 = vecs[256 + s2c], c_kk = vecs[512 + s2c], c_ka = vecs[768 + s2c], c_rk = vecs[1024 + s2c];
    const int ib = wv & 3, jh = wv >> 2;
    f32x4 St0 = {0.f, 0.f, 0.f, 0.f}, St1 = {0.f, 0.f, 0.f, 0.f};
    int cur = 0;
    RwPre pre;
    rw_prefetch(pre, proj, 0, h, tid);
#pragma unroll 1
    for (int t0 = 0; t0 < SEQ; t0 += 32) {
        __syncthreads();
#pragma unroll
        for (int k = 0; k < 3; ++k) {
            const int i = tid + k * NTHREADS;
            if (i < 1280) {
                const int tt = i / 40, gq = i % 40; const int col = rw_col(gq, h);
                const uint4 cu = pre.cu[k], pr = pre.pr[k];
                const float4 m0 = *(const float4*)(mu + col), m1 = *(const float4*)(mu + col + 4);
                float o[8];
                { float c, q;
                  c = __uint_as_float(cu.x << 16); q = __uint_as_float(pr.x << 16); o[0] = c + (q - c) * m0.x;
                  c = __uint_as_float(cu.x & 0xffff0000u); q = __uint_as_float(pr.x & 0xffff0000u); o[1] = c + (q - c) * m0.y;
                  c = __uint_as_float(cu.y << 16); q = __uint_as_float(pr.y << 16); o[2] = c + (q - c) * m0.z;
                  c = __uint_as_float(cu.y & 0xffff0000u); q = __uint_as_float(pr.y & 0xffff0000u); o[3] = c + (q - c) * m0.w;
                  c = __uint_as_float(cu.z << 16); q = __uint_as_float(pr.z << 16); o[4] = c + (q - c) * m1.x;
                  c = __uint_as_float(cu.z & 0xffff0000u); q = __uint_as_float(pr.z & 0xffff0000u); o[5] = c + (q - c) * m1.y;
                  c = __uint_as_float(cu.w << 16); q = __uint_as_float(pr.w << 16); o[6] = c + (q - c) * m1.z;
                  c = __uint_as_float(cu.w & 0xffff0000u); q = __uint_as_float(pr.w & 0xffff0000u); o[7] = c + (q - c) * m1.w; }
                if (gq < 24) {
                    float* dst = gq < 8 ? xr + tt * 64 + gq * 8 : gq < 16 ? xk + tt * 64 + (gq - 8) * 8 : xv + tt * 64 + (gq - 16) * 8;
                    *(float4*)dst = make_float4(o[0], o[1], o[2], o[3]); *(float4*)(dst + 4) = make_float4(o[4], o[5], o[6], o[7]);
                } else {
                    if (gq < 28) {
#pragma unroll
                        for (int e = 0; e < 8; ++e) o[e] = ftanh(o[e]);
                    } else if (gq >= 32) {
#pragma unroll
                        for (int e = 0; e < 8; ++e) o[e] = fsigmoid(o[e]);
                    }
                    bf16_t* dst = gq < 28 ? XW + tt * 40 + (gq - 24) * 8 : gq < 32 ? XA + tt * 40 + (gq - 28) * 8 : XG + tt * RW_RS + (gq - 32) * 8;
                    uint4 w; w.x = pk_bf16(o[0], o[1]); w.y = pk_bf16(o[2], o[3]); w.z = pk_bf16(o[4], o[5]); w.w = pk_bf16(o[6], o[7]);
                    *(uint4*)dst = w;
                }
            }
        }
        if (t0 + 32 < SEQ) rw_prefetch(pre, proj, t0 + 32, h, tid);
        __syncthreads();
        {
            const f32x4 z4 = {0.f, 0.f, 0.f, 0.f};
            const int arow = s2mt * 16 + n;
            const f32x4 dec = MF16(*(const bf16x8*)(XW + arow * 40 + 8 * g), *(const bf16x8*)(WupT + s2c * 40 + 8 * g), z4);
            const f32x4 av = MF16(*(const bf16x8*)(XA + arow * 40 + 8 * g), *(const bf16x8*)(AupT + s2c * 40 + 8 * g), z4);
            const f32x4 gt = tt64(XG + arow * RW_RS, GupT + s2c * RW_RS, g, z4);
            const float dk = -0.6065306597126334f * LOG2E;
#pragma unroll
            for (int r = 0; r < 4; ++r) {
                const int tt = s2mt * 16 + 4 * g + r, i = tt * 64 + s2c;
                const float a = fsigmoid(av[r] + c_a0);
                const float kraw = xk[i], rv = xr[i];
                const float kku = kraw * c_kk, kp = kraw * (1.0f + (a - 1.0f) * c_ka);
                const float n2 = red16(kku * kku), bo = red16(rv * kp * c_rk);
                lw[i] = dk * fsigmoid(dec[r] + c_w0); gg[i] = gt[r]; kk[i] = kku; ab[i] = a; xk[i] = kp;
                if (n == 0) { pn2[tt * 4 + (wv >> 1)] = n2; pbo[tt * 4 + (wv >> 1)] = bo; }
            }
        }
        __syncthreads();
        {
            const int c3 = tid & 63, part = tid >> 6, ta = 2 * part;
#pragma unroll 1
            for (int cb = 0; cb < 2; ++cb) {
                const int rb = cb * 16;
                float cum = 0.f, cumA = 0.f, cumB = 0.f, lwA = 0.f, lwB = 0.f;
#pragma unroll
                for (int t = 0; t < 16; ++t) { const float lv = lw[(rb + t) * 64 + c3]; cum += lv; if (t == ta) { cumA = cum; lwA = lv; } if (t == ta + 1) { cumB = cum; lwB = lv; } }
                const int iA = (rb + ta) * 64 + c3, iB = iA + 64;
                const float4 nA = *(const float4*)(pn2 + (rb + ta) * 4), nB = *(const float4*)(pn2 + (rb + ta + 1) * 4);
                const float invA = 1.0f / fmaxf(sqrtf((nA.x + nA.y) + (nA.z + nA.w)), 1e-12f), invB = 1.0f / fmaxf(sqrtf((nB.x + nB.y) + (nB.z + nB.w)), 1e-12f);
                const float GA = __builtin_amdgcn_exp2f(cumA), GiA = __builtin_amdgcn_exp2f(-cumA), GmA = __builtin_amdgcn_exp2f(cumA - lwA), GcA = __builtin_amdgcn_exp2f(cum - cumA);
                const float GB = __builtin_amdgcn_exp2f(cumB), GiB = __builtin_amdgcn_exp2f(-cumB), GmB = __builtin_amdgcn_exp2f(cumB - lwB), GcB = __builtin_amdgcn_exp2f(cum - cumB);
                const float kkA = kk[iA] * invA, kkB = kk[iB] * invB, bA = kkA * ab[iA], bB = kkB * ab[iB], kpA = xk[iA], kpB = xk[iB], rA = xr[iA], rB = xr[iB], vA = xv[iA], vB = xv[iB];
                bf16_t* KT = RW_KT(cb);
                KT[ta * RW_RS + c3] = f2bf(kkA * GmA); KT[(ta + 1) * RW_RS + c3] = f2bf(kkB * GmB);
                RW_BT(cb)[ta * RW_RS + c3] = f2bf(bA * GiA); RW_BT(cb)[(ta + 1) * RW_RS + c3] = f2bf(bB * GiB);
                RW_KK(cb)[ta * RW_RS + c3] = f2bf(kpA * GiA); RW_KK(cb)[(ta + 1) * RW_RS + c3] = f2bf(kpB * GiB);
                RW_RT(cb)[ta * RW_RS + c3] = f2bf(rA * GA); RW_RT(cb)[(ta + 1) * RW_RS + c3] = f2bf(rB * GB);
                ((unsigned*)RW_BH(cb))[c3 * (RW_TS / 2) + part] = pk_bf16(bA * GcA, bB * GcB);
                ((unsigned*)RW_KH(cb))[c3 * (RW_TS / 2) + part] = pk_bf16(kpA * GcA, kpB * GcB);
                ((unsigned*)RW_VT(cb))[c3 * (RW_TS / 2) + part] = pk_bf16(vA, vB);
                if (part == 0) RW_GC(cb)[c3] = __builtin_amdgcn_exp2f(cum);
            }
        }
        __syncthreads();
        {
            const f32x4 z4 = {0.f, 0.f, 0.f, 0.f};
            const int role = wv & 3, cs = wv >> 2;
            const bf16_t* KT = RW_KT(cs); const bf16_t* BT = RW_BT(cs); const bf16_t* KKb = RW_KK(cs); const bf16_t* RT = RW_RT(cs);
            if (role == 0) {
                f32x4 cl = tt64(KT + n * RW_RS, BT + n * RW_RS, g, z4);
                f32x4 clt = tt64(BT + n * RW_RS, KT + n * RW_RS, g, z4);
                f32x4 U;
#pragma unroll
                for (int r = 0; r < 4; ++r) { if (!(4 * g + r > n)) cl[r] = 0.f; if (!(n > 4 * g + r)) clt[r] = 0.f; U[r] = ((4 * g + r == n) ? 1.0f : 0.0f) - clt[r]; }
                const f32x4 m2 = MF16(frag_lo(clt), frag_lo(cl), z4), m2t = MF16(frag_lo(cl), frag_lo(clt), z4);
                U = MF16(frag_lo(m2), frag_lo(U), U);
                const f32x4 m4 = MF16(frag_lo(m2t), frag_lo(m2), z4), m4t = MF16(frag_lo(m2), frag_lo(m2t), z4);
                U = MF16(frag_lo(m4), frag_lo(U), U);
                const f32x4 m8 = MF16(frag_lo(m4t), frag_lo(m4), z4);
                U = MF16(frag_lo(m8), frag_lo(U), U);
                uint2 w; w.x = pk_bf16(U[0], U[1]); w.y = pk_bf16(U[2], U[3]);
                *(uint2*)(RW_TA(cs) + n * RW_TS + 4 * g) = w;
            } else {
                const bf16_t* ar = (role == 2) ? BT : KKb; const bf16_t* br = (role == 1) ? KT : RT; bf16_t* dst = (role == 1) ? RW_AAK(cs) : (role == 2) ? RW_ARB(cs) : RW_ARK(cs);
                f32x4 c = tt64(ar + n * RW_RS, br + n * RW_RS, g, z4);
                const int lim = (role == 1) ? n : n + 1;
#pragma unroll
                for (int r = 0; r < 4; ++r) if (!(4 * g + r < lim)) c[r] = 0.f;
                uint2 w; w.x = pk_bf16(c[0], c[1]); w.y = pk_bf16(c[2], c[3]);
                *(uint2*)(dst + n * RW_TS + 4 * g) = w;
            }
        }
        __syncthreads();
#pragma unroll 1
        for (int cb = 0; cb < 2; ++cb) {
            const bf16_t* Sold = cur ? Sb1 : Sb0; bf16_t* Snew = cur ? Sb0 : Sb1;
            const f32x4 z4 = {0.f, 0.f, 0.f, 0.f};
            const uint2 zz = make_uint2(0u, 0u);
            const bf16_t* srow = Sold + (ib * 16 + n) * RW_RS;
            f32x4 q = tt64(RW_KT(cb) + n * RW_RS, srow, g, z4);
            const uint2 aak = *(const uint2*)(RW_AAK(cb) + n * RW_TS + 4 * g), vt = *(const uint2*)(RW_VT(cb) + (ib * 16 + n) * RW_TS + 4 * g);
            q = MF16(frag_u2(aak, zz), frag_u2(vt, zz), q);
            const uint2 ta = *(const uint2*)(RW_TA(cb) + n * RW_TS + 4 * g);
            f32x4 sa = MF16(frag_u2(ta, zz), frag_lo(q), z4);
            sa = -sa;
            const bf16x8 a3 = frag_lo_hi(sa, vt);
            {
                const int j0 = (2 * jh) * 16 + n, j1 = j0 + 16;
                const uint2 bh0 = *(const uint2*)(RW_BH(cb) + j0 * RW_TS + 4 * g), kh0 = *(const uint2*)(RW_KH(cb) + j0 * RW_TS + 4 * g);
                const uint2 bh1 = *(const uint2*)(RW_BH(cb) + j1 * RW_TS + 4 * g), kh1 = *(const uint2*)(RW_KH(cb) + j1 * RW_TS + 4 * g);
                St0 = St0 * RW_GC(cb)[j0]; St1 = St1 * RW_GC(cb)[j1];
                St0 = MF16(a3, frag_u2(bh0, kh0), St0);
                St1 = MF16(a3, frag_u2(bh1, kh1), St1);
#pragma unroll
                for (int r = 0; r < 4; ++r) { Snew[(ib * 16 + 4 * g + r) * RW_RS + j0] = f2bf(St0[r]); Snew[(ib * 16 + 4 * g + r) * RW_RS + j1] = f2bf(St1[r]); }
            }
            if (jh == 1) {
                f32x4 y = tt64(RW_RT(cb) + n * RW_RS, srow, g, z4);
                const uint2 arb = *(const uint2*)(RW_ARB(cb) + n * RW_TS + 4 * g), ark = *(const uint2*)(RW_ARK(cb) + n * RW_TS + 4 * g);
                y = MF16(frag_u2(arb, ark), a3, y);
#pragma unroll
                for (int r = 0; r < 4; ++r) yy[cb * 1024 + (4 * g + r) * 64 + ib * 16 + n] = y[r];
            }
            cur ^= 1;
            __syncthreads();
        }
        {
            const int tok = pset * 16 + ptt, i = tok * 64 + pc;
            const float4 yv = *(const float4*)(yy + pset * 1024 + ptt * 64 + pc), vv = *(const float4*)(xv + i), gv = *(const float4*)(gg + i), b4 = *(const float4*)(pbo + tok * 4);
            const float mean = red16((yv.x + yv.y) + (yv.z + yv.w)) * (1.0f / 64.0f);
            const float4 d = make_float4(yv.x - mean, yv.y - mean, yv.z - mean, yv.w - mean);
            const float var = red16((d.x * d.x + d.y * d.y) + (d.z * d.z + d.w * d.w)) * (1.0f / 64.0f);
            const float rs = rsqrtf(var + 64e-5f), bo = (b4.x + b4.y) + (b4.z + b4.w);
            uint2 w;
            w.x = pk_bf16((d.x * rs * v_lg.x + v_lb.x + bo * vv.x) * gv.x, (d.y * rs * v_lg.y + v_lb.y + bo * vv.y) * gv.y);
            w.y = pk_bf16((d.z * rs * v_lg.z + v_lb.z + bo * vv.z) * gv.z, (d.w * rs * v_lg.w + v_lb.w + bo * vv.w) * gv.w);
            *(uint2*)(mix + (size_t)(t0 + tok) * DM + pc) = w;
        }
    }
}

__device__ __forceinline__ void phase_mixers(const Params& p, int l, unsigned char* lds) {
    unsigned* ctl = (unsigned*)(p.ws + WS_CTL);
    int* slot = (int*)(lds + LDS_BYTES - 64);
#ifndef NO_RW
    for (int it = obid(); it < 128; it += gridDim.x) rwkv_item(p, l, it, lds);
#endif
    for (;;) {
        __syncthreads();
        if (otid() == 0) *slot = (int)atomicAdd(&ctl[CW_QUEUE + l * 64], 1u);
        __syncthreads();
        const int it = *slot;
        if (it >= 1024 + 1024 + 256) break;
        if (it < 1024) {
#ifndef NO_DA
            dam_item(p, l, it & 127, 7 - (it >> 7), lds);
#endif
        } else if (it < 2048) {
#ifndef NO_SB
            const int j = it - 1024; sbm_item(p, j & 127, 7 - (j >> 7), lds);
#endif
        } else conv_item(p, l, it - 2048);
    }
}

__global__ void __launch_bounds__(NTHREADS, 2) fwd(Params p) {
    extern __shared__ __attribute__((aligned(16))) unsigned char lds_raw[];
    if (threadIdx.x == 0) { ((unsigned*)lds_raw)[0] = 0u; ((unsigned*)lds_raw)[1] = 0u; ((unsigned*)lds_raw)[2] = 0u; ((unsigned*)lds_raw)[3] = 0u; }
    __syncthreads();
    unsigned char* lds = lds_raw + 16;
    XcdBarrier bar = xcd_barrier_post((unsigned*)(p.ws + WS_CTL) + CW_BAR, (volatile LAS unsigned*)lds_raw);
#ifndef ONLY
#define ONLY -1
#endif
#define PH(k) (ONLY < 0 || ONLY == (k))
    if (PH(0)) prologue(p, lds);
    xcd_barrier(bar);
    for (int l = 0; l < NLAYER; ++l) {
        if (PH(1)) phase_inproj(p, l, lds);
        xcd_barrier(bar);
        if (PH(2)) phase_mixers(p, l, lds);
        xcd_barrier(bar);
        if (PH(3)) phase_outproj(p, l, lds);
        xcd_barrier(bar);
        if (PH(4)) phase_ln1_route(p, l, lds);
        xcd_barrier(bar);
        if (PH(5)) phase_moe_up(p, l, lds);
        xcd_barrier(bar);
        if (PH(6)) phase_moe_down(p, l, lds);
        xcd_barrier(bar);
        if (PH(7)) phase_ln2(p, l, lds);
        xcd_barrier(bar);
    }
}

extern "C" void kernel_launch(void* const* d_in, const int* in_sizes, int n_in, void* d_out, int out_size, void* d_ws, size_t ws_size, hipStream_t stream) {
    static int grid = 0;
    if (grid == 0) {
        if (n_in != 18 || in_sizes[0] != NTOK * DM || out_size != NTOK * DM || ws_size < WS_END) {
            fprintf(stderr, "kernel_launch: unexpected shapes: n_in %d in0 %d out %d ws %zu (need %llu)\n", n_in, n_in > 0 ? in_sizes[0] : -1, out_size, ws_size, (unsigned long long)WS_END);
            grid = -1; return;
        }
        int dev = 0, cus = 0, per_cu = 0;
        hipGetDevice(&dev);
        hipDeviceGetAttribute(&cus, hipDeviceAttributeMultiprocessorCount, dev);
        hipFuncSetAttribute((const void*)fwd, hipFuncAttributeMaxDynamicSharedMemorySize, LDS_BYTES);
        hipOccupancyMaxActiveBlocksPerMultiprocessor(&per_cu, (const void*)fwd, NTHREADS, LDS_BYTES);
        if (per_cu < 1) { fprintf(stderr, "kernel_launch: occupancy query says %d blocks per CU\n", per_cu); grid = -1; return; }
        grid = cus;
    }
    if (grid < 0) return;
    Params p{};
    p.x = (const float*)d_in[0]; p.w_in = (const float*)d_in[1]; p.w_out = (const float*)d_in[2]; p.da_lambda = (const float*)d_in[3]; p.da_subln = (const float*)d_in[4];
    p.sc_conv = (const float*)d_in[5]; p.rw_mu = (const float*)d_in[6]; p.rw_vecs = (const float*)d_in[7]; p.rw_w_up = (const float*)d_in[8]; p.rw_a_up = (const float*)d_in[9];
    p.rw_g_up = (const float*)d_in[10]; p.ln_gain = (const float*)d_in[11]; p.ln_bias = (const float*)d_in[12]; p.rel_bias = (const float*)d_in[13]; p.router_w = (const float*)d_in[14];
    p.router_b = (const float*)d_in[15]; p.moe_w_in = (const float*)d_in[16]; p.moe_w_down = (const float*)d_in[17];
    p.out = (float*)d_out; p.ws = (unsigned char*)d_ws;
    hipMemsetAsync((char*)d_ws + WS_CTL, 0, CTL_BYTES, stream);
    hipLaunchKernelGGL(fwd, dim3(grid), dim3(NTHREADS), LDS_BYTES, stream, p);
}
```

```cpp
#include <hip/hip_runtime.h>
#include <cstdio>
#include <cstdint>

typedef unsigned short bf16_t;
typedef short bf16x8 __attribute__((ext_vector_type(8)));
typedef float f32x4 __attribute__((ext_vector_type(4)));

#define NTOK 65536
#define SEQ 2048
#define DM 1024
#define PIN 3200
#define PINP 3328
#define NLAYER 4
#define NEXP 16
#define DEXP 256
#define NTHREADS 512
#define LDS_BYTES (152 * 1024)
#define ALPHA 1.6817928305074292f
#define LOG2E 1.4426950408889634f

#define WS_CTL 0ull
#define CTL_BYTES 65536ull
#define WS_BIASD (WS_CTL + CTL_BYTES)
#define WS_WIN (WS_BIASD + 4ull * 2048 * 4)
#define WS_WOUT (WS_WIN + 4ull * PINP * DM * 2)
#define WS_MWIN (WS_WOUT + 4ull * DM * DM * 2)
#define WS_MWDN (WS_MWIN + 4ull * 16 * 512 * 1024 * 2)
#define WS_XB (WS_MWDN + 4ull * 16 * 1024 * 256 * 2)
#define WS_MIX (WS_XB + (unsigned long long)NTOK * DM * 2)
#define WS_LTOK (WS_MIX + (unsigned long long)NTOK * DM * 2)
#define WS_LGATE (WS_LTOK + 16ull * NTOK * 4)
#define WS_PROJ (WS_LGATE + 16ull * NTOK * 4)
#define WS_YB (WS_PROJ + (192ull << 20))
#define WS_Y WS_PROJ
#define WS_H (WS_Y + (unsigned long long)(2 * NTOK + 256) * DM)
#define WS_X8 (WS_PROJ + (unsigned long long)NTOK * PINP * 2)
#define WS_W8 (WS_X8 + (unsigned long long)NTOK * DM)
#define WS_CT (WS_W8 + 4ull * PINP * DM)
#define WS_LAM (WS_CT + 4ull * 6 * 256 * 16)
#define WS_END (WS_LAM + 256ull)

#define CW_BAR 0
#define CW_CNT 4096
#define CW_QUEUE 8192
#define CW_FLAG 12288

#define XB_TMO      128
#define XB_XCNT(j)  (256  + 64 * (j))
#define XB_XSUB(j)  (1280 + 64 * (j))
#define XB_XGEN(j)  (2304 + 64 * (j))
#define XB_TOP      3328
#define XB_TOPGEN   3392
#define XCD_BAR_WORDS 3456
#define XB_SPIN_CAP (1u << 22)
#define LAS __attribute__((address_space(3)))

__device__ __forceinline__ unsigned xb_ld(unsigned* p)              { return __hip_atomic_load(p, __ATOMIC_RELAXED, __HIP_MEMORY_SCOPE_AGENT); }
__device__ __forceinline__ unsigned xb_add(unsigned* p, unsigned v) { return __hip_atomic_fetch_add(p, v, __ATOMIC_RELAXED, __HIP_MEMORY_SCOPE_AGENT); }
__device__ __forceinline__ unsigned xb_xcc_id() { return (unsigned)__builtin_amdgcn_s_getreg((3 << 11) | 20) & 0xFu; }
#define XB_SPIN(cond, bar) do { unsigned _sp = 0; while (cond) { __builtin_amdgcn_s_sleep(1); \
    if ((++_sp & 255u) == 0u) { if (xb_ld(&(bar)[XB_TMO])) break; if (_sp > XB_SPIN_CAP) { atomicAdd(&(bar)[XB_TMO], 1u); break; } } } } while (0)

struct XcdBarrier { unsigned* bar; unsigned x; volatile LAS unsigned* st; };

__device__ __forceinline__ XcdBarrier xcd_barrier_post(unsigned* bar, volatile LAS unsigned* st) {
    XcdBarrier b; b.bar = bar; b.x = xb_xcc_id(); b.st = st;
    if (threadIdx.x == 0) (void)xb_add(&bar[XB_XCNT(b.x)], 1u);
    return b;
}
__device__ __forceinline__ void xcd_barrier_complete(unsigned* bar, unsigned x, unsigned& nloc, unsigned& nx) {
    const unsigned G = gridDim.x * gridDim.y * gridDim.z;
    unsigned sum, cnt, mine, sp = 0u;
    for (;;) {
        sum = 0u; cnt = 0u; mine = 0u;
#pragma unroll
        for (unsigned j = 0; j < 16; ++j) { const unsigned c = xb_ld(&bar[XB_XCNT(j)]); sum += c; cnt += (c > 0u) ? 1u : 0u; mine = (j == x) ? c : mine; }
        if (sum == G) break;
        __builtin_amdgcn_s_sleep(1);
        if ((++sp & 255u) == 0u) { if (xb_ld(&bar[XB_TMO])) break; if (sp > XB_SPIN_CAP) { atomicAdd(&bar[XB_TMO], 1u); break; } }
    }
    nloc = mine > 0u ? mine : 1u; nx = cnt > 0u ? cnt : 1u;
}
__device__ __forceinline__ void xcd_barrier(const XcdBarrier& b) {
    asm volatile("s_waitcnt vmcnt(0)" ::: "memory");
    __syncthreads();
    if (threadIdx.x == 0) {
        unsigned* bar = b.bar;
        __builtin_amdgcn_s_waitcnt(0);
        const unsigned bx = xb_xcc_id();
        unsigned nloc = b.st[0], nx = b.st[1];
        if (nloc == 0u) { xcd_barrier_complete(bar, bx, nloc, nx); b.st[0] = nloc; b.st[1] = nx; }
        const unsigned old = xb_add(&bar[XB_XSUB(bx)], 1u);
        const unsigned gen = old / nloc;
        if (old + 1u == (gen + 1u) * nloc) {
            __builtin_amdgcn_fence(__ATOMIC_RELEASE, "agent");
            asm volatile("s_waitcnt vmcnt(0)" ::: "memory");
            const unsigned og = xb_add(&bar[XB_TOP], 1u);
            const unsigned tg = og / nx;
            if (og + 1u == (tg + 1u) * nx) xb_add(&bar[XB_TOPGEN], 1u);
            else XB_SPIN(xb_ld(&bar[XB_TOPGEN]) == tg, bar);
            __builtin_amdgcn_fence(__ATOMIC_ACQUIRE, "agent");
            xb_add(&bar[XB_XGEN(bx)], 1u);
            asm volatile("s_waitcnt vmcnt(0)" ::: "memory");
        } else {
            XB_SPIN(xb_ld(&bar[XB_XGEN(bx)]) == gen, bar);
            __builtin_amdgcn_fence(__ATOMIC_ACQUIRE, "agent");
            asm volatile("s_waitcnt vmcnt(0)" ::: "memory");
        }
    }
    __syncthreads();
}

__device__ __forceinline__ int otid() { int t = threadIdx.x; asm volatile("" : "+v"(t)); return t; }
__device__ __forceinline__ int obid() { int t = blockIdx.x; asm volatile("" : "+s"(t)); return t; }
__device__ __forceinline__ float bf2f(bf16_t v) { return __uint_as_float(((unsigned)v) << 16); }
__device__ __forceinline__ bf16_t f2bf(float f) { unsigned u = __float_as_uint(f); u += 0x7fffu + ((u >> 16) & 1u); return (bf16_t)(u >> 16); }
__device__ __forceinline__ float sigmoidf_(float x) { return 1.0f / (1.0f + expf(-x)); }
template <int CTRL> __device__ __forceinline__ float dppw_f(float v) { return __int_as_float(__builtin_amdgcn_update_dpp(0, __float_as_int(v), CTRL, 0xf, 0xf, true)); }
__device__ __forceinline__ float wave_sum(float v) {
    v += dppw_f<0xB1>(v); v += dppw_f<0x4E>(v); v += dppw_f<0x141>(v); v += dppw_f<0x140>(v);
    const float r0 = __int_as_float(__builtin_amdgcn_readlane(__float_as_int(v), 0)), r1 = __int_as_float(__builtin_amdgcn_readlane(__float_as_int(v), 16));
    const float r2 = __int_as_float(__builtin_amdgcn_readlane(__float_as_int(v), 32)), r3 = __int_as_float(__builtin_amdgcn_readlane(__float_as_int(v), 48));
    return (r0 + r1) + (r2 + r3);
}

typedef unsigned u32x4v __attribute__((ext_vector_type(4)));
typedef unsigned u32x2v __attribute__((ext_vector_type(2)));
typedef __bf16 bf16x2_t __attribute__((ext_vector_type(2)));
typedef float f32x2_t __attribute__((ext_vector_type(2)));
__device__ __forceinline__ unsigned pk_bf16(float lo, float hi) { const f32x2_t v = {lo, hi}; const bf16x2_t b = __builtin_convertvector(v, bf16x2_t); return __builtin_bit_cast(unsigned, b); }
__device__ __forceinline__ bf16x8 mk_frag(unsigned a, unsigned b, unsigned c, unsigned d) { u32x4v v; v.x = a; v.y = b; v.z = c; v.w = d; return __builtin_bit_cast(bf16x8, v); }

__device__ __forceinline__ unsigned pk_fp8x4(float a, float b, float c, float d) {
    a = __builtin_amdgcn_fmed3f(a, -448.f, 448.f); b = __builtin_amdgcn_fmed3f(b, -448.f, 448.f); c = __builtin_amdgcn_fmed3f(c, -448.f, 448.f); d = __builtin_amdgcn_fmed3f(d, -448.f, 448.f);
    int v = __builtin_amdgcn_cvt_pk_fp8_f32(a, b, 0, false);
    v = __builtin_amdgcn_cvt_pk_fp8_f32(c, d, v, true);
    return (unsigned)v;
}
#define Y8_SCALE 16.0f
__device__ __forceinline__ void fp8x8_to_f(const uint2& v, float (&o)[8]) {
    typedef float f2v __attribute__((ext_vector_type(2)));
    const f2v a = __builtin_amdgcn_cvt_pk_f32_fp8((int)v.x, false), b = __builtin_amdgcn_cvt_pk_f32_fp8((int)v.x, true), c = __builtin_amdgcn_cvt_pk_f32_fp8((int)v.y, false), d = __builtin_amdgcn_cvt_pk_f32_fp8((int)v.y, true);
    o[0] = a[0]; o[1] = a[1]; o[2] = b[0]; o[3] = b[1]; o[4] = c[0]; o[5] = c[1]; o[6] = d[0]; o[7] = d[1];
}
#define MIX8_SCALE 4.0f
#define WO8_SCALE 1024.0f
#define H8_SCALE 8.0f
#define WD8_SCALE 512.0f
#ifndef P1_BF16_TILES
#define P1_BF16_TILES 0x01C0
#endif
#define X8_SCALE 16.0f
#define W8_SCALE 512.0f
struct Params {
    const float* x; const float* w_in; const float* w_out; const float* da_lambda; const float* da_subln; const float* sc_conv;
    const float* rw_mu; const float* rw_vecs; const float* rw_w_up; const float* rw_a_up; const float* rw_g_up;
    const float* ln_gain; const float* ln_bias; const float* rel_bias; const float* router_w; const float* router_b;
    const float* moe_w_in; const float* moe_w_down;
    float* out; unsigned char* ws;
};

namespace pg8 {
#define PG8_LAS __attribute__((address_space(3)))
typedef unsigned short bf16_t;
typedef short bf16x8 __attribute__((ext_vector_type(8)));
typedef float f32x4 __attribute__((ext_vector_type(4)));
typedef unsigned u32x4 __attribute__((ext_vector_type(4)));
constexpr int BM = 256, BK = 64, HALF = 128, HTB = HALF * BK * 2  , STAGE_BYTES = 8 * HTB, NXCD = 8, WGM = 8;

__host__ __device__ __forceinline__ int lds_byte(int r, int c) { const int st = (r >> 4) * 2 + (c >> 5), rr = r & 15, cc = c & 31, ob = rr * 64 + cc * 2; return st * 1024 + (ob ^ (((ob >> 9) & 1) << 5)); }
__host__ __device__ __forceinline__ void stage_rc(int b, int& R, int& C) { const int st = b / 1024, sb = b % 1024, swz = sb ^ (((sb >> 9) & 1) << 5); R = (st >> 1) * 16 + swz / 64; C = (st & 1) * 32 + (swz % 64) / 2; }
__host__ __device__ __forceinline__ int perm32(int rho) { const int n = rho >> 4, i = rho & 15; return 8 * (i >> 2) + 4 * n + (i & 3); }

struct Unit { int pm, pn; };
struct Gemm { const bf16_t* A; const bf16_t* Bt; int M, N, K; int sw = 0x7f7f7f7f, sx = 0x7f7f7f7f; };

struct StaticOrder {
    int nM, nN, nwg, G, c;
    __host__ __device__ void init(int M, int N, int G_, int c_) { nM = M / BM; nN = N / BM; nwg = nM * nN; G = G_; c = c_; }
    __host__ __device__ bool next(int i, Unit& u) const {
        const long L = (long)i * G + c; if (L >= nwg) return false;
        int wgid = (int)L; { const int q = nwg / NXCD, r = nwg % NXCD, xcd = wgid % NXCD, off = wgid / NXCD; wgid = (xcd < r ? xcd * (q + 1) : r * (q + 1) + (xcd - r) * q) + off; }
        const int nig = WGM * nN, gid = wgid / nig, fm = gid * WGM, gsz = (nM - fm) < WGM ? (nM - fm) : WGM;
        u.pm = fm + ((wgid % nig) % gsz); u.pn = (wgid % nig) / gsz; return true;
    }
    __device__ __forceinline__ void a_ready(const Unit&) const {}
    __device__ __forceinline__ void done(const Unit&) const {}
};
struct StaticOrderSub : StaticOrder {
    unsigned long long tbl;
    __host__ __device__ bool next(int i, Unit& u) const { if (!StaticOrder::next(i, u)) return false; u.pn = (int)((tbl >> (4 * u.pn)) & 15ull); return true; }
};
__device__ __forceinline__ unsigned cvt_pk_bf16(float lo, float hi) { unsigned r; asm volatile("v_cvt_pk_bf16_f32 %0, %1, %2" : "=v"(r) : "v"(lo), "v"(hi)); return r; }
typedef int v8i32 __attribute__((ext_vector_type(8)));
typedef int v4i32 __attribute__((ext_vector_type(4)));
union Frag { bf16x8 kk[2]; v8i32 w; };
template <class Epi, class Sched, bool ALIGN_EPI = false, bool SP2 = false, bool FP8 = false>
__device__ __forceinline__ void gemm_phase(PG8_LAS unsigned char* lds, const Gemm g, const Sched& S, const Epi& E) {
    const int tid = otid(), wid = __builtin_amdgcn_readfirstlane(tid >> 6), lane = tid & 63, wr = wid >> 2, wc = wid & 3, fr = lane & 15, fq = lane >> 4;
    const int K = FP8 ? g.K / 2 : g.K, nt = K / BK;
    unsigned voffA[2], voffB[2];
#pragma unroll
    for (int i = 0; i < 2; ++i) { int R, C; stage_rc(tid * 16 + i * 8192, R, C); const int Rb = Epi::PERM ? ((R & ~31) + perm32(R & 31)) : R;
        voffA[i] = (unsigned)(R * K + C) * 2u; voffB[i] = (unsigned)(Rb * K + C) * 2u; }
    const size_t kstep = (size_t)(BK * 2);
    const size_t hstep = (size_t)HALF * K * 2;
    const size_t tstep = 2 * hstep;
    const unsigned ldsw = (unsigned)wid * 1024u;
    const int aoff = lds_byte(wr * 64 + fr, fq * 8), boff = lds_byte(wc * 32 + fr, fq * 8);
#define PG8_SA(b, h) (((b) * 2 + (h)) * HTB)
#define PG8_SB(b, h) ((4 + (b) * 2 + (h)) * HTB)
#define PG8_STAGE(bufoff, gbase, voff) do { _Pragma("unroll") for (int _i = 0; _i < 2; ++_i) \
        __builtin_amdgcn_global_load_lds((const unsigned*)((const char*)(gbase) + (voff)[_i]), (PG8_LAS unsigned*)(lds + (bufoff) + ldsw + _i * 8192), 16, 0, 0); } while (0)
#define PG8_LDA(dst, b, h) do { _Pragma("unroll") for (int m = 0; m < 4; ++m) _Pragma("unroll") for (int k = 0; k < 2; ++k) dst[m].kk[k] = *(const PG8_LAS bf16x8*)(lds + PG8_SA(b, h) + aoff + m * 2048 + k * 1024); } while (0)
#define PG8_LDB(dst, b, h) do { _Pragma("unroll") for (int n = 0; n < 2; ++n) _Pragma("unroll") for (int k = 0; k < 2; ++k) dst[n].kk[k] = *(const PG8_LAS bf16x8*)(lds + PG8_SB(b, h) + boff + n * 2048 + k * 1024); } while (0)
#define PG8_MMA(ai, bj, At, Bt) do { __builtin_amdgcn_s_setprio(1); _Pragma("unroll") for (int m = 0; m < 4; ++m) _Pragma("unroll") for (int n = 0; n < 2; ++n) { \
        if constexpr (FP8) asm volatile("v_mfma_scale_f32_16x16x128_f8f6f4 %0, %1, %2, %0, %3, %4 op_sel_hi:[0,0,0]" : "+v"(acc[ai][bj][m][n]) : "v"(Bt[n].w), "v"(At[m].w), "v"(scw), "v"(scx)); \
        else { _Pragma("unroll") for (int k = 0; k < 2; ++k) acc[ai][bj][m][n] = __builtin_amdgcn_mfma_f32_16x16x32_bf16(Bt[n].kk[k], At[m].kk[k], acc[ai][bj][m][n], 0, 0, 0); } } __builtin_amdgcn_s_setprio(0); } while (0)
#define PG8_WAIT_V(n) asm volatile("s_waitcnt vmcnt(" #n ")" ::: "memory")
#define PG8_WAIT_L(n) asm volatile("s_waitcnt lgkmcnt(" #n ")" ::: "memory")
#define PG8_BAR __builtin_amdgcn_s_barrier()
#define PG8_SCHED __builtin_amdgcn_sched_barrier(0)
    Unit cur, nxt; int ui = 0;
    if (!S.next(0, cur)) return;
    f32x4 acc[2][2][4][2];
#pragma unroll
    for (int a = 0; a < 2; ++a)
#pragma unroll
        for (int b = 0; b < 2; ++b)
#pragma unroll
            for (int m = 0; m < 4; ++m)
#pragma unroll
                for (int n = 0; n < 2; ++n) acc[a][b][m][n] = (f32x4){0.f, 0.f, 0.f, 0.f};
    Frag At[4], B0[2], B1[2];
    int scw = g.sw, scx = g.sx;
    if constexpr (FP8) asm volatile("" : "+v"(scw), "+v"(scx));
    const char* cA = (const char*)g.A + (size_t)cur.pm * tstep; const char* cB = (const char*)g.Bt + (size_t)cur.pn * tstep;
    S.a_ready(cur);
    if constexpr (SP2) {
        PG8_STAGE(PG8_SB(0, 0), cB, voffB); PG8_STAGE(PG8_SB(0, 1), cB + hstep, voffB); PG8_STAGE(PG8_SA(0, 0), cA, voffA); PG8_STAGE(PG8_SA(0, 1), cA + hstep, voffA);
        if (wr == 1) PG8_BAR;
        PG8_WAIT_V(2); PG8_BAR;
        PG8_STAGE(PG8_SB(1, 0), cB + kstep, voffB); PG8_STAGE(PG8_SA(1, 0), cA + kstep, voffA); PG8_STAGE(PG8_SB(1, 1), cB + hstep + kstep, voffB);
        PG8_WAIT_V(6); PG8_BAR;
    } else {
        PG8_STAGE(PG8_SB(0, 0), cB, voffB); PG8_STAGE(PG8_SA(0, 0), cA, voffA); PG8_STAGE(PG8_SB(0, 1), cB + hstep, voffB); PG8_STAGE(PG8_SA(0, 1), cA + hstep, voffA);
        if (wr == 1) PG8_BAR;
        PG8_WAIT_V(4); PG8_BAR;
        PG8_STAGE(PG8_SB(1, 0), cB + kstep, voffB); PG8_STAGE(PG8_SA(1, 0), cA + kstep, voffA); PG8_STAGE(PG8_SB(1, 1), cB + hstep + kstep, voffB);
        PG8_WAIT_V(6); PG8_BAR;
    }
    for (;;) {
        const bool has_next = S.next(ui + 1, nxt);
        const char* nA = has_next ? (const char*)g.A + (size_t)nxt.pm * tstep : cA; const char* nB = has_next ? (const char*)g.Bt + (size_t)nxt.pn * tstep : cB;
#pragma unroll 1
        for (int t = 0; t < nt; t += 2) {
            const bool last = (t == nt - 2);
            const char* a1 = cA + (size_t)(t + 1) * kstep;
            const char* a2 = last ? nA : cA + (size_t)(t + 2) * kstep; const char* b2 = last ? nB : cB + (size_t)(t + 2) * kstep;
            const char* a3 = a2 + kstep; const char* b3 = b2 + kstep;
            if (last && has_next) S.a_ready(nxt);
            if constexpr (SP2) {
            PG8_LDB(B0, 0, 0); PG8_LDB(B1, 0, 1); PG8_SCHED; PG8_LDA(At, 0, 0); PG8_STAGE(PG8_SA(1, 1), a1 + hstep, voffA);
            PG8_WAIT_V(8); PG8_WAIT_L(0); PG8_BAR; PG8_MMA(0, 0, At, B0); PG8_MMA(0, 1, At, B1); PG8_BAR; PG8_SCHED;
            PG8_LDA(At, 0, 1); PG8_STAGE(PG8_SB(0, 0), b2, voffB); PG8_STAGE(PG8_SB(0, 1), b2 + hstep, voffB); PG8_STAGE(PG8_SA(0, 0), a2, voffA);
            PG8_WAIT_V(8); PG8_WAIT_L(0); PG8_BAR; PG8_MMA(1, 0, At, B0); PG8_MMA(1, 1, At, B1); PG8_BAR; PG8_SCHED;
            PG8_LDB(B0, 1, 0); PG8_LDB(B1, 1, 1); PG8_SCHED; PG8_LDA(At, 1, 0); PG8_STAGE(PG8_SA(0, 1), a2 + hstep, voffA);
            PG8_WAIT_V(8); PG8_WAIT_L(0); PG8_BAR; PG8_MMA(0, 0, At, B0); PG8_MMA(0, 1, At, B1); PG8_BAR; PG8_SCHED;
            PG8_LDA(At, 1, 1); PG8_STAGE(PG8_SB(1, 0), b3, voffB); PG8_STAGE(PG8_SB(1, 1), b3 + hstep, voffB); PG8_STAGE(PG8_SA(1, 0), a3, voffA);
            PG8_WAIT_V(8); PG8_WAIT_L(0); PG8_BAR; PG8_MMA(1, 0, At, B0); PG8_MMA(1, 1, At, B1); PG8_BAR; PG8_SCHED;
            } else {
            PG8_LDB(B0, 0, 0); PG8_SCHED; PG8_LDA(At, 0, 0); PG8_STAGE(PG8_SA(1, 1), a1 + hstep, voffA);
            PG8_WAIT_L(8); PG8_BAR; PG8_WAIT_L(0); PG8_MMA(0, 0, At, B0); PG8_BAR; PG8_SCHED;
            PG8_LDB(B1, 0, 1); PG8_STAGE(PG8_SB(0, 0), b2, voffB);
            PG8_BAR; PG8_WAIT_L(0); PG8_MMA(0, 1, At, B1); PG8_BAR;
            PG8_LDA(At, 0, 1); PG8_STAGE(PG8_SA(0, 0), a2, voffA);
            PG8_BAR; PG8_WAIT_L(0); PG8_MMA(1, 0, At, B0); PG8_BAR; PG8_SCHED;
            PG8_STAGE(PG8_SB(0, 1), b2 + hstep, voffB);
            PG8_WAIT_V(6); PG8_BAR; PG8_MMA(1, 1, At, B1); PG8_BAR;
            PG8_LDB(B0, 1, 0); PG8_SCHED; PG8_LDA(At, 1, 0); PG8_STAGE(PG8_SA(0, 1), a2 + hstep, voffA);
            PG8_WAIT_L(8); PG8_BAR; PG8_WAIT_L(0); PG8_MMA(0, 0, At, B0); PG8_BAR; PG8_SCHED;
            PG8_LDB(B1, 1, 1); PG8_STAGE(PG8_SB(1, 0), b3, voffB);
            PG8_BAR; PG8_WAIT_L(0); PG8_MMA(0, 1, At, B1); PG8_BAR;
            PG8_LDA(At, 1, 1); PG8_STAGE(PG8_SA(1, 0), a3, voffA);
            PG8_BAR; PG8_WAIT_L(0); PG8_MMA(1, 0, At, B0); PG8_BAR; PG8_SCHED;
            PG8_STAGE(PG8_SB(1, 1), b3 + hstep, voffB);
            PG8_WAIT_V(6); PG8_BAR; PG8_MMA(1, 1, At, B1); PG8_BAR;
            }
        }
        if constexpr (FP8) asm volatile("s_nop 15\n\ts_nop 15" ::: "memory");
        if constexpr (ALIGN_EPI) { if (wr == 0) PG8_BAR; }
        if constexpr (!Epi::AFTER_DRAIN) { E(acc, cur, wr, wc, fr, fq); S.done(cur); }
        if (!has_next) break;
#pragma unroll
        for (int a = 0; a < 2; ++a)
#pragma unroll
            for (int b = 0; b < 2; ++b)
#pragma unroll
                for (int m = 0; m < 4; ++m)
#pragma unroll
                    for (int n = 0; n < 2; ++n) acc[a][b][m][n] = (f32x4){0.f, 0.f, 0.f, 0.f};
        cur = nxt; cA = nA; cB = nB; ++ui;
        if constexpr (ALIGN_EPI) { if (wr == 1) PG8_BAR; }
    }
    PG8_WAIT_V(0);
    if constexpr (!ALIGN_EPI) { if (wr == 0) PG8_BAR; }
    PG8_BAR;
    if constexpr (Epi::AFTER_DRAIN) { E.fused(acc, cur, wr, wc, fr, fq, lds, wid, lane); S.done(cur); }
#undef PG8_SA
#undef PG8_SB
#undef PG8_STAGE
#undef PG8_LDA
#undef PG8_LDB
#undef PG8_MMA
#undef PG8_WAIT_V
#undef PG8_WAIT_L
#undef PG8_BAR
#undef PG8_SCHED
}
}

namespace pg8 {
template <class Epi, class Sched, bool GATHER, bool FP8 = false>
__device__ __forceinline__ void gemm_phase_g(PG8_LAS unsigned char* lds, const int K, const Sched& S, const Epi& E, int sw = 0x7f7f7f7f, int sx = 0x7f7f7f7f) {
    typedef typename Sched::Unit UnitT;
    const int tid = otid(), wid = __builtin_amdgcn_readfirstlane(tid >> 6), lane = tid & 63, wr = wid >> 2, wc = wid & 3, fr = lane & 15, fq = lane >> 4;
    const int nt = K / BK;
    unsigned voffB[2];
#pragma unroll
    for (int i = 0; i < 2; ++i) { int R, C; stage_rc(tid * 16 + i * 8192, R, C); const int Rb = Epi::PERM ? ((R & ~31) + perm32(R & 31)) : R; voffB[i] = (unsigned)(Rb * K + C) * 2u; }
#define PG8_AOFF(unit, o0, o1) do { const int _tz = otid(); _Pragma("unroll") for (int _i = 0; _i < 2; ++_i) { int _R, _C; stage_rc(_tz * 16 + _i * 8192, _R, _C); \
        o0[_i] = S.arow_off(unit, _R) + (unsigned)_C * 2u; o1[_i] = S.arow_off(unit, HALF + _R) + (unsigned)_C * 2u; } } while (0)
    const size_t kstep = (size_t)(BK * 2);
    const size_t hstep = (size_t)HALF * K * 2;
    const unsigned ldsw = (unsigned)wid * 1024u;
    const int aoff = lds_byte(wr * 64 + fr, fq * 8), boff = lds_byte(wc * 32 + fr, fq * 8);
#define PG8_SA(b, h) (((b) * 2 + (h)) * HTB)
#define PG8_SB(b, h) ((4 + (b) * 2 + (h)) * HTB)
#define PG8_STAGE(bufoff, gbase, voff) do { _Pragma("unroll") for (int _i = 0; _i < 2; ++_i) \
        __builtin_amdgcn_global_load_lds((const unsigned*)((const char*)(gbase) + (voff)[_i]), (PG8_LAS unsigned*)(lds + (bufoff) + ldsw + _i * 8192), 16, 0, 0); } while (0)
#define PG8_LDA(dst, b, h) do { _Pragma("unroll") for (int m = 0; m < 4; ++m) _Pragma("unroll") for (int k = 0; k < 2; ++k) dst[m].kk[k] = *(const PG8_LAS bf16x8*)(lds + PG8_SA(b, h) + aoff + m * 2048 + k * 1024); } while (0)
#define PG8_LDB(dst, b, h) do { _Pragma("unroll") for (int n = 0; n < 2; ++n) _Pragma("unroll") for (int k = 0; k < 2; ++k) dst[n].kk[k] = *(const PG8_LAS bf16x8*)(lds + PG8_SB(b, h) + boff + n * 2048 + k * 1024); } while (0)
#define PG8_MMA(ai, bj, At, Bt) do { __builtin_amdgcn_s_setprio(1); _Pragma("unroll") for (int m = 0; m < 4; ++m) _Pragma("unroll") for (int n = 0; n < 2; ++n) { \
        if constexpr (FP8) asm volatile("v_mfma_scale_f32_16x16x128_f8f6f4 %0, %1, %2, %0, %3, %4 op_sel_hi:[0,0,0]" : "+v"(acc[ai][bj][m][n]) : "v"(Bt[n].w), "v"(At[m].w), "v"(scw), "v"(scx)); \
        else { _Pragma("unroll") for (int k = 0; k < 2; ++k) acc[ai][bj][m][n] = __builtin_amdgcn_mfma_f32_16x16x32_bf16(Bt[n].kk[k], At[m].kk[k], acc[ai][bj][m][n], 0, 0, 0); } } __builtin_amdgcn_s_setprio(0); } while (0)
#define PG8_WAIT_V(n) asm volatile("s_waitcnt vmcnt(" #n ")" ::: "memory")
#define PG8_WAIT_L(n) asm volatile("s_waitcnt lgkmcnt(" #n ")" ::: "memory")
#define PG8_BAR __builtin_amdgcn_s_barrier()
#define PG8_SCHED __builtin_amdgcn_sched_barrier(0)
    UnitT cur, nxt; int ui = 0;
    if (!S.next(0, cur)) return;
    f32x4 acc[2][2][4][2];
#pragma unroll
    for (int a = 0; a < 2; ++a)
#pragma unroll
        for (int b = 0; b < 2; ++b)
#pragma unroll
            for (int m = 0; m < 4; ++m)
#pragma unroll
                for (int n = 0; n < 2; ++n) acc[a][b][m][n] = (f32x4){0.f, 0.f, 0.f, 0.f};
    Frag At[4], B0[2], B1[2];
    int scw = sw, scx = sx;
    if constexpr (FP8) asm volatile("" : "+v"(scw), "+v"(scx));
    unsigned cvo0[2], cvo1[2];
    PG8_AOFF(cur, cvo0, cvo1);
    const char* cA = S.abase(cur); const char* cB = S.bbase(cur);
    PG8_STAGE(PG8_SB(0, 0), cB, voffB); PG8_STAGE(PG8_SB(0, 1), cB + hstep, voffB); PG8_STAGE(PG8_SA(0, 0), cA, cvo0); PG8_STAGE(PG8_SA(0, 1), cA, cvo1);
    if (wr == 1) PG8_BAR;
    PG8_WAIT_V(2); PG8_BAR;
    PG8_STAGE(PG8_SB(1, 0), cB + kstep, voffB); PG8_STAGE(PG8_SA(1, 0), cA + kstep, cvo0); PG8_STAGE(PG8_SB(1, 1), cB + hstep + kstep, voffB);
    PG8_WAIT_V(6); PG8_BAR;
#pragma unroll 1
    for (;;) {
        const bool has_next = S.next(ui + 1, nxt);
        const char* nA = has_next ? S.abase(nxt) : cA; const char* nB = has_next ? S.bbase(nxt) : cB;
        unsigned v20[2], v21[2];
#pragma unroll 1
        for (int t = 0; t < nt; t += 2) {
            const bool last = (t == nt - 2);
            const char* a1 = cA + (size_t)(t + 1) * kstep;
            const char* a2 = last ? nA : cA + (size_t)(t + 2) * kstep; const char* b2 = last ? nB : cB + (size_t)(t + 2) * kstep;
            const char* a3 = a2 + kstep; const char* b3 = b2 + kstep;
            if (GATHER && last && has_next) { PG8_AOFF(nxt, v20, v21); }
            else {
#pragma unroll
                for (int i = 0; i < 2; ++i) { v20[i] = cvo0[i]; v21[i] = cvo1[i]; } }
            PG8_LDB(B0, 0, 0); PG8_LDB(B1, 0, 1); PG8_SCHED; PG8_LDA(At, 0, 0); PG8_STAGE(PG8_SA(1, 1), a1, cvo1);
            PG8_WAIT_V(8); PG8_WAIT_L(0); PG8_BAR; PG8_MMA(0, 0, At, B0); PG8_MMA(0, 1, At, B1); PG8_BAR; PG8_SCHED;
            PG8_LDA(At, 0, 1); PG8_STAGE(PG8_SB(0, 0), b2, voffB); PG8_STAGE(PG8_SB(0, 1), b2 + hstep, voffB); PG8_STAGE(PG8_SA(0, 0), a2, v20);
            PG8_WAIT_V(8); PG8_WAIT_L(0); PG8_BAR; PG8_MMA(1, 0, At, B0); PG8_MMA(1, 1, At, B1); PG8_BAR; PG8_SCHED;
            PG8_LDB(B0, 1, 0); PG8_LDB(B1, 1, 1); PG8_SCHED; PG8_LDA(At, 1, 0); PG8_STAGE(PG8_SA(0, 1), a2, v21);
            PG8_WAIT_V(8); PG8_WAIT_L(0); PG8_BAR; PG8_MMA(0, 0, At, B0); PG8_MMA(0, 1, At, B1); PG8_BAR; PG8_SCHED;
            PG8_LDA(At, 1, 1); PG8_STAGE(PG8_SB(1, 0), b3, voffB); PG8_STAGE(PG8_SB(1, 1), b3 + hstep, voffB); PG8_STAGE(PG8_SA(1, 0), a3, v20);
            PG8_WAIT_V(8); PG8_WAIT_L(0); PG8_BAR; PG8_MMA(1, 0, At, B0); PG8_MMA(1, 1, At, B1); PG8_BAR; PG8_SCHED;
        }
        if constexpr (FP8) asm volatile("s_nop 15\n\ts_nop 15" ::: "memory");
        if (wr == 0) PG8_BAR;
        E(acc, cur, wr, wc, fr, fq);
        if (!has_next) break;
#pragma unroll
        for (int a = 0; a < 2; ++a)
#pragma unroll
            for (int b = 0; b < 2; ++b)
#pragma unroll
                for (int m = 0; m < 4; ++m)
#pragma unroll
                    for (int n = 0; n < 2; ++n) acc[a][b][m][n] = (f32x4){0.f, 0.f, 0.f, 0.f};
        cur = nxt; cA = nA; cB = nB; ++ui;
#pragma unroll
        for (int i = 0; i < 2; ++i) { cvo0[i] = v20[i]; cvo1[i] = v21[i]; }
        if (wr == 1) PG8_BAR;
    }
    PG8_WAIT_V(0);
    PG8_BAR;
#undef PG8_AOFF
#undef PG8_SA
#undef PG8_SB
#undef PG8_STAGE
#undef PG8_LDA
#undef PG8_LDB
#undef PG8_MMA
#undef PG8_WAIT_V
#undef PG8_WAIT_L
#undef PG8_BAR
#undef PG8_SCHED
}
}

struct TrTile { const float* src; bf16_t* dst; int K, N, k0, n0, mode; };
__device__ __forceinline__ TrTile tr_desc(const Params& p, int it) {
    TrTile t;
    bf16_t* win = (bf16_t*)(p.ws + WS_WIN); bf16_t* wout = (bf16_t*)(p.ws + WS_WOUT); bf16_t* mwin = (bf16_t*)(p.ws + WS_MWIN); bf16_t* mwdn = (bf16_t*)(p.ws + WS_MWDN);
    if (it < 3328) { const int l = it / 832, r = it % 832; t.src = p.w_in + (size_t)l * DM * PIN; t.dst = (bf16_t*)(p.ws + WS_W8 + (size_t)l * PINP * DM); t.K = DM; t.N = PIN; t.k0 = (r / 52) * 64; t.n0 = (r % 52) * 64; t.mode = 2; }
    else if (it < 4352) { const int j = it - 3328, l = j / 256, r = j % 256; t.src = p.w_out + (size_t)l * DM * DM; t.dst = (bf16_t*)(p.ws + WS_WOUT + (size_t)l * DM * DM); t.K = DM; t.N = DM; t.k0 = (r / 16) * 64; t.n0 = (r % 16) * 64; t.mode = 3; }
    else if (it < 12544) { const int j = it - 4352, le = j / 128, r = j % 128; t.src = p.moe_w_in + (size_t)le * 1024 * 512; t.dst = (bf16_t*)(p.ws + WS_MWIN + (size_t)le * 512 * 1024); t.K = 1024; t.N = 512; t.k0 = (r / 8) * 64; t.n0 = (r % 8) * 64; t.mode = 5; }
    else { const int j = it - 12544, le = j / 64, r = j % 64; t.src = p.moe_w_down + (size_t)le * 256 * 1024; t.dst = (bf16_t*)(p.ws + WS_MWDN + (size_t)le * 1024 * 256); t.K = 256; t.N = 1024; t.k0 = (r / 16) * 64; t.n0 = (r % 16) * 64; t.mode = 4; }
    return t;
}
__device__ __forceinline__ void tr_load(const TrTile& t, float (&v)[8], int tid) {
    const int c = tid & 63, r0 = tid >> 6;
    if (t.n0 < t.N) {
#pragma unroll
        for (int i = 0; i < 8; ++i) v[i] = t.src[(size_t)(t.k0 + r0 + i * 8) * t.N + t.n0 + c];
    } else {
#pragma unroll
        for (int i = 0; i < 8; ++i) v[i] = 0.f;
    }
}
__device__ __forceinline__ void prologue(const Params& p, unsigned char* lds) {
    float* tile = (float*)lds;
    const int G = gridDim.x, w = obid(), tid = otid();
    {
        bf16_t* xb = (bf16_t*)(p.ws + WS_XB); unsigned* x8 = (unsigned*)(p.ws + WS_X8);
        const size_t n4 = (size_t)NTOK * DM / 4, stride = (size_t)G * NTHREADS;
        size_t i = (size_t)w * NTHREADS + tid;
        for (; i + 3 * stride < n4; i += 4 * stride) {
            float4 v[4];
#pragma unroll
            for (int k = 0; k < 4; ++k) v[k] = ((const float4*)p.x)[i + k * stride];
#pragma unroll
            for (int k = 0; k < 4; ++k) { uint2 o; o.x = pg8::cvt_pk_bf16(v[k].x, v[k].y); o.y = pg8::cvt_pk_bf16(v[k].z, v[k].w); ((uint2*)xb)[i + k * stride] = o;
                x8[i + k * stride] = pk_fp8x4(v[k].x * X8_SCALE, v[k].y * X8_SCALE, v[k].z * X8_SCALE, v[k].w * X8_SCALE); }
        }
        for (; i < n4; i += stride) { const float4 v = ((const float4*)p.x)[i]; uint2 o; o.x = pg8::cvt_pk_bf16(v.x, v.y); o.y = pg8::cvt_pk_bf16(v.z, v.w); ((uint2*)xb)[i] = o;
            x8[i] = pk_fp8x4(v.x * X8_SCALE, v.y * X8_SCALE, v.z * X8_SCALE, v.w * X8_SCALE); }
    }
    {
        const int c = tid & 63, r0 = tid >> 6, nn = tid >> 3, kg = tid & 7;
        float* tileB = tile + 64 * 65 + 64;
        auto emit = [&](const TrTile& cur, const float* tl) {
        int n = cur.n0 + nn;
        if (cur.mode == 1 || cur.mode == 5) { const int j = n & 255; const int isu = n >> 8; n = (j >> 4) * 32 + isu * 16 + (j & 15); }
        float f[8];
#pragma unroll
        for (int i = 0; i < 8; ++i) f[i] = tl[(kg * 8 + i) * 65 + nn];
        if (cur.mode >= 3) {
            const float ws8 = cur.mode == 3 ? WO8_SCALE : cur.mode == 4 ? WD8_SCALE : W8_SCALE;
            uint2 o; o.x = pk_fp8x4(f[0] * ws8, f[1] * ws8, f[2] * ws8, f[3] * ws8); o.y = pk_fp8x4(f[4] * ws8, f[5] * ws8, f[6] * ws8, f[7] * ws8);
            *(uint2*)((unsigned char*)cur.dst + (size_t)n * cur.K + cur.k0 + kg * 8) = o;
        } else if (cur.mode == 2) {
            uint2 o; o.x = pk_fp8x4(f[0] * W8_SCALE, f[1] * W8_SCALE, f[2] * W8_SCALE, f[3] * W8_SCALE); o.y = pk_fp8x4(f[4] * W8_SCALE, f[5] * W8_SCALE, f[6] * W8_SCALE, f[7] * W8_SCALE);
            const size_t eo = (size_t)((unsigned char*)cur.dst - (p.ws + WS_W8)) + (size_t)n * cur.K + cur.k0 + kg * 8;
            *(uint2*)(p.ws + WS_W8 + eo) = o;
            pg8::u32x4 ob; ob.x = pg8::cvt_pk_bf16(f[0], f[1]); ob.y = pg8::cvt_pk_bf16(f[2], f[3]); ob.z = pg8::cvt_pk_bf16(f[4], f[5]); ob.w = pg8::cvt_pk_bf16(f[6], f[7]);
            if ((P1_BF16_TILES >> (n >> 8)) & 1) *(pg8::u32x4*)(p.ws + WS_WIN + eo * 2) = ob;
        } else {
        pg8::u32x4 o; o.x = pg8::cvt_pk_bf16(f[0], f[1]); o.y = pg8::cvt_pk_bf16(f[2], f[3]); o.z = pg8::cvt_pk_bf16(f[4], f[5]); o.w = pg8::cvt_pk_bf16(f[6], f[7]);
        *(pg8::u32x4*)(cur.dst + (size_t)n * cur.K + cur.k0 + kg * 8) = o;
        }
        };
        int it = w;
        float v0[8], v1[8];
        TrTile c0 = tr_desc(p, it < 16640 ? it : 0), c1 = tr_desc(p, it + G < 16640 ? it + G : 0);
        if (it < 16640) tr_load(c0, v0, tid);
        if (it + G < 16640) tr_load(c1, v1, tid);
#pragma unroll 1
        for (; it < 16640; it += 2 * G) {
            __syncthreads();
#pragma unroll
            for (int i = 0; i < 8; ++i) { tile[(r0 + i * 8) * 65 + c] = v0[i]; tileB[(r0 + i * 8) * 65 + c] = v1[i]; }
            const int n0i = it + 2 * G, n1i = it + 3 * G;
            TrTile n0 = tr_desc(p, n0i < 16640 ? n0i : 0), n1 = tr_desc(p, n1i < 16640 ? n1i : 0);
            if (n0i < 16640) tr_load(n0, v0, tid);
            if (n1i < 16640) tr_load(n1, v1, tid);
            __syncthreads();
            emit(c0, tile);
            if (it + G < 16640) emit(c1, tileB);
            c0 = n0; c1 = n1;
        }
    }
    {
        for (int i = w * NTHREADS + tid; i < 4 * 6 * 256; i += G * NTHREADS) {
            const int h = i / 1536, idx = i % 1536;
            const int di = idx >> 8, j = (idx >> 6) & 3, ln = idx & 63;
            const int d0 = 32 * di + (ln & 31) - 8 * j - 4 * (ln >> 5);
            float v[4];
#pragma unroll
            for (int e = 0; e < 4; ++e) {
                const int d = d0 - e; const int n = d > 0 ? d : 0;
                int bucket;
                if (n < 16) bucket = n;
                else { const float nf = (float)n; int lg = 16 + (int)(logf(nf / 16.0f) / 2.0794415416798357f * 16.0f); bucket = lg < 31 ? lg : 31; }
                v[e] = d >= 0 ? p.rel_bias[bucket * 4 + h] * LOG2E : -INFINITY;
            }
            *(float4*)(p.ws + WS_CT + (size_t)i * 16) = make_float4(v[0], v[1], v[2], v[3]);
        }
        if (w == 0 && tid < 4) {
            float* lamb = (float*)(p.ws + WS_LAM);
            const float* lp = p.da_lambda + (size_t)tid * 128;
            float s1 = 0.f, s2 = 0.f;
            for (int i = 0; i < 32; ++i) { s1 += lp[i] * lp[32 + i]; s2 += lp[64 + i] * lp[96 + i]; }
            const float lam_init = 0.8f - 0.6f * expf(-0.3f * (float)tid);
            lamb[tid * 2] = expf(s1) - expf(s2) + lam_init; lamb[tid * 2 + 1] = lam_init;
            lamb[8 + tid] = __builtin_amdgcn_exp2f(p.rel_bias[31 * 4 + tid] * LOG2E);
        }
    }
    {
        float* bd = (float*)(p.ws + WS_BIASD);
        for (int i = w * NTHREADS + tid; i < 4 * 2048; i += G * NTHREADS) {
            const int h = i >> 11, n = i & 2047;
            int bucket;
            if (n < 16) bucket = n;
            else { const float nf = (float)n; int lg = 16 + (int)(logf(nf / 16.0f) / 2.0794415416798357f * 16.0f); bucket = lg < 31 ? lg : 31; }
            bd[i] = p.rel_bias[bucket * 4 + h];
        }
    }
}

struct EpiProjP {
    static constexpr bool PERM = true, AFTER_DRAIN = false;
    bf16_t* O;
    __device__ __forceinline__ void operator()(const pg8::f32x4 (&acc)[2][2][4][2], const pg8::Unit& u, int wr, int wc, int fr, int fq) const {
        const int row0 = u.pm * 256 + wr * 64 + fr, col0 = u.pn * 256 + wc * 32 + 8 * fq;
#pragma unroll
        for (int ai = 0; ai < 2; ++ai)
#pragma unroll
            for (int m = 0; m < 4; ++m) { bf16_t* rowp = O + (size_t)(row0 + ai * 128 + m * 16) * PINP + col0;
#pragma unroll
                for (int bj = 0; bj < 2; ++bj) { const pg8::f32x4 v0 = acc[ai][bj][m][0], v1 = acc[ai][bj][m][1];
                    pg8::u32x4 w; w.x = pg8::cvt_pk_bf16(v0[0], v0[1]); w.y = pg8::cvt_pk_bf16(v0[2], v0[3]); w.z = pg8::cvt_pk_bf16(v1[0], v1[1]); w.w = pg8::cvt_pk_bf16(v1[2], v1[3]);
                    *(pg8::u32x4*)(rowp + bj * 128) = w; } }
    }
};
__device__ __forceinline__ void phase_inproj(const Params& p, int l, unsigned char* lds) {
    unsigned long long t8 = 0ull, t16 = 0ull; int n8 = 0, n16 = 0;
#pragma unroll
    for (int t = 0; t < PINP / 256; ++t) { if ((P1_BF16_TILES >> t) & 1) { t16 |= (unsigned long long)t << (4 * n16); ++n16; } else { t8 |= (unsigned long long)t << (4 * n8); ++n8; } }
    EpiProjP E{(bf16_t*)(p.ws + WS_PROJ)};
    if (n8 > 0) {
        pg8::Gemm g{(const bf16_t*)(p.ws + WS_X8), (const bf16_t*)(p.ws + WS_W8 + (size_t)l * PINP * DM), NTOK, PINP, DM, 0x76767676, 0x7b7b7b7b};
        pg8::StaticOrderSub S; S.init(NTOK, n8 * 256, (int)gridDim.x, obid()); S.tbl = t8;
        pg8::gemm_phase<EpiProjP, pg8::StaticOrderSub, true, true, true>((PG8_LAS unsigned char*)lds, g, S, E);
    }
    if (n16 > 0) {
        pg8::Gemm g{(const bf16_t*)(p.ws + WS_XB), (const bf16_t*)(p.ws + WS_WIN) + (size_t)l * PINP * DM, NTOK, PINP, DM};
        pg8::StaticOrderSub S; S.init(NTOK, n16 * 256, (int)gridDim.x, obid()); S.tbl = t16;
        pg8::gemm_phase<EpiProjP, pg8::StaticOrderSub, true, true, false>((PG8_LAS unsigned char*)lds, g, S, E);
    }
}

struct EpiOutP {
    static constexpr bool PERM = true, AFTER_DRAIN = false;
    const bf16_t* xh; bf16_t* out;
    __device__ __forceinline__ void operator()(const pg8::f32x4 (&acc)[2][2][4][2], const pg8::Unit& u, int wr, int wc, int fr, int fq) const {
        const int row0 = u.pm * 256 + wr * 64 + fr, col0 = u.pn * 256 + wc * 32 + 8 * fq;
        pg8::u32x4 r[2][4][2];
#pragma unroll
        for (int ai = 0; ai < 2; ++ai)
#pragma unroll
            for (int m = 0; m < 4; ++m)
#pragma unroll
                for (int bj = 0; bj < 2; ++bj) r[ai][m][bj] = *(const pg8::u32x4*)(xh + (size_t)(row0 + ai * 128 + m * 16) * DM + col0 + bj * 128);
#pragma unroll
        for (int ai = 0; ai < 2; ++ai)
#pragma unroll
            for (int m = 0; m < 4; ++m)
#pragma unroll
                for (int bj = 0; bj < 2; ++bj) { const size_t o = (size_t)(row0 + ai * 128 + m * 16) * DM + col0 + bj * 128;
                    const pg8::u32x4 q = r[ai][m][bj];
                    float xv[8];
                    xv[0] = __uint_as_float(q.x << 16); xv[1] = __uint_as_float(q.x & 0xffff0000u); xv[2] = __uint_as_float(q.y << 16); xv[3] = __uint_as_float(q.y & 0xffff0000u);
                    xv[4] = __uint_as_float(q.z << 16); xv[5] = __uint_as_float(q.z & 0xffff0000u); xv[6] = __uint_as_float(q.w << 16); xv[7] = __uint_as_float(q.w & 0xffff0000u);
                    const pg8::f32x4 v0 = acc[ai][bj][m][0], v1 = acc[ai][bj][m][1];
                    pg8::u32x4 w; w.x = pg8::cvt_pk_bf16(ALPHA * xv[0] + v0[0], ALPHA * xv[1] + v0[1]); w.y = pg8::cvt_pk_bf16(ALPHA * xv[2] + v0[2], ALPHA * xv[3] + v0[3]);
                    w.z = pg8::cvt_pk_bf16(ALPHA * xv[4] + v1[0], ALPHA * xv[5] + v1[1]); w.w = pg8::cvt_pk_bf16(ALPHA * xv[6] + v1[2], ALPHA * xv[7] + v1[3]);
                    *(pg8::u32x4*)(out + o) = w; }
    }
};
__device__ __forceinline__ void phase_outproj(const Params& p, int l, unsigned char* lds) {
    pg8::Gemm g{(const bf16_t*)(p.ws + WS_MIX), (const bf16_t*)(p.ws + WS_WOUT + (size_t)l * DM * DM), NTOK, DM, DM, 0x75757575, 0x7d7d7d7d};
    pg8::StaticOrder S; S.init(NTOK, DM, (int)gridDim.x, obid());
    EpiOutP E{(const bf16_t*)(p.ws + WS_XB), (bf16_t*)(p.ws + WS_YB)};
    pg8::gemm_phase<EpiOutP, pg8::StaticOrder, true, true, true>((PG8_LAS unsigned char*)lds, g, S, E);
}

__device__ __forceinline__ void ln_row(float (&v)[16], const float* gain, const float* bias, int lane) {
    float s = 0.f;
#pragma unroll
    for (int i = 0; i < 16; ++i) s += v[i];
    s = wave_sum(s);
    const float mean = s * (1.0f / 1024.0f);
    float q = 0.f;
#pragma unroll
    for (int i = 0; i < 16; ++i) { const float d = v[i] - mean; q += d * d; }
    q = wave_sum(q);
    const float rstd = rsqrtf(q * (1.0f / 1024.0f) + 1e-5f);
#pragma unroll
    for (int j = 0; j < 4; ++j) {
        const float4 g = *(const float4*)(gain + j * 256 + lane * 4), b = *(const float4*)(bias + j * 256 + lane * 4);
        v[j * 4 + 0] = (v[j * 4 + 0] - mean) * rstd * g.x + b.x; v[j * 4 + 1] = (v[j * 4 + 1] - mean) * rstd * g.y + b.y;
        v[j * 4 + 2] = (v[j * 4 + 2] - mean) * rstd * g.z + b.z; v[j * 4 + 3] = (v[j * 4 + 3] - mean) * rstd * g.w + b.w;
    }
}
__device__ __forceinline__ void bf8_to_f(const uint4& v, float (&o)[8]) {
    o[0] = __uint_as_float(v.x << 16); o[1] = __uint_as_float(v.x & 0xffff0000u); o[2] = __uint_as_float(v.y << 16); o[3] = __uint_as_float(v.y & 0xffff0000u);
    o[4] = __uint_as_float(v.z << 16); o[5] = __uint_as_float(v.z & 0xffff0000u); o[6] = __uint_as_float(v.w << 16); o[7] = __uint_as_float(v.w & 0xffff0000u);
}
__device__ __forceinline__ void load_gb(float (&gn)[16], float (&bs)[16], const float* gain, const float* bias, int lane) {
#pragma unroll
    for (int j = 0; j < 4; ++j) { const float4 g = *(const float4*)(gain + j * 256 + lane * 4), b = *(const float4*)(bias + j * 256 + lane * 4);
        gn[j * 4] = g.x; gn[j * 4 + 1] = g.y; gn[j * 4 + 2] = g.z; gn[j * 4 + 3] = g.w; bs[j * 4] = b.x; bs[j * 4 + 1] = b.y; bs[j * 4 + 2] = b.z; bs[j * 4 + 3] = b.w; }
}
__device__ __forceinline__ void ln_row_r(float (&v)[16], const float (&gn)[16], const float (&bs)[16]) {
    float s = 0.f;
#pragma unroll
    for (int i = 0; i < 16; ++i) s += v[i];
    s = wave_sum(s);
    const float mean = s * (1.0f / 1024.0f);
    float q = 0.f;
#pragma unroll
    for (int i = 0; i < 16; ++i) { const float d = v[i] - mean; q += d * d; }
    q = wave_sum(q);
    const float rstd = rsqrtf(q * (1.0f / 1024.0f) + 1e-5f);
#pragma unroll
    for (int i = 0; i < 16; ++i) v[i] = (v[i] - mean) * rstd * gn[i] + bs[i];
}
__device__ __forceinline__ void load_row_bf(float (&v)[16], const bf16_t* src, int lane) {
#pragma unroll
    for (int j = 0; j < 4; ++j) { const ushort4 t = *(const ushort4*)(src + j * 256 + lane * 4); v[j * 4] = bf2f(t.x); v[j * 4 + 1] = bf2f(t.y); v[j * 4 + 2] = bf2f(t.z); v[j * 4 + 3] = bf2f(t.w); }
}
__device__ __forceinline__ void store_row_bf(const float (&v)[16], bf16_t* xbo, int lane) {
#pragma unroll
    for (int j = 0; j < 4; ++j) { uint2 o; o.x = pk_bf16(v[j * 4], v[j * 4 + 1]); o.y = pk_bf16(v[j * 4 + 2], v[j * 4 + 3]); *(uint2*)(xbo + j * 256 + lane * 4) = o; }
}
__device__ __forceinline__ void store_row(const float (&v)[16], float* xo, bf16_t* xbo, int lane) {
#pragma unroll
    for (int j = 0; j < 4; ++j) {
        *(float4*)(xo + j * 256 + lane * 4) = make_float4(v[j * 4], v[j * 4 + 1], v[j * 4 + 2], v[j * 4 + 3]);
        uint2 o; o.x = pk_bf16(v[j * 4], v[j * 4 + 1]); o.y = pk_bf16(v[j * 4 + 2], v[j * 4 + 3]); *(uint2*)(xbo + j * 256 + lane * 4) = o;
    }
}

__device__ __forceinline__ void route_pick(const float (&lg)[16], const float* rb, int& i1, int& i2, float& g1, float& g2) {
    float aff[16], sl[16];
#pragma unroll
    for (int e = 0; e < 16; ++e) { aff[e] = sigmoidf_(lg[e]); sl[e] = aff[e] + rb[e]; }
    float bestg = -INFINITY; int bg = 0;
#pragma unroll
    for (int g = 0; g < 4; ++g) {
        float m1 = -INFINITY, m2 = -INFINITY;
#pragma unroll
        for (int k = 0; k < 4; ++k) { const float s = sl[g * 4 + k]; if (s > m1) { m2 = m1; m1 = s; } else if (s > m2) m2 = s; }
        const float gs = m1 + m2;
        if (gs > bestg) { bestg = gs; bg = g; }
    }
    float b1 = -INFINITY; i1 = 0; float a1 = 0.f;
#pragma unroll
    for (int e = 0; e < 16; ++e) { const bool in = (e >> 2) == bg; if (in && sl[e] > b1) { b1 = sl[e]; i1 = e; a1 = aff[e]; } }
    float b2 = -INFINITY; i2 = 0; float a2 = 0.f;
#pragma unroll
    for (int e = 0; e < 16; ++e) { const bool in = ((e >> 2) == bg) && (e != i1); if (in && sl[e] > b2) { b2 = sl[e]; i2 = e; a2 = aff[e]; } }
    const float inv = 1.0f / (a1 + a2);
    g1 = a1 * inv; g2 = a2 * inv;
}
__device__ __forceinline__ float rs16(const float (&v)[16], int lane) {
    float a8[8];
    const bool b0 = lane & 1, b1 = lane & 2, b2 = lane & 4, b3 = lane & 8;
#pragma unroll
    for (int i = 0; i < 8; ++i) { const float keep = b0 ? v[i + 8] : v[i], give = b0 ? v[i] : v[i + 8]; a8[i] = keep + dppw_f<0xB1>(give); }
    float a4[4];
#pragma unroll
    for (int i = 0; i < 4; ++i) { const float keep = b1 ? a8[i + 4] : a8[i], give = b1 ? a8[i] : a8[i + 4]; a4[i] = keep + dppw_f<0x4E>(give); }
    float a2[2];
#pragma unroll
    for (int i = 0; i < 2; ++i) { const float keep = b2 ? a4[i + 2] : a4[i], give = b2 ? a4[i] : a4[i + 2]; a2[i] = keep + __shfl_xor(give, 4); }
    const float keep = b3 ? a2[1] : a2[0], give = b3 ? a2[0] : a2[1];
    return keep + __shfl_xor(give, 8);
}
__device__ __forceinline__ void store_row_lds_bf(const float (&v)[16], bf16_t* dst, int lane) {
#pragma unroll
    for (int j = 0; j < 4; ++j) { uint2 o; o.x = pg8::cvt_pk_bf16(v[j * 4], v[j * 4 + 1]); o.y = pg8::cvt_pk_bf16(v[j * 4 + 2], v[j * 4 + 3]); *(uint2*)(dst + j * 256 + lane * 4) = o; }
}
#define LN1_XS 1032
__device__ __forceinline__ void phase_ln1_route(const Params& p, int l, unsigned char* lds) {
    const int tid = otid(), lane = tid & 63, wid = tid >> 6, n = lane & 15, g = lane >> 4;
    int* sel_e = (int*)lds;
    float* sel_g = (float*)(lds + 2048);
    int* rank = (int*)(lds + 4096);
    int* base = (int*)(lds + 6144);
    float* lgs = (float*)(lds + 8192);
    bf16_t* xt = (bf16_t*)(lds + 24576);
    float* red = (float*)(lds + 24576 + 32 * LN1_XS * 2);
    bf16_t* xb = (bf16_t*)(p.ws + WS_XB); const bf16_t* yb = (const bf16_t*)(p.ws + WS_YB);
    unsigned* ctl = (unsigned*)(p.ws + WS_CTL);
    int* ltok = (int*)(p.ws + WS_LTOK);
    const float* gain = p.ln_gain + (size_t)(l * 2 + 0) * DM; const float* bias = p.ln_bias + (size_t)(l * 2 + 0) * DM;
    bf16x8 ah[4], al[4];
#pragma unroll
    for (int ks = 0; ks < 4; ++ks) {
        float wv[8];
#pragma unroll
        for (int e = 0; e < 8; ++e) wv[e] = p.router_w[(size_t)(wid * 128 + ks * 32 + g * 8 + e) * 16 + n];
        unsigned hi[4], lo[4];
#pragma unroll
        for (int q = 0; q < 4; ++q) {
            hi[q] = pk_bf16(wv[2 * q], wv[2 * q + 1]);
            const float h0 = __uint_as_float(hi[q] << 16), h1 = __uint_as_float(hi[q] & 0xffff0000u);
            lo[q] = pk_bf16(wv[2 * q] - h0, wv[2 * q + 1] - h1);
        }
        ah[ks] = mk_frag(hi[0], hi[1], hi[2], hi[3]); al[ks] = mk_frag(lo[0], lo[1], lo[2], lo[3]);
    }
    float gn[16], bs[16];
    load_gb(gn, bs, gain, bias, lane);
    for (int chunk = obid(); chunk < NTOK / 256; chunk += gridDim.x) {
        __syncthreads();
        ushort4 ra0[4], ra1[4], rb0[4], rb1[4];
#define LN1_LDRAW(R0, R1, lrow_) do { const size_t _r = (size_t)chunk * 256 + (lrow_); _Pragma("unroll") for (int j = 0; j < 4; ++j) { R0[j] = *(const ushort4*)(yb + _r * DM + j * 256 + lane * 4); R1[j] = *(const ushort4*)(yb + (_r + 1) * DM + j * 256 + lane * 4); } } while (0)
#define LN1_CVT(v, R) do { _Pragma("unroll") for (int j = 0; j < 4; ++j) { v[j * 4] = bf2f(R[j].x); v[j * 4 + 1] = bf2f(R[j].y); v[j * 4 + 2] = bf2f(R[j].z); v[j * 4 + 3] = bf2f(R[j].w); } } while (0)
#define LN1_EMIT(v0, v1, lrow_, slot_) do { const size_t row = (size_t)chunk * 256 + (lrow_); \
            ln_row_r(v0, gn, bs); ln_row_r(v1, gn, bs); \
              \
            unsigned char* x8 = p.ws + WS_X8 + row * DM;        \
            _Pragma("unroll") for (int j = 0; j < 4; ++j) { *(unsigned*)(x8 + j * 256 + lane * 4) = pk_fp8x4(v0[j * 4] * X8_SCALE, v0[j * 4 + 1] * X8_SCALE, v0[j * 4 + 2] * X8_SCALE, v0[j * 4 + 3] * X8_SCALE); \
                *(unsigned*)(x8 + DM + j * 256 + lane * 4) = pk_fp8x4(v1[j * 4] * X8_SCALE, v1[j * 4 + 1] * X8_SCALE, v1[j * 4 + 2] * X8_SCALE, v1[j * 4 + 3] * X8_SCALE); } \
            store_row_lds_bf(v0, xt + (slot_) * LN1_XS, lane); store_row_lds_bf(v1, xt + ((slot_) + 1) * LN1_XS, lane); } while (0)
        LN1_LDRAW(ra0, ra1, wid * 4); LN1_LDRAW(rb0, rb1, wid * 4 + 2);
#pragma unroll 1
        for (int grp = 0; grp < 8; ++grp) {
            const int ng = grp < 7 ? grp + 1 : 7;
            float v0[16], v1[16];
            LN1_CVT(v0, ra0); LN1_CVT(v1, ra1);
            LN1_LDRAW(ra0, ra1, ng * 32 + wid * 4);
            LN1_EMIT(v0, v1, grp * 32 + wid * 4, wid * 4);
            LN1_CVT(v0, rb0); LN1_CVT(v1, rb1);
            LN1_LDRAW(rb0, rb1, ng * 32 + wid * 4 + 2);
            LN1_EMIT(v0, v1, grp * 32 + wid * 4 + 2, wid * 4 + 2);
            __syncthreads();
#pragma unroll
            for (int ct = 0; ct < 2; ++ct) {
                f32x4 acc = {0.f, 0.f, 0.f, 0.f};
#pragma unroll
                for (int ks = 0; ks < 4; ++ks) {
                    const bf16x8 bx = *(const bf16x8*)(xt + (ct * 16 + n) * LN1_XS + wid * 128 + ks * 32 + g * 8);
                    acc = __builtin_amdgcn_mfma_f32_16x16x32_bf16(ah[ks], bx, acc, 0, 0, 0);
                    acc = __builtin_amdgcn_mfma_f32_16x16x32_bf16(al[ks], bx, acc, 0, 0, 0);
                }
                *(float4*)(red + (wid * 32 + ct * 16 + n) * 16 + 4 * g) = make_float4(acc[0], acc[1], acc[2], acc[3]);
            }
            __syncthreads();
            { const int tok = tid >> 4, e = tid & 15; float sum = 0.f;
#pragma unroll
              for (int w = 0; w < 8; ++w) sum += red[(w * 32 + tok) * 16 + e];
              lgs[(grp * 32 + tok) * 16 + e] = sum; }
        }
        __syncthreads();
        if (tid < 256) {
            float lg[16];
#pragma unroll
            for (int q = 0; q < 4; ++q) { const float4 t = *(const float4*)(lgs + tid * 16 + q * 4); lg[q * 4] = t.x; lg[q * 4 + 1] = t.y; lg[q * 4 + 2] = t.z; lg[q * 4 + 3] = t.w; }
            int i1, i2; float g1, g2;
            route_pick(lg, p.router_b, i1, i2, g1, g2);
            sel_e[tid * 2] = i1; sel_e[tid * 2 + 1] = i2; sel_g[tid * 2] = g1; sel_g[tid * 2 + 1] = g2;
        }
        __syncthreads();
        int my_e, my_rank;
        {
            my_e = sel_e[tid]; my_rank = 0;
            const unsigned long long lt = (1ull << lane) - 1ull;
#pragma unroll
            for (int e = 0; e < 16; ++e) {
                const unsigned long long m = __ballot(my_e == e);
                if (my_e == e) my_rank = __popcll(m & lt);
                if (lane == 0) rank[wid * 16 + e] = __popcll(m);
            }
        }
        __syncthreads();
        if (tid < 16) {
            int c = 0;
#pragma unroll
            for (int w = 0; w < 8; ++w) { const int t = rank[w * 16 + tid]; rank[w * 16 + tid] = c; c += t; }
            base[tid] = (int)atomicAdd(&ctl[CW_CNT + (l * 16 + tid) * 64], (unsigned)c);
        }
        __syncthreads();
        {
            const int e = my_e; const int pos = base[e] + rank[wid * 16 + e] + my_rank;
            ltok[(size_t)e * NTOK + pos] = chunk * 256 + (tid >> 1);
            int* ti = (int*)(p.ws + WS_LGATE) + (size_t)(chunk * 256 + (tid >> 1)) * 4;
            ti[tid & 1] = (e << 17) | pos; ((float*)ti)[2 + (tid & 1)] = sel_g[tid];
        }
    }
}

#define MOE_TAB_OFF 131072
#define MOE_META_OFF (131072 + 4096)
struct MoeUnit { int e, rl, pn, n, ui, pb; };
__device__ __forceinline__ void moe_meta(const Params& p, int l, PG8_LAS int* meta) {
    unsigned* ctl = (unsigned*)(p.ws + WS_CTL);
    const int tid = otid();
    if (tid < 16) meta[tid] = (int)xb_ld(&ctl[CW_CNT + (l * 16 + tid) * 64]);
    __syncthreads();
    if (tid == 0) {
        int tb = 0, pb = 0;
        for (int e = 0; e < 16; ++e) { const int c = meta[e]; meta[16 + e] = tb; meta[33 + e] = pb; tb += (c + 255) >> 8; pb += c; }
        meta[32] = tb; meta[49] = pb;
    }
    __syncthreads();
}
struct MoeSchedCommon {
    typedef MoeUnit Unit;
    PG8_LAS const int* meta; int G, c;
    __device__ __forceinline__ int mu(int idx) const { return __builtin_amdgcn_readfirstlane(meta[idx]); }
    __device__ __forceinline__ void fill(int rt, int pn, int i, MoeUnit& u) const {
        int e = 0;
#pragma unroll
        for (int k = 1; k < 16; ++k) if (rt >= mu(16 + k)) e = k;
        u.pn = pn; u.e = e; u.rl = rt - mu(16 + e); u.n = mu(e) - u.rl * 256; u.pb = mu(33 + e) + u.rl * 256; u.ui = i;
    }
};
struct MoeSchedUp : MoeSchedCommon {
    PG8_LAS const unsigned short* tok16; const char* xb; const char* wbase; int i0, i1;
    __device__ __forceinline__ bool next(int i, MoeUnit& u) const {
        const int ii = i0 + i; if (ii >= i1) return false;
        int rt, pn;
        if ((G & 15) == 0) { rt = ii * (G >> 1) + ((c & 7) | ((c >> 4) << 3)); pn = (c >> 3) & 1; }
        else { const int L = ii * G + c; rt = L >> 1; pn = L & 1; }
        if (rt >= mu(32)) return false;
        fill(rt, pn, i, u); return true;
    }
    __device__ __forceinline__ const char* abase(const MoeUnit&) const { return xb; }
    __device__ __forceinline__ unsigned arow_off(const MoeUnit& u, int r) const { return (unsigned)tok16[u.ui * 256 + r] * 1024u; }
    __device__ __forceinline__ const char* bbase(const MoeUnit& u) const { return wbase + ((size_t)u.e * 512 + u.pn * 256) * 1024; }
};
struct MoeSchedDown : MoeSchedCommon {
    const char* hb; const char* wbase; int mode;
    __device__ __forceinline__ bool next(int i, MoeUnit& u) const {
        const int ntile = mu(32);
        int rt, pn;
        if (mode == 1) {
            if (c >= 32) { const int j = c - 32;
                if (i < 4) { rt = i * 56 + ((j & 7) | ((j >> 5) << 3)); pn = (j >> 3) & 3; } else { rt = 224 + (i - 4) * 64 + ((c & 7) | ((c >> 5) << 3)); pn = (c >> 3) & 3; } }
            else { rt = 224 + i * 64 + (c & 7); pn = (c >> 3) & 3; }
            if (rt >= 512) return false;
        } else if (mode == 2) {
            if (i > 0) return false;
            const int j = G - 1 - c; rt = 512 + (j >> 2); pn = j & 3;
            if (rt >= ntile) return false;
        } else {
            if ((G & 31) == 0) { rt = i * (G >> 2) + ((c & 7) | ((c >> 5) << 3)); pn = (c >> 3) & 3; } else { const int L = i * G + c; rt = L >> 2; pn = L & 3; }
            if (rt >= ntile) return false;
        }
        fill(rt, pn, i, u); return true;
    }
    __device__ __forceinline__ const char* abase(const MoeUnit& u) const { return hb + (size_t)u.pb * 256; }
    __device__ __forceinline__ unsigned arow_off(const MoeUnit&, int r) const { return (unsigned)r * 256u; }
    __device__ __forceinline__ const char* bbase(const MoeUnit& u) const { return wbase + ((size_t)u.e * 1024 + u.pn * 256) * 256; }
};
struct EpiUp {
    static constexpr bool PERM = false, AFTER_DRAIN = false;
    unsigned char* H;
    __device__ __forceinline__ void operator()(const pg8::f32x4 (&acc)[2][2][4][2], const MoeUnit& u, int wr, int wc, int fr, int fq) const {
        unsigned char* hb = H + u.pn * 128 + wc * 16 + fq * 4;
#pragma unroll
        for (int ai = 0; ai < 2; ++ai)
#pragma unroll
            for (int m = 0; m < 4; ++m) {
                const int r = ai * 128 + wr * 64 + m * 16 + fr;
                const int rr = (r < u.n) ? (u.pb + r) : (2 * NTOK + r);
#pragma unroll
                for (int bj = 0; bj < 2; ++bj) {
                    const pg8::f32x4 g = acc[ai][bj][m][0], uu = acc[ai][bj][m][1];
                    float hv[4];
#pragma unroll
                    for (int i = 0; i < 4; ++i) hv[i] = g[i] * __builtin_amdgcn_rcpf(1.0f + __builtin_amdgcn_exp2f(-g[i] * LOG2E)) * uu[i] * H8_SCALE;
                    *(unsigned*)(hb + (size_t)rr * DEXP + bj * 64) = pk_fp8x4(hv[0], hv[1], hv[2], hv[3]);
                }
            }
    }
};
struct EpiDown {
    static constexpr bool PERM = true, AFTER_DRAIN = false;
    unsigned char* Y8;
    __device__ __forceinline__ void operator()(const pg8::f32x4 (&acc)[2][2][4][2], const MoeUnit& u, int wr, int wc, int fr, int fq) const {
        unsigned char* yb = Y8 + u.pn * 256 + wc * 32 + 8 * fq;
#pragma unroll
        for (int ai = 0; ai < 2; ++ai)
#pragma unroll
            for (int m = 0; m < 4; ++m) {
                const int r = ai * 128 + wr * 64 + m * 16 + fr;
                const int rr = (r < u.n) ? (u.pb + r) : (2 * NTOK + r);
#pragma unroll
                for (int bj = 0; bj < 2; ++bj) { const pg8::f32x4 v0 = acc[ai][bj][m][0], v1 = acc[ai][bj][m][1];
                    uint2 w; w.x = pk_fp8x4(v0[0] * Y8_SCALE, v0[1] * Y8_SCALE, v0[2] * Y8_SCALE, v0[3] * Y8_SCALE); w.y = pk_fp8x4(v1[0] * Y8_SCALE, v1[1] * Y8_SCALE, v1[2] * Y8_SCALE, v1[3] * Y8_SCALE);
                    *(uint2*)(yb + (size_t)rr * DM + bj * 128) = w; }
            }
    }
};
__device__ __forceinline__ bool moe_up_rounds(const Params& p, int l, unsigned char* lds, int i0, int i1) {
    PG8_LAS unsigned char* L = (PG8_LAS unsigned char*)lds;
    PG8_LAS int* meta = (PG8_LAS int*)(L + MOE_META_OFF);
    PG8_LAS unsigned short* tok16 = (PG8_LAS unsigned short*)(L + MOE_TAB_OFF);
    MoeSchedUp S; S.meta = meta; S.G = (int)gridDim.x; S.c = obid(); S.tok16 = tok16; S.xb = (const char*)(p.ws + WS_X8); S.wbase = (const char*)(p.ws + WS_MWIN) + (size_t)l * 16 * 512 * 1024; S.i0 = i0; S.i1 = i1;
    bool any = false;
    {
        const int* ltok = (const int*)(p.ws + WS_LTOK); const int tid = otid();
        int tk[8]; bool ok[8];
#pragma unroll
        for (int i = 0; i < 8; ++i) {
            MoeUnit u; ok[i] = S.next(i, u);
            tk[i] = 0;
            if (ok[i] && tid < 256 && tid < u.n) tk[i] = ltok[(size_t)u.e * NTOK + u.rl * 256 + tid];
        }
#pragma unroll
        for (int i = 0; i < 8; ++i) if (ok[i]) { any = true; if (tid < 256) tok16[i * 256 + tid] = (unsigned short)tk[i]; }
    }
    __syncthreads();
    EpiUp E{p.ws + WS_H};
    pg8::gemm_phase_g<EpiUp, MoeSchedUp, true, true>(L, 512, S, E, 0x76767676, 0x7b7b7b7b);
    return any;
}
__device__ __forceinline__ void phase_moe_up(const Params& p, int l, unsigned char* lds) {
    PG8_LAS int* meta = (PG8_LAS int*)((PG8_LAS unsigned char*)lds + MOE_META_OFF);
    __syncthreads();
    moe_meta(p, l, meta);
    (void)moe_up_rounds(p, l, lds, 0, gridDim.x == 256 ? 4 : 8);
}
__device__ __forceinline__ void phase_moe_down(const Params& p, int l, unsigned char* lds) {
    PG8_LAS unsigned char* L = (PG8_LAS unsigned char*)lds;
    PG8_LAS int* meta = (PG8_LAS int*)(L + MOE_META_OFF);
    unsigned* ctl = (unsigned*)(p.ws + WS_CTL);
    const bool fast = gridDim.x == 256;
    __syncthreads();
    moe_meta(p, l, meta);
    if (fast && obid() < 32) {
        const bool any = moe_up_rounds(p, l, lds, 4, 5);
        if (any && otid() == 0) {
            __builtin_amdgcn_fence(__ATOMIC_RELEASE, "agent");
            asm volatile("s_waitcnt vmcnt(0)" ::: "memory");
            (void)xb_add(&ctl[CW_FLAG + l * 64], 1u);
        }
        __syncthreads();
    }
    MoeSchedDown S; S.meta = meta; S.G = (int)gridDim.x; S.c = obid(); S.hb = (const char*)(p.ws + WS_H); S.wbase = (const char*)(p.ws + WS_MWDN) + (size_t)l * 16 * 1024 * 256;
    EpiDown E{p.ws + WS_Y};
#pragma unroll 1
    for (int pass = 0; pass < 2; ++pass) {
        S.mode = fast ? 1 + pass : 0;
        if (pass == 1) {
            MoeUnit u;
            if (!fast || !S.next(0, u)) break;
            if (otid() == 0) {
                const unsigned need = 2u * (unsigned)(meta[32] - 512);
                XB_SPIN(xb_ld(&ctl[CW_FLAG + l * 64]) < need, ctl + CW_BAR);
                __builtin_amdgcn_fence(__ATOMIC_ACQUIRE, "agent");
                asm volatile("s_waitcnt vmcnt(0)" ::: "memory");
            }
            __syncthreads();
        }
        pg8::gemm_phase_g<EpiDown, MoeSchedDown, false, true>(L, 128, S, E, 0x76767676, 0x7c7c7c7c);
    }
}

__device__ __forceinline__ void phase_ln2(const Params& p, int l, unsigned char* lds) {
    const int tid = otid(), lane = tid & 63, wid = tid >> 6;
    bf16_t* xb = (bf16_t*)(p.ws + WS_XB); const unsigned char* Y8 = p.ws + WS_Y;
    const bf16_t* yb = (const bf16_t*)(p.ws + WS_YB);
    const float* gain1 = p.ln_gain + (size_t)(l * 2 + 0) * DM; const float* bias1 = p.ln_bias + (size_t)(l * 2 + 0) * DM;
    const float* gain = p.ln_gain + (size_t)(l * 2 + 1) * DM; const float* bias = p.ln_bias + (size_t)(l * 2 + 1) * DM;
    int* pbase = (int*)lds;
    __syncthreads();
    if (tid < 16) pbase[32 + tid] = (int)xb_ld(&((unsigned*)(p.ws + WS_CTL))[CW_CNT + (l * 16 + tid) * 64]);
    __syncthreads();
    if (tid == 0) { int pb = 0; for (int e = 0; e < 16; ++e) { pbase[e] = pb; pb += pbase[32 + e]; } }
    __syncthreads();
    float gn[16], bs[16];
#pragma unroll
    for (int j = 0; j < 2; ++j)
#pragma unroll
        for (int q = 0; q < 2; ++q) { const float4 g = *(const float4*)(gain + j * 512 + lane * 8 + q * 4), bb = *(const float4*)(bias + j * 512 + lane * 8 + q * 4);
            gn[j * 8 + q * 4] = g.x; gn[j * 8 + q * 4 + 1] = g.y; gn[j * 8 + q * 4 + 2] = g.z; gn[j * 8 + q * 4 + 3] = g.w; bs[j * 8 + q * 4] = bb.x; bs[j * 8 + q * 4 + 1] = bb.y; bs[j * 8 + q * 4 + 2] = bb.z; bs[j * 8 + q * 4 + 3] = bb.w; }
    float gn1[16], bs1[16];
#pragma unroll
    for (int j = 0; j < 2; ++j)
#pragma unroll
        for (int q = 0; q < 2; ++q) { const float4 g = *(const float4*)(gain1 + j * 512 + lane * 8 + q * 4), bb = *(const float4*)(bias1 + j * 512 + lane * 8 + q * 4);
            gn1[j * 8 + q * 4] = g.x; gn1[j * 8 + q * 4 + 1] = g.y; gn1[j * 8 + q * 4 + 2] = g.z; gn1[j * 8 + q * 4 + 3] = g.w; bs1[j * 8 + q * 4] = bb.x; bs1[j * 8 + q * 4 + 1] = bb.y; bs1[j * 8 + q * 4 + 2] = bb.z; bs1[j * 8 + q * 4 + 3] = bb.w; }
    const size_t rstep = (size_t)gridDim.x * 8;
    size_t row = (size_t)obid() * 8 + (size_t)__builtin_amdgcn_readfirstlane(wid);
#define LN2_CL(r_) ((r_) < NTOK ? (r_) : (size_t)(NTOK - 1))
#define LN2_TI(r_) (*(const int4*)(p.ws + WS_LGATE + LN2_CL(r_) * 16))
#define LN2_LOAD(X, A, B, r_, t_) do { { const size_t _rc = LN2_CL(r_); const size_t _p0 = (size_t)(pbase[(t_).x >> 17] + ((t_).x & 0x1ffff)), _p1 = (size_t)(pbase[(t_).y >> 17] + ((t_).y & 0x1ffff)); \
        _Pragma("unroll") for (int j = 0; j < 2; ++j) { X[j] = *(const uint4*)(yb + _rc * DM + j * 512 + lane * 8); A[j] = *(const uint2*)(Y8 + _p0 * DM + j * 512 + lane * 8); B[j] = *(const uint2*)(Y8 + _p1 * DM + j * 512 + lane * 8); } } } while (0)
#define LN2_STEP(Xc, Ac, Bc, tc, Xn, An, Bn, tl) do { \
        const float g0 = __int_as_float(tc.z) * (1.0f / Y8_SCALE), g1 = __int_as_float(tc.w) * (1.0f / Y8_SCALE); \
        tc = LN2_TI(row + 3 * rstep); \
        LN2_LOAD(Xn, An, Bn, row + 2 * rstep, tl); \
        float v[16]; \
        _Pragma("unroll") for (int j = 0; j < 2; ++j) { float fx[8]; bf8_to_f(Xc[j], fx); _Pragma("unroll") for (int i = 0; i < 8; ++i) v[j * 8 + i] = fx[i]; } \
        ln_row_r(v, gn1, bs1);        \
        _Pragma("unroll") for (int j = 0; j < 2; ++j) { float f0[8], f1[8]; fp8x8_to_f(Ac[j], f0); fp8x8_to_f(Bc[j], f1); \
            _Pragma("unroll") for (int i = 0; i < 8; ++i) v[j * 8 + i] = ALPHA * v[j * 8 + i] + g0 * f0[i] + g1 * f1[i]; } \
        ln_row_r(v, gn, bs); \
        _Pragma("unroll") for (int j = 0; j < 2; ++j) { \
            uint4 o; o.x = pk_bf16(v[j * 8], v[j * 8 + 1]); o.y = pk_bf16(v[j * 8 + 2], v[j * 8 + 3]); o.z = pk_bf16(v[j * 8 + 4], v[j * 8 + 5]); o.w = pk_bf16(v[j * 8 + 6], v[j * 8 + 7]); \
            if (l < NLAYER - 1) { *(uint4*)(xb + row * DM + j * 512 + lane * 8) = o;        \
                uint2 o8; o8.x = pk_fp8x4(v[j * 8] * X8_SCALE, v[j * 8 + 1] * X8_SCALE, v[j * 8 + 2] * X8_SCALE, v[j * 8 + 3] * X8_SCALE); o8.y = pk_fp8x4(v[j * 8 + 4] * X8_SCALE, v[j * 8 + 5] * X8_SCALE, v[j * 8 + 6] * X8_SCALE, v[j * 8 + 7] * X8_SCALE); \
                *(uint2*)(p.ws + WS_X8 + row * DM + j * 512 + lane * 8) = o8; } \
            if (l == NLAYER - 1) { \
                *(float4*)(p.out + row * DM + j * 512 + lane * 8) = make_float4(v[j * 8], v[j * 8 + 1], v[j * 8 + 2], v[j * 8 + 3]); \
                *(float4*)(p.out + row * DM + j * 512 + lane * 8 + 4) = make_float4(v[j * 8 + 4], v[j * 8 + 5], v[j * 8 + 6], v[j * 8 + 7]); } } \
        row += rstep; } while (0)
    uint4 x0[2], x1[2], x2[2]; uint2 a0[2], b0[2], a1[2], b1[2], a2[2], b2[2];
    int4 t0 = LN2_TI(row), t1 = LN2_TI(row + rstep), t2 = LN2_TI(row + 2 * rstep);
    LN2_LOAD(x0, a0, b0, row, t0);
    LN2_LOAD(x1, a1, b1, row + rstep, t1);
#pragma unroll 1
    for (;;) {
        if (row >= NTOK) break;
        LN2_STEP(x0, a0, b0, t0, x2, a2, b2, t2);
        if (row >= NTOK) break;
        LN2_STEP(x1, a1, b1, t1, x0, a0, b0, t0);
        if (row >= NTOK) break;
        LN2_STEP(x2, a2, b2, t2, x1, a1, b1, t1);
    }
#undef LN2_STEP
#undef LN2_CL
#undef LN2_TI
#undef LN2_LOAD
}

typedef float f32x16 __attribute__((ext_vector_type(16)));
#define AT_KSTR 72
#define AT_VSTR 68
#define AT_KBYTES (64 * AT_KSTR * 2)
#define AT_VBYTES (64 * AT_VSTR * 2)
__device__ __forceinline__ bf16x8 scale_frag(uint4 raw, float sc) {
    return mk_frag(pk_bf16(__uint_as_float(raw.x << 16) * sc, __uint_as_float(raw.x & 0xffff0000u) * sc), pk_bf16(__uint_as_float(raw.y << 16) * sc, __uint_as_float(raw.y & 0xffff0000u) * sc),
                   pk_bf16(__uint_as_float(raw.z << 16) * sc, __uint_as_float(raw.z & 0xffff0000u) * sc), pk_bf16(__uint_as_float(raw.w << 16) * sc, __uint_as_float(raw.w & 0xffff0000u) * sc));
}
struct AtStage {
    uint4 rk; uint2 rv0, rv1;
    __device__ __forceinline__ void load(const bf16_t* kbase, const bf16_t* vbase, int kt, int tid) {
        const int skey = tid >> 3, sc8 = tid & 7, vkp = tid >> 4, vdg = tid & 15;
        rk = *(const uint4*)(kbase + (size_t)(kt * 64 + skey) * PINP + sc8 * 8);
        rv0 = *(const uint2*)(vbase + (size_t)(kt * 64 + 2 * vkp) * PINP + vdg * 4);
        rv1 = *(const uint2*)(vbase + (size_t)(kt * 64 + 2 * vkp + 1) * PINP + vdg * 4);
    }
    __device__ __forceinline__ void store(LAS unsigned char* kb, LAS unsigned char* vb, int tid) const {
        const int skey = tid >> 3, sc8 = tid & 7, vkp = tid >> 4, vdg = tid & 15;
        { u32x4v t_; t_.x = rk.x; t_.y = rk.y; t_.z = rk.z; t_.w = rk.w; *(LAS u32x4v*)(kb + (skey * AT_KSTR + sc8 * 8) * 2) = t_; }
        LAS unsigned* vt = (LAS unsigned*)vb;
        vt[(vdg * 4 + 0) * (AT_VSTR / 2) + vkp] = (rv0.x & 0xffffu) | (rv1.x << 16);
        vt[(vdg * 4 + 1) * (AT_VSTR / 2) + vkp] = (rv0.x >> 16) | (rv1.x & 0xffff0000u);
        vt[(vdg * 4 + 2) * (AT_VSTR / 2) + vkp] = (rv0.y & 0xffffu) | (rv1.y << 16);
        vt[(vdg * 4 + 3) * (AT_VSTR / 2) + vkp] = (rv0.y >> 16) | (rv1.y & 0xffff0000u);
    }
};
__device__ __forceinline__ bf16x8 k_frag(const LAS unsigned char* kb, int keyrow, int dcol) { return *(const LAS bf16x8*)(kb + (keyrow * AT_KSTR + dcol) * 2); }
__device__ __forceinline__ bf16x8 v_frag(const LAS unsigned char* vb, int drow, int keycol) {
    const u32x2v a = *(const LAS u32x2v*)(vb + (drow * AT_VSTR + keycol) * 2), b = *(const LAS u32x2v*)(vb + (drow * AT_VSTR + keycol + 8) * 2);
    return mk_frag(a.x, a.y, b.x, b.y);
}
__device__ __forceinline__ void store_ot(unsigned char* dst  , const f32x16& o0, const f32x16& o1, int hh) {
#pragma unroll
    for (int q = 0; q < 4; ++q) {
        *(unsigned*)(dst + 8 * q + 4 * hh) = pk_fp8x4(o0[4 * q] * MIX8_SCALE, o0[4 * q + 1] * MIX8_SCALE, o0[4 * q + 2] * MIX8_SCALE, o0[4 * q + 3] * MIX8_SCALE);
        *(unsigned*)(dst + 32 + 8 * q + 4 * hh) = pk_fp8x4(o1[4 * q] * MIX8_SCALE, o1[4 * q + 1] * MIX8_SCALE, o1[4 * q + 2] * MIX8_SCALE, o1[4 * q + 3] * MIX8_SCALE);
    }
}

#define SB_VSTR 36
#define SB_WBYTES (32 * AT_KSTR * 2 + 64 * SB_VSTR * 2)
struct SbStage {
    u32x4v rk[4]; u32x2v rv0[4], rv1[4];
    __device__ __forceinline__ void load(const bf16_t* kbase, const bf16_t* vbase, int kb, int lane) {
        const int rsub = lane >> 3, c8 = lane & 7, kps = lane >> 4, dg = lane & 15;
#pragma unroll
        for (int j = 0; j < 4; ++j) {
            rk[j] = *(const u32x4v*)(kbase + (size_t)(kb * 32 + 8 * j + rsub) * PINP + c8 * 8);
            const int kp = 4 * j + kps;
            rv0[j] = *(const u32x2v*)(vbase + (size_t)(kb * 32 + 2 * kp) * PINP + dg * 4);
            rv1[j] = *(const u32x2v*)(vbase + (size_t)(kb * 32 + 2 * kp + 1) * PINP + dg * 4);
        }
    }
    __device__ __forceinline__ void store(LAS unsigned char* kb_, LAS unsigned char* vb_, int lane) const {
        const int rsub = lane >> 3, c8 = lane & 7, kps = lane >> 4, dg = lane & 15;
        LAS unsigned* vt = (LAS unsigned*)vb_;
#pragma unroll
        for (int j = 0; j < 4; ++j) {
            *(LAS u32x4v*)(kb_ + ((8 * j + rsub) * AT_KSTR + c8 * 8) * 2) = rk[j];
            const int kp = 4 * j + kps;
            vt[(dg * 4 + 0) * (SB_VSTR / 2) + kp] = (rv0[j].x & 0xffffu) | (rv1[j].x << 16);
            vt[(dg * 4 + 1) * (SB_VSTR / 2) + kp] = (rv0[j].x >> 16) | (rv1[j].x & 0xffff0000u);
            vt[(dg * 4 + 2) * (SB_VSTR / 2) + kp] = (rv0[j].y & 0xffffu) | (rv1[j].y << 16);
            vt[(dg * 4 + 3) * (SB_VSTR / 2) + kp] = (rv0[j].y >> 16) | (rv1[j].y & 0xffff0000u);
        }
    }
};
__device__ __forceinline__ bf16x8 sbv_frag(const LAS unsigned char* vb, int drow, int keycol) {
    const u32x2v a = *(const LAS u32x2v*)(vb + (drow * SB_VSTR + keycol) * 2), b = *(const LAS u32x2v*)(vb + (drow * SB_VSTR + keycol + 8) * 2);
    return mk_frag(a.x, a.y, b.x, b.y);
}
__device__ __forceinline__ void sbm_item(const Params& p, int bh, int qb, unsigned char* lds) {
    const int tid = otid(), lane = tid & 63, wid = tid >> 6, r = lane & 31, hh = lane >> 5;
    const int b = bh >> 2, h = bh & 3;
    const bf16_t* proj = (const bf16_t*)(p.ws + WS_PROJ) + (size_t)b * SEQ * PINP;
    const bf16_t* kbase = proj + 256 + h * 64; const bf16_t* vbase = proj + 512 + h * 64;
    const int q0w = qb * 256 + wid * 32, t = q0w + r;
    LAS unsigned char* const KW = (LAS unsigned char*)lds + wid * SB_WBYTES; LAS unsigned char* const VW = KW + 32 * AT_KSTR * 2;
    SbStage st;
    st.load(kbase, vbase, (q0w + 30) >> 5, lane);
    bf16x8 qf[4];
#pragma unroll
    for (int s = 0; s < 4; ++s) qf[s] = scale_frag(*(const uint4*)(proj + (size_t)t * PINP + h * 64 + 16 * s + 8 * hh), 0.125f * LOG2E);
    f32x16 O0, O1;
#pragma unroll
    for (int i = 0; i < 16; ++i) { O0[i] = 0.f; O1[i] = 0.f; }
    float carry = 1.f;
    __syncthreads();
    if (q0w + 31 > 0) {
        int kb = (q0w + 30) >> 5;
#pragma unroll 1
        for (; kb >= 0; --kb) {
            st.store(KW, VW, lane);
            if (kb > 0) st.load(kbase, vbase, kb - 1, lane);
            const int kbs = 32 * kb;
            f32x16 S;
#pragma unroll
            for (int i = 0; i < 16; ++i) S[i] = 0.f;
#pragma unroll
            for (int s = 0; s < 4; ++s) S = __builtin_amdgcn_mfma_f32_32x32x16_bf16(k_frag(KW, r, 16 * s + 8 * hh), qf[s], S, 0, 0, 0);
            const bool needmask = (kbs + 31 >= q0w);
            float sg[16], G[4];
#pragma unroll
            for (int q = 0; q < 4; ++q) {
                float om[4];
#pragma unroll
                for (int i = 0; i < 4; ++i) {
                    const float z = S[4 * q + i];
                    const float e = __builtin_amdgcn_exp2f(-fabsf(z));
                    const float rr = __builtin_amdgcn_rcpf(1.0f + e);
                    const float er = e * rr;
                    float sgm = z >= 0.f ? rr : er, omm = z >= 0.f ? er : rr;
                    if (needmask) { const int key = kbs + i + 8 * q + 4 * hh; if (key >= t) { sgm = 0.f; omm = 1.f; } }
                    sg[4 * q + i] = sgm; om[i] = omm;
                }
                const float pp2 = om[3], pp1 = pp2 * om[2], pp0 = pp1 * om[1];
                G[q] = pp0 * om[0];
                sg[4 * q + 2] *= pp2; sg[4 * q + 1] *= pp1; sg[4 * q + 0] *= pp0;
            }
            float Gp[4];
#pragma unroll
            for (int q = 0; q < 4; ++q) Gp[q] = __shfl_xor(G[q], 32);
            const float T0 = G[0] * Gp[0], T1 = G[1] * Gp[1], T2 = G[2] * Gp[2], T3 = G[3] * Gp[3];
            const float U2 = T3, U1 = T3 * T2, U0 = U1 * T1;
            float E[4];
            E[3] = carry; E[2] = carry * U2; E[1] = carry * U1; E[0] = carry * U0;
            if (hh == 0) { E[3] *= Gp[3]; E[2] *= Gp[2]; E[1] *= Gp[1]; E[0] *= Gp[0]; }
            carry = carry * U0 * T0;
#pragma unroll
            for (int q = 0; q < 4; ++q) { sg[4 * q] *= E[q]; sg[4 * q + 1] *= E[q]; sg[4 * q + 2] *= E[q]; sg[4 * q + 3] *= E[q]; }
            const bf16x8 P0 = mk_frag(pk_bf16(sg[0], sg[1]), pk_bf16(sg[2], sg[3]), pk_bf16(sg[4], sg[5]), pk_bf16(sg[6], sg[7]));
            const bf16x8 P1 = mk_frag(pk_bf16(sg[8], sg[9]), pk_bf16(sg[10], sg[11]), pk_bf16(sg[12], sg[13]), pk_bf16(sg[14], sg[15]));
            O0 = __builtin_amdgcn_mfma_f32_32x32x16_bf16(sbv_frag(VW, r, 4 * hh), P0, O0, 0, 0, 0);
            O0 = __builtin_amdgcn_mfma_f32_32x32x16_bf16(sbv_frag(VW, r, 16 + 4 * hh), P1, O0, 0, 0, 0);
            O1 = __builtin_amdgcn_mfma_f32_32x32x16_bf16(sbv_frag(VW, 32 + r, 4 * hh), P0, O1, 0, 0, 0);
            O1 = __builtin_amdgcn_mfma_f32_32x32x16_bf16(sbv_frag(VW, 32 + r, 16 + 4 * hh), P1, O1, 0, 0, 0);
            if (__all(carry < 0x1p-30f)) break;
        }
    }
    { const int tid2 = otid(), hh2 = (tid2 & 63) >> 5, t2 = qb * 256 + (tid2 >> 6) * 32 + (tid2 & 31);
      store_ot(p.ws + WS_MIX + (size_t)((bh >> 2) * SEQ + t2) * DM + (bh & 3) * 64, O0, O1, hh2); }
}

#define DA_CT_OFF 40960
__device__ __forceinline__ bf16x8 v_frag_p(const LAS unsigned char* q) { const u32x2v a = *(const LAS u32x2v*)q, b = *(const LAS u32x2v*)(q + 16); return mk_frag(a.x, a.y, b.x, b.y); }
__device__ __forceinline__ void da_block(const LAS unsigned char* kp, const LAS unsigned char* vp, const LAS unsigned char* vp2, const f32x16& C,
                                         const bf16x8 (&qf)[2][2], f32x16 (&O)[2][2], float (&lrun)[2], float one) {
#pragma clang fp reassociate(off)
    f32x16 S0, S1;
    {
        const bf16x8 k00 = *(const LAS bf16x8*)kp, k01 = *(const LAS bf16x8*)(kp + 32), k10 = *(const LAS bf16x8*)(kp + 64), k11 = *(const LAS bf16x8*)(kp + 96);
        S0 = __builtin_amdgcn_mfma_f32_32x32x16_bf16(k00, qf[0][0], C, 0, 0, 0);
        S1 = __builtin_amdgcn_mfma_f32_32x32x16_bf16(k10, qf[1][0], C, 0, 0, 0);
        S0 = __builtin_amdgcn_mfma_f32_32x32x16_bf16(k01, qf[0][1], S0, 0, 0, 0);
        S1 = __builtin_amdgcn_mfma_f32_32x32x16_bf16(k11, qf[1][1], S1, 0, 0, 0);
    }
    const bf16x8 va0 = v_frag_p(vp), vb0 = v_frag_p(vp + 32), va1 = v_frag_p(vp2), vb1 = v_frag_p(vp2 + 32);
    float ls0 = 0.f, ls1 = 0.f;
#pragma unroll
    for (int i = 0; i < 16; ++i) { const float p0 = __builtin_amdgcn_exp2f(S0[i]), p1 = __builtin_amdgcn_exp2f(S1[i]); S0[i] = p0; S1[i] = p1; ls0 += p0; ls1 = __builtin_fmaf(p1, one, ls1); }
    lrun[0] += ls0; lrun[1] = __builtin_fmaf(ls1, one, lrun[1]);
    const bf16x8 P00 = mk_frag(pk_bf16(S0[0], S0[1]), pk_bf16(S0[2], S0[3]), pk_bf16(S0[4], S0[5]), pk_bf16(S0[6], S0[7]));
    const bf16x8 P01 = mk_frag(pk_bf16(S0[8], S0[9]), pk_bf16(S0[10], S0[11]), pk_bf16(S0[12], S0[13]), pk_bf16(S0[14], S0[15]));
    const bf16x8 P10 = mk_frag(pk_bf16(S1[0], S1[1]), pk_bf16(S1[2], S1[3]), pk_bf16(S1[4], S1[5]), pk_bf16(S1[6], S1[7]));
    const bf16x8 P11 = mk_frag(pk_bf16(S1[8], S1[9]), pk_bf16(S1[10], S1[11]), pk_bf16(S1[12], S1[13]), pk_bf16(S1[14], S1[15]));
    O[0][0] = __builtin_amdgcn_mfma_f32_32x32x16_bf16(va0, P00, O[0][0], 0, 0, 0);
    O[1][0] = __builtin_amdgcn_mfma_f32_32x32x16_bf16(va0, P10, O[1][0], 0, 0, 0);
    O[0][1] = __builtin_amdgcn_mfma_f32_32x32x16_bf16(va1, P00, O[0][1], 0, 0, 0);
    O[1][1] = __builtin_amdgcn_mfma_f32_32x32x16_bf16(va1, P10, O[1][1], 0, 0, 0);
    O[0][0] = __builtin_amdgcn_mfma_f32_32x32x16_bf16(vb0, P01, O[0][0], 0, 0, 0);
    O[1][0] = __builtin_amdgcn_mfma_f32_32x32x16_bf16(vb0, P11, O[1][0], 0, 0, 0);
    O[0][1] = __builtin_amdgcn_mfma_f32_32x32x16_bf16(vb1, P01, O[0][1], 0, 0, 0);
    O[1][1] = __builtin_amdgcn_mfma_f32_32x32x16_bf16(vb1, P11, O[1][1], 0, 0, 0);
}
__device__ __forceinline__ void da_ctile(f32x16& C, const LAS unsigned char* cp) {
    const f32x4 c0 = *(const LAS f32x4*)cp, c1 = *(const LAS f32x4*)(cp + 1024), c2 = *(const LAS f32x4*)(cp + 2048), c3 = *(const LAS f32x4*)(cp + 3072);
#pragma unroll
    for (int i = 0; i < 4; ++i) { C[i] = c0[i]; C[4 + i] = c1[i]; C[8 + i] = c2[i]; C[12 + i] = c3[i]; }
}
__device__ __forceinline__ void dam_item(const Params& p, int l, int bh, int qb, unsigned char* lds, int* qslot, int qnxt) {
    const int tid = otid(), lane = tid & 63, wid = __builtin_amdgcn_readfirstlane(tid >> 6), r = lane & 31, hh = lane >> 5;
    const int b = bh >> 2, h = bh & 3;
    const bf16_t* proj = (const bf16_t*)(p.ws + WS_PROJ) + (size_t)b * SEQ * PINP;
    const bf16_t* kbase = proj + 1024 + h * 64; const bf16_t* vbase = proj + 1280 + h * 64;
    const float* biasd = (const float*)(p.ws + WS_BIASD) + h * 2048;
    const int q0w = qb * 256 + wid * 32, t = q0w + r;
    LAS unsigned char* const L = (LAS unsigned char*)lds;
#define KBUF(b_) (L + (b_) * AT_KBYTES)
#define VBUF(b_) (L + 2 * AT_KBYTES + (b_) * AT_VBYTES)
    bf16x8 qf[2][2];
#pragma unroll
    for (int m = 0; m < 2; ++m)
#pragma unroll
        for (int s = 0; s < 2; ++s) qf[m][s] = scale_frag(*(const uint4*)(proj + (size_t)t * PINP + 768 + h * 64 + m * 32 + 16 * s + 8 * hh), 0.17677669529663687f * LOG2E);
    f32x16 O[2][2];
#pragma unroll
    for (int m = 0; m < 2; ++m)
#pragma unroll
        for (int d = 0; d < 2; ++d)
#pragma unroll
            for (int i = 0; i < 16; ++i) O[m][d][i] = 0.f;
    float lrun[2] = {0.f, 0.f};
    f32x16 C;
#pragma unroll
    for (int i = 0; i < 16; ++i) C[i] = 0.f;
    const float sfar = ((const float*)(p.ws + WS_LAM))[8 + h];
    AtStage st;
    const int ktop = qb * 4 + 3;
    const int ktn = q0w >= 192 ? ((q0w - 192) >> 6) + 1 : 0;
    int onei = 0x3f800000; asm volatile("" : "+s"(onei)); const float one = __int_as_float(onei);
    __syncthreads();
    st.load(kbase, vbase, 0, tid);
    {
        const f32x4* ct = (const f32x4*)(p.ws + WS_CT) + (size_t)h * 1536;
        const f32x4 c0 = ct[tid], c1 = ct[tid + 512], c2 = ct[tid + 1024];
        *(LAS f32x4*)(L + DA_CT_OFF + tid * 16) = c0; *(LAS f32x4*)(L + DA_CT_OFF + (tid + 512) * 16) = c1; *(LAS f32x4*)(L + DA_CT_OFF + (tid + 1024) * 16) = c2;
    }
    st.store(KBUF(0), VBUF(0), tid);
    if (tid == 0) *qslot = qnxt;
    __syncthreads();
#pragma unroll 1
    for (int kt = 0; kt <= ktop; ++kt) {
        const int buf = kt & 1;
        if (kt < ktop) st.load(kbase, vbase, kt + 1, tid);
        if (64 * kt <= q0w) {
            if (kt == ktn && kt > 0) {
#pragma unroll
                for (int m = 0; m < 2; ++m) {
                    lrun[m] *= sfar;
#pragma unroll
                    for (int d = 0; d < 2; ++d)
#pragma unroll
                        for (int i = 0; i < 16; ++i) O[m][d][i] *= sfar;
                }
            }
            int ko = buf * AT_KBYTES + (r * AT_KSTR + 8 * hh) * 2, vo = 2 * AT_KBYTES + buf * AT_VBYTES + (r * AT_VSTR + 4 * hh) * 2;
            asm volatile("" : "+v"(ko), "+v"(vo));
            int vo2 = vo + 32 * AT_VSTR * 2;
            asm volatile("" : "+v"(vo2));
            const LAS unsigned char* kp = L + ko; const LAS unsigned char* vp = L + vo; const LAS unsigned char* vp2 = L + vo2;
            const int ci = (q0w - 64 * kt) >> 5;
            int co = DA_CT_OFF + (ci < 5 ? ci : 5) * 4096 + lane * 16;
            asm volatile("" : "+v"(co));
            const LAS unsigned char* cp = L + co;
            if (kt >= ktn) da_ctile(C, cp);
            da_block(kp, vp, vp2, C, qf, O, lrun, one);
            if (ci >= 1) {
                if (kt >= ktn) da_ctile(C, cp - 4096);
                da_block(kp + 32 * AT_KSTR * 2, vp + 64, vp2 + 64, C, qf, O, lrun, one);
            }
        }
        if (kt < ktop) st.store(KBUF(buf ^ 1), VBUF(buf ^ 1), tid);
        __syncthreads();
    }
    const int tid2 = otid(), hh2 = (tid2 & 63) >> 5, t2 = qb * 256 + (tid2 >> 6) * 32 + (tid2 & 31);
    float4 sg4[2][4];
#pragma unroll
    for (int d = 0; d < 2; ++d)
#pragma unroll
        for (int q = 0; q < 4; ++q) sg4[d][q] = *(const float4*)(p.da_subln + l * 64 + d * 32 + 8 * q + 4 * hh2);
    const float lam = ((const float*)(p.ws + WS_LAM))[l * 2], lam_init = ((const float*)(p.ws + WS_LAM))[l * 2 + 1];
    const float l0 = lrun[0] + __shfl_xor(lrun[0], 32), l1 = lrun[1] + __shfl_xor(lrun[1], 32);
    const float i0 = 1.0f / l0, i1 = lam / l1;
    float ms = 0.f;
#pragma unroll
    for (int d = 0; d < 2; ++d)
#pragma unroll
        for (int i = 0; i < 16; ++i) { const float o = O[0][d][i] * i0 - O[1][d][i] * i1; O[0][d][i] = o; ms += o * o; }
    ms += __shfl_xor(ms, 32);
    const float rs = rsqrtf(ms * (1.0f / 64.0f) + 1e-5f) * (1.0f - lam_init);
#pragma unroll
    for (int d = 0; d < 2; ++d)
#pragma unroll
        for (int q = 0; q < 4; ++q) { const float4 g4 = sg4[d][q]; O[0][d][4 * q] *= rs * g4.x; O[0][d][4 * q + 1] *= rs * g4.y; O[0][d][4 * q + 2] *= rs * g4.z; O[0][d][4 * q + 3] *= rs * g4.w; }
    store_ot(p.ws + WS_MIX + (size_t)((bh >> 2) * SEQ + t2) * DM + 256 + (bh & 3) * 64, O[0][0], O[0][1], hh2);
}

__device__ __forceinline__ void conv_item(const Params& p, int l, int item) {
    const int tid = otid();
    const bf16_t* proj = (const bf16_t*)(p.ws + WS_PROJ); unsigned char* mix = p.ws + WS_MIX;
    const float* cw = p.sc_conv + (size_t)l * 3 * 256;
    const int c8 = (tid & 31) * 8;
    float w0[8], w1[8], w2[8];
#pragma unroll
    for (int i = 0; i < 8; ++i) { w0[i] = cw[c8 + i]; w1[i] = cw[256 + c8 + i]; w2[i] = cw[512 + c8 + i]; }
#pragma unroll 4
    for (int k = 0; k < 16; ++k) {
        const int rr = (tid >> 5) + 16 * k;
        const size_t row = (size_t)item * 256 + rr; const int t = (int)(row & (SEQ - 1));
        const bf16_t* pr = proj + row * PINP + 1536 + c8;
        const uint4 zz = make_uint4(0u, 0u, 0u, 0u);
        const uint4 bv = *(const uint4*)pr, c2 = *(const uint4*)(pr + 256), h2 = *(const uint4*)(pr + 512);
        const uint4 c1 = t >= 1 ? *(const uint4*)(pr + 256 - PINP) : zz, h1 = t >= 1 ? *(const uint4*)(pr + 512 - PINP) : zz;
        const uint4 c0 = t >= 2 ? *(const uint4*)(pr + 256 - 2 * PINP) : zz, h0 = t >= 2 ? *(const uint4*)(pr + 512 - 2 * PINP) : zz;
        float fb[8], fc2[8], fh2[8], fc1[8], fh1[8], fc0[8], fh0[8], y[8];
        bf8_to_f(bv, fb); bf8_to_f(c2, fc2); bf8_to_f(h2, fh2); bf8_to_f(c1, fc1); bf8_to_f(h1, fh1); bf8_to_f(c0, fc0); bf8_to_f(h0, fh0);
#pragma unroll
        for (int i = 0; i < 8; ++i) y[i] = fb[i] * (w0[i] * (fc0[i] * fh0[i]) + w1[i] * (fc1[i] * fh1[i]) + w2[i] * (fc2[i] * fh2[i]));
        uint2 o; o.x = pk_fp8x4(y[0] * MIX8_SCALE, y[1] * MIX8_SCALE, y[2] * MIX8_SCALE, y[3] * MIX8_SCALE); o.y = pk_fp8x4(y[4] * MIX8_SCALE, y[5] * MIX8_SCALE, y[6] * MIX8_SCALE, y[7] * MIX8_SCALE);
        *(uint2*)(mix + row * DM + 512 + c8) = o;
    }
}

template <int CTRL> __device__ __forceinline__ float dpp_f(float v) { return __int_as_float(__builtin_amdgcn_update_dpp(0, __float_as_int(v), CTRL, 0xf, 0xf, true)); }
__device__ __forceinline__ float red16(float x) { x += dpp_f<0xB1>(x); x += dpp_f<0x4E>(x); x += dpp_f<0x141>(x); x += dpp_f<0x140>(x); return x; }
__device__ __forceinline__ float fsigmoid(float x) { return __builtin_amdgcn_rcpf(1.0f + __builtin_amdgcn_exp2f(-x * LOG2E)); }
__device__ __forceinline__ float ftanh(float x) { return 1.0f - 2.0f * __builtin_amdgcn_rcpf(1.0f + __builtin_amdgcn_exp2f(x * (2.0f * LOG2E))); }
#define MF16(a, b, c) __builtin_amdgcn_mfma_f32_16x16x32_bf16(a, b, c, 0, 0, 0)
__device__ __forceinline__ bf16x8 frag_lo(const f32x4& c) { return mk_frag(pk_bf16(c[0], c[1]), pk_bf16(c[2], c[3]), 0u, 0u); }
__device__ __forceinline__ bf16x8 frag_lo_hi(const f32x4& c, uint2 hi) { return mk_frag(pk_bf16(c[0], c[1]), pk_bf16(c[2], c[3]), hi.x, hi.y); }
__device__ __forceinline__ bf16x8 frag_u2(uint2 lo, uint2 hi) { return mk_frag(lo.x, lo.y, hi.x, hi.y); }
__device__ __forceinline__ f32x4 tt64(const bf16_t* arow, const bf16_t* brow, int g, f32x4 c) {
    c = MF16(*(const bf16x8*)(arow + 8 * g), *(const bf16x8*)(brow + 8 * g), c);
    c = MF16(*(const bf16x8*)(arow + 32 + 8 * g), *(const bf16x8*)(brow + 32 + 8 * g), c);
    return c;
}
#define RW_RS 72
#define RW_TS 20
struct RwPre { uint4 cu[3], pr[3]; };
__device__ __forceinline__ int rw_col(int gq, int h) { return gq < 8 ? h * 64 + gq * 8 : gq < 16 ? 256 + h * 64 + (gq - 8) * 8 : gq < 24 ? 512 + h * 64 + (gq - 16) * 8 : 768 + (gq - 24) * 8; }
__device__ __forceinline__ void rw_prefetch(RwPre& q, const bf16_t* proj, int t0, int h, int tid) {
#pragma unroll
    for (int k = 0; k < 3; ++k) {
        const int i = tid + k * NTHREADS;
        if (i < 1280) {
            const int tt = i / 40, gq = i % 40, t = t0 + tt, col = rw_col(gq, h);
            q.cu[k] = *(const uint4*)(proj + (size_t)t * PINP + col);
            q.pr[k] = (t > 0) ? *(const uint4*)(proj + (size_t)(t - 1) * PINP + col) : make_uint4(0u, 0u, 0u, 0u);
        }
    }
}
__device__ __forceinline__ void rwkv_item(const Params& p, int l, int bh, unsigned char* lds) {
    const int tid = otid(), b = bh >> 2, h = bh & 3;
    const int lane = tid & 63, wv = tid >> 6, n = lane & 15, g = lane >> 4;
    const bf16_t* proj = (const bf16_t*)(p.ws + WS_PROJ) + (size_t)b * SEQ * PINP + 2304;
    unsigned char* mix = p.ws + WS_MIX + (size_t)b * SEQ * DM + 768 + h * 64;
    const float* mu = p.rw_mu + (size_t)l * 896;
    const float* vecs = p.rw_vecs + (size_t)l * 7 * 256 + h * 64;
    bf16_t* WupT = (bf16_t*)lds; bf16_t* AupT = WupT + 64 * 40; bf16_t* GupT = AupT + 64 * 40;
    float* xr = (float*)(GupT + 64 * RW_RS); float* xk = xr + 2048; float* xv = xk + 2048;
    bf16_t* XW = (bf16_t*)(xv + 2048); bf16_t* XA = XW + 32 * 40; bf16_t* XG = XA + 32 * 40;
    float* gg = (float*)(XG + 32 * RW_RS);
    float* yy = gg + 2048;
    float* n2s = yy + 2048; float* pbo = n2s + 512;
    bf16_t* CS = (bf16_t*)(pbo + 128);
#define RW_SET (4 * 16 * RW_RS + 3 * 64 * RW_TS + 4 * 16 * RW_TS + 128)
#define RW_KT(s_) (CS + (s_) * RW_SET)
#define RW_BT(s_) (RW_KT(s_) + 16 * RW_RS)
#define RW_KK(s_) (RW_BT(s_) + 16 * RW_RS)
#define RW_RT(s_) (RW_KK(s_) + 16 * RW_RS)
#define RW_BH(s_) (RW_RT(s_) + 16 * RW_RS)
#define RW_KH(s_) (RW_BH(s_) + 64 * RW_TS)
#define RW_VT(s_) (RW_KH(s_) + 64 * RW_TS)
#define RW_AAK(s_) (RW_VT(s_) + 64 * RW_TS)
#define RW_ARB(s_) (RW_AAK(s_) + 16 * RW_TS)
#define RW_ARK(s_) (RW_ARB(s_) + 16 * RW_TS)
#define RW_TA(s_) (RW_ARK(s_) + 16 * RW_TS)
#define RW_GC(s_) ((float*)(RW_TA(s_) + 16 * RW_TS))
    __syncthreads();
    {
        float wu[4], au[4], gu[8];
#pragma unroll
        for (int k = 0; k < 4; ++k) { const int i = tid + k * NTHREADS, m = i >> 6, c = i & 63; wu[k] = p.rw_w_up[(size_t)l * 32 * 256 + m * 256 + h * 64 + c]; au[k] = p.rw_a_up[(size_t)l * 32 * 256 + m * 256 + h * 64 + c]; }
#pragma unroll
        for (int k = 0; k < 8; ++k) { const int i = tid + k * NTHREADS, m = i >> 6, c = i & 63; gu[k] = p.rw_g_up[(size_t)l * 64 * 256 + m * 256 + h * 64 + c]; }
#pragma unroll
        for (int k = 0; k < 4; ++k) { const int i = tid + k * NTHREADS, m = i >> 6, c = i & 63; WupT[c * 40 + m] = f2bf(wu[k]); AupT[c * 40 + m] = f2bf(au[k]); }
#pragma unroll
        for (int k = 0; k < 8; ++k) { const int i = tid + k * NTHREADS, m = i >> 6, c = i & 63; GupT[c * RW_RS + m] = f2bf(gu[k]); }
    }
    const int ptt = (tid & 255) >> 4, pc = (tid & 15) * 4, pset = tid >> 8;
    const float4 v_lg = *(const float4*)(vecs + 1280 + pc), v_lb = *(const float4*)(vecs + 1536 + pc);
    const int s2mt = wv & 1, s2c = (wv >> 1) * 16 + n;
    const float c_w0 = vecs[s2c], c_a0 = vecs[256 + s2c], c_kk = vecs[512 + s2c], c_ka = vecs[768 + s2c], c_rk = vecs[1024 + s2c];
    const int ib = wv & 3;
    f32x4 T0 = {0.f, 0.f, 0.f, 0.f}, T1 = T0, T2 = T0, T3 = T0;
    RwPre pre;
    rw_prefetch(pre, proj, 0, h, tid);
#pragma unroll 1
    for (int t0 = 0; t0 < SEQ; t0 += 32) {
        const int pb = (t0 >> 5) & 1;
        __syncthreads();
#pragma unroll
        for (int k = 0; k < 3; ++k) {
            const int i = tid + k * NTHREADS;
            if (i < 1280) {
                const int tt = i / 40, gq = i % 40; const int col = rw_col(gq, h);
                const uint4 cu = pre.cu[k], pr = pre.pr[k];
                const float4 m0 = *(const float4*)(mu + col), m1 = *(const float4*)(mu + col + 4);
                float o[8];
                { float c, q;
                  c = __uint_as_float(cu.x << 16); q = __uint_as_float(pr.x << 16); o[0] = c + (q - c) * m0.x;
                  c = __uint_as_float(cu.x & 0xffff0000u); q = __uint_as_float(pr.x & 0xffff0000u); o[1] = c + (q - c) * m0.y;
                  c = __uint_as_float(cu.y << 16); q = __uint_as_float(pr.y << 16); o[2] = c + (q - c) * m0.z;
                  c = __uint_as_float(cu.y & 0xffff0000u); q = __uint_as_float(pr.y & 0xffff0000u); o[3] = c + (q - c) * m0.w;
                  c = __uint_as_float(cu.z << 16); q = __uint_as_float(pr.z << 16); o[4] = c + (q - c) * m1.x;
                  c = __uint_as_float(cu.z & 0xffff0000u); q = __uint_as_float(pr.z & 0xffff0000u); o[5] = c + (q - c) * m1.y;
                  c = __uint_as_float(cu.w << 16); q = __uint_as_float(pr.w << 16); o[6] = c + (q - c) * m1.z;
                  c = __uint_as_float(cu.w & 0xffff0000u); q = __uint_as_float(pr.w & 0xffff0000u); o[7] = c + (q - c) * m1.w; }
                if (gq >= 8 && gq < 16) {
                    const float4 q0 = *(const float4*)(vecs + 512 + (gq - 8) * 8), q1 = *(const float4*)(vecs + 512 + (gq - 8) * 8 + 4);
                    const float a0 = o[0] * q0.x, a1 = o[1] * q0.y, a2 = o[2] * q0.z, a3 = o[3] * q0.w, a4 = o[4] * q1.x, a5 = o[5] * q1.y, a6 = o[6] * q1.z, a7 = o[7] * q1.w;
                    n2s[(pb * 32 + tt) * 8 + (gq - 8)] = ((a0 * a0 + a1 * a1) + (a2 * a2 + a3 * a3)) + ((a4 * a4 + a5 * a5) + (a6 * a6 + a7 * a7));
                }
                if (gq < 24) {
                    float* dst = gq < 8 ? xr + tt * 64 + gq * 8 : gq < 16 ? xk + tt * 64 + (gq - 8) * 8 : xv + tt * 64 + (gq - 16) * 8;
                    *(float4*)dst = make_float4(o[0], o[1], o[2], o[3]); *(float4*)(dst + 4) = make_float4(o[4], o[5], o[6], o[7]);
                } else {
                    if (gq < 28) {
#pragma unroll
                        for (int e = 0; e < 8; ++e) o[e] = ftanh(o[e]);
                    } else if (gq >= 32) {
#pragma unroll
                        for (int e = 0; e < 8; ++e) o[e] = fsigmoid(o[e]);
                    }
                    bf16_t* dst = gq < 28 ? XW + tt * 40 + (gq - 24) * 8 : gq < 32 ? XA + tt * 40 + (gq - 28) * 8 : XG + tt * RW_RS + (gq - 32) * 8;
                    uint4 w; w.x = pk_bf16(o[0], o[1]); w.y = pk_bf16(o[2], o[3]); w.z = pk_bf16(o[4], o[5]); w.w = pk_bf16(o[6], o[7]);
                    *(uint4*)dst = w;
                }
            }
        }
        if (t0 + 32 < SEQ) rw_prefetch(pre, proj, t0 + 32, h, tid);
        __syncthreads();
        {
            const f32x4 z4 = {0.f, 0.f, 0.f, 0.f};
            const int arow = s2mt * 16 + n;
            const f32x4 dec = MF16(*(const bf16x8*)(XW + arow * 40 + 8 * g), *(const bf16x8*)(WupT + s2c * 40 + 8 * g), z4);
            const f32x4 av = MF16(*(const bf16x8*)(XA + arow * 40 + 8 * g), *(const bf16x8*)(AupT + s2c * 40 + 8 * g), z4);
            const f32x4 gt = tt64(XG + arow * RW_RS, GupT + s2c * RW_RS, g, z4);
            const float dk = -0.6065306597126334f * LOG2E;
            float lwv[4], kkn[4], bb[4], kp[4], rv[4], vv[4];
#pragma unroll
            for (int r = 0; r < 4; ++r) {
                const int tt = s2mt * 16 + 4 * g + r, i = tt * 64 + s2c;
                const float a = fsigmoid(av[r] + c_a0);
                const float kraw = xk[i];
                rv[r] = xr[i]; vv[r] = xv[i];
                const float4 na = *(const float4*)(n2s + (pb * 32 + tt) * 8), nb = *(const float4*)(n2s + (pb * 32 + tt) * 8 + 4);
                const float inv = __builtin_amdgcn_rsqf(fmaxf(((na.x + na.y) + (na.z + na.w)) + ((nb.x + nb.y) + (nb.z + nb.w)), 1e-24f));
                kkn[r] = kraw * c_kk * inv; kp[r] = kraw * (1.0f + (a - 1.0f) * c_ka); bb[r] = kkn[r] * a;
                lwv[r] = dk * fsigmoid(dec[r] + c_w0);
                const float bo = red16(rv[r] * kp[r] * c_rk);
                gg[i] = gt[r];
                if (n == 0) pbo[tt * 4 + (wv >> 1)] = bo;
            }
            const float c0 = lwv[0], c1 = c0 + lwv[1], c2 = c1 + lwv[2], c3 = c2 + lwv[3];
            float tot = c3;
            { const float u = __shfl_up(tot, 16); if (g >= 1) tot += u; }
            { const float u = __shfl_up(tot, 32); if (g >= 2) tot += u; }
            const float off = tot - c3;
            const float cumC = __shfl(tot, 48 + n);
            const float cum[4] = {off + c0, off + c1, off + c2, off + c3};
            bf16_t* KT = RW_KT(s2mt); bf16_t* BT = RW_BT(s2mt); bf16_t* KKb = RW_KK(s2mt); bf16_t* RT = RW_RT(s2mt);
            float bh[4], kh[4];
#pragma unroll
            for (int r = 0; r < 4; ++r) {
                const float G = __builtin_amdgcn_exp2f(cum[r]), Gi = __builtin_amdgcn_exp2f(-cum[r]), Gm = __builtin_amdgcn_exp2f(cum[r] - lwv[r]), Gc = __builtin_amdgcn_exp2f(cumC - cum[r]);
                const int ro = (4 * g + r) * RW_RS + s2c;
                { const unsigned w0 = pk_bf16(kkn[r] * Gm, bb[r] * Gi), w1 = pk_bf16(kp[r] * Gi, rv[r] * G); KT[ro] = (bf16_t)w0; BT[ro] = (bf16_t)(w0 >> 16); KKb[ro] = (bf16_t)w1; RT[ro] = (bf16_t)(w1 >> 16); }
                bh[r] = bb[r] * Gc; kh[r] = kp[r] * Gc;
            }
            { uint2 w; w.x = pk_bf16(bh[0], bh[1]); w.y = pk_bf16(bh[2], bh[3]); *(uint2*)(RW_BH(s2mt) + s2c * RW_TS + 4 * g) = w; }
            { uint2 w; w.x = pk_bf16(kh[0], kh[1]); w.y = pk_bf16(kh[2], kh[3]); *(uint2*)(RW_KH(s2mt) + s2c * RW_TS + 4 * g) = w; }
            { uint2 w; w.x = pk_bf16(vv[0], vv[1]); w.y = pk_bf16(vv[2], vv[3]); *(uint2*)(RW_VT(s2mt) + s2c * RW_TS + 4 * g) = w; }
            if (g == 0) RW_GC(s2mt)[s2c] = __builtin_amdgcn_exp2f(cumC);
        }
        __syncthreads();
        {
            const f32x4 z4 = {0.f, 0.f, 0.f, 0.f};
            const int role = wv & 3, cs = wv >> 2;
            const bf16_t* KT = RW_KT(cs); const bf16_t* BT = RW_BT(cs); const bf16_t* KKb = RW_KK(cs); const bf16_t* RT = RW_RT(cs);
            if (role == 0) {
                f32x4 cl = tt64(KT + n * RW_RS, BT + n * RW_RS, g, z4);
                f32x4 clt = tt64(BT + n * RW_RS, KT + n * RW_RS, g, z4);
                f32x4 U;
#pragma unroll
                for (int r = 0; r < 4; ++r) { if (!(4 * g + r > n)) cl[r] = 0.f; if (!(n > 4 * g + r)) clt[r] = 0.f; U[r] = ((4 * g + r == n) ? 1.0f : 0.0f) - clt[r]; }
                const f32x4 m2 = MF16(frag_lo(clt), frag_lo(cl), z4), m2t = MF16(frag_lo(cl), frag_lo(clt), z4);
                U = MF16(frag_lo(m2), frag_lo(U), U);
                const f32x4 m4 = MF16(frag_lo(m2t), frag_lo(m2), z4), m4t = MF16(frag_lo(m2), frag_lo(m2t), z4);
                U = MF16(frag_lo(m4), frag_lo(U), U);
                const f32x4 m8 = MF16(frag_lo(m4t), frag_lo(m4), z4);
                U = MF16(frag_lo(m8), frag_lo(U), U);
                uint2 w; w.x = pk_bf16(U[0], U[1]); w.y = pk_bf16(U[2], U[3]);
                *(uint2*)(RW_TA(cs) + n * RW_TS + 4 * g) = w;
            } else {
                const bf16_t* ar = (role == 2) ? BT : KKb; const bf16_t* br = (role == 1) ? KT : RT; bf16_t* dst = (role == 1) ? RW_AAK(cs) : (role == 2) ? RW_ARB(cs) : RW_ARK(cs);
                f32x4 c = tt64(ar + n * RW_RS, br + n * RW_RS, g, z4);
                const int lim = (role == 1) ? n : n + 1;
#pragma unroll
                for (int r = 0; r < 4; ++r) if (!(4 * g + r < lim)) c[r] = 0.f;
                uint2 w; w.x = pk_bf16(c[0], c[1]); w.y = pk_bf16(c[2], c[3]);
                *(uint2*)(dst + n * RW_TS + 4 * g) = w;
            }
        }
        __syncthreads();
        if (wv < 4) {
            const f32x4 z4 = {0.f, 0.f, 0.f, 0.f};
            const uint2 zz = make_uint2(0u, 0u);
#define RW_JFRAG(base_, m_) frag_u2(*(const uint2*)((base_) + n * RW_RS + 32 * (m_) + 4 * g), *(const uint2*)((base_) + n * RW_RS + 32 * (m_) + 16 + 4 * g))
#define RW_OPS(c_) \
            const bf16x8 kt0##c_ = RW_JFRAG(RW_KT(c_), 0), kt1##c_ = RW_JFRAG(RW_KT(c_), 1), rt0##c_ = RW_JFRAG(RW_RT(c_), 0), rt1##c_ = RW_JFRAG(RW_RT(c_), 1); \
            const uint2 aak##c_ = *(const uint2*)(RW_AAK(c_) + n * RW_TS + 4 * g), vt##c_ = *(const uint2*)(RW_VT(c_) + (ib * 16 + n) * RW_TS + 4 * g), ta##c_ = *(const uint2*)(RW_TA(c_) + n * RW_TS + 4 * g); \
            const uint2 arb##c_ = *(const uint2*)(RW_ARB(c_) + n * RW_TS + 4 * g), ark##c_ = *(const uint2*)(RW_ARK(c_) + n * RW_TS + 4 * g); \
            const bf16x8 hk0##c_ = frag_u2(*(const uint2*)(RW_BH(c_) + n * RW_TS + 4 * g), *(const uint2*)(RW_KH(c_) + n * RW_TS + 4 * g)); \
            const bf16x8 hk1##c_ = frag_u2(*(const uint2*)(RW_BH(c_) + (16 + n) * RW_TS + 4 * g), *(const uint2*)(RW_KH(c_) + (16 + n) * RW_TS + 4 * g)); \
            const bf16x8 hk2##c_ = frag_u2(*(const uint2*)(RW_BH(c_) + (32 + n) * RW_TS + 4 * g), *(const uint2*)(RW_KH(c_) + (32 + n) * RW_TS + 4 * g)); \
            const bf16x8 hk3##c_ = frag_u2(*(const uint2*)(RW_BH(c_) + (48 + n) * RW_TS + 4 * g), *(const uint2*)(RW_KH(c_) + (48 + n) * RW_TS + 4 * g)); \
            const f32x4 gc0##c_ = *(const f32x4*)(RW_GC(c_) + 4 * g), gc1##c_ = *(const f32x4*)(RW_GC(c_) + 16 + 4 * g), gc2##c_ = *(const f32x4*)(RW_GC(c_) + 32 + 4 * g), gc3##c_ = *(const f32x4*)(RW_GC(c_) + 48 + 4 * g);
#define RW_CHAIN(c_) { \
            const bf16x8 sb0 = mk_frag(pk_bf16(T0[0], T0[1]), pk_bf16(T0[2], T0[3]), pk_bf16(T1[0], T1[1]), pk_bf16(T1[2], T1[3]));     \
            const bf16x8 sb1 = mk_frag(pk_bf16(T2[0], T2[1]), pk_bf16(T2[2], T2[3]), pk_bf16(T3[0], T3[1]), pk_bf16(T3[2], T3[3]));     \
            f32x4 q = MF16(kt0##c_, sb0, z4); q = MF16(kt1##c_, sb1, q);                        \
            f32x4 y = MF16(rt0##c_, sb0, z4); y = MF16(rt1##c_, sb1, y);                        \
            T0 = T0 * gc0##c_; T1 = T1 * gc1##c_; T2 = T2 * gc2##c_; T3 = T3 * gc3##c_;        \
            q = MF16(frag_u2(aak##c_, zz), frag_u2(vt##c_, zz), q);                            \
            f32x4 sa = MF16(frag_u2(ta##c_, zz), frag_lo(q), z4); sa = -sa;                    \
            const bf16x8 a3 = frag_lo_hi(sa, vt##c_);                                          \
            T0 = MF16(hk0##c_, a3, T0); T1 = MF16(hk1##c_, a3, T1); T2 = MF16(hk2##c_, a3, T2); T3 = MF16(hk3##c_, a3, T3);     \
            y = MF16(frag_u2(arb##c_, ark##c_), a3, y); \
            _Pragma("unroll") for (int r = 0; r < 4; ++r) yy[(c_) * 1024 + (4 * g + r) * 64 + ib * 16 + n] = y[r]; }
            { RW_OPS(0) RW_CHAIN(0) }
            { RW_OPS(1) RW_CHAIN(1) }
#undef RW_JFRAG
#undef RW_OPS
#undef RW_CHAIN
        }
        __syncthreads();
        {
            const int tok = pset * 16 + ptt, i = tok * 64 + pc;
            const float4 yv = *(const float4*)(yy + pset * 1024 + ptt * 64 + pc), vv = *(const float4*)(xv + i), gv = *(const float4*)(gg + i), b4 = *(const float4*)(pbo + tok * 4);
            const float mean = red16((yv.x + yv.y) + (yv.z + yv.w)) * (1.0f / 64.0f);
            const float4 d = make_float4(yv.x - mean, yv.y - mean, yv.z - mean, yv.w - mean);
            const float var = red16((d.x * d.x + d.y * d.y) + (d.z * d.z + d.w * d.w)) * (1.0f / 64.0f);
            const float rs = rsqrtf(var + 64e-5f), bo = (b4.x + b4.y) + (b4.z + b4.w);
            *(unsigned*)(mix + (size_t)(t0 + tok) * DM + pc) = pk_fp8x4((d.x * rs * v_lg.x + v_lb.x + bo * vv.x) * gv.x * MIX8_SCALE, (d.y * rs * v_lg.y + v_lb.y + bo * vv.y) * gv.y * MIX8_SCALE,
                                                                         (d.z * rs * v_lg.z + v_lb.z + bo * vv.z) * gv.z * MIX8_SCALE, (d.w * rs * v_lg.w + v_lb.w + bo * vv.w) * gv.w * MIX8_SCALE);
        }
    }
}

__device__ __forceinline__ void phase_mixers(const Params& p, int l, unsigned char* lds) {
    unsigned* ctl = (unsigned*)(p.ws + WS_CTL);
    int* slot = (int*)(lds + LDS_BYTES - 64);
#ifndef NO_RW
    for (int it = obid(); it < 128; it += gridDim.x) rwkv_item(p, l, it, lds);
#endif
    if (otid() == 0) *slot = (int)atomicAdd(&ctl[CW_QUEUE + l * 64], 1u);
    for (;;) {
        __syncthreads();
        const int it = *slot;
        __syncthreads();
        if (it >= 1024 + 512 + 256) break;
        if (it < 1024) {
            int nxt = 0;
            if (otid() == 0) nxt = (int)atomicAdd(&ctl[CW_QUEUE + l * 64], 1u);
#ifndef NO_DA
            dam_item(p, l, it & 127, 7 - (it >> 7), lds, slot, nxt);
#endif
        } else {
            if (it < 1536) {
#ifndef NO_SB
                const int j = it - 1024;
#pragma unroll 1
                for (int k = 0; k < 2; ++k) sbm_item(p, j & 127, 7 - 2 * (j >> 7) - k, lds);
#endif
            } else conv_item(p, l, it - 1536);
            if (otid() == 0) *slot = (int)atomicAdd(&ctl[CW_QUEUE + l * 64], 1u);
        }
    }
}

__global__ void __launch_bounds__(NTHREADS, 2) fwd(Params p) {
    extern __shared__ __attribute__((aligned(16))) unsigned char lds_raw[];
    if (threadIdx.x == 0) { ((unsigned*)lds_raw)[0] = 0u; ((unsigned*)lds_raw)[1] = 0u; ((unsigned*)lds_raw)[2] = 0u; ((unsigned*)lds_raw)[3] = 0u; }
    __syncthreads();
    unsigned char* lds = lds_raw + 16;
    XcdBarrier bar = xcd_barrier_post((unsigned*)(p.ws + WS_CTL) + CW_BAR, (volatile LAS unsigned*)lds_raw);
#ifndef ONLY
#define ONLY -1
#endif
#define PH(k) (ONLY < 0 || ONLY == (k))
    if (PH(0)) prologue(p, lds);
    xcd_barrier(bar);
    for (int l = 0; l < NLAYER; ++l) {
        if (PH(1)) phase_inproj(p, l, lds);
        xcd_barrier(bar);
        if (PH(2)) phase_mixers(p, l, lds);
        xcd_barrier(bar);
        if (PH(3)) phase_outproj(p, l, lds);
        xcd_barrier(bar);
        if (PH(4)) phase_ln1_route(p, l, lds);
        xcd_barrier(bar);
        if (PH(5)) phase_moe_up(p, l, lds);
        xcd_barrier(bar);
        if (PH(6)) phase_moe_down(p, l, lds);
        xcd_barrier(bar);
        if (PH(7)) phase_ln2(p, l, lds);
        xcd_barrier(bar);
    }
}

extern "C" void kernel_launch(void* const* d_in, const int* in_sizes, int n_in, void* d_out, int out_size, void* d_ws, size_t ws_size, hipStream_t stream) {
    static int grid = 0;
    if (grid == 0) {
        if (n_in != 18 || in_sizes[0] != NTOK * DM || out_size != NTOK * DM || ws_size < WS_END) {
            fprintf(stderr, "kernel_launch: unexpected shapes: n_in %d in0 %d out %d ws %zu (need %llu)\n", n_in, n_in > 0 ? in_sizes[0] : -1, out_size, ws_size, (unsigned long long)WS_END);
            grid = -1; return;
        }
        int dev = 0, cus = 0, per_cu = 0;
        hipGetDevice(&dev);
        hipDeviceGetAttribute(&cus, hipDeviceAttributeMultiprocessorCount, dev);
        hipFuncSetAttribute((const void*)fwd, hipFuncAttributeMaxDynamicSharedMemorySize, LDS_BYTES);
        hipOccupancyMaxActiveBlocksPerMultiprocessor(&per_cu, (const void*)fwd, NTHREADS, LDS_BYTES);
        if (per_cu < 1) { fprintf(stderr, "kernel_launch: occupancy query says %d blocks per CU\n", per_cu); grid = -1; return; }
        grid = cus;
    }
    if (grid < 0) return;
    Params p{};
    p.x = (const float*)d_in[0]; p.w_in = (const float*)d_in[1]; p.w_out = (const float*)d_in[2]; p.da_lambda = (const float*)d_in[3]; p.da_subln = (const float*)d_in[4];
    p.sc_conv = (const float*)d_in[5]; p.rw_mu = (const float*)d_in[6]; p.rw_vecs = (const float*)d_in[7]; p.rw_w_up = (const float*)d_in[8]; p.rw_a_up = (const float*)d_in[9];
    p.rw_g_up = (const float*)d_in[10]; p.ln_gain = (const float*)d_in[11]; p.ln_bias = (const float*)d_in[12]; p.rel_bias = (const float*)d_in[13]; p.router_w = (const float*)d_in[14];
    p.router_b = (const float*)d_in[15]; p.moe_w_in = (const float*)d_in[16]; p.moe_w_down = (const float*)d_in[17];
    p.out = (float*)d_out; p.ws = (unsigned char*)d_ws;
    hipMemsetAsync((char*)d_ws + WS_CTL, 0, CTL_BYTES, stream);
    hipLaunchKernelGGL(fwd, dim3(grid), dim3(NTHREADS), LDS_BYTES, stream, p);
}
```

```cpp
#include <hip/hip_runtime.h>
#include <cstdio>
#include <cstdint>

typedef unsigned short bf16_t;
typedef short bf16x8 __attribute__((ext_vector_type(8)));
typedef float f32x4 __attribute__((ext_vector_type(4)));

#define NTOK 65536
#define SEQ 2048
#define DM 1024
#define PIN 3200
#define PINP 3328
#define NLAYER 4
#define NEXP 16
#define DEXP 256
#define NTHREADS 512
#define LDS_BYTES (152 * 1024)
#define ALPHA 1.6817928305074292f
#define LOG2E 1.4426950408889634f

#define WS_CTL 0ull
#define CTL_BYTES 65536ull
#define WS_BIASD (WS_CTL + CTL_BYTES)
#define WS_WIN (WS_BIASD + 4ull * 2048 * 4)
#define WS_WOUT (WS_WIN + 4ull * PINP * DM * 2)
#define WS_MWIN (WS_WOUT + 4ull * DM * DM * 2)
#define WS_MWDN (WS_MWIN + 4ull * 16 * 512 * 1024 * 2)
#define WS_XB (WS_MWDN + 4ull * 16 * 1024 * 256 * 2)
#define WS_MIX (WS_XB + (unsigned long long)NTOK * DM * 2)
#define WS_LTOK (WS_MIX + (unsigned long long)NTOK * DM * 2)
#define WS_LGATE (WS_LTOK + 16ull * NTOK * 4)
#define WS_PROJ (WS_LGATE + 16ull * NTOK * 4)
#define WS_YB (WS_PROJ + (192ull << 20))
#define WS_Y WS_PROJ
#define WS_H (WS_Y + (unsigned long long)(2 * NTOK + 256) * DM)
#define WS_X8 (WS_PROJ + (unsigned long long)NTOK * PINP * 2)
#define WS_W8 (WS_X8 + (unsigned long long)NTOK * DM)
#define WS_CT (WS_W8 + 4ull * PINP * DM)
#define WS_LAM (WS_CT + 4ull * 6 * 256 * 16)
#define WS_END (WS_LAM + 256ull)

#define CW_BAR 0
#define CW_CNT 4096
#define CW_QUEUE 8192
#define CW_FLAG 12288

#define XB_TMO      128
#define XB_XCNT(j)  (256  + 64 * (j))
#define XB_XSUB(j)  (1280 + 64 * (j))
#define XB_XGEN(j)  (2304 + 64 * (j))
#define XB_TOP      3328
#define XB_TOPGEN   3392
#define XCD_BAR_WORDS 3456
#define XB_SPIN_CAP (1u << 22)
#define LAS __attribute__((address_space(3)))

__device__ __forceinline__ unsigned xb_ld(unsigned* p)              { return __hip_atomic_load(p, __ATOMIC_RELAXED, __HIP_MEMORY_SCOPE_AGENT); }
__device__ __forceinline__ unsigned xb_add(unsigned* p, unsigned v) { return __hip_atomic_fetch_add(p, v, __ATOMIC_RELAXED, __HIP_MEMORY_SCOPE_AGENT); }
__device__ __forceinline__ unsigned xb_xcc_id() { return (unsigned)__builtin_amdgcn_s_getreg((3 << 11) | 20) & 0xFu; }
#define XB_SPIN(cond, bar) do { unsigned _sp = 0; while (cond) { __builtin_amdgcn_s_sleep(1); \
    if ((++_sp & 255u) == 0u) { if (xb_ld(&(bar)[XB_TMO])) break; if (_sp > XB_SPIN_CAP) { atomicAdd(&(bar)[XB_TMO], 1u); break; } } } } while (0)

struct XcdBarrier { unsigned* bar; unsigned x; volatile LAS unsigned* st; };

__device__ __forceinline__ XcdBarrier xcd_barrier_post(unsigned* bar, volatile LAS unsigned* st) {
    XcdBarrier b; b.bar = bar; b.x = xb_xcc_id(); b.st = st;
    if (threadIdx.x == 0) (void)xb_add(&bar[XB_XCNT(b.x)], 1u);
    return b;
}
__device__ __forceinline__ void xcd_barrier_complete(unsigned* bar, unsigned x, unsigned& nloc, unsigned& nx) {
    const unsigned G = gridDim.x * gridDim.y * gridDim.z;
    unsigned sum, cnt, mine, sp = 0u;
    for (;;) {
        sum = 0u; cnt = 0u; mine = 0u;
#pragma unroll
        for (unsigned j = 0; j < 16; ++j) { const unsigned c = xb_ld(&bar[XB_XCNT(j)]); sum += c; cnt += (c > 0u) ? 1u : 0u; mine = (j == x) ? c : mine; }
        if (sum == G) break;
        __builtin_amdgcn_s_sleep(1);
        if ((++sp & 255u) == 0u) { if (xb_ld(&bar[XB_TMO])) break; if (sp > XB_SPIN_CAP) { atomicAdd(&bar[XB_TMO], 1u); break; } }
    }
    nloc = mine > 0u ? mine : 1u; nx = cnt > 0u ? cnt : 1u;
}
__device__ __forceinline__ void xcd_barrier(const XcdBarrier& b) {
    asm volatile("s_waitcnt vmcnt(0)" ::: "memory");
    __syncthreads();
    if (threadIdx.x == 0) {
        unsigned* bar = b.bar;
        __builtin_amdgcn_s_waitcnt(0);
        const unsigned bx = xb_xcc_id();
        unsigned nloc = b.st[0], nx = b.st[1];
        if (nloc == 0u) { xcd_barrier_complete(bar, bx, nloc, nx); b.st[0] = nloc; b.st[1] = nx; }
        const unsigned old = xb_add(&bar[XB_XSUB(bx)], 1u);
        const unsigned gen = old / nloc;
        if (old + 1u == (gen + 1u) * nloc) {
            __builtin_amdgcn_fence(__ATOMIC_RELEASE, "agent");
            asm volatile("s_waitcnt vmcnt(0)" ::: "memory");
            const unsigned og = xb_add(&bar[XB_TOP], 1u);
            const unsigned tg = og / nx;
            if (og + 1u == (tg + 1u) * nx) xb_add(&bar[XB_TOPGEN], 1u);
            else XB_SPIN(xb_ld(&bar[XB_TOPGEN]) == tg, bar);
            __builtin_amdgcn_fence(__ATOMIC_ACQUIRE, "agent");
            xb_add(&bar[XB_XGEN(bx)], 1u);
            asm volatile("s_waitcnt vmcnt(0)" ::: "memory");
        } else {
            XB_SPIN(xb_ld(&bar[XB_XGEN(bx)]) == gen, bar);
            __builtin_amdgcn_fence(__ATOMIC_ACQUIRE, "agent");
            asm volatile("s_waitcnt vmcnt(0)" ::: "memory");
        }
    }
    __syncthreads();
}

__device__ __forceinline__ int otid() { int t = threadIdx.x; asm volatile("" : "+v"(t)); return t; }
__device__ __forceinline__ int obid() { int t = blockIdx.x; asm volatile("" : "+s"(t)); return t; }
__device__ __forceinline__ float bf2f(bf16_t v) { return __uint_as_float(((unsigned)v) << 16); }
__device__ __forceinline__ bf16_t f2bf(float f) { unsigned u = __float_as_uint(f); u += 0x7fffu + ((u >> 16) & 1u); return (bf16_t)(u >> 16); }
__device__ __forceinline__ float sigmoidf_(float x) { return 1.0f / (1.0f + expf(-x)); }
template <int CTRL> __device__ __forceinline__ float dppw_f(float v) { return __int_as_float(__builtin_amdgcn_update_dpp(0, __float_as_int(v), CTRL, 0xf, 0xf, true)); }
__device__ __forceinline__ float wave_sum(float v) {
    v += dppw_f<0xB1>(v); v += dppw_f<0x4E>(v); v += dppw_f<0x141>(v); v += dppw_f<0x140>(v);
    const float r0 = __int_as_float(__builtin_amdgcn_readlane(__float_as_int(v), 0)), r1 = __int_as_float(__builtin_amdgcn_readlane(__float_as_int(v), 16));
    const float r2 = __int_as_float(__builtin_amdgcn_readlane(__float_as_int(v), 32)), r3 = __int_as_float(__builtin_amdgcn_readlane(__float_as_int(v), 48));
    return (r0 + r1) + (r2 + r3);
}

typedef unsigned u32x4v __attribute__((ext_vector_type(4)));
typedef unsigned u32x2v __attribute__((ext_vector_type(2)));
typedef __bf16 bf16x2_t __attribute__((ext_vector_type(2)));
typedef float f32x2_t __attribute__((ext_vector_type(2)));
__device__ __forceinline__ unsigned pk_bf16(float lo, float hi) { const f32x2_t v = {lo, hi}; const bf16x2_t b = __builtin_convertvector(v, bf16x2_t); return __builtin_bit_cast(unsigned, b); }
__device__ __forceinline__ bf16x8 mk_frag(unsigned a, unsigned b, unsigned c, unsigned d) { u32x4v v; v.x = a; v.y = b; v.z = c; v.w = d; return __builtin_bit_cast(bf16x8, v); }

__device__ __forceinline__ unsigned pk_fp8x4(float a, float b, float c, float d) {
    a = __builtin_amdgcn_fmed3f(a, -448.f, 448.f); b = __builtin_amdgcn_fmed3f(b, -448.f, 448.f); c = __builtin_amdgcn_fmed3f(c, -448.f, 448.f); d = __builtin_amdgcn_fmed3f(d, -448.f, 448.f);
    int v = __builtin_amdgcn_cvt_pk_fp8_f32(a, b, 0, false);
    v = __builtin_amdgcn_cvt_pk_fp8_f32(c, d, v, true);
    return (unsigned)v;
}
#define Y8_SCALE 16.0f
__device__ __forceinline__ void fp8x8_to_f(const uint2& v, float (&o)[8]) {
    typedef float f2v __attribute__((ext_vector_type(2)));
    const f2v a = __builtin_amdgcn_cvt_pk_f32_fp8((int)v.x, false), b = __builtin_amdgcn_cvt_pk_f32_fp8((int)v.x, true), c = __builtin_amdgcn_cvt_pk_f32_fp8((int)v.y, false), d = __builtin_amdgcn_cvt_pk_f32_fp8((int)v.y, true);
    o[0] = a[0]; o[1] = a[1]; o[2] = b[0]; o[3] = b[1]; o[4] = c[0]; o[5] = c[1]; o[6] = d[0]; o[7] = d[1];
}
#define MIX8_SCALE 4.0f
#define WO8_SCALE 1024.0f
#define H8_SCALE 8.0f
#define WD8_SCALE 512.0f
#ifndef P1_BF16_TILES
#define P1_BF16_TILES 0x0000
#endif
#define X8_SCALE 16.0f
#define W8_SCALE 512.0f
struct Params {
    const float* x; const float* w_in; const float* w_out; const float* da_lambda; const float* da_subln; const float* sc_conv;
    const float* rw_mu; const float* rw_vecs; const float* rw_w_up; const float* rw_a_up; const float* rw_g_up;
    const float* ln_gain; const float* ln_bias; const float* rel_bias; const float* router_w; const float* router_b;
    const float* moe_w_in; const float* moe_w_down;
    float* out; unsigned char* ws;
};

namespace pg8 {
#define PG8_LAS __attribute__((address_space(3)))
typedef unsigned short bf16_t;
typedef short bf16x8 __attribute__((ext_vector_type(8)));
typedef float f32x4 __attribute__((ext_vector_type(4)));
typedef unsigned u32x4 __attribute__((ext_vector_type(4)));
constexpr int BM = 256, BK = 64, HALF = 128, HTB = HALF * BK * 2  , STAGE_BYTES = 8 * HTB, NXCD = 8, WGM = 8;

__host__ __device__ __forceinline__ int lds_byte(int r, int c) { const int st = (r >> 4) * 2 + (c >> 5), rr = r & 15, cc = c & 31, ob = rr * 64 + cc * 2; return st * 1024 + (ob ^ (((ob >> 9) & 1) << 5)); }
__host__ __device__ __forceinline__ void stage_rc(int b, int& R, int& C) { const int st = b / 1024, sb = b % 1024, swz = sb ^ (((sb >> 9) & 1) << 5); R = (st >> 1) * 16 + swz / 64; C = (st & 1) * 32 + (swz % 64) / 2; }
__host__ __device__ __forceinline__ int perm32(int rho) { const int n = rho >> 4, i = rho & 15; return 8 * (i >> 2) + 4 * n + (i & 3); }

struct Unit { int pm, pn; };
struct Gemm { const bf16_t* A; const bf16_t* Bt; int M, N, K; int sw = 0x7f7f7f7f, sx = 0x7f7f7f7f; };

struct StaticOrder {
    int nM, nN, nwg, G, c;
    __host__ __device__ void init(int M, int N, int G_, int c_) { nM = M / BM; nN = N / BM; nwg = nM * nN; G = G_; c = c_; }
    __host__ __device__ bool next(int i, Unit& u) const {
        const long L = (long)i * G + c; if (L >= nwg) return false;
        int wgid = (int)L; { const int q = nwg / NXCD, r = nwg % NXCD, xcd = wgid % NXCD, off = wgid / NXCD; wgid = (xcd < r ? xcd * (q + 1) : r * (q + 1) + (xcd - r) * q) + off; }
        const int nig = WGM * nN, gid = wgid / nig, fm = gid * WGM, gsz = (nM - fm) < WGM ? (nM - fm) : WGM;
        u.pm = fm + ((wgid % nig) % gsz); u.pn = (wgid % nig) / gsz; return true;
    }
    __device__ __forceinline__ void a_ready(const Unit&) const {}
    __device__ __forceinline__ void done(const Unit&) const {}
};
struct StaticOrderSub : StaticOrder {
    unsigned long long tbl;
    __host__ __device__ bool next(int i, Unit& u) const { if (!StaticOrder::next(i, u)) return false; u.pn = (int)((tbl >> (4 * u.pn)) & 15ull); return true; }
};
__device__ __forceinline__ unsigned cvt_pk_bf16(float lo, float hi) { unsigned r; asm volatile("v_cvt_pk_bf16_f32 %0, %1, %2" : "=v"(r) : "v"(lo), "v"(hi)); return r; }
typedef int v8i32 __attribute__((ext_vector_type(8)));
typedef int v4i32 __attribute__((ext_vector_type(4)));
union Frag { bf16x8 kk[2]; v8i32 w; };
template <class Epi, class Sched, bool ALIGN_EPI = false, bool SP2 = false, bool FP8 = false>
__device__ __forceinline__ void gemm_phase(PG8_LAS unsigned char* lds, const Gemm g, const Sched& S, const Epi& E) {
    const int tid = otid(), wid = __builtin_amdgcn_readfirstlane(tid >> 6), lane = tid & 63, wr = wid >> 2, wc = wid & 3, fr = lane & 15, fq = lane >> 4;
    const int K = FP8 ? g.K / 2 : g.K, nt = K / BK;
    unsigned voffA[2], voffB[2];
#pragma unroll
    for (int i = 0; i < 2; ++i) { int R, C; stage_rc(tid * 16 + i * 8192, R, C); const int Rb = Epi::PERM ? ((R & ~31) + perm32(R & 31)) : R;
        voffA[i] = (unsigned)(R * K + C) * 2u; voffB[i] = (unsigned)(Rb * K + C) * 2u; }
    const size_t kstep = (size_t)(BK * 2);
    const size_t hstep = (size_t)HALF * K * 2;
    const size_t tstep = 2 * hstep;
    const unsigned ldsw = (unsigned)wid * 1024u;
    const int aoff = lds_byte(wr * 64 + fr, fq * 8), boff = lds_byte(wc * 32 + fr, fq * 8);
#define PG8_SA(b, h) (((b) * 2 + (h)) * HTB)
#define PG8_SB(b, h) ((4 + (b) * 2 + (h)) * HTB)
#define PG8_STAGE(bufoff, gbase, voff) do { _Pragma("unroll") for (int _i = 0; _i < 2; ++_i) \
        __builtin_amdgcn_global_load_lds((const unsigned*)((const char*)(gbase) + (voff)[_i]), (PG8_LAS unsigned*)(lds + (bufoff) + ldsw + _i * 8192), 16, 0, 0); } while (0)
#define PG8_LDA(dst, b, h) do { _Pragma("unroll") for (int m = 0; m < 4; ++m) _Pragma("unroll") for (int k = 0; k < 2; ++k) dst[m].kk[k] = *(const PG8_LAS bf16x8*)(lds + PG8_SA(b, h) + aoff + m * 2048 + k * 1024); } while (0)
#define PG8_LDB(dst, b, h) do { _Pragma("unroll") for (int n = 0; n < 2; ++n) _Pragma("unroll") for (int k = 0; k < 2; ++k) dst[n].kk[k] = *(const PG8_LAS bf16x8*)(lds + PG8_SB(b, h) + boff + n * 2048 + k * 1024); } while (0)
#define PG8_MMA(ai, bj, At, Bt) do { __builtin_amdgcn_s_setprio(1); _Pragma("unroll") for (int m = 0; m < 4; ++m) _Pragma("unroll") for (int n = 0; n < 2; ++n) { \
        if constexpr (FP8) asm volatile("v_mfma_scale_f32_16x16x128_f8f6f4 %0, %1, %2, %0, %3, %4 op_sel_hi:[0,0,0]" : "+v"(acc[ai][bj][m][n]) : "v"(Bt[n].w), "v"(At[m].w), "v"(scw), "v"(scx)); \
        else { _Pragma("unroll") for (int k = 0; k < 2; ++k) acc[ai][bj][m][n] = __builtin_amdgcn_mfma_f32_16x16x32_bf16(Bt[n].kk[k], At[m].kk[k], acc[ai][bj][m][n], 0, 0, 0); } } __builtin_amdgcn_s_setprio(0); } while (0)
#define PG8_WAIT_V(n) asm volatile("s_waitcnt vmcnt(" #n ")" ::: "memory")
#define PG8_WAIT_L(n) asm volatile("s_waitcnt lgkmcnt(" #n ")" ::: "memory")
#define PG8_BAR __builtin_amdgcn_s_barrier()
#define PG8_SCHED __builtin_amdgcn_sched_barrier(0)
    Unit cur, nxt; int ui = 0;
    if (!S.next(0, cur)) return;
    f32x4 acc[2][2][4][2];
#pragma unroll
    for (int a = 0; a < 2; ++a)
#pragma unroll
        for (int b = 0; b < 2; ++b)
#pragma unroll
            for (int m = 0; m < 4; ++m)
#pragma unroll
                for (int n = 0; n < 2; ++n) acc[a][b][m][n] = (f32x4){0.f, 0.f, 0.f, 0.f};
    Frag At[4], B0[2], B1[2];
    int scw = g.sw, scx = g.sx;
    if constexpr (FP8) asm volatile("" : "+v"(scw), "+v"(scx));
    const char* cA = (const char*)g.A + (size_t)cur.pm * tstep; const char* cB = (const char*)g.Bt + (size_t)cur.pn * tstep;
    S.a_ready(cur);
    if constexpr (SP2) {
        PG8_STAGE(PG8_SB(0, 0), cB, voffB); PG8_STAGE(PG8_SB(0, 1), cB + hstep, voffB); PG8_STAGE(PG8_SA(0, 0), cA, voffA); PG8_STAGE(PG8_SA(0, 1), cA + hstep, voffA);
        if (wr == 1) PG8_BAR;
        PG8_WAIT_V(2); PG8_BAR;
        PG8_STAGE(PG8_SB(1, 0), cB + kstep, voffB); PG8_STAGE(PG8_SA(1, 0), cA + kstep, voffA); PG8_STAGE(PG8_SB(1, 1), cB + hstep + kstep, voffB);
        PG8_WAIT_V(6); PG8_BAR;
    } else {
        PG8_STAGE(PG8_SB(0, 0), cB, voffB); PG8_STAGE(PG8_SA(0, 0), cA, voffA); PG8_STAGE(PG8_SB(0, 1), cB + hstep, voffB); PG8_STAGE(PG8_SA(0, 1), cA + hstep, voffA);
        if (wr == 1) PG8_BAR;
        PG8_WAIT_V(4); PG8_BAR;
        PG8_STAGE(PG8_SB(1, 0), cB + kstep, voffB); PG8_STAGE(PG8_SA(1, 0), cA + kstep, voffA); PG8_STAGE(PG8_SB(1, 1), cB + hstep + kstep, voffB);
        PG8_WAIT_V(6); PG8_BAR;
    }
    for (;;) {
        const bool has_next = S.next(ui + 1, nxt);
        const char* nA = has_next ? (const char*)g.A + (size_t)nxt.pm * tstep : cA; const char* nB = has_next ? (const char*)g.Bt + (size_t)nxt.pn * tstep : cB;
#pragma unroll 1
        for (int t = 0; t < nt; t += 2) {
            const bool last = (t == nt - 2);
            const char* a1 = cA + (size_t)(t + 1) * kstep;
            const char* a2 = last ? nA : cA + (size_t)(t + 2) * kstep; const char* b2 = last ? nB : cB + (size_t)(t + 2) * kstep;
            const char* a3 = a2 + kstep; const char* b3 = b2 + kstep;
            if (last && has_next) S.a_ready(nxt);
            if constexpr (SP2) {
            PG8_LDB(B0, 0, 0); PG8_LDB(B1, 0, 1); PG8_SCHED; PG8_LDA(At, 0, 0); PG8_STAGE(PG8_SA(1, 1), a1 + hstep, voffA);
            PG8_WAIT_V(8); PG8_WAIT_L(0); PG8_BAR; PG8_MMA(0, 0, At, B0); PG8_MMA(0, 1, At, B1); PG8_BAR; PG8_SCHED;
            PG8_LDA(At, 0, 1); PG8_STAGE(PG8_SB(0, 0), b2, voffB); PG8_STAGE(PG8_SB(0, 1), b2 + hstep, voffB); PG8_STAGE(PG8_SA(0, 0), a2, voffA);
            PG8_WAIT_V(8); PG8_WAIT_L(0); PG8_BAR; PG8_MMA(1, 0, At, B0); PG8_MMA(1, 1, At, B1); PG8_BAR; PG8_SCHED;
            PG8_LDB(B0, 1, 0); PG8_LDB(B1, 1, 1); PG8_SCHED; PG8_LDA(At, 1, 0); PG8_STAGE(PG8_SA(0, 1), a2 + hstep, voffA);
            PG8_WAIT_V(8); PG8_WAIT_L(0); PG8_BAR; PG8_MMA(0, 0, At, B0); PG8_MMA(0, 1, At, B1); PG8_BAR; PG8_SCHED;
            PG8_LDA(At, 1, 1); PG8_STAGE(PG8_SB(1, 0), b3, voffB); PG8_STAGE(PG8_SB(1, 1), b3 + hstep, voffB); PG8_STAGE(PG8_SA(1, 0), a3, voffA);
            PG8_WAIT_V(8); PG8_WAIT_L(0); PG8_BAR; PG8_MMA(1, 0, At, B0); PG8_MMA(1, 1, At, B1); PG8_BAR; PG8_SCHED;
            } else {
            PG8_LDB(B0, 0, 0); PG8_SCHED; PG8_LDA(At, 0, 0); PG8_STAGE(PG8_SA(1, 1), a1 + hstep, voffA);
            PG8_WAIT_L(8); PG8_BAR; PG8_WAIT_L(0); PG8_MMA(0, 0, At, B0); PG8_BAR; PG8_SCHED;
            PG8_LDB(B1, 0, 1); PG8_STAGE(PG8_SB(0, 0), b2, voffB);
            PG8_BAR; PG8_WAIT_L(0); PG8_MMA(0, 1, At, B1); PG8_BAR;
            PG8_LDA(At, 0, 1); PG8_STAGE(PG8_SA(0, 0), a2, voffA);
            PG8_BAR; PG8_WAIT_L(0); PG8_MMA(1, 0, At, B0); PG8_BAR; PG8_SCHED;
            PG8_STAGE(PG8_SB(0, 1), b2 + hstep, voffB);
            PG8_WAIT_V(6); PG8_BAR; PG8_MMA(1, 1, At, B1); PG8_BAR;
            PG8_LDB(B0, 1, 0); PG8_SCHED; PG8_LDA(At, 1, 0); PG8_STAGE(PG8_SA(0, 1), a2 + hstep, voffA);
            PG8_WAIT_L(8); PG8_BAR; PG8_WAIT_L(0); PG8_MMA(0, 0, At, B0); PG8_BAR; PG8_SCHED;
            PG8_LDB(B1, 1, 1); PG8_STAGE(PG8_SB(1, 0), b3, voffB);
            PG8_BAR; PG8_WAIT_L(0); PG8_MMA(0, 1, At, B1); PG8_BAR;
            PG8_LDA(At, 1, 1); PG8_STAGE(PG8_SA(1, 0), a3, voffA);
            PG8_BAR; PG8_WAIT_L(0); PG8_MMA(1, 0, At, B0); PG8_BAR; PG8_SCHED;
            PG8_STAGE(PG8_SB(1, 1), b3 + hstep, voffB);
            PG8_WAIT_V(6); PG8_BAR; PG8_MMA(1, 1, At, B1); PG8_BAR;
            }
        }
        if constexpr (FP8) asm volatile("s_nop 15\n\ts_nop 15" ::: "memory");
        if constexpr (ALIGN_EPI) { if (wr == 0) PG8_BAR; }
        if constexpr (!Epi::AFTER_DRAIN) { E(acc, cur, wr, wc, fr, fq); S.done(cur); }
        if (!has_next) break;
#pragma unroll
        for (int a = 0; a < 2; ++a)
#pragma unroll
            for (int b = 0; b < 2; ++b)
#pragma unroll
                for (int m = 0; m < 4; ++m)
#pragma unroll
                    for (int n = 0; n < 2; ++n) acc[a][b][m][n] = (f32x4){0.f, 0.f, 0.f, 0.f};
        cur = nxt; cA = nA; cB = nB; ++ui;
        if constexpr (ALIGN_EPI) { if (wr == 1) PG8_BAR; }
    }
    PG8_WAIT_V(0);
    if constexpr (!ALIGN_EPI) { if (wr == 0) PG8_BAR; }
    PG8_BAR;
    if constexpr (Epi::AFTER_DRAIN) { E.fused(acc, cur, wr, wc, fr, fq, lds, wid, lane); S.done(cur); }
#undef PG8_SA
#undef PG8_SB
#undef PG8_STAGE
#undef PG8_LDA
#undef PG8_LDB
#undef PG8_MMA
#undef PG8_WAIT_V
#undef PG8_WAIT_L
#undef PG8_BAR
#undef PG8_SCHED
}
}

namespace pg8 {
template <class Epi, class Sched, bool GATHER, bool FP8 = false>
__device__ __forceinline__ void gemm_phase_g(PG8_LAS unsigned char* lds, const int K, const Sched& S, const Epi& E, int sw = 0x7f7f7f7f, int sx = 0x7f7f7f7f) {
    typedef typename Sched::Unit UnitT;
    const int tid = otid(), wid = __builtin_amdgcn_readfirstlane(tid >> 6), lane = tid & 63, wr = wid >> 2, wc = wid & 3, fr = lane & 15, fq = lane >> 4;
    const int nt = K / BK;
    unsigned voffB[2];
#pragma unroll
    for (int i = 0; i < 2; ++i) { int R, C; stage_rc(tid * 16 + i * 8192, R, C); const int Rb = Epi::PERM ? ((R & ~31) + perm32(R & 31)) : R; voffB[i] = (unsigned)(Rb * K + C) * 2u; }
#define PG8_AOFF(unit, o0, o1) do { const int _tz = otid(); _Pragma("unroll") for (int _i = 0; _i < 2; ++_i) { int _R, _C; stage_rc(_tz * 16 + _i * 8192, _R, _C); \
        o0[_i] = S.arow_off(unit, _R) + (unsigned)_C * 2u; o1[_i] = S.arow_off(unit, HALF + _R) + (unsigned)_C * 2u; } } while (0)
    const size_t kstep = (size_t)(BK * 2);
    const size_t hstep = (size_t)HALF * K * 2;
    const unsigned ldsw = (unsigned)wid * 1024u;
    const int aoff = lds_byte(wr * 64 + fr, fq * 8), boff = lds_byte(wc * 32 + fr, fq * 8);
#define PG8_SA(b, h) (((b) * 2 + (h)) * HTB)
#define PG8_SB(b, h) ((4 + (b) * 2 + (h)) * HTB)
#define PG8_STAGE(bufoff, gbase, voff) do { _Pragma("unroll") for (int _i = 0; _i < 2; ++_i) \
        __builtin_amdgcn_global_load_lds((const unsigned*)((const char*)(gbase) + (voff)[_i]), (PG8_LAS unsigned*)(lds + (bufoff) + ldsw + _i * 8192), 16, 0, 0); } while (0)
#define PG8_LDA(dst, b, h) do { _Pragma("unroll") for (int m = 0; m < 4; ++m) _Pragma("unroll") for (int k = 0; k < 2; ++k) dst[m].kk[k] = *(const PG8_LAS bf16x8*)(lds + PG8_SA(b, h) + aoff + m * 2048 + k * 1024); } while (0)
#define PG8_LDB(dst, b, h) do { _Pragma("unroll") for (int n = 0; n < 2; ++n) _Pragma("unroll") for (int k = 0; k < 2; ++k) dst[n].kk[k] = *(const PG8_LAS bf16x8*)(lds + PG8_SB(b, h) + boff + n * 2048 + k * 1024); } while (0)
#define PG8_MMA(ai, bj, At, Bt) do { __builtin_amdgcn_s_setprio(1); _Pragma("unroll") for (int m = 0; m < 4; ++m) _Pragma("unroll") for (int n = 0; n < 2; ++n) { \
        if constexpr (FP8) asm volatile("v_mfma_scale_f32_16x16x128_f8f6f4 %0, %1, %2, %0, %3, %4 op_sel_hi:[0,0,0]" : "+v"(acc[ai][bj][m][n]) : "v"(Bt[n].w), "v"(At[m].w), "v"(scw), "v"(scx)); \
        else { _Pragma("unroll") for (int k = 0; k < 2; ++k) acc[ai][bj][m][n] = __builtin_amdgcn_mfma_f32_16x16x32_bf16(Bt[n].kk[k], At[m].kk[k], acc[ai][bj][m][n], 0, 0, 0); } } __builtin_amdgcn_s_setprio(0); } while (0)
#define PG8_WAIT_V(n) asm volatile("s_waitcnt vmcnt(" #n ")" ::: "memory")
#define PG8_WAIT_L(n) asm volatile("s_waitcnt lgkmcnt(" #n ")" ::: "memory")
#define PG8_BAR __builtin_amdgcn_s_barrier()
#define PG8_SCHED __builtin_amdgcn_sched_barrier(0)
    UnitT cur, nxt; int ui = 0;
    if (!S.next(0, cur)) return;
    f32x4 acc[2][2][4][2];
#pragma unroll
    for (int a = 0; a < 2; ++a)
#pragma unroll
        for (int b = 0; b < 2; ++b)
#pragma unroll
            for (int m = 0; m < 4; ++m)
#pragma unroll
                for (int n = 0; n < 2; ++n) acc[a][b][m][n] = (f32x4){0.f, 0.f, 0.f, 0.f};
    Frag At[4], B0[2], B1[2];
    int scw = sw, scx = sx;
    if constexpr (FP8) asm volatile("" : "+v"(scw), "+v"(scx));
    unsigned cvo0[2], cvo1[2];
    PG8_AOFF(cur, cvo0, cvo1);
    const char* cA = S.abase(cur); const char* cB = S.bbase(cur);
    PG8_STAGE(PG8_SB(0, 0), cB, voffB); PG8_STAGE(PG8_SB(0, 1), cB + hstep, voffB); PG8_STAGE(PG8_SA(0, 0), cA, cvo0); PG8_STAGE(PG8_SA(0, 1), cA, cvo1);
    if (wr == 1) PG8_BAR;
    PG8_WAIT_V(2); PG8_BAR;
    PG8_STAGE(PG8_SB(1, 0), cB + kstep, voffB); PG8_STAGE(PG8_SA(1, 0), cA + kstep, cvo0); PG8_STAGE(PG8_SB(1, 1), cB + hstep + kstep, voffB);
    PG8_WAIT_V(6); PG8_BAR;
#pragma unroll 1
    for (;;) {
        const bool has_next = S.next(ui + 1, nxt);
        const char* nA = has_next ? S.abase(nxt) : cA; const char* nB = has_next ? S.bbase(nxt) : cB;
        unsigned v20[2], v21[2];
#pragma unroll 1
        for (int t = 0; t < nt; t += 2) {
            const bool last = (t == nt - 2);
            const char* a1 = cA + (size_t)(t + 1) * kstep;
            const char* a2 = last ? nA : cA + (size_t)(t + 2) * kstep; const char* b2 = last ? nB : cB + (size_t)(t + 2) * kstep;
            const char* a3 = a2 + kstep; const char* b3 = b2 + kstep;
            if (GATHER && last && has_next) { PG8_AOFF(nxt, v20, v21); }
            else {
#pragma unroll
                for (int i = 0; i < 2; ++i) { v20[i] = cvo0[i]; v21[i] = cvo1[i]; } }
            PG8_LDB(B0, 0, 0); PG8_LDB(B1, 0, 1); PG8_SCHED; PG8_LDA(At, 0, 0); PG8_STAGE(PG8_SA(1, 1), a1, cvo1);
            PG8_WAIT_V(8); PG8_WAIT_L(0); PG8_BAR; PG8_MMA(0, 0, At, B0); PG8_MMA(0, 1, At, B1); PG8_BAR; PG8_SCHED;
            PG8_LDA(At, 0, 1); PG8_STAGE(PG8_SB(0, 0), b2, voffB); PG8_STAGE(PG8_SB(0, 1), b2 + hstep, voffB); PG8_STAGE(PG8_SA(0, 0), a2, v20);
            PG8_WAIT_V(8); PG8_WAIT_L(0); PG8_BAR; PG8_MMA(1, 0, At, B0); PG8_MMA(1, 1, At, B1); PG8_BAR; PG8_SCHED;
            PG8_LDB(B0, 1, 0); PG8_LDB(B1, 1, 1); PG8_SCHED; PG8_LDA(At, 1, 0); PG8_STAGE(PG8_SA(0, 1), a2, v21);
            PG8_WAIT_V(8); PG8_WAIT_L(0); PG8_BAR; PG8_MMA(0, 0, At, B0); PG8_MMA(0, 1, At, B1); PG8_BAR; PG8_SCHED;
            PG8_LDA(At, 1, 1); PG8_STAGE(PG8_SB(1, 0), b3, voffB); PG8_STAGE(PG8_SB(1, 1), b3 + hstep, voffB); PG8_STAGE(PG8_SA(1, 0), a3, v20);
            PG8_WAIT_V(8); PG8_WAIT_L(0); PG8_BAR; PG8_MMA(1, 0, At, B0); PG8_MMA(1, 1, At, B1); PG8_BAR; PG8_SCHED;
        }
        if constexpr (FP8) asm volatile("s_nop 15\n\ts_nop 15" ::: "memory");
        if (wr == 0) PG8_BAR;
        E(acc, cur, wr, wc, fr, fq);
        if (!has_next) break;
#pragma unroll
        for (int a = 0; a < 2; ++a)
#pragma unroll
            for (int b = 0; b < 2; ++b)
#pragma unroll
                for (int m = 0; m < 4; ++m)
#pragma unroll
                    for (int n = 0; n < 2; ++n) acc[a][b][m][n] = (f32x4){0.f, 0.f, 0.f, 0.f};
        cur = nxt; cA = nA; cB = nB; ++ui;
#pragma unroll
        for (int i = 0; i < 2; ++i) { cvo0[i] = v20[i]; cvo1[i] = v21[i]; }
        if (wr == 1) PG8_BAR;
    }
    PG8_WAIT_V(0);
    PG8_BAR;
#undef PG8_AOFF
#undef PG8_SA
#undef PG8_SB
#undef PG8_STAGE
#undef PG8_LDA
#undef PG8_LDB
#undef PG8_MMA
#undef PG8_WAIT_V
#undef PG8_WAIT_L
#undef PG8_BAR
#undef PG8_SCHED
}
}

struct TrTile { const float* src; bf16_t* dst; int K, N, k0, n0, mode; };
__device__ __forceinline__ TrTile tr_desc(const Params& p, int it) {
    TrTile t;
    bf16_t* win = (bf16_t*)(p.ws + WS_WIN); bf16_t* wout = (bf16_t*)(p.ws + WS_WOUT); bf16_t* mwin = (bf16_t*)(p.ws + WS_MWIN); bf16_t* mwdn = (bf16_t*)(p.ws + WS_MWDN);
    if (it < 3328) { const int l = it / 832, r = it % 832; t.src = p.w_in + (size_t)l * DM * PIN; t.dst = (bf16_t*)(p.ws + WS_W8 + (size_t)l * PINP * DM); t.K = DM; t.N = PIN; t.k0 = (r / 52) * 64; t.n0 = (r % 52) * 64; t.mode = 2; }
    else if (it < 4352) { const int j = it - 3328, l = j / 256, r = j % 256; t.src = p.w_out + (size_t)l * DM * DM; t.dst = (bf16_t*)(p.ws + WS_WOUT + (size_t)l * DM * DM); t.K = DM; t.N = DM; t.k0 = (r / 16) * 64; t.n0 = (r % 16) * 64; t.mode = 3; }
    else if (it < 12544) { const int j = it - 4352, le = j / 128, r = j % 128; t.src = p.moe_w_in + (size_t)le * 1024 * 512; t.dst = (bf16_t*)(p.ws + WS_MWIN + (size_t)le * 512 * 1024); t.K = 1024; t.N = 512; t.k0 = (r / 8) * 64; t.n0 = (r % 8) * 64; t.mode = 5; }
    else { const int j = it - 12544, le = j / 64, r = j % 64; t.src = p.moe_w_down + (size_t)le * 256 * 1024; t.dst = (bf16_t*)(p.ws + WS_MWDN + (size_t)le * 1024 * 256); t.K = 256; t.N = 1024; t.k0 = (r / 16) * 64; t.n0 = (r % 16) * 64; t.mode = 4; }
    return t;
}
__device__ __forceinline__ void tr_load(const TrTile& t, float (&v)[8], int tid) {
    const int c = tid & 63, r0 = tid >> 6;
    if (t.n0 < t.N) {
#pragma unroll
        for (int i = 0; i < 8; ++i) v[i] = t.src[(size_t)(t.k0 + r0 + i * 8) * t.N + t.n0 + c];
    } else {
#pragma unroll
        for (int i = 0; i < 8; ++i) v[i] = 0.f;
    }
}
__device__ __forceinline__ void prologue(const Params& p, unsigned char* lds) {
    float* tile = (float*)lds;
    const int G = gridDim.x, w = obid(), tid = otid();
    {
        bf16_t* xb = (bf16_t*)(p.ws + WS_XB); unsigned* x8 = (unsigned*)(p.ws + WS_X8);
        const size_t n4 = (size_t)NTOK * DM / 4, stride = (size_t)G * NTHREADS;
        size_t i = (size_t)w * NTHREADS + tid;
        for (; i + 3 * stride < n4; i += 4 * stride) {
            float4 v[4];
#pragma unroll
            for (int k = 0; k < 4; ++k) v[k] = ((const float4*)p.x)[i + k * stride];
#pragma unroll
            for (int k = 0; k < 4; ++k) { uint2 o; o.x = pg8::cvt_pk_bf16(v[k].x, v[k].y); o.y = pg8::cvt_pk_bf16(v[k].z, v[k].w); ((uint2*)xb)[i + k * stride] = o;
                x8[i + k * stride] = pk_fp8x4(v[k].x * X8_SCALE, v[k].y * X8_SCALE, v[k].z * X8_SCALE, v[k].w * X8_SCALE); }
        }
        for (; i < n4; i += stride) { const float4 v = ((const float4*)p.x)[i]; uint2 o; o.x = pg8::cvt_pk_bf16(v.x, v.y); o.y = pg8::cvt_pk_bf16(v.z, v.w); ((uint2*)xb)[i] = o;
            x8[i] = pk_fp8x4(v.x * X8_SCALE, v.y * X8_SCALE, v.z * X8_SCALE, v.w * X8_SCALE); }
    }
    {
        const int c = tid & 63, r0 = tid >> 6, nn = tid >> 3, kg = tid & 7;
        float* tileB = tile + 64 * 65 + 64;
        auto emit = [&](const TrTile& cur, const float* tl) {
        int n = cur.n0 + nn;
        if (cur.mode == 1 || cur.mode == 5) { const int j = n & 255; const int isu = n >> 8; n = (j >> 4) * 32 + isu * 16 + (j & 15); }
        float f[8];
#pragma unroll
        for (int i = 0; i < 8; ++i) f[i] = tl[(kg * 8 + i) * 65 + nn];
        if (cur.mode >= 3) {
            const float ws8 = cur.mode == 3 ? WO8_SCALE : cur.mode == 4 ? WD8_SCALE : W8_SCALE;
            uint2 o; o.x = pk_fp8x4(f[0] * ws8, f[1] * ws8, f[2] * ws8, f[3] * ws8); o.y = pk_fp8x4(f[4] * ws8, f[5] * ws8, f[6] * ws8, f[7] * ws8);
            *(uint2*)((unsigned char*)cur.dst + (size_t)n * cur.K + cur.k0 + kg * 8) = o;
        } else if (cur.mode == 2) {
            uint2 o; o.x = pk_fp8x4(f[0] * W8_SCALE, f[1] * W8_SCALE, f[2] * W8_SCALE, f[3] * W8_SCALE); o.y = pk_fp8x4(f[4] * W8_SCALE, f[5] * W8_SCALE, f[6] * W8_SCALE, f[7] * W8_SCALE);
            const size_t eo = (size_t)((unsigned char*)cur.dst - (p.ws + WS_W8)) + (size_t)n * cur.K + cur.k0 + kg * 8;
            *(uint2*)(p.ws + WS_W8 + eo) = o;
            pg8::u32x4 ob; ob.x = pg8::cvt_pk_bf16(f[0], f[1]); ob.y = pg8::cvt_pk_bf16(f[2], f[3]); ob.z = pg8::cvt_pk_bf16(f[4], f[5]); ob.w = pg8::cvt_pk_bf16(f[6], f[7]);
            if ((P1_BF16_TILES >> (n >> 8)) & 1) *(pg8::u32x4*)(p.ws + WS_WIN + eo * 2) = ob;
        } else {
        pg8::u32x4 o; o.x = pg8::cvt_pk_bf16(f[0], f[1]); o.y = pg8::cvt_pk_bf16(f[2], f[3]); o.z = pg8::cvt_pk_bf16(f[4], f[5]); o.w = pg8::cvt_pk_bf16(f[6], f[7]);
        *(pg8::u32x4*)(cur.dst + (size_t)n * cur.K + cur.k0 + kg * 8) = o;
        }
        };
        int it = w;
        float v0[8], v1[8];
        TrTile c0 = tr_desc(p, it < 16640 ? it : 0), c1 = tr_desc(p, it + G < 16640 ? it + G : 0);
        if (it < 16640) tr_load(c0, v0, tid);
        if (it + G < 16640) tr_load(c1, v1, tid);
#pragma unroll 1
        for (; it < 16640; it += 2 * G) {
            __syncthreads();
#pragma unroll
            for (int i = 0; i < 8; ++i) { tile[(r0 + i * 8) * 65 + c] = v0[i]; tileB[(r0 + i * 8) * 65 + c] = v1[i]; }
            const int n0i = it + 2 * G, n1i = it + 3 * G;
            TrTile n0 = tr_desc(p, n0i < 16640 ? n0i : 0), n1 = tr_desc(p, n1i < 16640 ? n1i : 0);
            if (n0i < 16640) tr_load(n0, v0, tid);
            if (n1i < 16640) tr_load(n1, v1, tid);
            __syncthreads();
            emit(c0, tile);
            if (it + G < 16640) emit(c1, tileB);
            c0 = n0; c1 = n1;
        }
    }
    {
        for (int i = w * NTHREADS + tid; i < 4 * 6 * 256; i += G * NTHREADS) {
            const int h = i / 1536, idx = i % 1536;
            const int di = idx >> 8, j = (idx >> 6) & 3, ln = idx & 63;
            const int d0 = 32 * di + (ln & 31) - 8 * j - 4 * (ln >> 5);
            float v[4];
#pragma unroll
            for (int e = 0; e < 4; ++e) {
                const int d = d0 - e; const int n = d > 0 ? d : 0;
                int bucket;
                if (n < 16) bucket = n;
                else { const float nf = (float)n; int lg = 16 + (int)(logf(nf / 16.0f) / 2.0794415416798357f * 16.0f); bucket = lg < 31 ? lg : 31; }
                v[e] = d >= 0 ? p.rel_bias[bucket * 4 + h] * LOG2E : -INFINITY;
            }
            *(float4*)(p.ws + WS_CT + (size_t)i * 16) = make_float4(v[0], v[1], v[2], v[3]);
        }
        if (w == 0 && tid < 4) {
            float* lamb = (float*)(p.ws + WS_LAM);
            const float* lp = p.da_lambda + (size_t)tid * 128;
            float s1 = 0.f, s2 = 0.f;
            for (int i = 0; i < 32; ++i) { s1 += lp[i] * lp[32 + i]; s2 += lp[64 + i] * lp[96 + i]; }
            const float lam_init = 0.8f - 0.6f * expf(-0.3f * (float)tid);
            lamb[tid * 2] = expf(s1) - expf(s2) + lam_init; lamb[tid * 2 + 1] = lam_init;
            lamb[8 + tid] = __builtin_amdgcn_exp2f(p.rel_bias[31 * 4 + tid] * LOG2E);
        }
    }
    {
        float* bd = (float*)(p.ws + WS_BIASD);
        for (int i = w * NTHREADS + tid; i < 4 * 2048; i += G * NTHREADS) {
            const int h = i >> 11, n = i & 2047;
            int bucket;
            if (n < 16) bucket = n;
            else { const float nf = (float)n; int lg = 16 + (int)(logf(nf / 16.0f) / 2.0794415416798357f * 16.0f); bucket = lg < 31 ? lg : 31; }
            bd[i] = p.rel_bias[bucket * 4 + h];
        }
    }
}

struct EpiProjP {
    static constexpr bool PERM = true, AFTER_DRAIN = false;
    bf16_t* O;
    __device__ __forceinline__ void operator()(const pg8::f32x4 (&acc)[2][2][4][2], const pg8::Unit& u, int wr, int wc, int fr, int fq) const {
        const int row0 = u.pm * 256 + wr * 64 + fr, col0 = u.pn * 256 + wc * 32 + 8 * fq;
#pragma unroll
        for (int ai = 0; ai < 2; ++ai)
#pragma unroll
            for (int m = 0; m < 4; ++m) { bf16_t* rowp = O + (size_t)(row0 + ai * 128 + m * 16) * PINP + col0;
#pragma unroll
                for (int bj = 0; bj < 2; ++bj) { const pg8::f32x4 v0 = acc[ai][bj][m][0], v1 = acc[ai][bj][m][1];
                    pg8::u32x4 w; w.x = pg8::cvt_pk_bf16(v0[0], v0[1]); w.y = pg8::cvt_pk_bf16(v0[2], v0[3]); w.z = pg8::cvt_pk_bf16(v1[0], v1[1]); w.w = pg8::cvt_pk_bf16(v1[2], v1[3]);
                    *(pg8::u32x4*)(rowp + bj * 128) = w; } }
    }
};
__device__ __forceinline__ void phase_inproj(const Params& p, int l, unsigned char* lds) {
    unsigned long long t8 = 0ull, t16 = 0ull; int n8 = 0, n16 = 0;
#pragma unroll
    for (int t = 0; t < PINP / 256; ++t) { if ((P1_BF16_TILES >> t) & 1) { t16 |= (unsigned long long)t << (4 * n16); ++n16; } else { t8 |= (unsigned long long)t << (4 * n8); ++n8; } }
    EpiProjP E{(bf16_t*)(p.ws + WS_PROJ)};
    if (n8 > 0) {
        pg8::Gemm g{(const bf16_t*)(p.ws + WS_X8), (const bf16_t*)(p.ws + WS_W8 + (size_t)l * PINP * DM), NTOK, PINP, DM, 0x76767676, 0x7b7b7b7b};
        pg8::StaticOrderSub S; S.init(NTOK, n8 * 256, (int)gridDim.x, obid()); S.tbl = t8;
        pg8::gemm_phase<EpiProjP, pg8::StaticOrderSub, true, true, true>((PG8_LAS unsigned char*)lds, g, S, E);
    }
    if (n16 > 0) {
        pg8::Gemm g{(const bf16_t*)(p.ws + WS_XB), (const bf16_t*)(p.ws + WS_WIN) + (size_t)l * PINP * DM, NTOK, PINP, DM};
        pg8::StaticOrderSub S; S.init(NTOK, n16 * 256, (int)gridDim.x, obid()); S.tbl = t16;
        pg8::gemm_phase<EpiProjP, pg8::StaticOrderSub, true, true, false>((PG8_LAS unsigned char*)lds, g, S, E);
    }
}

struct EpiOutP {
    static constexpr bool PERM = true, AFTER_DRAIN = false;
    const bf16_t* xh; bf16_t* out;
    __device__ __forceinline__ void operator()(const pg8::f32x4 (&acc)[2][2][4][2], const pg8::Unit& u, int wr, int wc, int fr, int fq) const {
        const int row0 = u.pm * 256 + wr * 64 + fr, col0 = u.pn * 256 + wc * 32 + 8 * fq;
        pg8::u32x4 r[2][4][2];
#pragma unroll
        for (int ai = 0; ai < 2; ++ai)
#pragma unroll
            for (int m = 0; m < 4; ++m)
#pragma unroll
                for (int bj = 0; bj < 2; ++bj) r[ai][m][bj] = *(const pg8::u32x4*)(xh + (size_t)(row0 + ai * 128 + m * 16) * DM + col0 + bj * 128);
#pragma unroll
        for (int ai = 0; ai < 2; ++ai)
#pragma unroll
            for (int m = 0; m < 4; ++m)
#pragma unroll
                for (int bj = 0; bj < 2; ++bj) { const size_t o = (size_t)(row0 + ai * 128 + m * 16) * DM + col0 + bj * 128;
                    const pg8::u32x4 q = r[ai][m][bj];
                    float xv[8];
                    xv[0] = __uint_as_float(q.x << 16); xv[1] = __uint_as_float(q.x & 0xffff0000u); xv[2] = __uint_as_float(q.y << 16); xv[3] = __uint_as_float(q.y & 0xffff0000u);
                    xv[4] = __uint_as_float(q.z << 16); xv[5] = __uint_as_float(q.z & 0xffff0000u); xv[6] = __uint_as_float(q.w << 16); xv[7] = __uint_as_float(q.w & 0xffff0000u);
                    const pg8::f32x4 v0 = acc[ai][bj][m][0], v1 = acc[ai][bj][m][1];
                    pg8::u32x4 w; w.x = pg8::cvt_pk_bf16(ALPHA * xv[0] + v0[0], ALPHA * xv[1] + v0[1]); w.y = pg8::cvt_pk_bf16(ALPHA * xv[2] + v0[2], ALPHA * xv[3] + v0[3]);
                    w.z = pg8::cvt_pk_bf16(ALPHA * xv[4] + v1[0], ALPHA * xv[5] + v1[1]); w.w = pg8::cvt_pk_bf16(ALPHA * xv[6] + v1[2], ALPHA * xv[7] + v1[3]);
                    *(pg8::u32x4*)(out + o) = w; }
    }
};
__device__ __forceinline__ void phase_outproj(const Params& p, int l, unsigned char* lds) {
    pg8::Gemm g{(const bf16_t*)(p.ws + WS_MIX), (const bf16_t*)(p.ws + WS_WOUT + (size_t)l * DM * DM), NTOK, DM, DM, 0x75757575, 0x7d7d7d7d};
    pg8::StaticOrder S; S.init(NTOK, DM, (int)gridDim.x, obid());
    EpiOutP E{(const bf16_t*)(p.ws + WS_XB), (bf16_t*)(p.ws + WS_YB)};
    pg8::gemm_phase<EpiOutP, pg8::StaticOrder, true, true, true>((PG8_LAS unsigned char*)lds, g, S, E);
}

__device__ __forceinline__ void ln_row(float (&v)[16], const float* gain, const float* bias, int lane) {
    float s = 0.f;
#pragma unroll
    for (int i = 0; i < 16; ++i) s += v[i];
    s = wave_sum(s);
    const float mean = s * (1.0f / 1024.0f);
    float q = 0.f;
#pragma unroll
    for (int i = 0; i < 16; ++i) { const float d = v[i] - mean; q += d * d; }
    q = wave_sum(q);
    const float rstd = rsqrtf(q * (1.0f / 1024.0f) + 1e-5f);
#pragma unroll
    for (int j = 0; j < 4; ++j) {
        const float4 g = *(const float4*)(gain + j * 256 + lane * 4), b = *(const float4*)(bias + j * 256 + lane * 4);
        v[j * 4 + 0] = (v[j * 4 + 0] - mean) * rstd * g.x + b.x; v[j * 4 + 1] = (v[j * 4 + 1] - mean) * rstd * g.y + b.y;
        v[j * 4 + 2] = (v[j * 4 + 2] - mean) * rstd * g.z + b.z; v[j * 4 + 3] = (v[j * 4 + 3] - mean) * rstd * g.w + b.w;
    }
}
__device__ __forceinline__ void bf8_to_f(const uint4& v, float (&o)[8]) {
    o[0] = __uint_as_float(v.x << 16); o[1] = __uint_as_float(v.x & 0xffff0000u); o[2] = __uint_as_float(v.y << 16); o[3] = __uint_as_float(v.y & 0xffff0000u);
    o[4] = __uint_as_float(v.z << 16); o[5] = __uint_as_float(v.z & 0xffff0000u); o[6] = __uint_as_float(v.w << 16); o[7] = __uint_as_float(v.w & 0xffff0000u);
}
__device__ __forceinline__ void load_gb(float (&gn)[16], float (&bs)[16], const float* gain, const float* bias, int lane) {
#pragma unroll
    for (int j = 0; j < 4; ++j) { const float4 g = *(const float4*)(gain + j * 256 + lane * 4), b = *(const float4*)(bias + j * 256 + lane * 4);
        gn[j * 4] = g.x; gn[j * 4 + 1] = g.y; gn[j * 4 + 2] = g.z; gn[j * 4 + 3] = g.w; bs[j * 4] = b.x; bs[j * 4 + 1] = b.y; bs[j * 4 + 2] = b.z; bs[j * 4 + 3] = b.w; }
}
__device__ __forceinline__ void ln_row_r(float (&v)[16], const float (&gn)[16], const float (&bs)[16]) {
    float s = 0.f;
#pragma unroll
    for (int i = 0; i < 16; ++i) s += v[i];
    s = wave_sum(s);
    const float mean = s * (1.0f / 1024.0f);
    float q = 0.f;
#pragma unroll
    for (int i = 0; i < 16; ++i) { const float d = v[i] - mean; q += d * d; }
    q = wave_sum(q);
    const float rstd = rsqrtf(q * (1.0f / 1024.0f) + 1e-5f);
#pragma unroll
    for (int i = 0; i < 16; ++i) v[i] = (v[i] - mean) * rstd * gn[i] + bs[i];
}
__device__ __forceinline__ void load_row_bf(float (&v)[16], const bf16_t* src, int lane) {
#pragma unroll
    for (int j = 0; j < 4; ++j) { const ushort4 t = *(const ushort4*)(src + j * 256 + lane * 4); v[j * 4] = bf2f(t.x); v[j * 4 + 1] = bf2f(t.y); v[j * 4 + 2] = bf2f(t.z); v[j * 4 + 3] = bf2f(t.w); }
}
__device__ __forceinline__ void store_row_bf(const float (&v)[16], bf16_t* xbo, int lane) {
#pragma unroll
    for (int j = 0; j < 4; ++j) { uint2 o; o.x = pk_bf16(v[j * 4], v[j * 4 + 1]); o.y = pk_bf16(v[j * 4 + 2], v[j * 4 + 3]); *(uint2*)(xbo + j * 256 + lane * 4) = o; }
}
__device__ __forceinline__ void store_row(const float (&v)[16], float* xo, bf16_t* xbo, int lane) {
#pragma unroll
    for (int j = 0; j < 4; ++j) {
        *(float4*)(xo + j * 256 + lane * 4) = make_float4(v[j * 4], v[j * 4 + 1], v[j * 4 + 2], v[j * 4 + 3]);
        uint2 o; o.x = pk_bf16(v[j * 4], v[j * 4 + 1]); o.y = pk_bf16(v[j * 4 + 2], v[j * 4 + 3]); *(uint2*)(xbo + j * 256 + lane * 4) = o;
    }
}

__device__ __forceinline__ void route_pick(const float (&lg)[16], const float* rb, int& i1, int& i2, float& g1, float& g2) {
    float aff[16], sl[16];
#pragma unroll
    for (int e = 0; e < 16; ++e) { aff[e] = sigmoidf_(lg[e]); sl[e] = aff[e] + rb[e]; }
    float bestg = -INFINITY; int bg = 0;
#pragma unroll
    for (int g = 0; g < 4; ++g) {
        float m1 = -INFINITY, m2 = -INFINITY;
#pragma unroll
        for (int k = 0; k < 4; ++k) { const float s = sl[g * 4 + k]; if (s > m1) { m2 = m1; m1 = s; } else if (s > m2) m2 = s; }
        const float gs = m1 + m2;
        if (gs > bestg) { bestg = gs; bg = g; }
    }
    float b1 = -INFINITY; i1 = 0; float a1 = 0.f;
#pragma unroll
    for (int e = 0; e < 16; ++e) { const bool in = (e >> 2) == bg; if (in && sl[e] > b1) { b1 = sl[e]; i1 = e; a1 = aff[e]; } }
    float b2 = -INFINITY; i2 = 0; float a2 = 0.f;
#pragma unroll
    for (int e = 0; e < 16; ++e) { const bool in = ((e >> 2) == bg) && (e != i1); if (in && sl[e] > b2) { b2 = sl[e]; i2 = e; a2 = aff[e]; } }
    const float inv = 1.0f / (a1 + a2);
    g1 = a1 * inv; g2 = a2 * inv;
}
__device__ __forceinline__ float rs16(const float (&v)[16], int lane) {
    float a8[8];
    const bool b0 = lane & 1, b1 = lane & 2, b2 = lane & 4, b3 = lane & 8;
#pragma unroll
    for (int i = 0; i < 8; ++i) { const float keep = b0 ? v[i + 8] : v[i], give = b0 ? v[i] : v[i + 8]; a8[i] = keep + dppw_f<0xB1>(give); }
    float a4[4];
#pragma unroll
    for (int i = 0; i < 4; ++i) { const float keep = b1 ? a8[i + 4] : a8[i], give = b1 ? a8[i] : a8[i + 4]; a4[i] = keep + dppw_f<0x4E>(give); }
    float a2[2];
#pragma unroll
    for (int i = 0; i < 2; ++i) { const float keep = b2 ? a4[i + 2] : a4[i], give = b2 ? a4[i] : a4[i + 2]; a2[i] = keep + __shfl_xor(give, 4); }
    const float keep = b3 ? a2[1] : a2[0], give = b3 ? a2[0] : a2[1];
    return keep + __shfl_xor(give, 8);
}
__device__ __forceinline__ void store_row_lds_bf(const float (&v)[16], bf16_t* dst, int lane) {
#pragma unroll
    for (int j = 0; j < 4; ++j) { uint2 o; o.x = pg8::cvt_pk_bf16(v[j * 4], v[j * 4 + 1]); o.y = pg8::cvt_pk_bf16(v[j * 4 + 2], v[j * 4 + 3]); *(uint2*)(dst + j * 256 + lane * 4) = o; }
}
#define LN1_XS 1032
__device__ __forceinline__ void phase_ln1_route(const Params& p, int l, unsigned char* lds) {
    const int tid = otid(), lane = tid & 63, wid = tid >> 6, n = lane & 15, g = lane >> 4;
    int* sel_e = (int*)lds;
    float* sel_g = (float*)(lds + 2048);
    int* rank = (int*)(lds + 4096);
    int* base = (int*)(lds + 6144);
    float* lgs = (float*)(lds + 8192);
    bf16_t* xt = (bf16_t*)(lds + 24576);
    float* red = (float*)(lds + 24576 + 32 * LN1_XS * 2);
    bf16_t* xb = (bf16_t*)(p.ws + WS_XB); const bf16_t* yb = (const bf16_t*)(p.ws + WS_YB);
    unsigned* ctl = (unsigned*)(p.ws + WS_CTL);
    int* ltok = (int*)(p.ws + WS_LTOK);
    const float* gain = p.ln_gain + (size_t)(l * 2 + 0) * DM; const float* bias = p.ln_bias + (size_t)(l * 2 + 0) * DM;
    bf16x8 ah[4], al[4];
#pragma unroll
    for (int ks = 0; ks < 4; ++ks) {
        float wv[8];
#pragma unroll
        for (int e = 0; e < 8; ++e) wv[e] = p.router_w[(size_t)(wid * 128 + ks * 32 + g * 8 + e) * 16 + n];
        unsigned hi[4], lo[4];
#pragma unroll
        for (int q = 0; q < 4; ++q) {
            hi[q] = pk_bf16(wv[2 * q], wv[2 * q + 1]);
            const float h0 = __uint_as_float(hi[q] << 16), h1 = __uint_as_float(hi[q] & 0xffff0000u);
            lo[q] = pk_bf16(wv[2 * q] - h0, wv[2 * q + 1] - h1);
        }
        ah[ks] = mk_frag(hi[0], hi[1], hi[2], hi[3]); al[ks] = mk_frag(lo[0], lo[1], lo[2], lo[3]);
    }
    float gn[16], bs[16];
    load_gb(gn, bs, gain, bias, lane);
    for (int chunk = obid(); chunk < NTOK / 256; chunk += gridDim.x) {
        __syncthreads();
        ushort4 ra0[4], ra1[4], rb0[4], rb1[4];
#define LN1_LDRAW(R0, R1, lrow_) do { const size_t _r = (size_t)chunk * 256 + (lrow_); _Pragma("unroll") for (int j = 0; j < 4; ++j) { R0[j] = *(const ushort4*)(yb + _r * DM + j * 256 + lane * 4); R1[j] = *(const ushort4*)(yb + (_r + 1) * DM + j * 256 + lane * 4); } } while (0)
#define LN1_CVT(v, R) do { _Pragma("unroll") for (int j = 0; j < 4; ++j) { v[j * 4] = bf2f(R[j].x); v[j * 4 + 1] = bf2f(R[j].y); v[j * 4 + 2] = bf2f(R[j].z); v[j * 4 + 3] = bf2f(R[j].w); } } while (0)
#define LN1_EMIT(v0, v1, lrow_, slot_) do { const size_t row = (size_t)chunk * 256 + (lrow_); \
            ln_row_r(v0, gn, bs); ln_row_r(v1, gn, bs); \
              \
            unsigned char* x8 = p.ws + WS_X8 + row * DM;        \
            _Pragma("unroll") for (int j = 0; j < 4; ++j) { *(unsigned*)(x8 + j * 256 + lane * 4) = pk_fp8x4(v0[j * 4] * X8_SCALE, v0[j * 4 + 1] * X8_SCALE, v0[j * 4 + 2] * X8_SCALE, v0[j * 4 + 3] * X8_SCALE); \
                *(unsigned*)(x8 + DM + j * 256 + lane * 4) = pk_fp8x4(v1[j * 4] * X8_SCALE, v1[j * 4 + 1] * X8_SCALE, v1[j * 4 + 2] * X8_SCALE, v1[j * 4 + 3] * X8_SCALE); } \
            store_row_lds_bf(v0, xt + (slot_) * LN1_XS, lane); store_row_lds_bf(v1, xt + ((slot_) + 1) * LN1_XS, lane); } while (0)
        LN1_LDRAW(ra0, ra1, wid * 4); LN1_LDRAW(rb0, rb1, wid * 4 + 2);
#pragma unroll 1
        for (int grp = 0; grp < 8; ++grp) {
            const int ng = grp < 7 ? grp + 1 : 7;
            float v0[16], v1[16];
            LN1_CVT(v0, ra0); LN1_CVT(v1, ra1);
            LN1_LDRAW(ra0, ra1, ng * 32 + wid * 4);
            LN1_EMIT(v0, v1, grp * 32 + wid * 4, wid * 4);
            LN1_CVT(v0, rb0); LN1_CVT(v1, rb1);
            LN1_LDRAW(rb0, rb1, ng * 32 + wid * 4 + 2);
            LN1_EMIT(v0, v1, grp * 32 + wid * 4 + 2, wid * 4 + 2);
            __syncthreads();
#pragma unroll
            for (int ct = 0; ct < 2; ++ct) {
                f32x4 acc = {0.f, 0.f, 0.f, 0.f};
#pragma unroll
                for (int ks = 0; ks < 4; ++ks) {
                    const bf16x8 bx = *(const bf16x8*)(xt + (ct * 16 + n) * LN1_XS + wid * 128 + ks * 32 + g * 8);
                    acc = __builtin_amdgcn_mfma_f32_16x16x32_bf16(ah[ks], bx, acc, 0, 0, 0);
                    acc = __builtin_amdgcn_mfma_f32_16x16x32_bf16(al[ks], bx, acc, 0, 0, 0);
                }
                *(float4*)(red + (wid * 32 + ct * 16 + n) * 16 + 4 * g) = make_float4(acc[0], acc[1], acc[2], acc[3]);
            }
            __syncthreads();
            { const int tok = tid >> 4, e = tid & 15; float sum = 0.f;
#pragma unroll
              for (int w = 0; w < 8; ++w) sum += red[(w * 32 + tok) * 16 + e];
              lgs[(grp * 32 + tok) * 16 + e] = sum; }
        }
        __syncthreads();
        if (tid < 256) {
            float lg[16];
#pragma unroll
            for (int q = 0; q < 4; ++q) { const float4 t = *(const float4*)(lgs + tid * 16 + q * 4); lg[q * 4] = t.x; lg[q * 4 + 1] = t.y; lg[q * 4 + 2] = t.z; lg[q * 4 + 3] = t.w; }
            int i1, i2; float g1, g2;
            route_pick(lg, p.router_b, i1, i2, g1, g2);
            sel_e[tid * 2] = i1; sel_e[tid * 2 + 1] = i2; sel_g[tid * 2] = g1; sel_g[tid * 2 + 1] = g2;
        }
        __syncthreads();
        int my_e, my_rank;
        {
            my_e = sel_e[tid]; my_rank = 0;
            const unsigned long long lt = (1ull << lane) - 1ull;
#pragma unroll
            for (int e = 0; e < 16; ++e) {
                const unsigned long long m = __ballot(my_e == e);
                if (my_e == e) my_rank = __popcll(m & lt);
                if (lane == 0) rank[wid * 16 + e] = __popcll(m);
            }
        }
        __syncthreads();
        if (tid < 16) {
            int c = 0;
#pragma unroll
            for (int w = 0; w < 8; ++w) { const int t = rank[w * 16 + tid]; rank[w * 16 + tid] = c; c += t; }
            base[tid] = (int)atomicAdd(&ctl[CW_CNT + (l * 16 + tid) * 64], (unsigned)c);
        }
        __syncthreads();
        {
            const int e = my_e; const int pos = base[e] + rank[wid * 16 + e] + my_rank;
            ltok[(size_t)e * NTOK + pos] = chunk * 256 + (tid >> 1);
            int* ti = (int*)(p.ws + WS_LGATE) + (size_t)(chunk * 256 + (tid >> 1)) * 4;
            ti[tid & 1] = (e << 17) | pos; ((float*)ti)[2 + (tid & 1)] = sel_g[tid];
        }
    }
}

#define MOE_TAB_OFF 131072
#define MOE_META_OFF (131072 + 4096)
struct MoeUnit { int e, rl, pn, n, ui, pb; };
__device__ __forceinline__ void moe_meta(const Params& p, int l, PG8_LAS int* meta) {
    unsigned* ctl = (unsigned*)(p.ws + WS_CTL);
    const int tid = otid();
    if (tid < 16) meta[tid] = (int)xb_ld(&ctl[CW_CNT + (l * 16 + tid) * 64]);
    __syncthreads();
    if (tid == 0) {
        int tb = 0, pb = 0;
        for (int e = 0; e < 16; ++e) { const int c = meta[e]; meta[16 + e] = tb; meta[33 + e] = pb; tb += (c + 255) >> 8; pb += c; }
        meta[32] = tb; meta[49] = pb;
    }
    __syncthreads();
}
struct MoeSchedCommon {
    typedef MoeUnit Unit;
    PG8_LAS const int* meta; int G, c;
    __device__ __forceinline__ int mu(int idx) const { return __builtin_amdgcn_readfirstlane(meta[idx]); }
    __device__ __forceinline__ void fill(int rt, int pn, int i, MoeUnit& u) const {
        int e = 0;
#pragma unroll
        for (int k = 1; k < 16; ++k) if (rt >= mu(16 + k)) e = k;
        u.pn = pn; u.e = e; u.rl = rt - mu(16 + e); u.n = mu(e) - u.rl * 256; u.pb = mu(33 + e) + u.rl * 256; u.ui = i;
    }
};
struct MoeSchedUp : MoeSchedCommon {
    PG8_LAS const unsigned short* tok16; const char* xb; const char* wbase; int i0, i1;
    __device__ __forceinline__ bool next(int i, MoeUnit& u) const {
        const int ii = i0 + i; if (ii >= i1) return false;
        int rt, pn;
        if ((G & 15) == 0) { rt = ii * (G >> 1) + ((c & 7) | ((c >> 4) << 3)); pn = (c >> 3) & 1; }
        else { const int L = ii * G + c; rt = L >> 1; pn = L & 1; }
        if (rt >= mu(32)) return false;
        fill(rt, pn, i, u); return true;
    }
    __device__ __forceinline__ const char* abase(const MoeUnit&) const { return xb; }
    __device__ __forceinline__ unsigned arow_off(const MoeUnit& u, int r) const { return (unsigned)tok16[u.ui * 256 + r] * 1024u; }
    __device__ __forceinline__ const char* bbase(const MoeUnit& u) const { return wbase + ((size_t)u.e * 512 + u.pn * 256) * 1024; }
};
struct MoeSchedDown : MoeSchedCommon {
    const char* hb; const char* wbase; int mode;
    __device__ __forceinline__ bool next(int i, MoeUnit& u) const {
        const int ntile = mu(32);
        int rt, pn;
        if (mode == 1) {
            if (c >= 32) { const int j = c - 32;
                if (i < 4) { rt = i * 56 + ((j & 7) | ((j >> 5) << 3)); pn = (j >> 3) & 3; } else { rt = 224 + (i - 4) * 64 + ((c & 7) | ((c >> 5) << 3)); pn = (c >> 3) & 3; } }
            else { rt = 224 + i * 64 + (c & 7); pn = (c >> 3) & 3; }
            if (rt >= 512) return false;
        } else if (mode == 2) {
            if (i > 0) return false;
            const int j = G - 1 - c; rt = 512 + (j >> 2); pn = j & 3;
            if (rt >= ntile) return false;
        } else {
            if ((G & 31) == 0) { rt = i * (G >> 2) + ((c & 7) | ((c >> 5) << 3)); pn = (c >> 3) & 3; } else { const int L = i * G + c; rt = L >> 2; pn = L & 3; }
            if (rt >= ntile) return false;
        }
        fill(rt, pn, i, u); return true;
    }
    __device__ __forceinline__ const char* abase(const MoeUnit& u) const { return hb + (size_t)u.pb * 256; }
    __device__ __forceinline__ unsigned arow_off(const MoeUnit&, int r) const { return (unsigned)r * 256u; }
    __device__ __forceinline__ const char* bbase(const MoeUnit& u) const { return wbase + ((size_t)u.e * 1024 + u.pn * 256) * 256; }
};
struct EpiUp {
    static constexpr bool PERM = false, AFTER_DRAIN = false;
    unsigned char* H;
    __device__ __forceinline__ void operator()(const pg8::f32x4 (&acc)[2][2][4][2], const MoeUnit& u, int wr, int wc, int fr, int fq) const {
        unsigned char* hb = H + u.pn * 128 + wc * 16 + fq * 4;
#pragma unroll
        for (int ai = 0; ai < 2; ++ai)
#pragma unroll
            for (int m = 0; m < 4; ++m) {
                const int r = ai * 128 + wr * 64 + m * 16 + fr;
                const int rr = (r < u.n) ? (u.pb + r) : (2 * NTOK + r);
#pragma unroll
                for (int bj = 0; bj < 2; ++bj) {
                    const pg8::f32x4 g = acc[ai][bj][m][0], uu = acc[ai][bj][m][1];
                    float hv[4];
#pragma unroll
                    for (int i = 0; i < 4; ++i) hv[i] = g[i] * __builtin_amdgcn_rcpf(1.0f + __builtin_amdgcn_exp2f(-g[i] * LOG2E)) * uu[i] * H8_SCALE;
                    *(unsigned*)(hb + (size_t)rr * DEXP + bj * 64) = pk_fp8x4(hv[0], hv[1], hv[2], hv[3]);
                }
            }
    }
};
struct EpiDown {
    static constexpr bool PERM = true, AFTER_DRAIN = false;
    unsigned char* Y8;
    __device__ __forceinline__ void operator()(const pg8::f32x4 (&acc)[2][2][4][2], const MoeUnit& u, int wr, int wc, int fr, int fq) const {
        unsigned char* yb = Y8 + u.pn * 256 + wc * 32 + 8 * fq;
#pragma unroll
        for (int ai = 0; ai < 2; ++ai)
#pragma unroll
            for (int m = 0; m < 4; ++m) {
                const int r = ai * 128 + wr * 64 + m * 16 + fr;
                const int rr = (r < u.n) ? (u.pb + r) : (2 * NTOK + r);
#pragma unroll
                for (int bj = 0; bj < 2; ++bj) { const pg8::f32x4 v0 = acc[ai][bj][m][0], v1 = acc[ai][bj][m][1];
                    uint2 w; w.x = pk_fp8x4(v0[0] * Y8_SCALE, v0[1] * Y8_SCALE, v0[2] * Y8_SCALE, v0[3] * Y8_SCALE); w.y = pk_fp8x4(v1[0] * Y8_SCALE, v1[1] * Y8_SCALE, v1[2] * Y8_SCALE, v1[3] * Y8_SCALE);
                    *(uint2*)(yb + (size_t)rr * DM + bj * 128) = w; }
            }
    }
};
__device__ __forceinline__ bool moe_up_rounds(const Params& p, int l, unsigned char* lds, int i0, int i1) {
    PG8_LAS unsigned char* L = (PG8_LAS unsigned char*)lds;
    PG8_LAS int* meta = (PG8_LAS int*)(L + MOE_META_OFF);
    PG8_LAS unsigned short* tok16 = (PG8_LAS unsigned short*)(L + MOE_TAB_OFF);
    MoeSchedUp S; S.meta = meta; S.G = (int)gridDim.x; S.c = obid(); S.tok16 = tok16; S.xb = (const char*)(p.ws + WS_X8); S.wbase = (const char*)(p.ws + WS_MWIN) + (size_t)l * 16 * 512 * 1024; S.i0 = i0; S.i1 = i1;
    bool any = false;
    {
        const int* ltok = (const int*)(p.ws + WS_LTOK); const int tid = otid();
        int tk[8]; bool ok[8];
#pragma unroll
        for (int i = 0; i < 8; ++i) {
            MoeUnit u; ok[i] = S.next(i, u);
            tk[i] = 0;
            if (ok[i] && tid < 256 && tid < u.n) tk[i] = ltok[(size_t)u.e * NTOK + u.rl * 256 + tid];
        }
#pragma unroll
        for (int i = 0; i < 8; ++i) if (ok[i]) { any = true; if (tid < 256) tok16[i * 256 + tid] = (unsigned short)tk[i]; }
    }
    __syncthreads();
    EpiUp E{p.ws + WS_H};
    pg8::gemm_phase_g<EpiUp, MoeSchedUp, true, true>(L, 512, S, E, 0x76767676, 0x7b7b7b7b);
    return any;
}
__device__ __forceinline__ void phase_moe_up(const Params& p, int l, unsigned char* lds) {
    PG8_LAS int* meta = (PG8_LAS int*)((PG8_LAS unsigned char*)lds + MOE_META_OFF);
    __syncthreads();
    moe_meta(p, l, meta);
    (void)moe_up_rounds(p, l, lds, 0, gridDim.x == 256 ? 4 : 8);
}
__device__ __forceinline__ void phase_moe_down(const Params& p, int l, unsigned char* lds) {
    PG8_LAS unsigned char* L = (PG8_LAS unsigned char*)lds;
    PG8_LAS int* meta = (PG8_LAS int*)(L + MOE_META_OFF);
    unsigned* ctl = (unsigned*)(p.ws + WS_CTL);
    const bool fast = gridDim.x == 256;
    __syncthreads();
    moe_meta(p, l, meta);
    if (fast && obid() < 32) {
        const bool any = moe_up_rounds(p, l, lds, 4, 5);
        if (any && otid() == 0) {
            __builtin_amdgcn_fence(__ATOMIC_RELEASE, "agent");
            asm volatile("s_waitcnt vmcnt(0)" ::: "memory");
            (void)xb_add(&ctl[CW_FLAG + l * 64], 1u);
        }
        __syncthreads();
    }
    MoeSchedDown S; S.meta = meta; S.G = (int)gridDim.x; S.c = obid(); S.hb = (const char*)(p.ws + WS_H); S.wbase = (const char*)(p.ws + WS_MWDN) + (size_t)l * 16 * 1024 * 256;
    EpiDown E{p.ws + WS_Y};
#pragma unroll 1
    for (int pass = 0; pass < 2; ++pass) {
        S.mode = fast ? 1 + pass : 0;
        if (pass == 1) {
            MoeUnit u;
            if (!fast || !S.next(0, u)) break;
            if (otid() == 0) {
                const unsigned need = 2u * (unsigned)(meta[32] - 512);
                XB_SPIN(xb_ld(&ctl[CW_FLAG + l * 64]) < need, ctl + CW_BAR);
                __builtin_amdgcn_fence(__ATOMIC_ACQUIRE, "agent");
                asm volatile("s_waitcnt vmcnt(0)" ::: "memory");
            }
            __syncthreads();
        }
        pg8::gemm_phase_g<EpiDown, MoeSchedDown, false, true>(L, 128, S, E, 0x76767676, 0x7c7c7c7c);
    }
}

__device__ __forceinline__ void phase_ln2(const Params& p, int l, unsigned char* lds) {
    const int tid = otid(), lane = tid & 63, wid = tid >> 6;
    bf16_t* xb = (bf16_t*)(p.ws + WS_XB); const unsigned char* Y8 = p.ws + WS_Y;
    const bf16_t* yb = (const bf16_t*)(p.ws + WS_YB);
    const float* gain1 = p.ln_gain + (size_t)(l * 2 + 0) * DM; const float* bias1 = p.ln_bias + (size_t)(l * 2 + 0) * DM;
    const float* gain = p.ln_gain + (size_t)(l * 2 + 1) * DM; const float* bias = p.ln_bias + (size_t)(l * 2 + 1) * DM;
    int* pbase = (int*)lds;
    __syncthreads();
    if (tid < 16) pbase[32 + tid] = (int)xb_ld(&((unsigned*)(p.ws + WS_CTL))[CW_CNT + (l * 16 + tid) * 64]);
    __syncthreads();
    if (tid == 0) { int pb = 0; for (int e = 0; e < 16; ++e) { pbase[e] = pb; pb += pbase[32 + e]; } }
    __syncthreads();
    float gn[16], bs[16];
#pragma unroll
    for (int j = 0; j < 2; ++j)
#pragma unroll
        for (int q = 0; q < 2; ++q) { const float4 g = *(const float4*)(gain + j * 512 + lane * 8 + q * 4), bb = *(const float4*)(bias + j * 512 + lane * 8 + q * 4);
            gn[j * 8 + q * 4] = g.x; gn[j * 8 + q * 4 + 1] = g.y; gn[j * 8 + q * 4 + 2] = g.z; gn[j * 8 + q * 4 + 3] = g.w; bs[j * 8 + q * 4] = bb.x; bs[j * 8 + q * 4 + 1] = bb.y; bs[j * 8 + q * 4 + 2] = bb.z; bs[j * 8 + q * 4 + 3] = bb.w; }
    float gn1[16], bs1[16];
#pragma unroll
    for (int j = 0; j < 2; ++j)
#pragma unroll
        for (int q = 0; q < 2; ++q) { const float4 g = *(const float4*)(gain1 + j * 512 + lane * 8 + q * 4), bb = *(const float4*)(bias1 + j * 512 + lane * 8 + q * 4);
            gn1[j * 8 + q * 4] = g.x; gn1[j * 8 + q * 4 + 1] = g.y; gn1[j * 8 + q * 4 + 2] = g.z; gn1[j * 8 + q * 4 + 3] = g.w; bs1[j * 8 + q * 4] = bb.x; bs1[j * 8 + q * 4 + 1] = bb.y; bs1[j * 8 + q * 4 + 2] = bb.z; bs1[j * 8 + q * 4 + 3] = bb.w; }
    const size_t rstep = (size_t)gridDim.x * 8;
    size_t row = (size_t)obid() * 8 + (size_t)__builtin_amdgcn_readfirstlane(wid);
#define LN2_CL(r_) ((r_) < NTOK ? (r_) : (size_t)(NTOK - 1))
#define LN2_TI(r_) (*(const int4*)(p.ws + WS_LGATE + LN2_CL(r_) * 16))
#define LN2_LOAD(X, A, B, r_, t_) do { { const size_t _rc = LN2_CL(r_); const size_t _p0 = (size_t)(pbase[(t_).x >> 17] + ((t_).x & 0x1ffff)), _p1 = (size_t)(pbase[(t_).y >> 17] + ((t_).y & 0x1ffff)); \
        _Pragma("unroll") for (int j = 0; j < 2; ++j) { X[j] = *(const uint4*)(yb + _rc * DM + j * 512 + lane * 8); A[j] = *(const uint2*)(Y8 + _p0 * DM + j * 512 + lane * 8); B[j] = *(const uint2*)(Y8 + _p1 * DM + j * 512 + lane * 8); } } } while (0)
#define LN2_STEP(Xc, Ac, Bc, tc, Xn, An, Bn, tl) do { \
        const float g0 = __int_as_float(tc.z) * (1.0f / Y8_SCALE), g1 = __int_as_float(tc.w) * (1.0f / Y8_SCALE); \
        tc = LN2_TI(row + 3 * rstep); \
        LN2_LOAD(Xn, An, Bn, row + 2 * rstep, tl); \
        float v[16]; \
        _Pragma("unroll") for (int j = 0; j < 2; ++j) { float fx[8]; bf8_to_f(Xc[j], fx); _Pragma("unroll") for (int i = 0; i < 8; ++i) v[j * 8 + i] = fx[i]; } \
        ln_row_r(v, gn1, bs1);        \
        _Pragma("unroll") for (int j = 0; j < 2; ++j) { float f0[8], f1[8]; fp8x8_to_f(Ac[j], f0); fp8x8_to_f(Bc[j], f1); \
            _Pragma("unroll") for (int i = 0; i < 8; ++i) v[j * 8 + i] = ALPHA * v[j * 8 + i] + g0 * f0[i] + g1 * f1[i]; } \
        ln_row_r(v, gn, bs); \
        _Pragma("unroll") for (int j = 0; j < 2; ++j) { \
            uint4 o; o.x = pk_bf16(v[j * 8], v[j * 8 + 1]); o.y = pk_bf16(v[j * 8 + 2], v[j * 8 + 3]); o.z = pk_bf16(v[j * 8 + 4], v[j * 8 + 5]); o.w = pk_bf16(v[j * 8 + 6], v[j * 8 + 7]); \
            if (l < NLAYER - 1) { *(uint4*)(xb + row * DM + j * 512 + lane * 8) = o;        \
                uint2 o8; o8.x = pk_fp8x4(v[j * 8] * X8_SCALE, v[j * 8 + 1] * X8_SCALE, v[j * 8 + 2] * X8_SCALE, v[j * 8 + 3] * X8_SCALE); o8.y = pk_fp8x4(v[j * 8 + 4] * X8_SCALE, v[j * 8 + 5] * X8_SCALE, v[j * 8 + 6] * X8_SCALE, v[j * 8 + 7] * X8_SCALE); \
                *(uint2*)(p.ws + WS_X8 + row * DM + j * 512 + lane * 8) = o8; } \
            if (l == NLAYER - 1) { \
                *(float4*)(p.out + row * DM + j * 512 + lane * 8) = make_float4(v[j * 8], v[j * 8 + 1], v[j * 8 + 2], v[j * 8 + 3]); \
                *(float4*)(p.out + row * DM + j * 512 + lane * 8 + 4) = make_float4(v[j * 8 + 4], v[j * 8 + 5], v[j * 8 + 6], v[j * 8 + 7]); } } \
        row += rstep; } while (0)
    uint4 x0[2], x1[2], x2[2]; uint2 a0[2], b0[2], a1[2], b1[2], a2[2], b2[2];
    int4 t0 = LN2_TI(row), t1 = LN2_TI(row + rstep), t2 = LN2_TI(row + 2 * rstep);
    LN2_LOAD(x0, a0, b0, row, t0);
    LN2_LOAD(x1, a1, b1, row + rstep, t1);
#pragma unroll 1
    for (;;) {
        if (row >= NTOK) break;
        LN2_STEP(x0, a0, b0, t0, x2, a2, b2, t2);
        if (row >= NTOK) break;
        LN2_STEP(x1, a1, b1, t1, x0, a0, b0, t0);
        if (row >= NTOK) break;
        LN2_STEP(x2, a2, b2, t2, x1, a1, b1, t1);
    }
#undef LN2_STEP
#undef LN2_CL
#undef LN2_TI
#undef LN2_LOAD
}

typedef float f32x16 __attribute__((ext_vector_type(16)));
#define AT_KSTR 72
#define AT_VSTR 68
#define AT_KBYTES (64 * AT_KSTR * 2)
#define AT_VBYTES (64 * AT_VSTR * 2)
__device__ __forceinline__ bf16x8 scale_frag(uint4 raw, float sc) {
    return mk_frag(pk_bf16(__uint_as_float(raw.x << 16) * sc, __uint_as_float(raw.x & 0xffff0000u) * sc), pk_bf16(__uint_as_float(raw.y << 16) * sc, __uint_as_float(raw.y & 0xffff0000u) * sc),
                   pk_bf16(__uint_as_float(raw.z << 16) * sc, __uint_as_float(raw.z & 0xffff0000u) * sc), pk_bf16(__uint_as_float(raw.w << 16) * sc, __uint_as_float(raw.w & 0xffff0000u) * sc));
}
struct AtStage {
    uint4 rk; uint2 rv0, rv1;
    __device__ __forceinline__ void load(const bf16_t* kbase, const bf16_t* vbase, int kt, int tid) {
        const int skey = tid >> 3, sc8 = tid & 7, vkp = tid >> 4, vdg = tid & 15;
        rk = *(const uint4*)(kbase + (size_t)(kt * 64 + skey) * PINP + sc8 * 8);
        rv0 = *(const uint2*)(vbase + (size_t)(kt * 64 + 2 * vkp) * PINP + vdg * 4);
        rv1 = *(const uint2*)(vbase + (size_t)(kt * 64 + 2 * vkp + 1) * PINP + vdg * 4);
    }
    __device__ __forceinline__ void store(LAS unsigned char* kb, LAS unsigned char* vb, int tid) const {
        const int skey = tid >> 3, sc8 = tid & 7, vkp = tid >> 4, vdg = tid & 15;
        { u32x4v t_; t_.x = rk.x; t_.y = rk.y; t_.z = rk.z; t_.w = rk.w; *(LAS u32x4v*)(kb + (skey * AT_KSTR + sc8 * 8) * 2) = t_; }
        LAS unsigned* vt = (LAS unsigned*)vb;
        vt[(vdg * 4 + 0) * (AT_VSTR / 2) + vkp] = (rv0.x & 0xffffu) | (rv1.x << 16);
        vt[(vdg * 4 + 1) * (AT_VSTR / 2) + vkp] = (rv0.x >> 16) | (rv1.x & 0xffff0000u);
        vt[(vdg * 4 + 2) * (AT_VSTR / 2) + vkp] = (rv0.y & 0xffffu) | (rv1.y << 16);
        vt[(vdg * 4 + 3) * (AT_VSTR / 2) + vkp] = (rv0.y >> 16) | (rv1.y & 0xffff0000u);
    }
};
__device__ __forceinline__ bf16x8 k_frag(const LAS unsigned char* kb, int keyrow, int dcol) { return *(const LAS bf16x8*)(kb + (keyrow * AT_KSTR + dcol) * 2); }
__device__ __forceinline__ bf16x8 v_frag(const LAS unsigned char* vb, int drow, int keycol) {
    const u32x2v a = *(const LAS u32x2v*)(vb + (drow * AT_VSTR + keycol) * 2), b = *(const LAS u32x2v*)(vb + (drow * AT_VSTR + keycol + 8) * 2);
    return mk_frag(a.x, a.y, b.x, b.y);
}
__device__ __forceinline__ void store_ot(unsigned char* dst  , const f32x16& o0, const f32x16& o1, int hh) {
#pragma unroll
    for (int q = 0; q < 4; ++q) {
        *(unsigned*)(dst + 8 * q + 4 * hh) = pk_fp8x4(o0[4 * q] * MIX8_SCALE, o0[4 * q + 1] * MIX8_SCALE, o0[4 * q + 2] * MIX8_SCALE, o0[4 * q + 3] * MIX8_SCALE);
        *(unsigned*)(dst + 32 + 8 * q + 4 * hh) = pk_fp8x4(o1[4 * q] * MIX8_SCALE, o1[4 * q + 1] * MIX8_SCALE, o1[4 * q + 2] * MIX8_SCALE, o1[4 * q + 3] * MIX8_SCALE);
    }
}

#define SB_VSTR 36
#define SB_WBYTES (32 * AT_KSTR * 2 + 64 * SB_VSTR * 2)
struct SbStage {
    u32x4v rk[4]; u32x2v rv0[4], rv1[4];
    __device__ __forceinline__ void load(const bf16_t* kbase, const bf16_t* vbase, int kb, int lane) {
        const int rsub = lane >> 3, c8 = lane & 7, kps = lane >> 4, dg = lane & 15;
#pragma unroll
        for (int j = 0; j < 4; ++j) {
            rk[j] = *(const u32x4v*)(kbase + (size_t)(kb * 32 + 8 * j + rsub) * PINP + c8 * 8);
            const int kp = 4 * j + kps;
            rv0[j] = *(const u32x2v*)(vbase + (size_t)(kb * 32 + 2 * kp) * PINP + dg * 4);
            rv1[j] = *(const u32x2v*)(vbase + (size_t)(kb * 32 + 2 * kp + 1) * PINP + dg * 4);
        }
    }
    __device__ __forceinline__ void store(LAS unsigned char* kb_, LAS unsigned char* vb_, int lane) const {
        const int rsub = lane >> 3, c8 = lane & 7, kps = lane >> 4, dg = lane & 15;
        LAS unsigned* vt = (LAS unsigned*)vb_;
#pragma unroll
        for (int j = 0; j < 4; ++j) {
            *(LAS u32x4v*)(kb_ + ((8 * j + rsub) * AT_KSTR + c8 * 8) * 2) = rk[j];
            const int kp = 4 * j + kps;
            vt[(dg * 4 + 0) * (SB_VSTR / 2) + kp] = (rv0[j].x & 0xffffu) | (rv1[j].x << 16);
            vt[(dg * 4 + 1) * (SB_VSTR / 2) + kp] = (rv0[j].x >> 16) | (rv1[j].x & 0xffff0000u);
            vt[(dg * 4 + 2) * (SB_VSTR / 2) + kp] = (rv0[j].y & 0xffffu) | (rv1[j].y << 16);
            vt[(dg * 4 + 3) * (SB_VSTR / 2) + kp] = (rv0[j].y >> 16) | (rv1[j].y & 0xffff0000u);
        }
    }
};
__device__ __forceinline__ bf16x8 sbv_frag(const LAS unsigned char* vb, int drow, int keycol) {
    const u32x2v a = *(const LAS u32x2v*)(vb + (drow * SB_VSTR + keycol) * 2), b = *(const LAS u32x2v*)(vb + (drow * SB_VSTR + keycol + 8) * 2);
    return mk_frag(a.x, a.y, b.x, b.y);
}
__device__ __forceinline__ void sbm_item(const Params& p, int bh, int qb, unsigned char* lds) {
    const int tid = otid(), lane = tid & 63, wid = tid >> 6, r = lane & 31, hh = lane >> 5;
    const int b = bh >> 2, h = bh & 3;
    const bf16_t* proj = (const bf16_t*)(p.ws + WS_PROJ) + (size_t)b * SEQ * PINP;
    const bf16_t* kbase = proj + 256 + h * 64; const bf16_t* vbase = proj + 512 + h * 64;
    const int q0w = qb * 256 + wid * 32, t = q0w + r;
    LAS unsigned char* const KW = (LAS unsigned char*)lds + wid * SB_WBYTES; LAS unsigned char* const VW = KW + 32 * AT_KSTR * 2;
    bf16x8 qf[4];
#pragma unroll
    for (int s = 0; s < 4; ++s) qf[s] = scale_frag(*(const uint4*)(proj + (size_t)t * PINP + h * 64 + 16 * s + 8 * hh), 0.125f * LOG2E);
    f32x16 O0, O1;
#pragma unroll
    for (int i = 0; i < 16; ++i) { O0[i] = 0.f; O1[i] = 0.f; }
    float carry = 1.f;
    SbStage st;
    __syncthreads();
    if (q0w + 31 > 0) {
        int kb = (q0w + 30) >> 5;
        st.load(kbase, vbase, kb, lane);
#pragma unroll 1
        for (; kb >= 0; --kb) {
            st.store(KW, VW, lane);
            if (kb > 0) st.load(kbase, vbase, kb - 1, lane);
            const int kbs = 32 * kb;
            f32x16 S;
#pragma unroll
            for (int i = 0; i < 16; ++i) S[i] = 0.f;
#pragma unroll
            for (int s = 0; s < 4; ++s) S = __builtin_amdgcn_mfma_f32_32x32x16_bf16(k_frag(KW, r, 16 * s + 8 * hh), qf[s], S, 0, 0, 0);
            const bool needmask = (kbs + 31 >= q0w);
            float sg[16], G[4];
#pragma unroll
            for (int q = 0; q < 4; ++q) {
                float om[4];
#pragma unroll
                for (int i = 0; i < 4; ++i) {
                    const float z = S[4 * q + i];
                    const float e = __builtin_amdgcn_exp2f(-fabsf(z));
                    const float rr = __builtin_amdgcn_rcpf(1.0f + e);
                    const float er = e * rr;
                    float sgm = z >= 0.f ? rr : er, omm = z >= 0.f ? er : rr;
                    if (needmask) { const int key = kbs + i + 8 * q + 4 * hh; if (key >= t) { sgm = 0.f; omm = 1.f; } }
                    sg[4 * q + i] = sgm; om[i] = omm;
                }
                const float pp2 = om[3], pp1 = pp2 * om[2], pp0 = pp1 * om[1];
                G[q] = pp0 * om[0];
                sg[4 * q + 2] *= pp2; sg[4 * q + 1] *= pp1; sg[4 * q + 0] *= pp0;
            }
            float Gp[4];
#pragma unroll
            for (int q = 0; q < 4; ++q) Gp[q] = __shfl_xor(G[q], 32);
            const float T0 = G[0] * Gp[0], T1 = G[1] * Gp[1], T2 = G[2] * Gp[2], T3 = G[3] * Gp[3];
            const float U2 = T3, U1 = T3 * T2, U0 = U1 * T1;
            float E[4];
            E[3] = carry; E[2] = carry * U2; E[1] = carry * U1; E[0] = carry * U0;
            if (hh == 0) { E[3] *= Gp[3]; E[2] *= Gp[2]; E[1] *= Gp[1]; E[0] *= Gp[0]; }
            carry = carry * U0 * T0;
#pragma unroll
            for (int q = 0; q < 4; ++q) { sg[4 * q] *= E[q]; sg[4 * q + 1] *= E[q]; sg[4 * q + 2] *= E[q]; sg[4 * q + 3] *= E[q]; }
            const bf16x8 P0 = mk_frag(pk_bf16(sg[0], sg[1]), pk_bf16(sg[2], sg[3]), pk_bf16(sg[4], sg[5]), pk_bf16(sg[6], sg[7]));
            const bf16x8 P1 = mk_frag(pk_bf16(sg[8], sg[9]), pk_bf16(sg[10], sg[11]), pk_bf16(sg[12], sg[13]), pk_bf16(sg[14], sg[15]));
            O0 = __builtin_amdgcn_mfma_f32_32x32x16_bf16(sbv_frag(VW, r, 4 * hh), P0, O0, 0, 0, 0);
            O0 = __builtin_amdgcn_mfma_f32_32x32x16_bf16(sbv_frag(VW, r, 16 + 4 * hh), P1, O0, 0, 0, 0);
            O1 = __builtin_amdgcn_mfma_f32_32x32x16_bf16(sbv_frag(VW, 32 + r, 4 * hh), P0, O1, 0, 0, 0);
            O1 = __builtin_amdgcn_mfma_f32_32x32x16_bf16(sbv_frag(VW, 32 + r, 16 + 4 * hh), P1, O1, 0, 0, 0);
            if (__all(carry < 0x1p-30f)) break;
        }
    }
    { const int tid2 = otid(), hh2 = (tid2 & 63) >> 5, t2 = qb * 256 + (tid2 >> 6) * 32 + (tid2 & 31);
      store_ot(p.ws + WS_MIX + (size_t)((bh >> 2) * SEQ + t2) * DM + (bh & 3) * 64, O0, O1, hh2); }
}

#define DA_CT_OFF 40960
__device__ __forceinline__ bf16x8 v_frag_p(const LAS unsigned char* q) { const u32x2v a = *(const LAS u32x2v*)q, b = *(const LAS u32x2v*)(q + 16); return mk_frag(a.x, a.y, b.x, b.y); }
__device__ __forceinline__ void da_block(const LAS unsigned char* kp, const LAS unsigned char* vp, const LAS unsigned char* vp2, const f32x16& C,
                                         const bf16x8 (&qf)[2][2], f32x16 (&O)[2][2], float (&lrun)[2], float one) {
#pragma clang fp reassociate(off)
    f32x16 S0, S1;
    {
        const bf16x8 k00 = *(const LAS bf16x8*)kp, k01 = *(const LAS bf16x8*)(kp + 32), k10 = *(const LAS bf16x8*)(kp + 64), k11 = *(const LAS bf16x8*)(kp + 96);
        S0 = __builtin_amdgcn_mfma_f32_32x32x16_bf16(k00, qf[0][0], C, 0, 0, 0);
        S1 = __builtin_amdgcn_mfma_f32_32x32x16_bf16(k10, qf[1][0], C, 0, 0, 0);
        S0 = __builtin_amdgcn_mfma_f32_32x32x16_bf16(k01, qf[0][1], S0, 0, 0, 0);
        S1 = __builtin_amdgcn_mfma_f32_32x32x16_bf16(k11, qf[1][1], S1, 0, 0, 0);
    }
    const bf16x8 va0 = v_frag_p(vp), vb0 = v_frag_p(vp + 32), va1 = v_frag_p(vp2), vb1 = v_frag_p(vp2 + 32);
    float ls0 = 0.f, ls1 = 0.f;
#pragma unroll
    for (int i = 0; i < 16; ++i) { const float p0 = __builtin_amdgcn_exp2f(S0[i]), p1 = __builtin_amdgcn_exp2f(S1[i]); S0[i] = p0; S1[i] = p1; ls0 += p0; ls1 = __builtin_fmaf(p1, one, ls1); }
    lrun[0] += ls0; lrun[1] = __builtin_fmaf(ls1, one, lrun[1]);
    const bf16x8 P00 = mk_frag(pk_bf16(S0[0], S0[1]), pk_bf16(S0[2], S0[3]), pk_bf16(S0[4], S0[5]), pk_bf16(S0[6], S0[7]));
    const bf16x8 P01 = mk_frag(pk_bf16(S0[8], S0[9]), pk_bf16(S0[10], S0[11]), pk_bf16(S0[12], S0[13]), pk_bf16(S0[14], S0[15]));
    const bf16x8 P10 = mk_frag(pk_bf16(S1[0], S1[1]), pk_bf16(S1[2], S1[3]), pk_bf16(S1[4], S1[5]), pk_bf16(S1[6], S1[7]));
    const bf16x8 P11 = mk_frag(pk_bf16(S1[8], S1[9]), pk_bf16(S1[10], S1[11]), pk_bf16(S1[12], S1[13]), pk_bf16(S1[14], S1[15]));
    O[0][0] = __builtin_amdgcn_mfma_f32_32x32x16_bf16(va0, P00, O[0][0], 0, 0, 0);
    O[1][0] = __builtin_amdgcn_mfma_f32_32x32x16_bf16(va0, P10, O[1][0], 0, 0, 0);
    O[0][1] = __builtin_amdgcn_mfma_f32_32x32x16_bf16(va1, P00, O[0][1], 0, 0, 0);
    O[1][1] = __builtin_amdgcn_mfma_f32_32x32x16_bf16(va1, P10, O[1][1], 0, 0, 0);
    O[0][0] = __builtin_amdgcn_mfma_f32_32x32x16_bf16(vb0, P01, O[0][0], 0, 0, 0);
    O[1][0] = __builtin_amdgcn_mfma_f32_32x32x16_bf16(vb0, P11, O[1][0], 0, 0, 0);
    O[0][1] = __builtin_amdgcn_mfma_f32_32x32x16_bf16(vb1, P01, O[0][1], 0, 0, 0);
    O[1][1] = __builtin_amdgcn_mfma_f32_32x32x16_bf16(vb1, P11, O[1][1], 0, 0, 0);
}
__device__ __forceinline__ void da_ctile(f32x16& C, const LAS unsigned char* cp) {
    const f32x4 c0 = *(const LAS f32x4*)cp, c1 = *(const LAS f32x4*)(cp + 1024), c2 = *(const LAS f32x4*)(cp + 2048), c3 = *(const LAS f32x4*)(cp + 3072);
#pragma unroll
    for (int i = 0; i < 4; ++i) { C[i] = c0[i]; C[4 + i] = c1[i]; C[8 + i] = c2[i]; C[12 + i] = c3[i]; }
}
__device__ __forceinline__ void dam_item(const Params& p, int l, int bh, int qb, unsigned char* lds, int* qslot, int qnxt) {
    const int tid = otid(), lane = tid & 63, wid = __builtin_amdgcn_readfirstlane(tid >> 6), r = lane & 31, hh = lane >> 5;
    const int b = bh >> 2, h = bh & 3;
    const bf16_t* proj = (const bf16_t*)(p.ws + WS_PROJ) + (size_t)b * SEQ * PINP;
    const bf16_t* kbase = proj + 1024 + h * 64; const bf16_t* vbase = proj + 1280 + h * 64;
    const float* biasd = (const float*)(p.ws + WS_BIASD) + h * 2048;
    const int q0w = qb * 256 + wid * 32, t = q0w + r;
    LAS unsigned char* const L = (LAS unsigned char*)lds;
#define KBUF(b_) (L + (b_) * AT_KBYTES)
#define VBUF(b_) (L + 2 * AT_KBYTES + (b_) * AT_VBYTES)
    bf16x8 qf[2][2];
#pragma unroll
    for (int m = 0; m < 2; ++m)
#pragma unroll
        for (int s = 0; s < 2; ++s) qf[m][s] = scale_frag(*(const uint4*)(proj + (size_t)t * PINP + 768 + h * 64 + m * 32 + 16 * s + 8 * hh), 0.17677669529663687f * LOG2E);
    f32x16 O[2][2];
#pragma unroll
    for (int m = 0; m < 2; ++m)
#pragma unroll
        for (int d = 0; d < 2; ++d)
#pragma unroll
            for (int i = 0; i < 16; ++i) O[m][d][i] = 0.f;
    float lrun[2] = {0.f, 0.f};
    f32x16 C;
#pragma unroll
    for (int i = 0; i < 16; ++i) C[i] = 0.f;
    const float sfar = ((const float*)(p.ws + WS_LAM))[8 + h];
    AtStage st;
    const int ktop = qb * 4 + 3;
    const int ktn = q0w >= 192 ? ((q0w - 192) >> 6) + 1 : 0;
    int onei = 0x3f800000; asm volatile("" : "+s"(onei)); const float one = __int_as_float(onei);
    __syncthreads();
    st.load(kbase, vbase, 0, tid);
    {
        const f32x4* ct = (const f32x4*)(p.ws + WS_CT) + (size_t)h * 1536;
        const f32x4 c0 = ct[tid], c1 = ct[tid + 512], c2 = ct[tid + 1024];
        *(LAS f32x4*)(L + DA_CT_OFF + tid * 16) = c0; *(LAS f32x4*)(L + DA_CT_OFF + (tid + 512) * 16) = c1; *(LAS f32x4*)(L + DA_CT_OFF + (tid + 1024) * 16) = c2;
    }
    st.store(KBUF(0), VBUF(0), tid);
    if (tid == 0) *qslot = qnxt;
    __syncthreads();
#pragma unroll 1
    for (int kt = 0; kt <= ktop; ++kt) {
        const int buf = kt & 1;
        if (kt < ktop) st.load(kbase, vbase, kt + 1, tid);
        if (64 * kt <= q0w) {
            if (kt == ktn && kt > 0) {
#pragma unroll
                for (int m = 0; m < 2; ++m) {
                    lrun[m] *= sfar;
#pragma unroll
                    for (int d = 0; d < 2; ++d)
#pragma unroll
                        for (int i = 0; i < 16; ++i) O[m][d][i] *= sfar;
                }
            }
            int ko = buf * AT_KBYTES + (r * AT_KSTR + 8 * hh) * 2, vo = 2 * AT_KBYTES + buf * AT_VBYTES + (r * AT_VSTR + 4 * hh) * 2;
            asm volatile("" : "+v"(ko), "+v"(vo));
            int vo2 = vo + 32 * AT_VSTR * 2;
            asm volatile("" : "+v"(vo2));
            const LAS unsigned char* kp = L + ko; const LAS unsigned char* vp = L + vo; const LAS unsigned char* vp2 = L + vo2;
            const int ci = (q0w - 64 * kt) >> 5;
            int co = DA_CT_OFF + (ci < 5 ? ci : 5) * 4096 + lane * 16;
            asm volatile("" : "+v"(co));
            const LAS unsigned char* cp = L + co;
            if (kt >= ktn) da_ctile(C, cp);
            da_block(kp, vp, vp2, C, qf, O, lrun, one);
            if (ci >= 1) {
                if (kt >= ktn) da_ctile(C, cp - 4096);
                da_block(kp + 32 * AT_KSTR * 2, vp + 64, vp2 + 64, C, qf, O, lrun, one);
            }
        }
        if (kt < ktop) st.store(KBUF(buf ^ 1), VBUF(buf ^ 1), tid);
        __syncthreads();
    }
    const int tid2 = otid(), hh2 = (tid2 & 63) >> 5, t2 = qb * 256 + (tid2 >> 6) * 32 + (tid2 & 31);
    const float lam = ((const float*)(p.ws + WS_LAM))[l * 2], lam_init = ((const float*)(p.ws + WS_LAM))[l * 2 + 1];
    const float l0 = lrun[0] + __shfl_xor(lrun[0], 32), l1 = lrun[1] + __shfl_xor(lrun[1], 32);
    const float i0 = 1.0f / l0, i1 = lam / l1;
    float ms = 0.f;
#pragma unroll
    for (int d = 0; d < 2; ++d)
#pragma unroll
        for (int i = 0; i < 16; ++i) { const float o = O[0][d][i] * i0 - O[1][d][i] * i1; O[0][d][i] = o; ms += o * o; }
    ms += __shfl_xor(ms, 32);
    const float rs = rsqrtf(ms * (1.0f / 64.0f) + 1e-5f) * (1.0f - lam_init);
    const float* sgn = p.da_subln + l * 64;
#pragma unroll
    for (int d = 0; d < 2; ++d)
#pragma unroll
        for (int i = 0; i < 16; ++i) O[0][d][i] *= rs * sgn[d * 32 + (i & 3) + 8 * (i >> 2) + 4 * hh2];
    store_ot(p.ws + WS_MIX + (size_t)((bh >> 2) * SEQ + t2) * DM + 256 + (bh & 3) * 64, O[0][0], O[0][1], hh2);
}

__device__ __forceinline__ void conv_item(const Params& p, int l, int item) {
    const int tid = otid();
    const bf16_t* proj = (const bf16_t*)(p.ws + WS_PROJ); unsigned char* mix = p.ws + WS_MIX;
    const float* cw = p.sc_conv + (size_t)l * 3 * 256;
    const int c8 = (tid & 31) * 8;
    float w0[8], w1[8], w2[8];
#pragma unroll
    for (int i = 0; i < 8; ++i) { w0[i] = cw[c8 + i]; w1[i] = cw[256 + c8 + i]; w2[i] = cw[512 + c8 + i]; }
#pragma unroll 4
    for (int k = 0; k < 16; ++k) {
        const int rr = (tid >> 5) + 16 * k;
        const size_t row = (size_t)item * 256 + rr; const int t = (int)(row & (SEQ - 1));
        const bf16_t* pr = proj + row * PINP + 1536 + c8;
        const uint4 zz = make_uint4(0u, 0u, 0u, 0u);
        const uint4 bv = *(const uint4*)pr, c2 = *(const uint4*)(pr + 256), h2 = *(const uint4*)(pr + 512);
        const uint4 c1 = t >= 1 ? *(const uint4*)(pr + 256 - PINP) : zz, h1 = t >= 1 ? *(const uint4*)(pr + 512 - PINP) : zz;
        const uint4 c0 = t >= 2 ? *(const uint4*)(pr + 256 - 2 * PINP) : zz, h0 = t >= 2 ? *(const uint4*)(pr + 512 - 2 * PINP) : zz;
        float fb[8], fc2[8], fh2[8], fc1[8], fh1[8], fc0[8], fh0[8], y[8];
        bf8_to_f(bv, fb); bf8_to_f(c2, fc2); bf8_to_f(h2, fh2); bf8_to_f(c1, fc1); bf8_to_f(h1, fh1); bf8_to_f(c0, fc0); bf8_to_f(h0, fh0);
#pragma unroll
        for (int i = 0; i < 8; ++i) y[i] = fb[i] * (w0[i] * (fc0[i] * fh0[i]) + w1[i] * (fc1[i] * fh1[i]) + w2[i] * (fc2[i] * fh2[i]));
        uint2 o; o.x = pk_fp8x4(y[0] * MIX8_SCALE, y[1] * MIX8_SCALE, y[2] * MIX8_SCALE, y[3] * MIX8_SCALE); o.y = pk_fp8x4(y[4] * MIX8_SCALE, y[5] * MIX8_SCALE, y[6] * MIX8_SCALE, y[7] * MIX8_SCALE);
        *(uint2*)(mix + row * DM + 512 + c8) = o;
    }
}

template <int CTRL> __device__ __forceinline__ float dpp_f(float v) { return __int_as_float(__builtin_amdgcn_update_dpp(0, __float_as_int(v), CTRL, 0xf, 0xf, true)); }
__device__ __forceinline__ float red16(float x) { x += dpp_f<0xB1>(x); x += dpp_f<0x4E>(x); x += dpp_f<0x141>(x); x += dpp_f<0x140>(x); return x; }
__device__ __forceinline__ float fsigmoid(float x) { return __builtin_amdgcn_rcpf(1.0f + __builtin_amdgcn_exp2f(-x * LOG2E)); }
__device__ __forceinline__ float ftanh(float x) { return 1.0f - 2.0f * __builtin_amdgcn_rcpf(1.0f + __builtin_amdgcn_exp2f(x * (2.0f * LOG2E))); }
#define MF16(a, b, c) __builtin_amdgcn_mfma_f32_16x16x32_bf16(a, b, c, 0, 0, 0)
__device__ __forceinline__ bf16x8 frag_lo(const f32x4& c) { return mk_frag(pk_bf16(c[0], c[1]), pk_bf16(c[2], c[3]), 0u, 0u); }
__device__ __forceinline__ bf16x8 frag_lo_hi(const f32x4& c, uint2 hi) { return mk_frag(pk_bf16(c[0], c[1]), pk_bf16(c[2], c[3]), hi.x, hi.y); }
__device__ __forceinline__ bf16x8 frag_u2(uint2 lo, uint2 hi) { return mk_frag(lo.x, lo.y, hi.x, hi.y); }
__device__ __forceinline__ f32x4 tt64(const bf16_t* arow, const bf16_t* brow, int g, f32x4 c) {
    c = MF16(*(const bf16x8*)(arow + 8 * g), *(const bf16x8*)(brow + 8 * g), c);
    c = MF16(*(const bf16x8*)(arow + 32 + 8 * g), *(const bf16x8*)(brow + 32 + 8 * g), c);
    return c;
}
#define RW_RS 72
#define RW_TS 20
struct RwPre { uint4 cu[3], pr[3]; };
__device__ __forceinline__ int rw_col(int gq, int h) { return gq < 8 ? h * 64 + gq * 8 : gq < 16 ? 256 + h * 64 + (gq - 8) * 8 : gq < 24 ? 512 + h * 64 + (gq - 16) * 8 : 768 + (gq - 24) * 8; }
__device__ __forceinline__ void rw_prefetch(RwPre& q, const bf16_t* proj, int t0, int h, int tid) {
#pragma unroll
    for (int k = 0; k < 3; ++k) {
        const int i = tid + k * NTHREADS;
        if (i < 1280) {
            const int tt = i / 40, gq = i % 40, t = t0 + tt, col = rw_col(gq, h);
            q.cu[k] = *(const uint4*)(proj + (size_t)t * PINP + col);
            q.pr[k] = (t > 0) ? *(const uint4*)(proj + (size_t)(t - 1) * PINP + col) : make_uint4(0u, 0u, 0u, 0u);
        }
    }
}
__device__ __forceinline__ void rwkv_item(const Params& p, int l, int bh, unsigned char* lds) {
    const int tid = otid(), b = bh >> 2, h = bh & 3;
    const int lane = tid & 63, wv = tid >> 6, n = lane & 15, g = lane >> 4;
    const bf16_t* proj = (const bf16_t*)(p.ws + WS_PROJ) + (size_t)b * SEQ * PINP + 2304;
    unsigned char* mix = p.ws + WS_MIX + (size_t)b * SEQ * DM + 768 + h * 64;
    const float* mu = p.rw_mu + (size_t)l * 896;
    const float* vecs = p.rw_vecs + (size_t)l * 7 * 256 + h * 64;
    bf16_t* WupT = (bf16_t*)lds; bf16_t* AupT = WupT + 64 * 40; bf16_t* GupT = AupT + 64 * 40;
    float* xr = (float*)(GupT + 64 * RW_RS); float* xk = xr + 2048; float* xv = xk + 2048;
    bf16_t* XW = (bf16_t*)(xv + 2048); bf16_t* XA = XW + 32 * 40; bf16_t* XG = XA + 32 * 40;
    float* gg = (float*)(XG + 32 * RW_RS);
    float* yy = gg + 2048;
    float* n2s = yy + 2048; float* pbo = n2s + 512;
    bf16_t* CS = (bf16_t*)(pbo + 128);
#define RW_SET (4 * 16 * RW_RS + 3 * 64 * RW_TS + 4 * 16 * RW_TS + 128)
#define RW_KT(s_) (CS + (s_) * RW_SET)
#define RW_BT(s_) (RW_KT(s_) + 16 * RW_RS)
#define RW_KK(s_) (RW_BT(s_) + 16 * RW_RS)
#define RW_RT(s_) (RW_KK(s_) + 16 * RW_RS)
#define RW_BH(s_) (RW_RT(s_) + 16 * RW_RS)
#define RW_KH(s_) (RW_BH(s_) + 64 * RW_TS)
#define RW_VT(s_) (RW_KH(s_) + 64 * RW_TS)
#define RW_AAK(s_) (RW_VT(s_) + 64 * RW_TS)
#define RW_ARB(s_) (RW_AAK(s_) + 16 * RW_TS)
#define RW_ARK(s_) (RW_ARB(s_) + 16 * RW_TS)
#define RW_TA(s_) (RW_ARK(s_) + 16 * RW_TS)
#define RW_GC(s_) ((float*)(RW_TA(s_) + 16 * RW_TS))
    __syncthreads();
    {
        float wu[4], au[4], gu[8];
#pragma unroll
        for (int k = 0; k < 4; ++k) { const int i = tid + k * NTHREADS, m = i >> 6, c = i & 63; wu[k] = p.rw_w_up[(size_t)l * 32 * 256 + m * 256 + h * 64 + c]; au[k] = p.rw_a_up[(size_t)l * 32 * 256 + m * 256 + h * 64 + c]; }
#pragma unroll
        for (int k = 0; k < 8; ++k) { const int i = tid + k * NTHREADS, m = i >> 6, c = i & 63; gu[k] = p.rw_g_up[(size_t)l * 64 * 256 + m * 256 + h * 64 + c]; }
#pragma unroll
        for (int k = 0; k < 4; ++k) { const int i = tid + k * NTHREADS, m = i >> 6, c = i & 63; WupT[c * 40 + m] = f2bf(wu[k]); AupT[c * 40 + m] = f2bf(au[k]); }
#pragma unroll
        for (int k = 0; k < 8; ++k) { const int i = tid + k * NTHREADS, m = i >> 6, c = i & 63; GupT[c * RW_RS + m] = f2bf(gu[k]); }
    }
    const int ptt = (tid & 255) >> 4, pc = (tid & 15) * 4, pset = tid >> 8;
    const float4 v_lg = *(const float4*)(vecs + 1280 + pc), v_lb = *(const float4*)(vecs + 1536 + pc);
    const int s2mt = wv & 1, s2c = (wv >> 1) * 16 + n;
    const float c_w0 = vecs[s2c], c_a0 = vecs[256 + s2c], c_kk = vecs[512 + s2c], c_ka = vecs[768 + s2c], c_rk = vecs[1024 + s2c];
    const int ib = wv & 3;
    f32x4 T0 = {0.f, 0.f, 0.f, 0.f}, T1 = T0, T2 = T0, T3 = T0;
    RwPre pre;
    rw_prefetch(pre, proj, 0, h, tid);
#pragma unroll 1
    for (int t0 = 0; t0 < SEQ; t0 += 32) {
        const int pb = (t0 >> 5) & 1;
        __syncthreads();
#pragma unroll
        for (int k = 0; k < 3; ++k) {
            const int i = tid + k * NTHREADS;
            if (i < 1280) {
                const int tt = i / 40, gq = i % 40; const int col = rw_col(gq, h);
                const uint4 cu = pre.cu[k], pr = pre.pr[k];
                const float4 m0 = *(const float4*)(mu + col), m1 = *(const float4*)(mu + col + 4);
                float o[8];
                { float c, q;
                  c = __uint_as_float(cu.x << 16); q = __uint_as_float(pr.x << 16); o[0] = c + (q - c) * m0.x;
                  c = __uint_as_float(cu.x & 0xffff0000u); q = __uint_as_float(pr.x & 0xffff0000u); o[1] = c + (q - c) * m0.y;
                  c = __uint_as_float(cu.y << 16); q = __uint_as_float(pr.y << 16); o[2] = c + (q - c) * m0.z;
                  c = __uint_as_float(cu.y & 0xffff0000u); q = __uint_as_float(pr.y & 0xffff0000u); o[3] = c + (q - c) * m0.w;
                  c = __uint_as_float(cu.z << 16); q = __uint_as_float(pr.z << 16); o[4] = c + (q - c) * m1.x;
                  c = __uint_as_float(cu.z & 0xffff0000u); q = __uint_as_float(pr.z & 0xffff0000u); o[5] = c + (q - c) * m1.y;
                  c = __uint_as_float(cu.w << 16); q = __uint_as_float(pr.w << 16); o[6] = c + (q - c) * m1.z;
                  c = __uint_as_float(cu.w & 0xffff0000u); q = __uint_as_float(pr.w & 0xffff0000u); o[7] = c + (q - c) * m1.w; }
                if (gq >= 8 && gq < 16) {
                    const float4 q0 = *(const float4*)(vecs + 512 + (gq - 8) * 8), q1 = *(const float4*)(vecs + 512 + (gq - 8) * 8 + 4);
                    const float a0 = o[0] * q0.x, a1 = o[1] * q0.y, a2 = o[2] * q0.z, a3 = o[3] * q0.w, a4 = o[4] * q1.x, a5 = o[5] * q1.y, a6 = o[6] * q1.z, a7 = o[7] * q1.w;
                    n2s[(pb * 32 + tt) * 8 + (gq - 8)] = ((a0 * a0 + a1 * a1) + (a2 * a2 + a3 * a3)) + ((a4 * a4 + a5 * a5) + (a6 * a6 + a7 * a7));
                }
                if (gq < 24) {
                    float* dst = gq < 8 ? xr + tt * 64 + gq * 8 : gq < 16 ? xk + tt * 64 + (gq - 8) * 8 : xv + tt * 64 + (gq - 16) * 8;
                    *(float4*)dst = make_float4(o[0], o[1], o[2], o[3]); *(float4*)(dst + 4) = make_float4(o[4], o[5], o[6], o[7]);
                } else {
                    if (gq < 28) {
#pragma unroll
                        for (int e = 0; e < 8; ++e) o[e] = ftanh(o[e]);
                    } else if (gq >= 32) {
#pragma unroll
                        for (int e = 0; e < 8; ++e) o[e] = fsigmoid(o[e]);
                    }
                    bf16_t* dst = gq < 28 ? XW + tt * 40 + (gq - 24) * 8 : gq < 32 ? XA + tt * 40 + (gq - 28) * 8 : XG + tt * RW_RS + (gq - 32) * 8;
                    uint4 w; w.x = pk_bf16(o[0], o[1]); w.y = pk_bf16(o[2], o[3]); w.z = pk_bf16(o[4], o[5]); w.w = pk_bf16(o[6], o[7]);
                    *(uint4*)dst = w;
                }
            }
        }
        if (t0 + 32 < SEQ) rw_prefetch(pre, proj, t0 + 32, h, tid);
        __syncthreads();
        {
            const f32x4 z4 = {0.f, 0.f, 0.f, 0.f};
            const int arow = s2mt * 16 + n;
            const f32x4 dec = MF16(*(const bf16x8*)(XW + arow * 40 + 8 * g), *(const bf16x8*)(WupT + s2c * 40 + 8 * g), z4);
            const f32x4 av = MF16(*(const bf16x8*)(XA + arow * 40 + 8 * g), *(const bf16x8*)(AupT + s2c * 40 + 8 * g), z4);
            const f32x4 gt = tt64(XG + arow * RW_RS, GupT + s2c * RW_RS, g, z4);
            const float dk = -0.6065306597126334f * LOG2E;
            float lwv[4], kkn[4], bb[4], kp[4], rv[4], vv[4];
#pragma unroll
            for (int r = 0; r < 4; ++r) {
                const int tt = s2mt * 16 + 4 * g + r, i = tt * 64 + s2c;
                const float a = fsigmoid(av[r] + c_a0);
                const float kraw = xk[i];
                rv[r] = xr[i]; vv[r] = xv[i];
                const float4 na = *(const float4*)(n2s + (pb * 32 + tt) * 8), nb = *(const float4*)(n2s + (pb * 32 + tt) * 8 + 4);
                const float inv = __builtin_amdgcn_rsqf(fmaxf(((na.x + na.y) + (na.z + na.w)) + ((nb.x + nb.y) + (nb.z + nb.w)), 1e-24f));
                kkn[r] = kraw * c_kk * inv; kp[r] = kraw * (1.0f + (a - 1.0f) * c_ka); bb[r] = kkn[r] * a;
                lwv[r] = dk * fsigmoid(dec[r] + c_w0);
                const float bo = red16(rv[r] * kp[r] * c_rk);
                gg[i] = gt[r];
                if (n == 0) pbo[tt * 4 + (wv >> 1)] = bo;
            }
            const float c0 = lwv[0], c1 = c0 + lwv[1], c2 = c1 + lwv[2], c3 = c2 + lwv[3];
            float tot = c3;
            { const float u = __shfl_up(tot, 16); if (g >= 1) tot += u; }
            { const float u = __shfl_up(tot, 32); if (g >= 2) tot += u; }
            const float off = tot - c3;
            const float cumC = __shfl(tot, 48 + n);
            const float cum[4] = {off + c0, off + c1, off + c2, off + c3};
            bf16_t* KT = RW_KT(s2mt); bf16_t* BT = RW_BT(s2mt); bf16_t* KKb = RW_KK(s2mt); bf16_t* RT = RW_RT(s2mt);
            float bh[4], kh[4];
#pragma unroll
            for (int r = 0; r < 4; ++r) {
                const float G = __builtin_amdgcn_exp2f(cum[r]), Gi = __builtin_amdgcn_exp2f(-cum[r]), Gm = __builtin_amdgcn_exp2f(cum[r] - lwv[r]), Gc = __builtin_amdgcn_exp2f(cumC - cum[r]);
                const int ro = (4 * g + r) * RW_RS + s2c;
                { const unsigned w0 = pk_bf16(kkn[r] * Gm, bb[r] * Gi), w1 = pk_bf16(kp[r] * Gi, rv[r] * G); KT[ro] = (bf16_t)w0; BT[ro] = (bf16_t)(w0 >> 16); KKb[ro] = (bf16_t)w1; RT[ro] = (bf16_t)(w1 >> 16); }
                bh[r] = bb[r] * Gc; kh[r] = kp[r] * Gc;
            }
            { uint2 w; w.x = pk_bf16(bh[0], bh[1]); w.y = pk_bf16(bh[2], bh[3]); *(uint2*)(RW_BH(s2mt) + s2c * RW_TS + 4 * g) = w; }
            { uint2 w; w.x = pk_bf16(kh[0], kh[1]); w.y = pk_bf16(kh[2], kh[3]); *(uint2*)(RW_KH(s2mt) + s2c * RW_TS + 4 * g) = w; }
            { uint2 w; w.x = pk_bf16(vv[0], vv[1]); w.y = pk_bf16(vv[2], vv[3]); *(uint2*)(RW_VT(s2mt) + s2c * RW_TS + 4 * g) = w; }
            if (g == 0) RW_GC(s2mt)[s2c] = __builtin_amdgcn_exp2f(cumC);
        }
        __syncthreads();
        {
            const f32x4 z4 = {0.f, 0.f, 0.f, 0.f};
            const int role = wv & 3, cs = wv >> 2;
            const bf16_t* KT = RW_KT(cs); const bf16_t* BT = RW_BT(cs); const bf16_t* KKb = RW_KK(cs); const bf16_t* RT = RW_RT(cs);
            if (role == 0) {
                f32x4 cl = tt64(KT + n * RW_RS, BT + n * RW_RS, g, z4);
                f32x4 clt = tt64(BT + n * RW_RS, KT + n * RW_RS, g, z4);
                f32x4 U;
#pragma unroll
                for (int r = 0; r < 4; ++r) { if (!(4 * g + r > n)) cl[r] = 0.f; if (!(n > 4 * g + r)) clt[r] = 0.f; U[r] = ((4 * g + r == n) ? 1.0f : 0.0f) - clt[r]; }
                const f32x4 m2 = MF16(frag_lo(clt), frag_lo(cl), z4), m2t = MF16(frag_lo(cl), frag_lo(clt), z4);
                U = MF16(frag_lo(m2), frag_lo(U), U);
                const f32x4 m4 = MF16(frag_lo(m2t), frag_lo(m2), z4), m4t = MF16(frag_lo(m2), frag_lo(m2t), z4);
                U = MF16(frag_lo(m4), frag_lo(U), U);
                const f32x4 m8 = MF16(frag_lo(m4t), frag_lo(m4), z4);
                U = MF16(frag_lo(m8), frag_lo(U), U);
                uint2 w; w.x = pk_bf16(U[0], U[1]); w.y = pk_bf16(U[2], U[3]);
                *(uint2*)(RW_TA(cs) + n * RW_TS + 4 * g) = w;
            } else {
                const bf16_t* ar = (role == 2) ? BT : KKb; const bf16_t* br = (role == 1) ? KT : RT; bf16_t* dst = (role == 1) ? RW_AAK(cs) : (role == 2) ? RW_ARB(cs) : RW_ARK(cs);
                f32x4 c = tt64(ar + n * RW_RS, br + n * RW_RS, g, z4);
                const int lim = (role == 1) ? n : n + 1;
#pragma unroll
                for (int r = 0; r < 4; ++r) if (!(4 * g + r < lim)) c[r] = 0.f;
                uint2 w; w.x = pk_bf16(c[0], c[1]); w.y = pk_bf16(c[2], c[3]);
                *(uint2*)(dst + n * RW_TS + 4 * g) = w;
            }
        }
        __syncthreads();
        if (wv < 4) {
            const f32x4 z4 = {0.f, 0.f, 0.f, 0.f};
            const uint2 zz = make_uint2(0u, 0u);
#define RW_JFRAG(base_, m_) frag_u2(*(const uint2*)((base_) + n * RW_RS + 32 * (m_) + 4 * g), *(const uint2*)((base_) + n * RW_RS + 32 * (m_) + 16 + 4 * g))
#define RW_OPS(c_) \
            const bf16x8 kt0##c_ = RW_JFRAG(RW_KT(c_), 0), kt1##c_ = RW_JFRAG(RW_KT(c_), 1), rt0##c_ = RW_JFRAG(RW_RT(c_), 0), rt1##c_ = RW_JFRAG(RW_RT(c_), 1); \
            const uint2 aak##c_ = *(const uint2*)(RW_AAK(c_) + n * RW_TS + 4 * g), vt##c_ = *(const uint2*)(RW_VT(c_) + (ib * 16 + n) * RW_TS + 4 * g), ta##c_ = *(const uint2*)(RW_TA(c_) + n * RW_TS + 4 * g); \
            const uint2 arb##c_ = *(const uint2*)(RW_ARB(c_) + n * RW_TS + 4 * g), ark##c_ = *(const uint2*)(RW_ARK(c_) + n * RW_TS + 4 * g); \
            const bf16x8 hk0##c_ = frag_u2(*(const uint2*)(RW_BH(c_) + n * RW_TS + 4 * g), *(const uint2*)(RW_KH(c_) + n * RW_TS + 4 * g)); \
            const bf16x8 hk1##c_ = frag_u2(*(const uint2*)(RW_BH(c_) + (16 + n) * RW_TS + 4 * g), *(const uint2*)(RW_KH(c_) + (16 + n) * RW_TS + 4 * g)); \
            const bf16x8 hk2##c_ = frag_u2(*(const uint2*)(RW_BH(c_) + (32 + n) * RW_TS + 4 * g), *(const uint2*)(RW_KH(c_) + (32 + n) * RW_TS + 4 * g)); \
            const bf16x8 hk3##c_ = frag_u2(*(const uint2*)(RW_BH(c_) + (48 + n) * RW_TS + 4 * g), *(const uint2*)(RW_KH(c_) + (48 + n) * RW_TS + 4 * g)); \
            const f32x4 gc0##c_ = *(const f32x4*)(RW_GC(c_) + 4 * g), gc1##c_ = *(const f32x4*)(RW_GC(c_) + 16 + 4 * g), gc2##c_ = *(const f32x4*)(RW_GC(c_) + 32 + 4 * g), gc3##c_ = *(const f32x4*)(RW_GC(c_) + 48 + 4 * g);
#define RW_CHAIN(c_) { \
            const bf16x8 sb0 = mk_frag(pk_bf16(T0[0], T0[1]), pk_bf16(T0[2], T0[3]), pk_bf16(T1[0], T1[1]), pk_bf16(T1[2], T1[3]));     \
            const bf16x8 sb1 = mk_frag(pk_bf16(T2[0], T2[1]), pk_bf16(T2[2], T2[3]), pk_bf16(T3[0], T3[1]), pk_bf16(T3[2], T3[3]));     \
            f32x4 q = MF16(kt0##c_, sb0, z4); q = MF16(kt1##c_, sb1, q);                        \
            f32x4 y = MF16(rt0##c_, sb0, z4); y = MF16(rt1##c_, sb1, y);                        \
            T0 = T0 * gc0##c_; T1 = T1 * gc1##c_; T2 = T2 * gc2##c_; T3 = T3 * gc3##c_;        \
            q = MF16(frag_u2(aak##c_, zz), frag_u2(vt##c_, zz), q);                            \
            f32x4 sa = MF16(frag_u2(ta##c_, zz), frag_lo(q), z4); sa = -sa;                    \
            const bf16x8 a3 = frag_lo_hi(sa, vt##c_);                                          \
            T0 = MF16(hk0##c_, a3, T0); T1 = MF16(hk1##c_, a3, T1); T2 = MF16(hk2##c_, a3, T2); T3 = MF16(hk3##c_, a3, T3);     \
            y = MF16(frag_u2(arb##c_, ark##c_), a3, y); \
            _Pragma("unroll") for (int r = 0; r < 4; ++r) yy[(c_) * 1024 + (4 * g + r) * 64 + ib * 16 + n] = y[r]; }
            { RW_OPS(0) RW_CHAIN(0) }
            { RW_OPS(1) RW_CHAIN(1) }
#undef RW_JFRAG
#undef RW_OPS
#undef RW_CHAIN
        }
        __syncthreads();
        {
            const int tok = pset * 16 + ptt, i = tok * 64 + pc;
            const float4 yv = *(const float4*)(yy + pset * 1024 + ptt * 64 + pc), vv = *(const float4*)(xv + i), gv = *(const float4*)(gg + i), b4 = *(const float4*)(pbo + tok * 4);
            const float mean = red16((yv.x + yv.y) + (yv.z + yv.w)) * (1.0f / 64.0f);
            const float4 d = make_float4(yv.x - mean, yv.y - mean, yv.z - mean, yv.w - mean);
            const float var = red16((d.x * d.x + d.y * d.y) + (d.z * d.z + d.w * d.w)) * (1.0f / 64.0f);
            const float rs = rsqrtf(var + 64e-5f), bo = (b4.x + b4.y) + (b4.z + b4.w);
            *(unsigned*)(mix + (size_t)(t0 + tok) * DM + pc) = pk_fp8x4((d.x * rs * v_lg.x + v_lb.x + bo * vv.x) * gv.x * MIX8_SCALE, (d.y * rs * v_lg.y + v_lb.y + bo * vv.y) * gv.y * MIX8_SCALE,
                                                                         (d.z * rs * v_lg.z + v_lb.z + bo * vv.z) * gv.z * MIX8_SCALE, (d.w * rs * v_lg.w + v_lb.w + bo * vv.w) * gv.w * MIX8_SCALE);
        }
    }
}

__device__ __forceinline__ void phase_mixers(const Params& p, int l, unsigned char* lds) {
    unsigned* ctl = (unsigned*)(p.ws + WS_CTL);
    int* slot = (int*)(lds + LDS_BYTES - 64);
#ifndef NO_RW
    for (int it = obid(); it < 128; it += gridDim.x) rwkv_item(p, l, it, lds);
#endif
    if (otid() == 0) *slot = (int)atomicAdd(&ctl[CW_QUEUE + l * 64], 1u);
    for (;;) {
        __syncthreads();
        const int it = *slot;
        __syncthreads();
        if (it >= 1024 + 512 + 256) break;
        if (it < 1024) {
            int nxt = 0;
            if (otid() == 0) nxt = (int)atomicAdd(&ctl[CW_QUEUE + l * 64], 1u);
#ifndef NO_DA
            dam_item(p, l, it & 127, 7 - (it >> 7), lds, slot, nxt);
#endif
        } else {
            if (it < 1536) {
#ifndef NO_SB
                const int j = it - 1024;
#pragma unroll 1
                for (int k = 0; k < 2; ++k) sbm_item(p, j & 127, 7 - 2 * (j >> 7) - k, lds);
#endif
            } else conv_item(p, l, it - 1536);
            if (otid() == 0) *slot = (int)atomicAdd(&ctl[CW_QUEUE + l * 64], 1u);
        }
    }
}

__global__ void __launch_bounds__(NTHREADS, 2) fwd(Params p) {
    extern __shared__ __attribute__((aligned(16))) unsigned char lds_raw[];
    if (threadIdx.x == 0) { ((unsigned*)lds_raw)[0] = 0u; ((unsigned*)lds_raw)[1] = 0u; ((unsigned*)lds_raw)[2] = 0u; ((unsigned*)lds_raw)[3] = 0u; }
    __syncthreads();
    unsigned char* lds = lds_raw + 16;
    XcdBarrier bar = xcd_barrier_post((unsigned*)(p.ws + WS_CTL) + CW_BAR, (volatile LAS unsigned*)lds_raw);
#ifndef ONLY
#define ONLY -1
#endif
#define PH(k) (ONLY < 0 || ONLY == (k))
    if (PH(0)) prologue(p, lds);
    xcd_barrier(bar);
    for (int l = 0; l < NLAYER; ++l) {
        if (PH(1)) phase_inproj(p, l, lds);
        xcd_barrier(bar);
        if (PH(2)) phase_mixers(p, l, lds);
        xcd_barrier(bar);
        if (PH(3)) phase_outproj(p, l, lds);
        xcd_barrier(bar);
        if (PH(4)) phase_ln1_route(p, l, lds);
        xcd_barrier(bar);
        if (PH(5)) phase_moe_up(p, l, lds);
        xcd_barrier(bar);
        if (PH(6)) phase_moe_down(p, l, lds);
        xcd_barrier(bar);
        if (PH(7)) phase_ln2(p, l, lds);
        xcd_barrier(bar);
    }
}

extern "C" void kernel_launch(void* const* d_in, const int* in_sizes, int n_in, void* d_out, int out_size, void* d_ws, size_t ws_size, hipStream_t stream) {
    static int grid = 0;
    if (grid == 0) {
        if (n_in != 18 || in_sizes[0] != NTOK * DM || out_size != NTOK * DM || ws_size < WS_END) {
            fprintf(stderr, "kernel_launch: unexpected shapes: n_in %d in0 %d out %d ws %zu (need %llu)\n", n_in, n_in > 0 ? in_sizes[0] : -1, out_size, ws_size, (unsigned long long)WS_END);
            grid = -1; return;
        }
        int dev = 0, cus = 0, per_cu = 0;
        hipGetDevice(&dev);
        hipDeviceGetAttribute(&cus, hipDeviceAttributeMultiprocessorCount, dev);
        hipFuncSetAttribute((const void*)fwd, hipFuncAttributeMaxDynamicSharedMemorySize, LDS_BYTES);
        hipOccupancyMaxActiveBlocksPerMultiprocessor(&per_cu, (const void*)fwd, NTHREADS, LDS_BYTES);
        if (per_cu < 1) { fprintf(stderr, "kernel_launch: occupancy query says %d blocks per CU\n", per_cu); grid = -1; return; }
        grid = cus;
    }
    if (grid < 0) return;
    Params p{};
    p.x = (const float*)d_in[0]; p.w_in = (const float*)d_in[1]; p.w_out = (const float*)d_in[2]; p.da_lambda = (const float*)d_in[3]; p.da_subln = (const float*)d_in[4];
    p.sc_conv = (const float*)d_in[5]; p.rw_mu = (const float*)d_in[6]; p.rw_vecs = (const float*)d_in[7]; p.rw_w_up = (const float*)d_in[8]; p.rw_a_up = (const float*)d_in[9];
    p.rw_g_up = (const float*)d_in[10]; p.ln_gain = (const float*)d_in[11]; p.ln_bias = (const float*)d_in[12]; p.rel_bias = (const float*)d_in[13]; p.router_w = (const float*)d_in[14];
    p.router_b = (const float*)d_in[15]; p.moe_w_in = (const float*)d_in[16]; p.moe_w_down = (const float*)d_in[17];
    p.out = (float*)d_out; p.ws = (unsigned char*)d_ws;
    hipMemsetAsync((char*)d_ws + WS_CTL, 0, CTL_BYTES, stream);
    hipLaunchKernelGGL(fwd, dim3(grid), dim3(NTHREADS), LDS_BYTES, stream, p);
}
```
